# Optimizing an MI355X kernel written in HIP

```python
import jax
import jax.numpy as jnp
from jax import lax
import numpy as np

D_MODEL = 4096
BATCH = 2
SEQ = 4096
DEPTH = 2

CTX_LEN = 256
GRID_W = 64
N_SUB = 3
FFN_DIM = 5632
FFN_RES = 0.5
GM_GROUPS = 8
GM_GROUP_CH = 128
GM_CHUNK = 128
GM_WIDTH = GM_GROUPS * GM_GROUP_CH
DN_HEADS = 8
DN_DK = 128
DN_DV = 128
DN_WIDTH = DN_HEADS * DN_DV
DN_CHUNK = 64
CONV_K = 5
NA_HEADS = 16
NA_DH = 128
NA_WIDTH = NA_HEADS * NA_DH
NA_KH_MAX = 8
NA_KW = 16
ROPE_BASE = 10000.0
EPS = 1e-6
NEG = -1e30
IN_SPLITS = (2 * DN_WIDTH, 2 * DN_HEADS, 2 * DN_HEADS, NA_WIDTH, NA_WIDTH,
             DN_WIDTH, NA_WIDTH, DN_WIDTH, GM_WIDTH, GM_WIDTH, D_MODEL, D_MODEL, D_MODEL)
N_CTX_STATE_SPLITS = 5
N_CTX_STATE_COLS = sum(IN_SPLITS[:N_CTX_STATE_SPLITS])
IN_WIDTH = sum(IN_SPLITS)

kernel_name = 'hybrid_gmlp_deltanet_natten_dit_block'


def rmsnorm(x, w):
    xf = x.astype(jnp.float32)
    y = xf * lax.rsqrt(jnp.mean(xf * xf, axis=-1, keepdims=True) + EPS)
    return (y * w.astype(jnp.float32)).astype(x.dtype)


def layernorm(x, w):
    xf = x.astype(jnp.float32)
    mu = jnp.mean(xf, axis=-1, keepdims=True)
    var = jnp.mean(jnp.square(xf - mu), axis=-1, keepdims=True)
    return ((xf - mu) * lax.rsqrt(var + EPS) * w.astype(jnp.float32)).astype(x.dtype)


def l2norm(x):
    xf = x.astype(jnp.float32)
    return xf * lax.rsqrt(jnp.sum(xf * xf, axis=-1, keepdims=True) + EPS)


def adaln(h, norm_w, mod, i):
    return rmsnorm(h, norm_w) * (1 + mod[..., i, 1, :]) + mod[..., i, 0, :]


def swiglu(x, w1, w3, w2):
    return (jax.nn.silu(x @ w1) * (x @ w3)) @ w2


def ffn_sublayer(h, mod, i, norm_w, w1, w3, w2):
    return h + FFN_RES * mod[..., i, 2, :] * swiglu(adaln(h, norm_w, mod, i), w1, w3, w2)


def split_cols(z, sizes):
    offs = np.cumsum(np.array(sizes))[:-1].tolist()
    return jnp.split(z, offs, axis=-1)


def axial_rope(x, rows, cols):
    half = x.shape[-1] // 2
    nf = half // 2
    freqs = ROPE_BASE ** (-jnp.arange(nf, dtype=jnp.float32) / nf)

    def rot(xp, pos):
        ang = pos.astype(jnp.float32)[:, None] * freqs[None, :]
        cos = jnp.cos(ang)[None, :, None, :]
        sin = jnp.sin(ang)[None, :, None, :]
        x1, x2 = xp[..., :nf], xp[..., nf:]
        return jnp.concatenate([x1 * cos - x2 * sin, x2 * cos + x1 * sin], axis=-1)

    return jnp.concatenate([rot(x[..., :half], rows), rot(x[..., half:], cols)], axis=-1).astype(x.dtype)


def short_conv(x, w):
    c = x.shape[-1]
    y = lax.conv_general_dilated(x, w[:, None, :].astype(x.dtype), window_strides=(1,),
                                 padding=[(CONV_K // 2, CONV_K // 2)],
                                 dimension_numbers=('NWC', 'WIO', 'NWC'), feature_group_count=c)
    return jax.nn.silu(y)


def chunk_gated_delta(q, k, v, g, beta, s0):
    b, t, h, _ = k.shape
    n = t // DN_CHUNK
    cv = lambda u: u.reshape(b, n, DN_CHUNK, h, u.shape[-1]).transpose(1, 0, 3, 2, 4)
    cs = lambda u: u.reshape(b, n, DN_CHUNK, h).transpose(1, 0, 3, 2)
    k, v = cv(k), cv(v)
    gc = jnp.cumsum(cs(g), axis=-1)
    bt = cs(beta)[..., None]
    idx = jnp.arange(DN_CHUNK)
    incl = idx[:, None] >= idx[None, :]
    strict = idx[:, None] > idx[None, :]
    diff = gc[..., :, None] - gc[..., None, :]
    decay = jnp.where(incl, jnp.exp(jnp.where(incl, diff, 0.0)), 0.0)
    k_beta = k * bt
    a = jnp.where(strict, jnp.einsum('nbhid,nbhjd->nbhij', k_beta, k) * decay, 0.0) + jnp.eye(DN_CHUNK, dtype=k.dtype)
    rhs = jnp.concatenate([v * bt, k_beta * jnp.exp(gc)[..., None]], axis=-1)
    sol = lax.linalg.triangular_solve(a, rhs, left_side=True, lower=True, unit_diagonal=True)
    u_val, w_cum = sol[..., :DN_DV], sol[..., DN_DV:]
    with_out = q is not None
    xs = (k, u_val, w_cum, gc)
    if with_out:
        q = cv(q)
        qk = jnp.where(incl, jnp.einsum('nbhid,nbhjd->nbhij', q, k) * decay, 0.0)
        xs = xs + (q, qk)

    def step(s, xs_i):
        k_i, u_i, w_i, g_i = xs_i[:4]
        v_new = u_i - jnp.einsum('bhck,bhkv->bhcv', w_i, s)
        g_last = g_i[..., -1:]
        s_next = s * jnp.exp(g_last)[..., None] + jnp.einsum(
            'bhck,bhcv->bhkv', k_i * jnp.exp(g_last - g_i)[..., None], v_new)
        if not with_out:
            return s_next, None
        q_i, qk_i = xs_i[4:]
        o = (jnp.einsum('bhck,bhkv->bhcv', q_i * jnp.exp(g_i)[..., None], s)
             + jnp.einsum('bhij,bhjv->bhiv', qk_i, v_new))
        return s_next, o

    s_fin, o = lax.scan(step, s0, xs)
    if with_out:
        o = o.transpose(1, 0, 3, 2, 4).reshape(b, t, h, DN_DV)
    return o, s_fin


def dn_prep(z_kv, z_alpha, z_beta, z_q, conv_w, a_log, dt_bias, pos):
    b, t = z_kv.shape[:2]
    hk = lambda u: u.reshape(b, t, DN_HEADS, DN_DK)
    hv = lambda u: u.reshape(b, t, DN_HEADS, DN_DV)
    k, v = jnp.split(short_conv(z_kv, conv_w[:, :2 * DN_WIDTH]), 2, axis=-1)
    k = l2norm(hk(k))
    v = hv(v).astype(jnp.float32)
    q = None
    if z_q is not None:
        q = l2norm(hk(short_conv(z_q, conv_w[:, 2 * DN_WIDTH:])))
    if pos is not None:
        k = axial_rope(k, *pos)
        q = axial_rope(q, *pos)
    if q is not None:
        q = q * DN_DK ** -0.5
    alpha = z_alpha.astype(jnp.float32).reshape(b, t, 2, DN_HEADS)
    g = -jnp.exp(a_log.astype(jnp.float32)) * jax.nn.softplus(alpha + dt_bias.astype(jnp.float32))
    beta = jax.nn.sigmoid(z_beta.astype(jnp.float32).reshape(b, t, 2, DN_HEADS))
    return q, k, v, g, beta


def dn_bidir(q, k, v, g, beta, s0_f, s0_b):
    rev = lambda u: None if u is None else jnp.flip(u, axis=1)
    o_f, s_f = chunk_gated_delta(q, k, v, g[:, :, 0], beta[:, :, 0], s0_f)
    o_b, s_b = chunk_gated_delta(rev(q), rev(k), rev(v), rev(g[:, :, 1]), rev(beta[:, :, 1]), s0_b)
    o = None if q is None else o_f + rev(o_b)
    return o, s_f, s_b


def dn_out(o, z_gate, w):
    b, t = z_gate.shape[:2]
    y = rmsnorm(o, w).reshape(b, t, DN_WIDTH)
    return (y * jax.nn.silu(z_gate.astype(jnp.float32))).astype(z_gate.dtype)


def gmlp_mix(z_u, z_v, sgu_w, sgu_b, sgu_norm_w):
    b, t, _ = z_u.shape
    u = jax.nn.gelu(z_u)
    v = layernorm(jax.nn.gelu(z_v), sgu_norm_w)
    vc = v.reshape(b, t // GM_CHUNK, GM_CHUNK, GM_GROUPS, GM_GROUP_CH)
    s = jnp.einsum('gpq,bnqgc->bnpgc', sgu_w.astype(v.dtype), vc) + sgu_b.T[None, None, :, :, None]
    return u * s.reshape(b, t, GM_WIDTH)


def na_attend(q, k, v, k_ctx, v_ctx, rpb):
    b, s, h, dh = q.shape
    rows = s // GRID_W
    kh = min(NA_KH_MAX, rows)
    qg = q.reshape(b, rows, GRID_W, h, dh)
    kg = k.reshape(b, rows, GRID_W, h, dh)
    vg = v.reshape(b, rows, GRID_W, h, dh)
    cols = jnp.arange(GRID_W)
    col_start = jnp.clip(cols - NA_KW // 2, 0, GRID_W - NA_KW)
    col_ok = (cols[None, :] >= col_start[:, None]) & (cols[None, :] < col_start[:, None] + NA_KW)
    dc_idx = jnp.clip(cols[None, :] - cols[:, None] + NA_KW - 1, 0, 2 * NA_KW - 2)
    rpb = rpb.astype(jnp.float32)
    scale = dh ** -0.5

    def row_block(r):
        r0 = jnp.clip(r - kh // 2, 0, rows - kh)
        q_r = lax.dynamic_index_in_dim(qg, r, axis=1, keepdims=False)
        k_r = lax.dynamic_slice_in_dim(kg, r0, kh, axis=1)
        v_r = lax.dynamic_slice_in_dim(vg, r0, kh, axis=1)
        dr_idx = r0 + jnp.arange(kh) - r + NA_KH_MAX - 1
        bias = rpb[:, dr_idx[:, None, None], dc_idx[None, :, :]].transpose(0, 2, 1, 3)
        bias = jnp.where(col_ok[None, :, None, :], bias, NEG)
        s_loc = jnp.einsum('bqhd,bkwhd->bhqkw', q_r, k_r).astype(jnp.float32) * scale + bias[None]
        s_ctx = jnp.einsum('bqhd,bchd->bhqc', q_r, k_ctx).astype(jnp.float32) * scale
        n_loc = kh * GRID_W
        p = jax.nn.softmax(jnp.concatenate([s_loc.reshape(b, h, GRID_W, n_loc), s_ctx], axis=-1), axis=-1)
        p = p.astype(v.dtype)
        p_loc = p[..., :n_loc].reshape(b, h, GRID_W, kh, GRID_W)
        return (jnp.einsum('bhqkw,bkwhd->bqhd', p_loc, v_r)
                + jnp.einsum('bhqc,bchd->bqhd', p[..., n_loc:], v_ctx))

    o = lax.map(row_block, jnp.arange(rows))
    return o.transpose(1, 0, 2, 3, 4).reshape(b, s, h * dh)


def ctx_attend(q, k, v):
    b, l, h, dh = q.shape
    s = jnp.einsum('bqhd,bkhd->bhqk', q, k).astype(jnp.float32) * dh ** -0.5
    p = jax.nn.softmax(s, axis=-1).astype(v.dtype)
    return jnp.einsum('bhqk,bkhd->bqhd', p, v).reshape(b, l, h * dh)


def merge(y_a, y_b, y_c, g_a, g_b, g_c, proj_a, proj_b, proj_c, w_out):
    y = (jax.nn.sigmoid(g_a) * (y_a @ proj_a) + jax.nn.sigmoid(g_b) * (y_b @ proj_b)
         + jax.nn.sigmoid(g_c) * (y_c @ proj_c))
    return y @ w_out


def mixer(h, hc, w_in, conv_w, a_log, dt_bias, dn_norm_w, sgu_w, sgu_b, sgu_norm_w, rpb,
          proj_a, proj_b, proj_c, w_out, ctx_out):
    b, s, _ = h.shape
    z = split_cols(h @ w_in, IN_SPLITS)
    if ctx_out:
        zc = split_cols(hc @ w_in, IN_SPLITS)
    else:
        zc = split_cols(hc @ w_in[:, :N_CTX_STATE_COLS], IN_SPLITS[:N_CTX_STATE_SPLITS])
    t = jnp.arange(s)
    pos = (t // GRID_W, t % GRID_W)
    qc, kc, vc, gc, bc = dn_prep(zc[0], zc[1], zc[2], zc[5] if ctx_out else None, conv_w, a_log, dt_bias, None)
    s0 = jnp.zeros((b, DN_HEADS, DN_DK, DN_DV), jnp.float32)
    oc_dn, s_f, s_b = dn_bidir(qc, kc, vc, gc, bc, s0, s0)
    ql, kl, vl, gl, bl = dn_prep(z[0], z[1], z[2], z[5], conv_w, a_log, dt_bias, pos)
    o_dn, _, _ = dn_bidir(ql, kl, vl, gl, bl, s_f, s_b)
    y_b = dn_out(o_dn, z[7], dn_norm_w)
    heads = lambda u: u.reshape(u.shape[0], u.shape[1], NA_HEADS, NA_DH)
    k_ctx, v_ctx = heads(zc[3]), heads(zc[4])
    y_c = na_attend(heads(z[6]), heads(z[3]), heads(z[4]), k_ctx, v_ctx, rpb)
    y_a = gmlp_mix(z[8], z[9], sgu_w, sgu_b, sgu_norm_w)
    y = merge(y_a, y_b, y_c, z[10], z[11], z[12], proj_a, proj_b, proj_c, w_out)
    if not ctx_out:
        return y, None
    yc = merge(gmlp_mix(zc[8], zc[9], sgu_w, sgu_b, sgu_norm_w), dn_out(oc_dn, zc[7], dn_norm_w),
               ctx_attend(heads(zc[6]), k_ctx, v_ctx), zc[10], zc[11], zc[12], proj_a, proj_b, proj_c, w_out)
    return y, yc


def setup_inputs(seed: int = 0) -> dict:
    key = jax.random.key(seed)
    ks = jax.random.split(key, 24)
    f32 = jnp.float32
    nrm = lambda k, shape, sc: jax.random.normal(k, shape, f32) * sc
    L, D = DEPTH, D_MODEL
    dt = jnp.exp(jax.random.uniform(ks[13], (L, 2, DN_HEADS), f32, np.log(1e-3), np.log(1e-1)))
    return {
        'x': nrm(ks[0], (BATCH, SEQ, D), 1.0),
        'c': nrm(ks[1], (BATCH, D), 1.0),
        'ctx': nrm(ks[2], (BATCH, CTX_LEN, D), 1.0),
        'c_ctx': nrm(ks[3], (D,), 1.0),
        'ada_w': nrm(ks[4], (L, D, N_SUB * 3 * D), 0.5 * D ** -0.5),
        'ada_b': nrm(ks[5], (L, N_SUB * 3 * D), 0.02),
        'norm_w': 1.0 + nrm(ks[6], (L, N_SUB, D), 0.02),
        'ffn_w1': nrm(ks[7], (L, 2, D, FFN_DIM), D ** -0.5),
        'ffn_w3': nrm(ks[8], (L, 2, D, FFN_DIM), D ** -0.5),
        'ffn_w2': nrm(ks[9], (L, 2, FFN_DIM, D), FFN_DIM ** -0.5),
        'w_in': nrm(ks[10], (L, D, IN_WIDTH), D ** -0.5),
        'conv_w': nrm(ks[11], (L, CONV_K, 3 * DN_WIDTH), CONV_K ** -0.5),
        'dn_a_log': jnp.log(jax.random.uniform(ks[12], (L, 2, DN_HEADS), f32, 1.0, 16.0)),
        'dn_dt_bias': dt + jnp.log(-jnp.expm1(-dt)),
        'dn_norm_w': 1.0 + nrm(ks[14], (L, DN_DV), 0.02),
        'sgu_w': nrm(ks[15], (L, GM_GROUPS, GM_CHUNK, GM_CHUNK), GM_CHUNK ** -0.5),
        'sgu_b': 1.0 + nrm(ks[16], (L, GM_GROUPS, GM_CHUNK), 0.02),
        'sgu_norm_w': 1.0 + nrm(ks[17], (L, GM_WIDTH), 0.02),
        'na_rpb': nrm(ks[18], (L, NA_HEADS, 2 * NA_KH_MAX - 1, 2 * NA_KW - 1), 0.1),
        'proj_a': nrm(ks[19], (L, GM_WIDTH, D), GM_WIDTH ** -0.5),
        'proj_b': nrm(ks[20], (L, DN_WIDTH, D), DN_WIDTH ** -0.5),
        'proj_c': nrm(ks[21], (L, NA_WIDTH, D), NA_WIDTH ** -0.5),
        'w_out': nrm(ks[22], (L, D, D), D ** -0.5),
        'final_norm_w': 1.0 + nrm(ks[23], (D,), 0.02),
    }


def reference(x, c, ctx, c_ctx, ada_w, ada_b, norm_w, ffn_w1, ffn_w3, ffn_w2, w_in, conv_w, dn_a_log,
              dn_dt_bias, dn_norm_w, sgu_w, sgu_b, sgu_norm_w, na_rpb, proj_a, proj_b, proj_c, w_out,
              final_norm_w):
    b = x.shape[0]
    h, hc = x, ctx
    for l in range(DEPTH):
        last = l == DEPTH - 1
        m = (jax.nn.silu(c) @ ada_w[l] + ada_b[l]).reshape(b, 1, N_SUB, 3, D_MODEL)
        mc = (jax.nn.silu(c_ctx) @ ada_w[l] + ada_b[l]).reshape(N_SUB, 3, D_MODEL)
        h = ffn_sublayer(h, m, 0, norm_w[l, 0], ffn_w1[l, 0], ffn_w3[l, 0], ffn_w2[l, 0])
        hc = ffn_sublayer(hc, mc, 0, norm_w[l, 0], ffn_w1[l, 0], ffn_w3[l, 0], ffn_w2[l, 0])
        y, yc = mixer(adaln(h, norm_w[l, 1], m, 1), adaln(hc, norm_w[l, 1], mc, 1), w_in[l], conv_w[l],
                      dn_a_log[l], dn_dt_bias[l], dn_norm_w[l], sgu_w[l], sgu_b[l], sgu_norm_w[l], na_rpb[l],
                      proj_a[l], proj_b[l], proj_c[l], w_out[l], not last)
        h = h + m[..., 1, 2, :] * y
        h = ffn_sublayer(h, m, 2, norm_w[l, 2], ffn_w1[l, 1], ffn_w3[l, 1], ffn_w2[l, 1])
        if not last:
            hc = hc + mc[1, 2] * yc
            hc = ffn_sublayer(hc, mc, 2, norm_w[l, 2], ffn_w1[l, 1], ffn_w3[l, 1], ffn_w2[l, 1])
    return rmsnorm(h, final_norm_w)
```

```cpp
#include <hip/hip_runtime.h>
#include <cstdio>
#include <cstdint>

namespace pg8 {
#define PG8_LAS __attribute__((address_space(3)))
typedef unsigned short bf16_t;
typedef short bf16x8 __attribute__((ext_vector_type(8)));
typedef float f32x4 __attribute__((ext_vector_type(4)));
typedef unsigned u32x4 __attribute__((ext_vector_type(4)));
constexpr int BM = 256, BK = 64, HALF = 128, HTB = HALF * BK * 2  , STAGE_BYTES = 8 * HTB, NXCD = 8, WGM = 8;

__host__ __device__ __forceinline__ int lds_byte(int r, int c) { const int st = (r >> 4) * 2 + (c >> 5), rr = r & 15, cc = c & 31, ob = rr * 64 + cc * 2; return st * 1024 + (ob ^ (((ob >> 9) & 1) << 5)); }
__host__ __device__ __forceinline__ void stage_rc(int b, int& R, int& C) { const int st = b / 1024, sb = b % 1024, swz = sb ^ (((sb >> 9) & 1) << 5); R = (st >> 1) * 16 + swz / 64; C = (st & 1) * 32 + (swz % 64) / 2; }
__host__ __device__ __forceinline__ int perm32(int rho) { const int n = rho >> 4, i = rho & 15; return 8 * (i >> 2) + 4 * n + (i & 3); }

struct Unit { int pm, pn, kt0, nt, ks; };
struct Gemm { const bf16_t* A; const bf16_t* Bt; int M, N, K, lda, ldb; };

struct StaticOrder {
    int nM, nN, nwg, G, c;
    __host__ __device__ void init(int M, int N, int G_, int c_) { nM = M / BM; nN = N / BM; nwg = nM * nN; G = G_; c = c_; }
    __host__ __device__ bool next(int i, Unit& u) const {
        const long L = (long)i * G + c; if (L >= nwg) return false;
        int wgid = (int)L; { const int q = nwg / NXCD, r = nwg % NXCD, xcd = wgid % NXCD, off = wgid / NXCD; wgid = (xcd < r ? xcd * (q + 1) : r * (q + 1) + (xcd - r) * q) + off; }
        const int nig = WGM * nN, gid = wgid / nig, fm = gid * WGM, gsz = (nM - fm) < WGM ? (nM - fm) : WGM;
        u.pm = fm + ((wgid % nig) % gsz); u.pn = (wgid % nig) / gsz; u.kt0 = 0; u.nt = 0; u.ks = -1; return true;
    }
    __device__ __forceinline__ void a_ready(const Unit&) const {}
    __device__ __forceinline__ void done(const Unit&) const {}
};

struct SubOrder {
    int G, c, kmode;
    __device__ __forceinline__ bool next(int i, Unit& u) const {
        const int idx = i * G + c; if (idx >= 256) return false;
        const int tile = idx >> 3, ks = idx & 7; u.pm = 32 + (tile >> 4); u.pn = tile & 15; u.ks = ks;
        if (kmode == 0) { u.kt0 = 8 * ks; u.nt = 8; } else { u.kt0 = ks < 4 ? 12 * ks : 48 + 10 * (ks - 4); u.nt = ks < 4 ? 12 : 10; }
        return true;
    }
    __device__ __forceinline__ void a_ready(const Unit&) const {}
    __device__ __forceinline__ void done(const Unit&) const {}
};

struct CombOrder {
    StaticOrder main; SubOrder sub; int nfirst; bool sub_first;
    __device__ __forceinline__ void init(int M, int N, int G, int c, int kmode, bool has_sub, bool sf) {
        main.init(M, N, G, c); sub = SubOrder{G, c, kmode}; sub_first = sf;
        const int my_main = c < main.nwg ? (main.nwg - c + G - 1) / G : 0, my_sub = (has_sub && c < 256) ? (256 - c + G - 1) / G : 0;
        nfirst = sf ? my_sub : (has_sub ? my_main : (1 << 30));
    }
    __device__ __forceinline__ bool next(int i, Unit& u) const {
        const bool in_first = i < nfirst, use_sub = (sub_first == in_first);
        const int j = in_first ? i : i - nfirst, G = main.G, c = main.c;
        const int idx = j * G + c, idc = idx < 255 ? idx : 255, tile = idc >> 3, ks = idc & 7;
        const int kt0s = sub.kmode == 0 ? 8 * ks : (ks < 4 ? 12 * ks : 48 + 10 * (ks - 4)), nts = sub.kmode == 0 ? 8 : (ks < 4 ? 12 : 10);
        int wgid = idx < main.nwg - 1 ? idx : main.nwg - 1;
        { const int q = main.nwg / NXCD, r = main.nwg % NXCD, xcd = wgid % NXCD, off = wgid / NXCD; wgid = (xcd < r ? xcd * (q + 1) : r * (q + 1) + (xcd - r) * q) + off; }
        const int nig = WGM * main.nN, gid = wgid / nig, fm = gid * WGM, gsz = (main.nM - fm) < WGM ? (main.nM - fm) : WGM;
        const int pmm = fm + ((wgid % nig) % gsz), pnm = (wgid % nig) / gsz;
        u.pm = use_sub ? 32 + (tile >> 4) : pmm; u.pn = use_sub ? (tile & 15) : pnm; u.kt0 = use_sub ? kt0s : 0; u.nt = use_sub ? nts : 0; u.ks = use_sub ? ks : -1;
        return use_sub ? idx < 256 : idx < main.nwg;
    }
    __device__ __forceinline__ void a_ready(const Unit&) const {}
    __device__ __forceinline__ void done(const Unit&) const {}
};

struct SplitOrder {
    int nM, nN, nwg, G, c, nfull, hk; bool split;
    __device__ __forceinline__ void init(int M, int N, int K, int G_, int c_, bool want) { nM = M / BM; nN = N / BM; nwg = nM * nN; G = G_; c = c_; nfull = nwg / G; hk = K / BK / 2;
        split = want && (nwg - nfull * G) * 2 == G && (hk & 1) == 0; }
    __device__ __forceinline__ bool next(int i, Unit& u) const {
        const bool half = split && i >= nfull;
        const int L = half ? nfull * G + (c >> 1) : i * G + c;
        int wgid = L < nwg - 1 ? L : nwg - 1;
        { const int q = nwg / NXCD, r = nwg % NXCD, xcd = wgid % NXCD, off = wgid / NXCD; wgid = (xcd < r ? xcd * (q + 1) : r * (q + 1) + (xcd - r) * q) + off; }
        const int nig = WGM * nN, gid = wgid / nig, fm = gid * WGM, gsz = (nM - fm) < WGM ? (nM - fm) : WGM;
        u.pm = fm + ((wgid % nig) % gsz); u.pn = (wgid % nig) / gsz; u.kt0 = half ? (c & 1) * hk : 0; u.nt = half ? hk : 0; u.ks = half ? c : -1;
        return half ? i == nfull : L < nwg;
    }
    __device__ __forceinline__ void a_ready(const Unit&) const {}
    __device__ __forceinline__ void done(const Unit&) const {}
};

struct PanelOrder {
    int G, c;
    __device__ __forceinline__ bool next(int i, Unit& u) const {
        const int x = c & 7, j = c >> 3, xa = G == 256;
        const int pl = xa ? 4 * (x >> 1) + (j & 3) : (c >> 4), pn = xa ? 8 * (x & 1) + (j >> 2) : (c & 15), ppr = G >> 4;
        u.pm = i * ppr + pl; u.pn = pn; u.kt0 = 0; u.nt = 0; u.ks = -1;
        return u.pm < 32;
    }
    __device__ __forceinline__ void a_ready(const Unit&) const {}
    __device__ __forceinline__ void done(const Unit&) const {}
};

typedef __bf16 pg8_bf16x2 __attribute__((ext_vector_type(2)));
__device__ __forceinline__ unsigned cvt_pk_bf16(float lo, float hi) { pg8_bf16x2 v = {(__bf16)lo, (__bf16)hi}; return __builtin_bit_cast(unsigned, v); }

__device__ __forceinline__ float bf_lo(unsigned u) { return __builtin_bit_cast(float, u << 16); }
__device__ __forceinline__ float bf_hi(unsigned u) { return __builtin_bit_cast(float, u & 0xffff0000u); }
__device__ __forceinline__ float fast_sigmoid(float x) { return __builtin_amdgcn_rcpf(1.0f + __expf(-x)); }
__device__ __forceinline__ float fast_silu(float x) { return x * fast_sigmoid(x); }
__device__ __forceinline__ int rm_src(int lane) { return (((lane >> 2) + 16 * (lane & 3)) << 2); }
__device__ __forceinline__ int mf_src(int lane) { return ((4 * (lane & 15) + (lane >> 4)) << 2); }
typedef int pg8_i32x4 __attribute__((ext_vector_type(4)));
__device__ __forceinline__ pg8_i32x4 lperm_i(const pg8_i32x4 v, int a) { pg8_i32x4 r;
    r.x = __builtin_amdgcn_ds_bpermute(a, v.x); r.y = __builtin_amdgcn_ds_bpermute(a, v.y); r.z = __builtin_amdgcn_ds_bpermute(a, v.z); r.w = __builtin_amdgcn_ds_bpermute(a, v.w); return r; }
__device__ __forceinline__ f32x4 lperm(const f32x4 v, int a) { return __builtin_bit_cast(f32x4, lperm_i(__builtin_bit_cast(pg8_i32x4, v), a)); }
__device__ __forceinline__ u32x4 lperm(const u32x4 v, int a) { return __builtin_bit_cast(u32x4, lperm_i(__builtin_bit_cast(pg8_i32x4, v), a)); }

struct EpiSwiGLU {
    static constexpr bool PERM = true, AFTER_DRAIN = false, MIDK = false;
    bf16_t* H; int ldh;
    __device__ __forceinline__ void operator()(const f32x4 (&acc)[2][2][4][2], const Unit& u, int wr, int wc, int fr, int fq) const {
        const int row0 = u.pm * BM + wr * 64 + fr, col0 = u.pn * HALF + wc * 32 + 8 * fq;
#pragma unroll
        for (int ai = 0; ai < 2; ++ai)
#pragma unroll
            for (int m = 0; m < 4; ++m) { bf16_t* rowp = H + (size_t)(row0 + ai * HALF + m * 16) * ldh + col0;
                const f32x4 a0 = acc[ai][0][m][0], a1 = acc[ai][0][m][1], b0 = acc[ai][1][m][0], b1 = acc[ai][1][m][1];
                u32x4 w; w.x = cvt_pk_bf16(fast_silu(a0[0]) * b0[0], fast_silu(a0[1]) * b0[1]); w.y = cvt_pk_bf16(fast_silu(a0[2]) * b0[2], fast_silu(a0[3]) * b0[3]);
                w.z = cvt_pk_bf16(fast_silu(a1[0]) * b1[0], fast_silu(a1[1]) * b1[1]); w.w = cvt_pk_bf16(fast_silu(a1[2]) * b1[2], fast_silu(a1[3]) * b1[3]);
                *(u32x4*)rowp = w; }
    }
};
struct EpiSwiGLUS {
    static constexpr bool PERM = true, AFTER_DRAIN = false, MIDK = false;
    EpiSwiGLU e; unsigned slab_off, flag_off;
    __device__ __forceinline__ void operator()(const f32x4 (&acc)[2][2][4][2], const Unit& u, int wr, int wc, int fr, int fq) const {
        if (u.ks < 0) { e(acc, u, wr, wc, fr, fq); return; }
        int lane = fr + 16 * fq; asm volatile("" : "+v"(lane));
        const int pair = u.ks >> 1, wid = wr * 4 + wc;
        const __attribute__((address_space(4))) char* kp = (const __attribute__((address_space(4))) char*)__builtin_amdgcn_kernarg_segment_ptr(); asm volatile("" : "+s"(kp));
        char* const wsb = *(char* const __attribute__((address_space(4)))*)(kp + 200);
        float* const slab = (float*)(wsb + slab_off); unsigned* const flags = (unsigned*)(wsb + flag_off);
        const unsigned off0 = (unsigned)(((pair * 8 + wid) * 32) * 64 + lane) * 16u;
        if ((u.ks & 1) == 0) {
            const __amdgpu_buffer_rsrc_t rs = __builtin_amdgcn_make_buffer_rsrc(slab, 0, 128 * 8 * 32 * 64 * 16, 0x00020000);
#pragma unroll
            for (int ai = 0; ai < 2; ++ai)
#pragma unroll
                for (int bj = 0; bj < 2; ++bj)
#pragma unroll
                    for (int m = 0; m < 4; ++m)
#pragma unroll
                        for (int n = 0; n < 2; ++n) __builtin_amdgcn_raw_buffer_store_b128(__builtin_bit_cast(u32x4, acc[ai][bj][m][n]), rs, off0 + (unsigned)((((ai * 2 + bj) * 4 + m) * 2 + n) * 1024), 0, 16);
            asm volatile("s_waitcnt vmcnt(0)" ::: "memory"); __builtin_amdgcn_s_barrier();
            if (wid == 0 && lane == 0) __hip_atomic_store(flags + pair * 32, 1u, __ATOMIC_RELAXED, __HIP_MEMORY_SCOPE_AGENT);
            return;
        }
        if (wid == 0 && lane == 0) { unsigned sp = 0u; while (__hip_atomic_load(flags + pair * 32, __ATOMIC_RELAXED, __HIP_MEMORY_SCOPE_AGENT) == 0u && ++sp < (1u << 21)) __builtin_amdgcn_s_sleep(1);
            __builtin_amdgcn_fence(__ATOMIC_ACQUIRE, "agent"); asm volatile("s_waitcnt vmcnt(0)" ::: "memory"); }
        __builtin_amdgcn_s_barrier();
        const char* sp_ = (const char*)slab + off0;
        const int row0 = u.pm * BM + wr * 64 + (lane & 15), col0 = u.pn * HALF + wc * 32 + 8 * (lane >> 4);
#pragma unroll
        for (int ai = 0; ai < 2; ++ai)
#pragma unroll
            for (int m = 0; m < 4; ++m) {
                const f32x4 a0 = acc[ai][0][m][0] + *(const f32x4*)(sp_ + (((ai * 2 + 0) * 4 + m) * 2 + 0) * 1024), a1 = acc[ai][0][m][1] + *(const f32x4*)(sp_ + (((ai * 2 + 0) * 4 + m) * 2 + 1) * 1024);
                const f32x4 b0 = acc[ai][1][m][0] + *(const f32x4*)(sp_ + (((ai * 2 + 1) * 4 + m) * 2 + 0) * 1024), b1 = acc[ai][1][m][1] + *(const f32x4*)(sp_ + (((ai * 2 + 1) * 4 + m) * 2 + 1) * 1024);
                u32x4 w; w.x = cvt_pk_bf16(fast_silu(a0[0]) * b0[0], fast_silu(a0[1]) * b0[1]); w.y = cvt_pk_bf16(fast_silu(a0[2]) * b0[2], fast_silu(a0[3]) * b0[3]);
                w.z = cvt_pk_bf16(fast_silu(a1[0]) * b1[0], fast_silu(a1[1]) * b1[1]); w.w = cvt_pk_bf16(fast_silu(a1[2]) * b1[2], fast_silu(a1[3]) * b1[3]);
                *(u32x4*)(e.H + (size_t)(row0 + ai * HALF + m * 16) * e.ldh + col0) = w;
                asm volatile("" ::: "memory"); }
    }
};
struct EpiResid {
    static constexpr bool PERM = false, AFTER_DRAIN = false, MIDK = false;
    const float* in_lat; const float* in_ctx; float* out; const float* gate; int gate_vstride; float coef;
    __device__ __forceinline__ void operator()(const f32x4 (&acc)[2][2][4][2], const Unit& u, int wr, int wc, int fr, int fq) const {
        const int v = u.pm < 16 ? 0 : (u.pm < 32 ? 1 : 2);
        const float* gp = gate + (size_t)v * gate_vstride;
        const int lane = fr + 16 * fq, nsel = (lane >> 2) & 1;
        const int pa0 = (((lane >> 3) + 16 * (lane & 3)) << 2), pa1 = pa0 + 32;
        const int row0 = u.pm * BM + wr * 64 + (lane >> 3), col0 = u.pn * BM + wc * 32 + 4 * (lane & 7);
        const float* inb = u.pm < 32 ? in_lat + (size_t)row0 * 4096 : in_ctx + (size_t)(row0 - 8192) * 4096;
        float* outb = out + (size_t)row0 * 4096;
        f32x4 gv[2];
#pragma unroll
        for (int bj = 0; bj < 2; ++bj) gv[bj] = *(const f32x4*)(gp + col0 + bj * HALF) * coef;
        f32x4 xa[2][2], xb[2][2];
#define PG8_RLD(dst, g) do { const size_t ro_ = (size_t)(((g) >> 2) * HALF + ((g) & 3) * 16) * 4096 + col0; _Pragma("unroll") for (int bj = 0; bj < 2; ++bj) _Pragma("unroll") for (int h = 0; h < 2; ++h) \
            dst[bj][h] = *(const f32x4*)(inb + ro_ + (size_t)(8 * h) * 4096 + bj * HALF); } while (0)
#define PG8_RST(src, g) do { const size_t ro_ = (size_t)(((g) >> 2) * HALF + ((g) & 3) * 16) * 4096 + col0; _Pragma("unroll") for (int bj = 0; bj < 2; ++bj) _Pragma("unroll") for (int h = 0; h < 2; ++h) { \
            const f32x4 t0_ = lperm(acc[(g) >> 2][bj][(g) & 3][0], h ? pa1 : pa0), t1_ = lperm(acc[(g) >> 2][bj][(g) & 3][1], h ? pa1 : pa0); \
            *(f32x4*)(outb + ro_ + (size_t)(8 * h) * 4096 + bj * HALF) = src[bj][h] + gv[bj] * (nsel ? t1_ : t0_); } } while (0)
        PG8_RLD(xa, 0);
#pragma unroll
        for (int g = 0; g < 8; g += 2) {
            PG8_RLD(xb, g + 1);
            PG8_RST(xa, g);
            if (g + 2 < 8) PG8_RLD(xa, g + 2);
            PG8_RST(xb, g + 1);
        }
#undef PG8_RLD
#undef PG8_RST
    }
};
struct EpiFinal {
    static constexpr bool PERM = false, AFTER_DRAIN = false, MIDK = false;
    const float* in; float* outp; const float* gate; int gate_vstride; float coef; const float* fw; float* stats  ; unsigned* cnt  ; PG8_LAS float* red  ;
    __device__ __forceinline__ void operator()(f32x4 (&acc)[2][2][4][2], const Unit& u, int wr, int wc, int fr, int fq) const {
        const int v = u.pm < 16 ? 0 : 1;
        const float* gp = gate + (size_t)v * gate_vstride;
        int lane = fr + 16 * fq; asm volatile("" : "+v"(lane));
        const int nsel = (lane >> 2) & 1;
        const int pa0 = (((lane >> 3) + 16 * (lane & 3)) << 2), pa1 = pa0 + 32;
        const int rl = wr * 64 + (lane >> 3);
        const int row0 = u.pm * BM + rl, col0 = u.pn * BM + wc * 32 + 4 * (lane & 7);
        const float* inb = in + (size_t)row0 * 4096;
#pragma unroll
        for (int g = 0; g < 8; ++g) {
            const size_t ro = (size_t)((g >> 2) * HALF + (g & 3) * 16) * 4096 + col0;
            float s0 = 0.f, s1 = 0.f;
#pragma unroll
            for (int bj = 0; bj < 2; ++bj) { f32x4& c0 = acc[g >> 2][bj][g & 3][0]; f32x4& c1 = acc[g >> 2][bj][g & 3][1];
                const f32x4 gvv = *(const f32x4*)(gp + col0 + bj * HALF) * coef;
                const f32x4 x0 = *(const f32x4*)(inb + ro + bj * HALF), x1 = *(const f32x4*)(inb + ro + (size_t)8 * 4096 + bj * HALF);
                const f32x4 t00 = lperm(c0, pa0), t10 = lperm(c1, pa0); const f32x4 h0 = x0 + gvv * (nsel ? t10 : t00);
                const f32x4 t01 = lperm(c0, pa1), t11 = lperm(c1, pa1); const f32x4 h1 = x1 + gvv * (nsel ? t11 : t01);
                c0 = h0; c1 = h1; asm volatile("" : "+v"(c0), "+v"(c1));
                s0 += (h0[0] * h0[0] + h0[1] * h0[1]) + (h0[2] * h0[2] + h0[3] * h0[3]); s1 += (h1[0] * h1[0] + h1[1] * h1[1]) + (h1[2] * h1[2] + h1[3] * h1[3]); }
            s0 += __shfl_xor(s0, 1); s0 += __shfl_xor(s0, 2); s0 += __shfl_xor(s0, 4); s1 += __shfl_xor(s1, 1); s1 += __shfl_xor(s1, 2); s1 += __shfl_xor(s1, 4);
            if ((lane & 7) == 0) { const int tr = (g >> 2) * HALF + (g & 3) * 16 + rl; red[tr * 4 + wc] = s0; red[(tr + 8) * 4 + wc] = s1; }
            asm volatile("" ::: "memory");
        }
        asm volatile("s_waitcnt lgkmcnt(0)" ::: "memory"); __builtin_amdgcn_s_barrier();
        if (wr == 0) { const int r = wc * 64 + lane; const float s = (red[r * 4] + red[r * 4 + 1]) + (red[r * 4 + 2] + red[r * 4 + 3]);
            __hip_atomic_store(stats + ((size_t)u.pm * BM + r) * 16 + u.pn, s, __ATOMIC_RELAXED, __HIP_MEMORY_SCOPE_AGENT); }
        asm volatile("s_waitcnt vmcnt(0) lgkmcnt(0)" ::: "memory"); __builtin_amdgcn_s_barrier();
        if (wr == 0 && wc == 0 && lane == 0) { unsigned* cp = cnt + u.pm * 32;
            (void)__hip_atomic_fetch_add(cp, 1u, __ATOMIC_RELAXED, __HIP_MEMORY_SCOPE_AGENT);
            unsigned sp = 0u; while (__hip_atomic_load(cp, __ATOMIC_RELAXED, __HIP_MEMORY_SCOPE_AGENT) < 16u && ++sp < (1u << 21)) __builtin_amdgcn_s_sleep(1);
            __builtin_amdgcn_fence(__ATOMIC_ACQUIRE, "agent"); asm volatile("s_waitcnt vmcnt(0)" ::: "memory"); }
        __builtin_amdgcn_s_barrier();
        if (wr == 0) { const int r = wc * 64 + lane; const float* sp_ = stats + ((size_t)u.pm * BM + r) * 16; float s = 0.f;
#pragma unroll
            for (int t = 0; t < 16; ++t) s += __hip_atomic_load(sp_ + t, __ATOMIC_RELAXED, __HIP_MEMORY_SCOPE_AGENT);
            red[1024 + r] = 1.0f / sqrtf(s * (1.0f / 4096.0f) + 1e-6f); }
        asm volatile("s_waitcnt vmcnt(0) lgkmcnt(0)" ::: "memory"); __builtin_amdgcn_s_barrier();
        float* outb = outp + (size_t)row0 * 4096;
#pragma unroll
        for (int g = 0; g < 8; ++g) {
#pragma unroll
            for (int bj = 0; bj < 2; ++bj) { const f32x4 fwv = *(const f32x4*)(fw + col0 + bj * HALF);
#pragma unroll
                for (int h = 0; h < 2; ++h) { const float rs = red[1024 + (g >> 2) * HALF + (g & 3) * 16 + 8 * h + rl];
                    *(f32x4*)(outb + (size_t)((g >> 2) * HALF + (g & 3) * 16 + 8 * h) * 4096 + col0 + bj * HALF) = acc[g >> 2][bj][g & 3][h] * rs * fwv; } }
            asm volatile("" ::: "memory"); }
        asm volatile("s_waitcnt lgkmcnt(0)" ::: "memory"); __builtin_amdgcn_s_barrier();
    }
};
struct EpiZ {
    static constexpr bool PERM = true, AFTER_DRAIN = false, MIDK = false;
    bf16_t* Z; int ldz; float* ZAB; int nmain; bf16_t* GF; int ga0; bf16_t* KF; bf16_t* QF; int nk0, nq0; bf16_t* VF; int nv0;
    __device__ __forceinline__ void operator()(const f32x4 (&acc)[2][2][4][2], const Unit& u, int wr, int wc, int fr, int fq) const {
        const int row0 = u.pm * BM + wr * 64 + fr;
        if (u.pn >= ga0 && u.pn < nmain && u.pm < 32) {
            bf16_t* gp = GF + ((((size_t)u.pm * 48 + (u.pn - ga0)) * 8 + (wr * 4 + wc)) * 16 * 64 + (fr + 16 * fq)) * 8;
#pragma unroll
            for (int ai = 0; ai < 2; ++ai)
#pragma unroll
                for (int m = 0; m < 4; ++m)
#pragma unroll
                    for (int bj = 0; bj < 2; ++bj) { f32x4 v0 = acc[ai][bj][m][0], v1 = acc[ai][bj][m][1];
#pragma unroll
                        for (int i = 0; i < 4; ++i) { v0[i] = __expf(-fminf(fmaxf(v0[i], -30.f), 30.f)); v1[i] = __expf(-fminf(fmaxf(v1[i], -30.f), 30.f)); }
                        u32x4 w; w.x = cvt_pk_bf16(v0[0], v0[1]); w.y = cvt_pk_bf16(v0[2], v0[3]); w.z = cvt_pk_bf16(v1[0], v1[1]); w.w = cvt_pk_bf16(v1[2], v1[3]);
                        *(u32x4*)(gp + ((ai * 4 + m) * 2 + bj) * 512) = w; }
        } else if (u.pm < 32 && (unsigned)(u.pn - nk0) < 8u) {
            const int b = u.pm >> 4, t0 = (u.pm & 15) * BM + wr * 64 + fr;
#pragma unroll
            for (int ai = 0; ai < 2; ++ai)
#pragma unroll
                for (int m = 0; m < 4; ++m)
#pragma unroll
                    for (int bj = 0; bj < 2; ++bj) { const f32x4 v0 = acc[ai][bj][m][0], v1 = acc[ai][bj][m][1]; const int t = t0 + ai * HALF + m * 16;
                        u32x4 w; w.x = cvt_pk_bf16(v0[0], v0[1]); w.y = cvt_pk_bf16(v0[2], v0[3]); w.z = cvt_pk_bf16(v1[0], v1[1]); w.w = cvt_pk_bf16(v1[2], v1[3]);
                        *(u32x4*)(KF + (((size_t)(b * 16 + 2 * (u.pn - nk0) + bj) * 1024 + (t >> 2)) * 512) + wc * 128 + fq * 32 + (t & 3) * 8) = w; }
        } else if (u.pm < 32 && (unsigned)(u.pn - nv0) < 8u) {
            const int b = u.pm >> 4, t0 = (u.pm & 15) * BM + wr * 64 + (fr & 8);
            const bool lo4 = (fr & 4) == 0, lo2 = (fr & 2) == 0, lo1 = (fr & 1) == 0;
#pragma unroll
            for (int ai = 0; ai < 2; ++ai)
#pragma unroll
                for (int m = 0; m < 4; ++m)
#pragma unroll
                    for (int bj = 0; bj < 2; ++bj) { const f32x4 v0 = acc[ai][bj][m][0], v1 = acc[ai][bj][m][1];
                        unsigned w0 = cvt_pk_bf16(v0[0], v0[1]), w1 = cvt_pk_bf16(v0[2], v0[3]), w2 = cvt_pk_bf16(v1[0], v1[1]), w3 = cvt_pk_bf16(v1[2], v1[3]);
                        { const unsigned r0 = (unsigned)__shfl_xor((int)(lo4 ? w2 : w0), 4), r1 = (unsigned)__shfl_xor((int)(lo4 ? w3 : w1), 4); w2 = lo4 ? r0 : w2; w3 = lo4 ? r1 : w3; w0 = lo4 ? w0 : r0; w1 = lo4 ? w1 : r1; }
                        { const unsigned r0 = (unsigned)__shfl_xor((int)(lo2 ? w1 : w0), 2), r1 = (unsigned)__shfl_xor((int)(lo2 ? w3 : w2), 2); w1 = lo2 ? r0 : w1; w3 = lo2 ? r1 : w3; w0 = lo2 ? w0 : r0; w2 = lo2 ? w2 : r1; }
                        { const unsigned p0 = (unsigned)__shfl_xor((int)w0, 1), p1 = (unsigned)__shfl_xor((int)w1, 1), p2 = (unsigned)__shfl_xor((int)w2, 1), p3 = (unsigned)__shfl_xor((int)w3, 1);
                          w0 = lo1 ? (w0 & 0xffffu) | (p0 << 16) : (p0 >> 16) | (w0 & 0xffff0000u); w1 = lo1 ? (w1 & 0xffffu) | (p1 << 16) : (p1 >> 16) | (w1 & 0xffff0000u);
                          w2 = lo1 ? (w2 & 0xffffu) | (p2 << 16) : (p2 >> 16) | (w2 & 0xffff0000u); w3 = lo1 ? (w3 & 0xffffu) | (p3 << 16) : (p3 >> 16) | (w3 & 0xffff0000u); }
                        u32x4 w; w.x = w0; w.y = w1; w.z = w2; w.w = w3;
                        *(u32x4*)(VF + ((((size_t)(b * 16 + 2 * (u.pn - nv0) + bj) * 512 + ((t0 + ai * HALF + m * 16) >> 3)) * 128) + wc * 32 + fq * 8 + (fr & 7)) * 8) = w; }
        } else if (u.pm < 32 && (unsigned)(u.pn - nq0) < 8u) {
            const int b = u.pm >> 4, rg0 = (u.pm & 15) * 16 + wr * 4;
#pragma unroll
            for (int ai = 0; ai < 2; ++ai)
#pragma unroll
                for (int m = 0; m < 4; ++m)
#pragma unroll
                    for (int bj = 0; bj < 2; ++bj) { const f32x4 v0 = acc[ai][bj][m][0], v1 = acc[ai][bj][m][1];
                        u32x4 w; w.x = cvt_pk_bf16(v0[0], v0[1]); w.y = cvt_pk_bf16(v0[2], v0[3]); w.z = cvt_pk_bf16(v1[0], v1[1]); w.w = cvt_pk_bf16(v1[2], v1[3]);
                        *(u32x4*)(QF + ((((size_t)(b * 16 + 2 * (u.pn - nq0) + bj) * 256 + rg0 + ai * 8 + m) * 4 + wc) * 64 + (fr + 16 * fq)) * 8) = w; }
        } else if (u.pn < nmain) {
            const int col0 = u.pn * BM + wc * 32 + 8 * fq;
#pragma unroll
            for (int ai = 0; ai < 2; ++ai)
#pragma unroll
                for (int m = 0; m < 4; ++m) { bf16_t* rowp = Z + (size_t)(row0 + ai * HALF + m * 16) * ldz + col0;
#pragma unroll
                    for (int bj = 0; bj < 2; ++bj) { const f32x4 v0 = acc[ai][bj][m][0], v1 = acc[ai][bj][m][1];
                        u32x4 w; w.x = cvt_pk_bf16(v0[0], v0[1]); w.y = cvt_pk_bf16(v0[2], v0[3]); w.z = cvt_pk_bf16(v1[0], v1[1]); w.w = cvt_pk_bf16(v1[2], v1[3]);
                        *(u32x4*)(rowp + bj * HALF) = w; } }
        } else if (wc == 0) {
#pragma unroll
            for (int ai = 0; ai < 2; ++ai)
#pragma unroll
                for (int m = 0; m < 4; ++m) { float* rowp = ZAB + (size_t)(row0 + ai * HALF + m * 16) * 32 + 8 * fq;
                    *(f32x4*)(rowp) = acc[ai][0][m][0]; *(f32x4*)(rowp + 4) = acc[ai][0][m][1]; }
        }
    }
};
template <int S> struct EpiMerge {
    static constexpr bool PERM = true, AFTER_DRAIN = false, MIDK = false;
    const bf16_t* Z; int ldz; int gcol; float* YF; bf16_t* YB;
    __device__ __forceinline__ void operator()(const f32x4 (&acc)[2][2][4][2], const Unit& u, int wr, int wc, int fr, int fq) const {
        const int row0 = u.pm * BM + wr * 64 + fr, col0 = u.pn * BM + wc * 32 + 8 * fq;
#pragma unroll
        for (int ai = 0; ai < 2; ++ai)
#pragma unroll
            for (int m = 0; m < 4; ++m) { const size_t row = (size_t)(row0 + ai * HALF + m * 16);
#pragma unroll
                for (int bj = 0; bj < 2; ++bj) { const int c = col0 + bj * HALF;
                    const u32x4 g = *(const u32x4*)(Z + row * ldz + gcol + c);
                    f32x4 t0 = acc[ai][bj][m][0], t1 = acc[ai][bj][m][1];
                    t0[0] *= fast_sigmoid(bf_lo(g.x)); t0[1] *= fast_sigmoid(bf_hi(g.x)); t0[2] *= fast_sigmoid(bf_lo(g.y)); t0[3] *= fast_sigmoid(bf_hi(g.y));
                    t1[0] *= fast_sigmoid(bf_lo(g.z)); t1[1] *= fast_sigmoid(bf_hi(g.z)); t1[2] *= fast_sigmoid(bf_lo(g.w)); t1[3] *= fast_sigmoid(bf_hi(g.w));
                    float* yf = YF + row * 4096 + c;
                    if (S == 0) { *(f32x4*)yf = t0; *(f32x4*)(yf + 4) = t1; }
                    else { t0 += *(const f32x4*)yf; t1 += *(const f32x4*)(yf + 4);
                        if (S == 1) { *(f32x4*)yf = t0; *(f32x4*)(yf + 4) = t1; }
                        else { u32x4 w; w.x = cvt_pk_bf16(t0[0], t0[1]); w.y = cvt_pk_bf16(t0[2], t0[3]); w.z = cvt_pk_bf16(t1[0], t1[1]); w.w = cvt_pk_bf16(t1[2], t1[3]);
                            *(u32x4*)(YB + row * 4096 + c) = w; } } }
                asm volatile("" ::: "memory"); }
    }
};

struct EpiSlab {
    static constexpr bool PERM = false, AFTER_DRAIN = false, MIDK = false;
    float* slab;
    __device__ __forceinline__ void operator()(const f32x4 (&acc)[2][2][4][2], const Unit& u, int wr, int wc, int fr, int fq) const {
        const int row0 = u.pm * BM + wr * 64 + fr - 8192, col0 = u.pn * BM + wc * 32 + 4 * fq;
        float* outb = slab + ((size_t)u.ks * 512 + row0) * 4096 + col0;
#pragma unroll
        for (int ai = 0; ai < 2; ++ai)
#pragma unroll
            for (int m = 0; m < 4; ++m)
#pragma unroll
                for (int bj = 0; bj < 2; ++bj)
#pragma unroll
                    for (int n = 0; n < 2; ++n) *(f32x4*)(outb + (size_t)(ai * HALF + m * 16) * 4096 + bj * HALF + n * 16) = acc[ai][bj][m][n];
    }
};

struct EpiSlabP {
    static constexpr bool PERM = true, AFTER_DRAIN = false, MIDK = false;
    float* slab;
    __device__ __forceinline__ void operator()(const f32x4 (&acc)[2][2][4][2], const Unit& u, int wr, int wc, int fr, int fq) const {
        const int row0 = u.pm * BM + wr * 64 + fr - 8192, col0 = u.pn * BM + wc * 32 + 8 * fq;
        float* outb = slab + ((size_t)u.ks * 512 + row0) * 4096 + col0;
#pragma unroll
        for (int ai = 0; ai < 2; ++ai)
#pragma unroll
            for (int m = 0; m < 4; ++m)
#pragma unroll
                for (int bj = 0; bj < 2; ++bj) { float* o = outb + (size_t)(ai * HALF + m * 16) * 4096 + bj * HALF; *(f32x4*)o = acc[ai][bj][m][0]; *(f32x4*)(o + 4) = acc[ai][bj][m][1]; }
    }
};
struct EpiResidSlab {
    static constexpr bool PERM = false, AFTER_DRAIN = false, MIDK = false;
    EpiResid r; EpiSlab s;
    __device__ __forceinline__ void operator()(const f32x4 (&acc)[2][2][4][2], const Unit& u, int wr, int wc, int fr, int fq) const { if (u.ks >= 0) s(acc, u, wr, wc, fr, fq); else r(acc, u, wr, wc, fr, fq); }
};
struct EpiMergeH {
    static constexpr bool PERM = true, AFTER_DRAIN = false, MIDK = true;
    static constexpr int T1 = 16, T2 = 32;
    const bf16_t* GF; bf16_t* YB;
    __device__ __forceinline__ void midk(f32x4 (&acc)[2][2][4][2], const Unit& u, int which, int wr, int wc, int fr, int fq) const {
        int lane = fr + 16 * fq; asm volatile("" : "+v"(lane));
        const bf16_t* gn0 = GF + ((((size_t)u.pm * 48 + which * 16 + u.pn) * 8 + (wr * 4 + wc)) * 16 * 64 + lane) * 8;
#pragma unroll
        for (int ai = 0; ai < 2; ++ai)
#pragma unroll
            for (int mp = 0; mp < 4; mp += 2) {
                u32x4 gn[2][2], gd[2][2];
#pragma unroll
                for (int mm = 0; mm < 2; ++mm)
#pragma unroll
                    for (int bj = 0; bj < 2; ++bj) { const int o = ((ai * 4 + mp + mm) * 2 + bj) * 512;
                        gn[mm][bj] = *(const u32x4*)(gn0 + o); gd[mm][bj] = *(const u32x4*)(gn0 + (size_t)16 * 8 * 16 * 64 * 8 + o); }
#pragma unroll
                for (int mm = 0; mm < 2; ++mm)
#pragma unroll
                    for (int bj = 0; bj < 2; ++bj) { const u32x4 a = gn[mm][bj], b = gd[mm][bj]; f32x4& t0 = acc[ai][bj][mp + mm][0]; f32x4& t1 = acc[ai][bj][mp + mm][1];
                        t0[0] *= (1.f + (bf_lo(b.x))) * __builtin_amdgcn_rcpf(1.f + (bf_lo(a.x))); t0[1] *= (1.f + (bf_hi(b.x))) * __builtin_amdgcn_rcpf(1.f + (bf_hi(a.x)));
                        t0[2] *= (1.f + (bf_lo(b.y))) * __builtin_amdgcn_rcpf(1.f + (bf_lo(a.y))); t0[3] *= (1.f + (bf_hi(b.y))) * __builtin_amdgcn_rcpf(1.f + (bf_hi(a.y)));
                        t1[0] *= (1.f + (bf_lo(b.z))) * __builtin_amdgcn_rcpf(1.f + (bf_lo(a.z))); t1[1] *= (1.f + (bf_hi(b.z))) * __builtin_amdgcn_rcpf(1.f + (bf_hi(a.z)));
                        t1[2] *= (1.f + (bf_lo(b.w))) * __builtin_amdgcn_rcpf(1.f + (bf_lo(a.w))); t1[3] *= (1.f + (bf_hi(b.w))) * __builtin_amdgcn_rcpf(1.f + (bf_hi(a.w))); }
                asm volatile("" ::: "memory");
            }
    }
    __device__ __forceinline__ void operator()(const f32x4 (&acc)[2][2][4][2], const Unit& u, int wr, int wc, int fr, int fq) const {
        const int row0 = u.pm * BM + wr * 64 + fr, col0 = u.pn * BM + wc * 32 + 8 * fq;
        const bf16_t* gc0 = GF + ((((size_t)u.pm * 48 + 32 + u.pn) * 8 + (wr * 4 + wc)) * 16 * 64 + (fr + 16 * fq)) * 8;
#pragma unroll
        for (int ai = 0; ai < 2; ++ai)
#pragma unroll
            for (int m = 0; m < 4; ++m) { const size_t row = (size_t)(row0 + ai * HALF + m * 16);
#pragma unroll
                for (int bj = 0; bj < 2; ++bj) { const int c = col0 + bj * HALF;
                    const u32x4 g = *(const u32x4*)(gc0 + ((ai * 4 + m) * 2 + bj) * 512);
                    f32x4 t0 = acc[ai][bj][m][0], t1 = acc[ai][bj][m][1];
                    t0[0] *= __builtin_amdgcn_rcpf(1.f + (bf_lo(g.x))); t0[1] *= __builtin_amdgcn_rcpf(1.f + (bf_hi(g.x))); t0[2] *= __builtin_amdgcn_rcpf(1.f + (bf_lo(g.y))); t0[3] *= __builtin_amdgcn_rcpf(1.f + (bf_hi(g.y)));
                    t1[0] *= __builtin_amdgcn_rcpf(1.f + (bf_lo(g.z))); t1[1] *= __builtin_amdgcn_rcpf(1.f + (bf_hi(g.z))); t1[2] *= __builtin_amdgcn_rcpf(1.f + (bf_lo(g.w))); t1[3] *= __builtin_amdgcn_rcpf(1.f + (bf_hi(g.w)));
                    u32x4 w; w.x = cvt_pk_bf16(t0[0], t0[1]); w.y = cvt_pk_bf16(t0[2], t0[3]); w.z = cvt_pk_bf16(t1[0], t1[1]); w.w = cvt_pk_bf16(t1[2], t1[3]);
                    *(u32x4*)(YB + row * 4096 + c) = w; }
                if (m & 1) asm volatile("" ::: "memory"); }
    }
};
struct EpiMergeHS {
    static constexpr bool PERM = true, AFTER_DRAIN = false, MIDK = true;
    static constexpr int T1 = EpiMergeH::T1, T2 = EpiMergeH::T2;
    EpiMergeH m; EpiSlabP s;
    __device__ __forceinline__ void midk(f32x4 (&acc)[2][2][4][2], const Unit& u, int which, int wr, int wc, int fr, int fq) const { if (u.ks < 0) m.midk(acc, u, which, wr, wc, fr, fq); }
    __device__ __forceinline__ void operator()(const f32x4 (&acc)[2][2][4][2], const Unit& u, int wr, int wc, int fr, int fq) const { if (u.ks >= 0) s(acc, u, wr, wc, fr, fq); else m(acc, u, wr, wc, fr, fq); }
};
template <class Epi, class Sched, bool ALIGN_EPI = false, bool SP2 = false>
__device__ __forceinline__ void gemm_phase(PG8_LAS unsigned char* lds, const Gemm g, const Sched& S, const Epi& E, int wave0) {
    int tid = wave0 * 64 + (int)__builtin_amdgcn_mbcnt_hi(~0u, __builtin_amdgcn_mbcnt_lo(~0u, 0u)); asm volatile("" : "+v"(tid));
    const int wid = __builtin_amdgcn_readfirstlane(tid >> 6), lane = tid & 63, wr = wid >> 2, wc = wid & 3, fr = lane & 15, fq = lane >> 4;
    const int ntdef = g.K / BK;
    unsigned voffA[2], voffB[2];
#pragma unroll
    for (int i = 0; i < 2; ++i) { int R, C; stage_rc(tid * 16 + i * 8192, R, C); const int Rb = Epi::PERM ? ((R & ~31) + perm32(R & 31)) : R;
        voffA[i] = (unsigned)(R * g.lda + C) * 2u; voffB[i] = (unsigned)(Rb * g.ldb + C) * 2u; }
    const size_t kstep = (size_t)(BK * 2);
    const size_t hstepA = (size_t)HALF * g.lda * 2, hstepB = (size_t)HALF * g.ldb * 2;
    const size_t tstepA = 2 * hstepA, tstepB = 2 * hstepB;
    const unsigned ldsw = (unsigned)wid * 1024u;
    const int aoff = lds_byte(wr * 64 + fr, fq * 8), boff = lds_byte(wc * 32 + fr, fq * 8);
#define PG8_SA(b, h) (((b) * 2 + (h)) * HTB)
#define PG8_SB(b, h) ((4 + (b) * 2 + (h)) * HTB)
#define PG8_STAGE(bufoff, gbase, voff) do { _Pragma("unroll") for (int _i = 0; _i < 2; ++_i) \
        __builtin_amdgcn_global_load_lds((const unsigned*)((const char*)(gbase) + (voff)[_i]), (PG8_LAS unsigned*)(lds + (bufoff) + ldsw + _i * 8192), 16, 0, 0); } while (0)
#define PG8_LDA(dst, b, h) do { _Pragma("unroll") for (int m = 0; m < 4; ++m) _Pragma("unroll") for (int k = 0; k < 2; ++k) dst[m][k] = *(const PG8_LAS bf16x8*)(lds + PG8_SA(b, h) + aoff + m * 2048 + k * 1024); } while (0)
#define PG8_LDB(dst, b, h) do { _Pragma("unroll") for (int n = 0; n < 2; ++n) _Pragma("unroll") for (int k = 0; k < 2; ++k) dst[n][k] = *(const PG8_LAS bf16x8*)(lds + PG8_SB(b, h) + boff + n * 2048 + k * 1024); } while (0)
#define PG8_MMA(ai, bj, At, Bt) do { __builtin_amdgcn_s_setprio(1); _Pragma("unroll") for (int m = 0; m < 4; ++m) _Pragma("unroll") for (int n = 0; n < 2; ++n) _Pragma("unroll") for (int k = 0; k < 2; ++k) \
        acc[ai][bj][m][n] = __builtin_amdgcn_mfma_f32_16x16x32_bf16(Bt[n][k], At[m][k], acc[ai][bj][m][n], 0, 0, 0); __builtin_amdgcn_s_setprio(0); } while (0)
#define PG8_WAIT_V(n) asm volatile("s_waitcnt vmcnt(" #n ")" ::: "memory")
#define PG8_WAIT_L(n) asm volatile("s_waitcnt lgkmcnt(" #n ")" ::: "memory")
#define PG8_BAR __builtin_amdgcn_s_barrier()
#define PG8_SCHED __builtin_amdgcn_sched_barrier(0)
    Unit cur, nxt; int ui = 0;
    if (!S.next(0, cur)) return;
    f32x4 acc[2][2][4][2];
#pragma unroll
    for (int a = 0; a < 2; ++a)
#pragma unroll
        for (int b = 0; b < 2; ++b)
#pragma unroll
            for (int m = 0; m < 4; ++m)
#pragma unroll
                for (int n = 0; n < 2; ++n) acc[a][b][m][n] = (f32x4){0.f, 0.f, 0.f, 0.f};
    bf16x8 At[4][2], B0[2][2], B1[2][2];
    const char* cA = (const char*)g.A + (size_t)cur.pm * tstepA + (size_t)cur.kt0 * kstep; const char* cB = (const char*)g.Bt + (size_t)cur.pn * tstepB + (size_t)cur.kt0 * kstep;
    S.a_ready(cur);
    if constexpr (SP2) {
        PG8_STAGE(PG8_SB(0, 0), cB, voffB); PG8_STAGE(PG8_SB(0, 1), cB + hstepB, voffB); PG8_STAGE(PG8_SA(0, 0), cA, voffA); PG8_STAGE(PG8_SA(0, 1), cA + hstepA, voffA);
        if (wr == 1) PG8_BAR;
        PG8_WAIT_V(2); PG8_BAR;
        PG8_STAGE(PG8_SB(1, 0), cB + kstep, voffB); PG8_STAGE(PG8_SA(1, 0), cA + kstep, voffA); PG8_STAGE(PG8_SB(1, 1), cB + hstepB + kstep, voffB);
        PG8_WAIT_V(6); PG8_BAR;
    } else {
        PG8_STAGE(PG8_SB(0, 0), cB, voffB); PG8_STAGE(PG8_SA(0, 0), cA, voffA); PG8_STAGE(PG8_SB(0, 1), cB + hstepB, voffB); PG8_STAGE(PG8_SA(0, 1), cA + hstepA, voffA);
        if (wr == 1) PG8_BAR;
        PG8_WAIT_V(4); PG8_BAR;
        PG8_STAGE(PG8_SB(1, 0), cB + kstep, voffB); PG8_STAGE(PG8_SA(1, 0), cA + kstep, voffA); PG8_STAGE(PG8_SB(1, 1), cB + hstepB + kstep, voffB);
        PG8_WAIT_V(6); PG8_BAR;
    }
    for (;;) {
        const bool has_next = S.next(ui + 1, nxt);
        const char* nA = has_next ? (const char*)g.A + (size_t)nxt.pm * tstepA + (size_t)nxt.kt0 * kstep : cA; const char* nB = has_next ? (const char*)g.Bt + (size_t)nxt.pn * tstepB + (size_t)nxt.kt0 * kstep : cB;
        const int nt = cur.nt > 0 ? cur.nt : ntdef;
        for (int t = 0; t < nt; t += 2) {
            const bool last = (t == nt - 2);
            const char* a1 = cA + (size_t)(t + 1) * kstep;
            const char* a2 = last ? nA : cA + (size_t)(t + 2) * kstep; const char* b2 = last ? nB : cB + (size_t)(t + 2) * kstep;
            const char* a3 = a2 + kstep; const char* b3 = b2 + kstep;
            if (last && has_next) S.a_ready(nxt);
            if constexpr (Epi::MIDK) { if (t == Epi::T1 || t == Epi::T2) E.midk(acc, cur, t == Epi::T1 ? 0 : 1, wr, wc, fr, fq); }
            if constexpr (SP2) {
            PG8_LDB(B0, 0, 0); PG8_LDB(B1, 0, 1); PG8_SCHED; PG8_LDA(At, 0, 0); PG8_STAGE(PG8_SA(1, 1), a1 + hstepA, voffA);
            PG8_WAIT_V(8); PG8_WAIT_L(0); PG8_BAR; PG8_MMA(0, 0, At, B0); PG8_MMA(0, 1, At, B1); PG8_BAR; PG8_SCHED;
            PG8_LDA(At, 0, 1); PG8_STAGE(PG8_SB(0, 0), b2, voffB); PG8_STAGE(PG8_SB(0, 1), b2 + hstepB, voffB); PG8_STAGE(PG8_SA(0, 0), a2, voffA);
            PG8_WAIT_V(8); PG8_WAIT_L(0); PG8_BAR; PG8_MMA(1, 0, At, B0); PG8_MMA(1, 1, At, B1); PG8_BAR; PG8_SCHED;
            PG8_LDB(B0, 1, 0); PG8_LDB(B1, 1, 1); PG8_SCHED; PG8_LDA(At, 1, 0); PG8_STAGE(PG8_SA(0, 1), a2 + hstepA, voffA);
            PG8_WAIT_V(8); PG8_WAIT_L(0); PG8_BAR; PG8_MMA(0, 0, At, B0); PG8_MMA(0, 1, At, B1); PG8_BAR; PG8_SCHED;
            PG8_LDA(At, 1, 1); PG8_STAGE(PG8_SB(1, 0), b3, voffB); PG8_STAGE(PG8_SB(1, 1), b3 + hstepB, voffB); PG8_STAGE(PG8_SA(1, 0), a3, voffA);
            PG8_WAIT_V(8); PG8_WAIT_L(0); PG8_BAR; PG8_MMA(1, 0, At, B0); PG8_MMA(1, 1, At, B1); PG8_BAR; PG8_SCHED;
            } else {
            PG8_LDB(B0, 0, 0); PG8_SCHED; PG8_LDA(At, 0, 0); PG8_STAGE(PG8_SA(1, 1), a1 + hstepA, voffA);
            PG8_WAIT_L(8); PG8_BAR; PG8_WAIT_L(0); PG8_MMA(0, 0, At, B0); PG8_BAR; PG8_SCHED;
            PG8_LDB(B1, 0, 1); PG8_STAGE(PG8_SB(0, 0), b2, voffB);
            PG8_BAR; PG8_WAIT_L(0); PG8_MMA(0, 1, At, B1); PG8_BAR;
            PG8_LDA(At, 0, 1); PG8_STAGE(PG8_SA(0, 0), a2, voffA);
            PG8_BAR; PG8_WAIT_L(0); PG8_MMA(1, 0, At, B0); PG8_BAR; PG8_SCHED;
            PG8_STAGE(PG8_SB(0, 1), b2 + hstepB, voffB);
            PG8_WAIT_V(6); PG8_BAR; PG8_MMA(1, 1, At, B1); PG8_BAR;
            PG8_LDB(B0, 1, 0); PG8_SCHED; PG8_LDA(At, 1, 0); PG8_STAGE(PG8_SA(0, 1), a2 + hstepA, voffA);
            PG8_WAIT_L(8); PG8_BAR; PG8_WAIT_L(0); PG8_MMA(0, 0, At, B0); PG8_BAR; PG8_SCHED;
            PG8_LDB(B1, 1, 1); PG8_STAGE(PG8_SB(1, 0), b3, voffB);
            PG8_BAR; PG8_WAIT_L(0); PG8_MMA(0, 1, At, B1); PG8_BAR;
            PG8_LDA(At, 1, 1); PG8_STAGE(PG8_SA(1, 0), a3, voffA);
            PG8_BAR; PG8_WAIT_L(0); PG8_MMA(1, 0, At, B0); PG8_BAR; PG8_SCHED;
            PG8_STAGE(PG8_SB(1, 1), b3 + hstepB, voffB);
            PG8_WAIT_V(6); PG8_BAR; PG8_MMA(1, 1, At, B1); PG8_BAR;
            }
        }
        if constexpr (ALIGN_EPI) { if (wr == 0) PG8_BAR; }
        if constexpr (!Epi::AFTER_DRAIN) { E(acc, cur, wr, wc, fr, fq); S.done(cur); }
        if (!has_next) break;
#pragma unroll
        for (int a = 0; a < 2; ++a)
#pragma unroll
            for (int b = 0; b < 2; ++b)
#pragma unroll
                for (int m = 0; m < 4; ++m)
#pragma unroll
                    for (int n = 0; n < 2; ++n) acc[a][b][m][n] = (f32x4){0.f, 0.f, 0.f, 0.f};
        cur = nxt; cA = nA; cB = nB; ++ui;
        if constexpr (ALIGN_EPI) { if (wr == 1) PG8_BAR; }
    }
    PG8_WAIT_V(0);
    if constexpr (!ALIGN_EPI) { if (wr == 0) PG8_BAR; }
    PG8_BAR;
    if constexpr (Epi::AFTER_DRAIN) { E.fused(acc, cur, wr, wc, fr, fq, lds, wid, lane); S.done(cur); }
#undef PG8_SA
#undef PG8_SB
#undef PG8_STAGE
#undef PG8_LDA
#undef PG8_LDB
#undef PG8_MMA
#undef PG8_WAIT_V
#undef PG8_WAIT_L
#undef PG8_BAR
#undef PG8_SCHED
}
}

constexpr int DM = 4096, FF = 5632, SEQ = 4096, CTXL = 256, TL = 8192, TC = 512, MR = TL + TC, NLAYER = 2;
constexpr int ZW = 24576, ZN = 24832, INW = 24608, MODW = 36864;
constexpr int Z_DNK = 0, Z_DNV = 1024, Z_NAK = 2048, Z_NAV = 4096, Z_DNQ = 6144, Z_NAQ = 7168, Z_DNG = 9216, Z_GMU = 10240, Z_GMV = 11264, Z_GA = 12288;
constexpr float EPS = 1e-6f;
constexpr int NWAVES = 8, NTHR = 512;
typedef unsigned short bf16;
typedef float f32x4 __attribute__((ext_vector_type(4)));
typedef float f32x2 __attribute__((ext_vector_type(2)));
typedef unsigned v4u __attribute__((ext_vector_type(4)));
typedef unsigned v2u __attribute__((ext_vector_type(2)));
#define GAS __attribute__((address_space(1)))

constexpr size_t al256(size_t x) { return (x + 255) & ~(size_t)255; }
constexpr size_t WS_CTL = 0, CTL_ZERO_BYTES = 1u << 20;
constexpr size_t WS_MOD = CTL_ZERO_BYTES;
constexpr size_t WS_W13 = WS_MOD + al256((size_t)NLAYER * 3 * MODW * 4);
constexpr size_t SZ_W13 = (size_t)2 * FF * DM * 2;
constexpr size_t WS_W2 = WS_W13 + 4 * SZ_W13;
constexpr size_t SZ_W2 = (size_t)DM * FF * 2;
constexpr size_t WS_WIN = WS_W2 + 4 * SZ_W2;
constexpr size_t SZ_WIN = (size_t)ZN * DM * 2;
constexpr size_t WS_PC = WS_WIN + 2 * SZ_WIN;
constexpr size_t SZ_SQ = (size_t)DM * DM * 2;
constexpr size_t WS_WO = WS_PC + 2 * SZ_SQ;
constexpr size_t WS_H = WS_WO + 2 * SZ_SQ;
constexpr size_t WS_XN = WS_H + (size_t)MR * DM * 4;
constexpr size_t WS_HB = WS_XN + (size_t)MR * DM * 2;
constexpr size_t WS_Z = WS_HB + (size_t)MR * FF * 2;
constexpr size_t WS_ZAB = WS_Z + (size_t)MR * ZW * 2;
constexpr size_t SZ_DN = (size_t)MR * 1024 * 4;
constexpr size_t WS_G = WS_ZAB + (size_t)MR * 32 * 4;
constexpr size_t WS_BETA = WS_G + (size_t)MR * 16 * 4;
constexpr size_t WS_OF = WS_BETA + (size_t)MR * 16 * 4, WS_OB = WS_OF + SZ_DN;
constexpr size_t WS_VN = WS_OB + SZ_DN;
constexpr size_t WS_YCAT = WS_VN + SZ_DN;
constexpr size_t WS_YF = WS_YCAT + (size_t)MR * DM * 2;
constexpr size_t WS_YB = WS_YF + (size_t)MR * DM * 4;
constexpr size_t WS_VTL = WS_YB + (size_t)MR * DM * 2;
constexpr size_t WS_VTC = WS_VTL + (size_t)2 * 16 * 128 * SEQ * 2;
constexpr size_t WS_KB = WS_VTC + (size_t)2 * 16 * 128 * CTXL * 2;
constexpr size_t WS_QB = WS_KB + (size_t)MR * 1024 * 2;
constexpr size_t WS_KT = WS_QB + (size_t)MR * 1024 * 2;
constexpr size_t SZ_KT = (size_t)2 * 8 * 128 * (CTXL + SEQ) * 2;
constexpr size_t WS_VT2 = WS_KT + SZ_KT;
constexpr size_t WS_WB = WS_VT2 + SZ_KT;
constexpr size_t WS_UB = WS_WB + (size_t)2176 * 64 * 128 * 2;
constexpr size_t WS_QKM = WS_UB + (size_t)2176 * 64 * 128 * 4;
constexpr size_t WS_EG = WS_QKM + (size_t)2176 * 64 * 64 * 2;
constexpr size_t WS_ROPE = WS_EG + (size_t)2176 * 128 * 4;
constexpr size_t WS_SLAB = WS_ROPE + 2048 * 2 * 4;
constexpr size_t WS_GF = WS_SLAB + (size_t)8 * TC * DM * 4;
constexpr size_t WS_END = WS_GF + (size_t)32 * 48 * 8 * 16 * 64 * 8 * 2;
constexpr int CW_AQ = 1024;
constexpr int CW_FN = 2048;
constexpr int CW_UF = 8192;
constexpr int CW_BAR = 4096;

constexpr int RING_BYTES = 131072, MISC_OFF = RING_BYTES + 320, LDS_BYTES = 147456;

#define LAS __attribute__((address_space(3)))
#define LDS_WAIT() asm volatile("s_waitcnt lgkmcnt(0)" ::: "memory")
#define VM_WAIT() asm volatile("s_waitcnt vmcnt(0)" ::: "memory")
#define XB_TMO      128
#define XB_XCNT(j)  (256  + 64 * (j))
#define XB_XSUB(j)  (1280 + 64 * (j))
#define XB_XGEN(j)  (2304 + 64 * (j))
#define XB_TOP      3328
#define XB_TOPGEN   3392
#define XCD_BAR_WORDS 3456
#define XB_SPIN_CAP (1u << 18)

__device__ __forceinline__ unsigned xb_ld(unsigned* p)              { return __hip_atomic_load(p, __ATOMIC_RELAXED, __HIP_MEMORY_SCOPE_AGENT); }
__device__ __forceinline__ unsigned xb_add(unsigned* p, unsigned v) { return __hip_atomic_fetch_add(p, v, __ATOMIC_RELAXED, __HIP_MEMORY_SCOPE_AGENT); }
__device__ __forceinline__ unsigned xb_xcc_id() { return (unsigned)__builtin_amdgcn_s_getreg((3 << 11) | 20) & 0xFu; }
#define XB_SPIN(cond, bar) do { unsigned _sp = 0; while (cond) { __builtin_amdgcn_s_sleep(1); \
    if ((++_sp & 255u) == 0u) { if (xb_ld(&(bar)[XB_TMO])) break; if (_sp > XB_SPIN_CAP) { atomicAdd(&(bar)[XB_TMO], 1u); break; } } } } while (0)

struct XcdBarrier {
    unsigned* bar; unsigned x;
    volatile LAS unsigned* st;
};

__device__ __forceinline__ XcdBarrier xcd_barrier_post(unsigned* bar, volatile LAS unsigned* st) {
    XcdBarrier b; b.bar = bar; b.x = xb_xcc_id(); b.st = st;
    if (threadIdx.x == 0) (void)xb_add(&bar[XB_XCNT(b.x)], 1u);
    return b;
}
__device__ __forceinline__ void xcd_barrier_complete(unsigned* bar, unsigned x, unsigned& nloc, unsigned& nx) {
    const unsigned G = gridDim.x * gridDim.y * gridDim.z;
    unsigned sum, cnt, mine, sp = 0u;
    for (;;) {
        sum = 0u; cnt = 0u; mine = 0u;
#pragma unroll
        for (unsigned j = 0; j < 16; ++j) { const unsigned c = xb_ld(&bar[XB_XCNT(j)]); sum += c; cnt += (c > 0u) ? 1u : 0u; mine = (j == x) ? c : mine; }
        if (sum == G) break;
        __builtin_amdgcn_s_sleep(1);
        if ((++sp & 255u) == 0u) { if (xb_ld(&bar[XB_TMO])) break; if (sp > XB_SPIN_CAP) { atomicAdd(&bar[XB_TMO], 1u); break; } }
    }
    nloc = mine > 0u ? mine : 1u; nx = cnt > 0u ? cnt : 1u;
}

__device__ __forceinline__ void xcd_barrier(const XcdBarrier& b) {
    asm volatile("s_waitcnt vmcnt(0)" ::: "memory");
    __syncthreads();
    if (threadIdx.x == 0) {
        unsigned* bar = b.bar;
        __builtin_amdgcn_s_waitcnt(0);
        unsigned nloc = b.st[0], nx = b.st[1];
        if (nloc == 0u) { xcd_barrier_complete(bar, b.x, nloc, nx); b.st[0] = nloc; b.st[1] = nx; }
        const unsigned old = xb_add(&bar[XB_XSUB(b.x)], 1u);
        const unsigned gen = old / nloc;
        if (old + 1u == (gen + 1u) * nloc) {
            __builtin_amdgcn_fence(__ATOMIC_RELEASE, "agent");
            asm volatile("s_waitcnt vmcnt(0)" ::: "memory");
            const unsigned og = xb_add(&bar[XB_TOP], 1u);
            const unsigned tg = og / nx;
            if (og + 1u == (tg + 1u) * nx) xb_add(&bar[XB_TOPGEN], 1u);
            else XB_SPIN(xb_ld(&bar[XB_TOPGEN]) == tg, bar);
            __builtin_amdgcn_fence(__ATOMIC_ACQUIRE, "agent");
            xb_add(&bar[XB_XGEN(b.x)], 1u);
            asm volatile("s_waitcnt vmcnt(0)" ::: "memory");
        } else {
            XB_SPIN(xb_ld(&bar[XB_XGEN(b.x)]) == gen, bar);
            __builtin_amdgcn_fence(__ATOMIC_ACQUIRE, "agent");
            asm volatile("s_waitcnt vmcnt(0)" ::: "memory");
        }
    }
    __syncthreads();
}

__device__ __forceinline__ float wave_sum(float v) {
#pragma unroll
    for (int o = 1; o < 64; o <<= 1) v += __shfl_xor(v, o);
    return v;
}
__device__ __forceinline__ float wave_max(float v) {
#pragma unroll
    for (int o = 1; o < 64; o <<= 1) v = fmaxf(v, __shfl_xor(v, o));
    return v;
}
__device__ __forceinline__ float bflo(unsigned u) { return __builtin_bit_cast(float, u << 16); }
__device__ __forceinline__ float bfhi(unsigned u) { return __builtin_bit_cast(float, u & 0xffff0000u); }
typedef __bf16 bf16x2v_t __attribute__((ext_vector_type(2)));
__device__ __forceinline__ unsigned pk2(float lo, float hi) { bf16x2v_t v = {(__bf16)lo, (__bf16)hi}; return __builtin_bit_cast(unsigned, v); }
__device__ __forceinline__ float sigmoidf_(float x) { return 1.0f / (1.0f + __expf(-x)); }
__device__ __forceinline__ float siluf_(float x) { return x * sigmoidf_(x); }
__device__ __forceinline__ float gelu_tanh(float x) { const float u = 1.5957691216057308f * (x + 0.044715f * x * x * x); return x / (1.0f + __expf(-u)); }
__device__ __forceinline__ void row_info(int row, int& base, int& t, int& T, int& v) {
    if (row < TL) { const int b = row >> 12; base = b << 12; t = row & 4095; T = SEQ; v = b; }
    else { const int r = row - TL; const int b = r >> 8; base = TL + (b << 8); t = r & 255; T = CTXL; v = 2; }
}

__device__ __forceinline__ void cvt_load(const float* __restrict__ W, int N, int k0, int n0, float (&t)[32], int lane) {
    const unsigned loff = (unsigned)((lane >> 5) * N + (lane & 31));
#pragma unroll
    for (int i = 0; i < 32; ++i) { const float* pr = W + (size_t)(k0 + 2 * i) * N + n0; asm volatile("" : "+s"(pr)); t[i] = __builtin_nontemporal_load((const GAS float*)pr + loff); }
}
__device__ __forceinline__ void cvt_lds(const float (&t)[32], LAS float* scr, int lane) {
#pragma unroll
    for (int i = 0; i < 32; ++i) scr[(2 * i + (lane >> 5)) * 33 + (lane & 31)] = t[i];
    LDS_WAIT(); asm volatile("" ::: "memory");
}
__device__ __forceinline__ void cvt_store(bf16* WT, size_t dpitch, int k0, size_t dbase, LAS float* scr, int lane) {
    const int c = lane & 7;
#pragma unroll
    for (int j = 0; j < 4; ++j) { const int n = (lane >> 3) + 8 * j; const LAS float* s = scr + (8 * c) * 33 + n;
        v4u o; o.x = pk2(s[0 * 33], s[1 * 33]); o.y = pk2(s[2 * 33], s[3 * 33]); o.z = pk2(s[4 * 33], s[5 * 33]); o.w = pk2(s[6 * 33], s[7 * 33]);
        __builtin_nontemporal_store(o, (GAS v4u*)(WT + dbase + (size_t)n * dpitch + k0 + 8 * c)); }
    LDS_WAIT(); asm volatile("" ::: "memory");
}
template <int MODE> __device__ __forceinline__ void cvt_matrix(const float* __restrict__ W, int K, int N, bf16* WT, size_t dpitch, int koff, int gw, int NGW, LAS float* scr, int lane) {
    const int nblk = N / 32, ngroups = (K / 512) * nblk, wg = gw >> 3, G_ = NGW >> 3, wv = gw & 7;
    float t[32];
    if (wg < ngroups) { const int kq = wg / nblk, nb = wg - kq * nblk; cvt_load(W, N, (8 * kq + wv) * 64, nb * 32, t, lane); }
    for (int gi = wg; gi < ngroups; gi += G_) {
        const int kq = gi / nblk, nb = gi - kq * nblk, kb = 8 * kq + wv, n0 = nb * 32;
        int drow0;
        if (MODE == 0) drow0 = n0;
        else if (MODE == 1) drow0 = (n0 >> 7) * 256 + (n0 & 127);
        else if (MODE == 2) drow0 = (n0 >> 7) * 256 + 128 + (n0 & 127);
        else drow0 = nb < 64 ? n0 : (nb == 64 ? ZW : n0 - 32);
        cvt_lds(t, scr, lane);
        { const int g2 = gi + G_; if (g2 < ngroups) { const int kq2 = g2 / nblk, nb2 = g2 - kq2 * nblk; cvt_load(W, N, (8 * kq2 + wv) * 64, nb2 * 32, t, lane); } }
        cvt_store(WT, dpitch, kb * 64, (size_t)drow0 * dpitch + koff, scr, lane);
    }
}

__device__ __forceinline__ void mod_phase(const float* __restrict__ cvec, const float* __restrict__ cctx, const float* __restrict__ ada_w, const float* __restrict__ ada_b, float* mod,
                                          LAS unsigned char* lds, int tid, int lane, int wave, int bid, int G, int l_lo, int l_hi) {
    LAS float* sc = (LAS float*)lds;
    LAS float* red = (LAS float*)(lds + 49152);
    for (int i = tid; i < 3 * DM; i += NTHR) { const int v = i >> 12, k = i & 4095; const float x = v < 2 ? cvec[v * DM + k] : cctx[k]; sc[i] = siluf_(x); }
    __syncthreads();
    const int cl = lane & 15, kr = lane >> 4;
    for (int item = l_lo * (MODW / 64) + bid; item < l_hi * (MODW / 64); item += G) {
        const int l = item / (MODW / 64), cb = item - l * (MODW / 64), col0 = cb * 64;
        const float* wp = ada_w + (size_t)l * DM * MODW + col0 + 4 * cl;
        f32x4 a0 = {0.f, 0.f, 0.f, 0.f}, a1 = a0, a2 = a0;
#pragma unroll 8
        for (int i = 0; i < 128; ++i) { const int k = wave * 4 + kr + 32 * i;
            const f32x4 w = *(const f32x4*)(wp + (size_t)k * MODW);
            a0 += w * sc[k]; a1 += w * sc[DM + k]; a2 += w * sc[2 * DM + k]; }
#pragma unroll
        for (int e = 0; e < 4; ++e) { a0[e] += __shfl_xor(a0[e], 16); a0[e] += __shfl_xor(a0[e], 32); a1[e] += __shfl_xor(a1[e], 16); a1[e] += __shfl_xor(a1[e], 32); a2[e] += __shfl_xor(a2[e], 16); a2[e] += __shfl_xor(a2[e], 32); }
        if (kr == 0) {
#pragma unroll
            for (int e = 0; e < 4; ++e) { red[(wave * 3 + 0) * 64 + 4 * cl + e] = a0[e]; red[(wave * 3 + 1) * 64 + 4 * cl + e] = a1[e]; red[(wave * 3 + 2) * 64 + 4 * cl + e] = a2[e]; } }
        __syncthreads();
        if (tid < 192) { const int v = tid >> 6, c = tid & 63; float s = 0.f;
#pragma unroll
            for (int w = 0; w < 8; ++w) s += red[(w * 3 + v) * 64 + c];
            mod[((size_t)l * 3 + v) * MODW + col0 + c] = s + ada_b[(size_t)l * MODW + col0 + c]; }
        __syncthreads();
    }
}

__device__ __forceinline__ void norm_phase(const float* in_lat, const float* in_ctx, const float* __restrict__ nw, const float* modl  , int isub, bf16* xn, int nrows,
                                           const float* slab, const float* gatev, float coef, float* hctx_out, LAS unsigned char* lds, int tid, int lane, int gw, int NGW) {
    LAS float* AL = (LAS float*)lds;
    LAS float* SL = AL + 3 * DM;
    __syncthreads();
    for (int i = tid; i < 3 * DM / 4; i += NTHR) { const int v = i >> 10, c = (i & 1023) * 4;
        const f32x4 w = *(const f32x4*)(nw + c), sc = *(const f32x4*)(modl + (size_t)v * MODW + (isub * 3 + 1) * DM + c), sh = *(const f32x4*)(modl + (size_t)v * MODW + (isub * 3 + 0) * DM + c);
        *(LAS f32x4*)(AL + v * DM + c) = w * (sc + 1.0f); *(LAS f32x4*)(SL + v * DM + c) = sh; }
    __syncthreads();
    f32x4 xq[16];
    if (gw < nrows) { const float* s0 = gw < TL ? in_lat + (size_t)gw * DM : in_ctx + (size_t)(gw - TL) * DM;
#pragma unroll
        for (int j = 0; j < 16; ++j) xq[j] = *(const f32x4*)(s0 + 4 * (lane + 64 * j)); }
    for (int row = gw; row < nrows; row += NGW) {
        const int v = row < SEQ ? 0 : (row < TL ? 1 : 2);
        f32x4 x[16]; float ss = 0.f;
#pragma unroll
        for (int j = 0; j < 16; ++j) x[j] = xq[j];
        { const int nr = row + NGW;
          if (nr < nrows) { const float* s1 = nr < TL ? in_lat + (size_t)nr * DM : in_ctx + (size_t)(nr - TL) * DM;
#pragma unroll
            for (int j = 0; j < 16; ++j) xq[j] = *(const f32x4*)(s1 + 4 * (lane + 64 * j)); } }
        if (slab != nullptr && row >= TL) {
            float* ho = hctx_out + (size_t)(row - TL) * DM;
#pragma unroll
            for (int j = 0; j < 16; ++j) { const int c = 4 * (lane + 64 * j); f32x4 s = *(const f32x4*)(slab + (size_t)(row - TL) * DM + c);
#pragma unroll
                for (int k = 1; k < 8; ++k) s += *(const f32x4*)(slab + ((size_t)k * 512 + (row - TL)) * DM + c);
                x[j] += (*(const f32x4*)(gatev + c) * coef) * s; *(f32x4*)(ho + c) = x[j]; }
        }
#pragma unroll
        for (int j = 0; j < 16; ++j) ss += (x[j][0] * x[j][0] + x[j][1] * x[j][1]) + (x[j][2] * x[j][2] + x[j][3] * x[j][3]);
        const float r = 1.0f / sqrtf(wave_sum(ss) * (1.0f / DM) + EPS);
#pragma unroll
        for (int j = 0; j < 16; ++j) { const int c = 4 * (lane + 64 * j);
            const f32x4 a = *(const LAS f32x4*)(AL + v * DM + c), sh = *(const LAS f32x4*)(SL + v * DM + c);
            const f32x4 y = (x[j] * r) * a + sh;
            v2u o; o.x = pk2(y[0], y[1]); o.y = pk2(y[2], y[3]);
            *(v2u*)(xn + (size_t)row * DM + c) = o; }
    }
}
__device__ __forceinline__ void final_norm_phase(const float* h, const float* __restrict__ fw, float* out, int lane, int gw, int NGW) {
    for (int row = gw; row < TL; row += NGW) {
        const float* src = h + (size_t)row * DM;
        f32x4 x[16]; float ss = 0.f;
#pragma unroll
        for (int j = 0; j < 16; ++j) { x[j] = *(const f32x4*)(src + 4 * (lane + 64 * j)); ss += (x[j][0] * x[j][0] + x[j][1] * x[j][1]) + (x[j][2] * x[j][2] + x[j][3] * x[j][3]); }
        const float r = 1.0f / sqrtf(wave_sum(ss) * (1.0f / DM) + EPS);
#pragma unroll
        for (int j = 0; j < 16; ++j) { const int c = 4 * (lane + 64 * j); const f32x4 w = *(const f32x4*)(fw + c);
            *(f32x4*)(out + (size_t)row * DM + c) = (x[j] * r) * w;
            if ((j & 3) == 3) asm volatile("" ::: "memory"); }
    }
}

__device__ __forceinline__ void gm_prep_phase(const bf16* z, const float* __restrict__ snw, float* vn, int lane, int gw, int NGW) {
    v4u pu[2] = {{0u, 0u, 0u, 0u}, {0u, 0u, 0u, 0u}};
    if (gw < MR) { pu[0] = *(const v4u*)(z + (size_t)gw * ZW + Z_GMV + 8 * lane); pu[1] = *(const v4u*)(z + (size_t)gw * ZW + Z_GMV + 8 * lane + 512); }
    for (int row = gw; row < MR; row += NGW) {
        float x[16]; float s = 0.f;
        const v4u cu0 = pu[0], cu1 = pu[1];
        if (row + NGW < MR) { pu[0] = *(const v4u*)(z + (size_t)(row + NGW) * ZW + Z_GMV + 8 * lane); pu[1] = *(const v4u*)(z + (size_t)(row + NGW) * ZW + Z_GMV + 8 * lane + 512); }
#pragma unroll
        for (int j = 0; j < 2; ++j) { const v4u u = j ? cu1 : cu0;
            x[8 * j + 0] = gelu_tanh(bflo(u.x)); x[8 * j + 1] = gelu_tanh(bfhi(u.x)); x[8 * j + 2] = gelu_tanh(bflo(u.y)); x[8 * j + 3] = gelu_tanh(bfhi(u.y));
            x[8 * j + 4] = gelu_tanh(bflo(u.z)); x[8 * j + 5] = gelu_tanh(bfhi(u.z)); x[8 * j + 6] = gelu_tanh(bflo(u.w)); x[8 * j + 7] = gelu_tanh(bfhi(u.w)); }
#pragma unroll
        for (int i = 0; i < 16; ++i) s += x[i];
        const float mu = wave_sum(s) * (1.0f / 1024.0f); float q = 0.f;
#pragma unroll
        for (int i = 0; i < 16; ++i) { x[i] -= mu; q += x[i] * x[i]; }
        const float rs = 1.0f / sqrtf(wave_sum(q) * (1.0f / 1024.0f) + EPS);
#pragma unroll
        for (int j = 0; j < 2; ++j) { const int c = 8 * lane + 512 * j;
            const f32x4 w0 = *(const f32x4*)(snw + c), w1 = *(const f32x4*)(snw + c + 4);
            *(f32x4*)(vn + (size_t)row * 1024 + c) = (f32x4){x[8 * j + 0] * rs * w0[0], x[8 * j + 1] * rs * w0[1], x[8 * j + 2] * rs * w0[2], x[8 * j + 3] * rs * w0[3]};
            *(f32x4*)(vn + (size_t)row * 1024 + c + 4) = (f32x4){x[8 * j + 4] * rs * w1[0], x[8 * j + 5] * rs * w1[1], x[8 * j + 6] * rs * w1[2], x[8 * j + 7] * rs * w1[3]}; }
    }
}

__device__ __forceinline__ void dn_out_phase(const float* of, const float* ob, const bf16* z, const float* __restrict__ dnw, bf16* ycat, int nrows, int lane, int gw, int NGW) {
    const int sub = lane >> 4, l16 = lane & 15;
    const f32x4 w0 = *(const f32x4*)(dnw + 8 * l16), w1 = *(const f32x4*)(dnw + 8 * l16 + 4);
    f32x4 pf0 = {0.f, 0.f, 0.f, 0.f}, pf1 = pf0, pb0 = pf0, pb1 = pf0; v4u pg = {0u, 0u, 0u, 0u};
    { const int it0 = gw * 4 + sub; if (it0 < nrows * 8) { const int row = it0 >> 3, hd = it0 & 7; const size_t o = (size_t)row * 1024 + hd * 128 + 8 * l16;
        pf0 = *(const f32x4*)(of + o); pf1 = *(const f32x4*)(of + o + 4); pb0 = *(const f32x4*)(ob + o); pb1 = *(const f32x4*)(ob + o + 4); pg = *(const v4u*)(z + (size_t)row * ZW + Z_DNG + hd * 128 + 8 * l16); } }
    for (int it = gw * 4 + sub; it < nrows * 8; it += NGW * 4) {
        const int row = it >> 3, hd = it & 7;
        f32x4 a0 = pf0 + pb0, a1 = pf1 + pb1; const v4u gu = pg;
        { const int it2 = it + NGW * 4; if (it2 < nrows * 8) { const int row2 = it2 >> 3, hd2 = it2 & 7; const size_t o2 = (size_t)row2 * 1024 + hd2 * 128 + 8 * l16;
            pf0 = *(const f32x4*)(of + o2); pf1 = *(const f32x4*)(of + o2 + 4); pb0 = *(const f32x4*)(ob + o2); pb1 = *(const f32x4*)(ob + o2 + 4); pg = *(const v4u*)(z + (size_t)row2 * ZW + Z_DNG + hd2 * 128 + 8 * l16); } }
        float ss = (a0[0] * a0[0] + a0[1] * a0[1]) + (a0[2] * a0[2] + a0[3] * a0[3]) + (a1[0] * a1[0] + a1[1] * a1[1]) + (a1[2] * a1[2] + a1[3] * a1[3]);
        ss += __shfl_xor(ss, 1); ss += __shfl_xor(ss, 2); ss += __shfl_xor(ss, 4); ss += __shfl_xor(ss, 8);
        const float r = 1.0f / sqrtf(ss * (1.0f / 128.0f) + EPS);
        v4u out; out.x = pk2(a0[0] * r * w0[0] * siluf_(bflo(gu.x)), a0[1] * r * w0[1] * siluf_(bfhi(gu.x))); out.y = pk2(a0[2] * r * w0[2] * siluf_(bflo(gu.y)), a0[3] * r * w0[3] * siluf_(bfhi(gu.y)));
        out.z = pk2(a1[0] * r * w1[0] * siluf_(bflo(gu.z)), a1[1] * r * w1[1] * siluf_(bfhi(gu.z))); out.w = pk2(a1[2] * r * w1[2] * siluf_(bflo(gu.w)), a1[3] * r * w1[3] * siluf_(bfhi(gu.w)));
        *(v4u*)(ycat + (size_t)row * DM + 1024 + hd * 128 + 8 * l16) = out;
    }
}
__device__ __forceinline__ void merge_ctx_phase(const float* slab, const bf16* z, bf16* yb, int lane, int gw, int NGW) {
    for (int r = gw; r < TC; r += NGW) { const size_t row = (size_t)TL + r;
#pragma unroll 4
        for (int j = 0; j < 16; ++j) { const int c = 4 * (lane + 64 * j); f32x4 y = {0.f, 0.f, 0.f, 0.f};
#pragma unroll
            for (int br = 0; br < 3; ++br) { const v2u gu = *(const v2u*)(z + row * ZW + Z_GA + br * 4096 + c);
                f32x4 s = {0.f, 0.f, 0.f, 0.f};
#pragma unroll
                for (int k = (br == 0 ? 0 : (br == 1 ? 2 : 4)); k < (br == 0 ? 2 : (br == 1 ? 4 : 8)); ++k) s += *(const f32x4*)(slab + ((size_t)k * 512 + r) * DM + c);
                y[0] += sigmoidf_(bflo(gu.x)) * s[0]; y[1] += sigmoidf_(bfhi(gu.x)) * s[1]; y[2] += sigmoidf_(bflo(gu.y)) * s[2]; y[3] += sigmoidf_(bfhi(gu.y)) * s[3]; }
            v2u o; o.x = pk2(y[0], y[1]); o.y = pk2(y[2], y[3]); *(v2u*)(yb + row * DM + c) = o; }
    }
}

__device__ __forceinline__ void vt_phase(const bf16* z, bf16* vf, bf16* vtc, LAS unsigned char* lds, int lane, int wave, int gw, int NGW) {
    LAS unsigned short* T = (LAS unsigned short*)(lds + wave * 8448);
    constexpr int NIT = 2 * 16 * 4 * 2;
    for (int it = gw; it < NIT; it += NGW) {
        const int dh = it & 1; int r = it >> 1; const int tb = 64 + (r & 3); r >>= 2; const int h = r & 15, b = r >> 4;
        const int row0 = tb < 64 ? b * SEQ + tb * 64 : TL + b * CTXL + (tb - 64) * 64;
#pragma unroll
        for (int j = 0; j < 8; ++j) { const int tok = 8 * j + (lane >> 3), ch = lane & 7;
            const v4u v = *(const v4u*)(z + (size_t)(row0 + tok) * ZW + Z_NAV + h * 128 + dh * 64 + 8 * ch);
            LAS unsigned* d = (LAS unsigned*)(T + tok * 66 + 8 * ch); d[0] = v.x; d[1] = v.y; d[2] = v.z; d[3] = v.w; }
        LDS_WAIT(); asm volatile("" ::: "memory");
        unsigned w[32];
#pragma unroll
        for (int t = 0; t < 32; ++t) w[t] = (unsigned)T[(2 * t) * 66 + lane] | ((unsigned)T[(2 * t + 1) * 66 + lane] << 16);
        if (tb < 64) { bf16* dst = vf + (((size_t)(b * 16 + h) * 512 + tb * 8) * 128 + dh * 64 + lane) * 8;
#pragma unroll
            for (int j = 0; j < 8; ++j) *(v4u*)(dst + (size_t)j * 1024) = (v4u){w[4 * j], w[4 * j + 1], w[4 * j + 2], w[4 * j + 3]};
        } else { bf16* dst = vtc + ((size_t)(b * 16 + h) * 128 + dh * 64 + lane) * CTXL + (tb - 64) * 64;
#pragma unroll
            for (int j = 0; j < 8; ++j) *(v4u*)(dst + 8 * j) = (v4u){w[4 * j], w[4 * j + 1], w[4 * j + 2], w[4 * j + 3]}; }
        LDS_WAIT(); asm volatile("" ::: "memory");
    }
}

typedef short bf16x8_t __attribute__((ext_vector_type(8)));
struct AttnState { float mrun, lrun; f32x4 oa[8]; };
template <bool LOC, bool QFR> __device__ __forceinline__ void attn_chunk(AttnState& st, const char* qbase, const char* kbase, const char* vbase,
                                                               const LAS unsigned char* KL, const LAS unsigned char* VL, const LAS float* rpbL, int cc, int drow0, int lo, int cg, int lane) {
    asm volatile("" : "+v"(lane));
    const int q = lane & 15, g = lane >> 4, krl = 8 * (q >> 2) + (q & 3);
    const int c = 16 * cg + q, c0 = min(max(c - 8, 0), 48);
    const unsigned kloff = (unsigned)((q >> 2) * 2048 + g * 64 + (q & 3) * 16), vloff = (unsigned)(g * 2048 + q * 16), qloff = QFR ? (unsigned)lane * 16u : (unsigned)(q * ZW + 8 * g) * 2u;
    const float scale = 0.08838834764831845f;
    f32x4 sX[4], sY[4];
    bf16x8_t fr[LOC ? 4 : 1][8];
    bf16x8_t qf[4];
#pragma unroll
    for (int k = 0; k < 4; ++k) qf[k] = *(const GAS bf16x8_t*)((const GAS char*)qbase + qloff + (QFR ? 1024 : 64) * k);
    if constexpr (LOC) {
#pragma unroll
        for (int i = 0; i < 4; ++i) { const char* pk = kbase + (size_t)i * 16384; asm volatile("" : "+s"(pk));
#pragma unroll
            for (int y = 0; y < 2; ++y)
#pragma unroll
                for (int k = 0; k < 4; ++k) fr[i][4 * y + k] = *(const GAS bf16x8_t*)((const GAS char*)pk + kloff + (1024 * y + 256 * k)); }
        asm volatile("" ::: "memory");
#pragma unroll
        for (int i = 0; i < 4; ++i) { f32x4 ax = {0.f, 0.f, 0.f, 0.f}, ay = ax;
#pragma unroll
            for (int k = 0; k < 4; ++k) { ax = __builtin_amdgcn_mfma_f32_16x16x32_bf16(fr[i][k], qf[k], ax, 0, 0, 0); ay = __builtin_amdgcn_mfma_f32_16x16x32_bf16(fr[i][4 + k], qf[k], ay, 0, 0, 0); }
            sX[i] = ax; sY[i] = ay; }
#pragma unroll
        for (int i = 0; i < 4; ++i) { const char* pv = vbase + (size_t)i * 16384; asm volatile("" : "+s"(pv));
#pragma unroll
            for (int d = 0; d < 8; ++d) fr[i][d] = *(const GAS bf16x8_t*)((const GAS char*)pv + vloff + 256 * d); }
        asm volatile("" ::: "memory");
    } else {
#pragma unroll
        for (int i = 0; i < 4; ++i) { const int keyx = 128 * cc + 32 * i + krl, keyy = keyx + 4;
            const int fx = ((keyx & 15) + 4 * ((keyx >> 4) & 1)) & 15, fy = ((keyy & 15) + 4 * ((keyy >> 4) & 1)) & 15;
            bf16x8_t kx[4], ky[4];
#pragma unroll
            for (int k = 0; k < 4; ++k) { kx[k] = *(const LAS bf16x8_t*)(KL + keyx * 256 + (((4 * k + g) ^ fx) << 4)); ky[k] = *(const LAS bf16x8_t*)(KL + keyy * 256 + (((4 * k + g) ^ fy) << 4)); }
            f32x4 ax = {0.f, 0.f, 0.f, 0.f}, ay = ax;
#pragma unroll
            for (int k = 0; k < 4; ++k) { ax = __builtin_amdgcn_mfma_f32_16x16x32_bf16(kx[k], qf[k], ax, 0, 0, 0); ay = __builtin_amdgcn_mfma_f32_16x16x32_bf16(ky[k], qf[k], ay, 0, 0, 0); }
            sX[i] = ax; sY[i] = ay; }
    }
    float mx = -3.0e38f;
#pragma unroll
    for (int i = 0; i < 4; ++i) {
#pragma unroll
        for (int e = 0; e < 4; ++e) {
            float x = sX[i][e] * scale, y = sY[i][e] * scale;
            if constexpr (LOC) { const int kcx = lo + 8 * g + e, kcy = kcx + 4; const int dr = drow0 + i;
                const bool vx = (kcx >= c0) && (kcx < c0 + 16), vy = (kcy >= c0) && (kcy < c0 + 16);
                const float bx = rpbL[dr * 31 + min(max(kcx - c + 15, 0), 30)], by = rpbL[dr * 31 + min(max(kcy - c + 15, 0), 30)];
                x = vx ? x + bx : -1.0e30f; y = vy ? y + by : -1.0e30f; }
            sX[i][e] = x; sY[i][e] = y; mx = fmaxf(mx, fmaxf(x, y)); }
    }
    mx = fmaxf(mx, __shfl_xor(mx, 16)); mx = fmaxf(mx, __shfl_xor(mx, 32));
    const float mnew = fmaxf(st.mrun, mx), alpha = __expf(st.mrun - mnew);
    st.mrun = mnew;
    float psum = 0.f;
#pragma unroll
    for (int i = 0; i < 4; ++i)
#pragma unroll
        for (int e = 0; e < 4; ++e) { const float x = __expf(sX[i][e] - mnew), y = __expf(sY[i][e] - mnew); sX[i][e] = x; sY[i][e] = y; psum += x + y; }
    st.lrun = st.lrun * alpha + psum;
#pragma unroll
    for (int d = 0; d < 8; ++d) st.oa[d] *= alpha;
#pragma unroll
    for (int i = 0; i < 4; ++i) {
        v4u pu; pu.x = pk2(sX[i][0], sX[i][1]); pu.y = pk2(sX[i][2], sX[i][3]); pu.z = pk2(sY[i][0], sY[i][1]); pu.w = pk2(sY[i][2], sY[i][3]);
        const bf16x8_t pf = __builtin_bit_cast(bf16x8_t, pu);
        if constexpr (LOC) {
#pragma unroll
            for (int d = 0; d < 8; ++d) st.oa[d] = __builtin_amdgcn_mfma_f32_16x16x32_bf16(fr[i][d], pf, st.oa[d], 0, 0, 0);
        } else { const int chn = 16 * cc + 4 * i + g; bf16x8_t vf[8];
#pragma unroll
            for (int d = 0; d < 8; ++d) vf[d] = *(const LAS bf16x8_t*)(VL + (16 * d + q) * 512 + ((chn ^ q) << 4));
#pragma unroll
            for (int d = 0; d < 8; ++d) st.oa[d] = __builtin_amdgcn_mfma_f32_16x16x32_bf16(vf[d], pf, st.oa[d], 0, 0, 0); }
    }
}
template <bool LOCAL> __device__ __forceinline__ void attn_unit(const bf16* z, const bf16* qfb, const bf16* vtl  , const bf16* kf, const LAS unsigned char* KL, const LAS unsigned char* VL, const LAS float* rpbL, bf16* ycat, int b, int r, int cg, int qb, int h, int lane) {
    const int qrow0 = LOCAL ? (b * SEQ + r * 64 + 16 * cg) : (TL + b * CTXL + 16 * qb);
    const int r0 = min(max(r - 4, 0), 56), lo = min(max(16 * cg - 8, 0), 32);
    const char* qbase = LOCAL ? (const char*)qfb + (((size_t)(b * 16 + h) * 256 + r * 4 + cg) * 4) * 1024 : (const char*)(z + (size_t)qrow0 * ZW + Z_NAQ + h * 128);
    AttnState st; st.mrun = -3.0e38f; st.lrun = 0.f;
#pragma unroll
    for (int d = 0; d < 8; ++d) st.oa[d] = (f32x4){0.f, 0.f, 0.f, 0.f};
    if constexpr (LOCAL) {
#pragma unroll 1
        for (int ck = 0; ck < 2; ++ck) {
            const int tok0 = (r0 + 4 * ck) * 64 + lo;
            const char* kbase = (const char*)kf + ((size_t)(b * 16 + h) * 1024 + (tok0 >> 2)) * 1024;
            const char* vbase = (const char*)vtl + ((size_t)(b * 16 + h) * 512 + (tok0 >> 3)) * 2048;
            attn_chunk<true, true>(st, qbase, kbase, vbase, KL, VL, rpbL, 0, r0 + 4 * ck - r + 7, lo, cg, lane);
        }
    }
#pragma unroll 1
    for (int cc = 0; cc < 2; ++cc) attn_chunk<false, LOCAL>(st, qbase, nullptr, nullptr, KL, VL, rpbL, cc, 0, 0, 0, lane);
    asm volatile("" : "+v"(lane));
    const int q = lane & 15, g = lane >> 4;
    float lrun = st.lrun;
    lrun += __shfl_xor(lrun, 16); lrun += __shfl_xor(lrun, 32);
    const float inv = 1.0f / lrun;
    bf16* op = ycat + (size_t)(qrow0 + q) * DM + 2048 + h * 128 + 4 * g;
#pragma unroll
    for (int d = 0; d < 8; ++d) { v2u o; o.x = pk2(st.oa[d][0] * inv, st.oa[d][1] * inv); o.y = pk2(st.oa[d][2] * inv, st.oa[d][3] * inv); *(v2u*)(op + 16 * d) = o; }
}

__device__ __forceinline__ int attn_item_bh(int it) { return (it & 7) + 8 * ((it >> 3) & 3); }
__device__ __forceinline__ void attn_wg(int it, const bf16* z, const bf16* vtl  , const bf16* kf, const bf16* qfb, const bf16* vtc, const float* __restrict__ rpb  , bf16* ycat, bool ctxq, bool stage, LAS unsigned char* lds, int tid) {
    const int bh = attn_item_bh(it), rp = it >> 5, b = bh >> 4, h = bh & 15;
    LAS unsigned char* KL = lds; LAS unsigned char* VL = lds + 65536; LAS float* rpbL = (LAS float*)(lds + RING_BYTES + 1024);
    asm volatile("" : "+v"(tid));
    __syncthreads();
    if (stage) {
#pragma unroll
    for (int j = 0; j < 8; ++j) { const int i = tid + NTHR * j; const int key = i >> 4, ch = i & 15; const int fk = ((key & 15) + 4 * ((key >> 4) & 1)) & 15;
        *(LAS v4u*)(KL + key * 256 + ((ch ^ fk) << 4)) = *(const v4u*)(z + (size_t)(TL + b * CTXL + key) * ZW + Z_NAK + h * 128 + 8 * ch); }
#pragma unroll
    for (int j = 0; j < 8; ++j) { const int i = tid + NTHR * j; const int dim = i >> 5, ch = i & 31;
        *(LAS v4u*)(VL + dim * 512 + ((ch ^ (dim & 15)) << 4)) = *(const v4u*)(vtc + ((size_t)(b * 16 + h) * 128 + dim) * CTXL + 8 * ch); }
    for (int i = tid; i < 465; i += NTHR) rpbL[i] = rpb[h * 465 + i];
    }
    __syncthreads();
    asm volatile("" : "+v"(tid));
    const int wave = __builtin_amdgcn_readfirstlane(tid >> 6), lane = tid & 63;
    attn_unit<true>(z, qfb, vtl, kf, KL, VL, rpbL, ycat, b, 2 * rp + (wave >> 2), wave & 3, 0, h, lane);
    if (ctxq && wave == 0 && (rp & 1) == 0) attn_unit<false>(z, qfb, vtl, kf, KL, VL, rpbL, ycat, b, 0, 0, rp >> 1, h, lane);
}

constexpr int NPOS = CTXL + SEQ;
__device__ __forceinline__ int pos_row(int b, int P) { return P < CTXL ? TL + b * CTXL + P : b * SEQ + (P - CTXL); }

__device__ __forceinline__ void rope_table_phase(float* rope, int lane, int gw, int NGW) {
    for (int i = gw * 64 + lane; i < 2048; i += NGW * 64) { const int pos = i >> 5, fi = i & 31; const float f = powf(10000.0f, -(float)fi * (1.0f / 32.0f)); float s, c; sincosf((float)pos * f, &s, &c); rope[2 * i] = c; rope[2 * i + 1] = s; }
}
__device__ __forceinline__ void dn_prep3_phase(const bf16* z, const float* zab, const float* __restrict__ convw, const float* __restrict__ a_log, const float* __restrict__ dt_bias, const float* rope,
                                               bf16* KB, bf16* QB, bf16* KT, bf16* VT2, float* gout, float* bout, int lane, int gw, int NGW) {
    const int i0 = (2 * lane) & 31; const bool second = (lane & 16) != 0;
#define DN_LOADZ(dst, itx) do { const int tb_ = (itx) >> 3, ch_ = ((itx) & 7) * 128 + 2 * lane; int t0_, T_, base_; \
        if (tb_ < 1024) { t0_ = (tb_ & 511) * 8; T_ = SEQ; base_ = (tb_ >> 9) * SEQ; } else { const int cb_ = tb_ - 1024; t0_ = (cb_ & 31) * 8; T_ = CTXL; base_ = TL + (cb_ >> 5) * CTXL; } \
        _Pragma("unroll") for (int w = 0; w < 3; ++w) { const int zc_ = (w == 0 ? Z_DNK : (w == 1 ? Z_DNV : Z_DNQ)) + ch_; \
            _Pragma("unroll") for (int r = 0; r < 12; ++r) { const int tt_ = t0_ - 2 + r; dst[w][r] = (tt_ >= 0 && tt_ < T_) ? *(const unsigned*)(z + (size_t)(base_ + tt_) * ZW + zc_) : 0u; } } } while (0)
    unsigned zn[3][12];
    if (gw < 1088 * 8) DN_LOADZ(zn, gw);
#pragma unroll 1
    for (int it = gw; it < 1088 * 8; it += NGW) {
        const int tb = it >> 3, hd = it & 7;
        int row0, b, t0, T, base, P0;
        if (tb < 1024) { row0 = tb * 8; b = tb >> 9; t0 = (tb & 511) * 8; T = SEQ; base = b * SEQ; P0 = CTXL + t0; }
        else { const int cb = tb - 1024; row0 = TL + cb * 8; b = cb >> 5; t0 = (cb & 31) * 8; T = CTXL; base = TL + b * CTXL; P0 = t0; }
        (void)T; (void)base;
        const int ch = hd * 128 + 2 * lane;
        unsigned zz[3][12]; f32x2 wv[3][5];
#pragma unroll
        for (int w = 0; w < 3; ++w) { const int wc = (w == 0 ? 0 : (w == 1 ? 1024 : 2048)) + ch;
#pragma unroll
            for (int r = 0; r < 12; ++r) zz[w][r] = zn[w][r];
#pragma unroll
            for (int j = 0; j < 5; ++j) wv[w][j] = *(const f32x2*)(convw + j * 3072 + wc); }
        if (it + NGW < 1088 * 8) DN_LOADZ(zn, it + NGW);
        f32x4 cs[8];
        if (tb < 1024) {
#pragma unroll
            for (int tk = 0; tk < 8; ++tk) { const int t = t0 + tk; const int pos = (lane < 32) ? (t >> 6) : (t & 63); cs[tk] = *(const f32x4*)(rope + (size_t)(pos * 32 + i0) * 2); }
        }
        float y[3][8][2]; float ssq[16];
#pragma unroll
        for (int w = 0; w < 3; ++w)
#pragma unroll
            for (int tk = 0; tk < 8; ++tk) { float a0 = 0.f, a1 = 0.f;
#pragma unroll
                for (int j = 0; j < 5; ++j) { a0 += wv[w][j][0] * bflo(zz[w][tk + j]); a1 += wv[w][j][1] * bfhi(zz[w][tk + j]); }
                y[w][tk][0] = siluf_(a0); y[w][tk][1] = siluf_(a1); }
#pragma unroll
        for (int tk = 0; tk < 8; ++tk) { ssq[tk] = y[0][tk][0] * y[0][tk][0] + y[0][tk][1] * y[0][tk][1]; ssq[8 + tk] = y[2][tk][0] * y[2][tk][0] + y[2][tk][1] * y[2][tk][1]; }
#pragma unroll
        for (int st = 0; st < 4; ++st) { const int msk = 1 << st; const bool up = (lane & msk) != 0;
#pragma unroll
            for (int j = 0; j < (8 >> st); ++j) { const float a = ssq[2 * j], c2 = ssq[2 * j + 1]; const float keep = up ? c2 : a, send = up ? a : c2; ssq[j] = keep + __shfl_xor(send, msk); } }
        float tot = ssq[0]; tot += __shfl_xor(tot, 16); tot += __shfl_xor(tot, 32);
        const float rnl = 1.0f / sqrtf(tot + EPS);
        unsigned kd[8], qd[8];
#pragma unroll
        for (int tk = 0; tk < 8; ++tk) {
            const float rk = __builtin_bit_cast(float, __builtin_amdgcn_readlane(__builtin_bit_cast(int, rnl), tk)), rq = __builtin_bit_cast(float, __builtin_amdgcn_readlane(__builtin_bit_cast(int, rnl), 8 + tk));
            float k0 = y[0][tk][0] * rk, k1 = y[0][tk][1] * rk, q0 = y[2][tk][0] * rq, q1 = y[2][tk][1] * rq;
            if (tb < 1024) { const f32x4 c4 = cs[tk];
                const float pk0 = __shfl_xor(k0, 16), pk1 = __shfl_xor(k1, 16), pq0 = __shfl_xor(q0, 16), pq1 = __shfl_xor(q1, 16);
                if (!second) { k0 = k0 * c4[0] - pk0 * c4[1]; k1 = k1 * c4[2] - pk1 * c4[3]; q0 = q0 * c4[0] - pq0 * c4[1]; q1 = q1 * c4[2] - pq1 * c4[3]; }
                else { k0 = k0 * c4[0] + pk0 * c4[1]; k1 = k1 * c4[2] + pk1 * c4[3]; q0 = q0 * c4[0] + pq0 * c4[1]; q1 = q1 * c4[2] + pq1 * c4[3]; } }
            q0 *= 0.08838834764831845f; q1 *= 0.08838834764831845f;
            y[0][tk][0] = k0; y[0][tk][1] = k1; y[2][tk][0] = q0; y[2][tk][1] = q1;
            kd[tk] = pk2(k0, k1); qd[tk] = pk2(q0, q1);
        }
        { const bool l2 = (lane & 2) == 0, l1 = (lane & 1) == 0;
#define DN_QT4(d) do { unsigned r0_ = (unsigned)__shfl_xor((int)(l2 ? d[2] : d[0]), 2), r1_ = (unsigned)__shfl_xor((int)(l2 ? d[3] : d[1]), 2); d[2] = l2 ? r0_ : d[2]; d[3] = l2 ? r1_ : d[3]; d[0] = l2 ? d[0] : r0_; d[1] = l2 ? d[1] : r1_; \
            r0_ = (unsigned)__shfl_xor((int)(l1 ? d[1] : d[0]), 1); r1_ = (unsigned)__shfl_xor((int)(l1 ? d[3] : d[2]), 1); d[1] = l1 ? r0_ : d[1]; d[3] = l1 ? r1_ : d[3]; d[0] = l1 ? d[0] : r0_; d[2] = l1 ? d[2] : r1_; } while (0)
          unsigned ka[4] = {kd[0], kd[1], kd[2], kd[3]}, kb2[4] = {kd[4], kd[5], kd[6], kd[7]}, qa[4] = {qd[0], qd[1], qd[2], qd[3]}, qb2[4] = {qd[4], qd[5], qd[6], qd[7]};
          DN_QT4(ka); DN_QT4(kb2); DN_QT4(qa); DN_QT4(qb2);
#undef DN_QT4
          const size_t fo2 = ((((((size_t)(b * 8 + hd) * 68 + (P0 >> 6)) * 4 + ((P0 >> 4) & 3)) * 4 + (lane >> 4)) * 4 + ((lane >> 2) & 3)) * 16 + (P0 & 15) + (lane & 3)) * 8;
          *(v4u*)(KB + fo2) = (v4u){ka[0], ka[1], ka[2], ka[3]}; *(v4u*)(KB + fo2 + 32) = (v4u){kb2[0], kb2[1], kb2[2], kb2[3]};
          *(v4u*)(QB + fo2) = (v4u){qa[0], qa[1], qa[2], qa[3]}; *(v4u*)(QB + fo2 + 32) = (v4u){qb2[0], qb2[1], qb2[2], qb2[3]}; }
        const size_t fo = (((((size_t)(b * 8 + hd) * 68 + (P0 >> 6)) * 8 + (lane >> 3)) * 2 + ((P0 >> 5) & 1)) * 64 + ((P0 >> 3) & 3) * 16 + 2 * (lane & 7)) * 8;
        bf16* ktp = KT + fo; bf16* vtp = VT2 + fo;
        *(v4u*)(ktp) = (v4u){pk2(y[0][0][0], y[0][1][0]), pk2(y[0][2][0], y[0][3][0]), pk2(y[0][4][0], y[0][5][0]), pk2(y[0][6][0], y[0][7][0])};
        *(v4u*)(ktp + 8) = (v4u){pk2(y[0][0][1], y[0][1][1]), pk2(y[0][2][1], y[0][3][1]), pk2(y[0][4][1], y[0][5][1]), pk2(y[0][6][1], y[0][7][1])};
        *(v4u*)(vtp) = (v4u){pk2(y[1][0][0], y[1][1][0]), pk2(y[1][2][0], y[1][3][0]), pk2(y[1][4][0], y[1][5][0]), pk2(y[1][6][0], y[1][7][0])};
        *(v4u*)(vtp + 8) = (v4u){pk2(y[1][0][1], y[1][1][1]), pk2(y[1][2][1], y[1][3][1]), pk2(y[1][4][1], y[1][5][1]), pk2(y[1][6][1], y[1][7][1])};
        if (lane < 16) { const int row = row0 + (lane & 7), dir = lane >> 3;
            const float alpha = zab[(size_t)row * 32 + dir * 8 + hd], bz = zab[(size_t)row * 32 + 16 + dir * 8 + hd];
            const float xs = alpha + dt_bias[dir * 8 + hd]; const float sp = xs > 20.f ? xs : log1pf(expf(xs));
            gout[(size_t)row * 16 + dir * 8 + hd] = -expf(a_log[dir * 8 + hd]) * sp;
            bout[(size_t)row * 16 + dir * 8 + hd] = 1.0f / (1.0f + expf(-bz)); }
    }
}
#undef DN_LOADZ


constexpr int NINST = 2 * 8 * 2 * 68;
__device__ __forceinline__ int chunk_P0(int dir, int n) { return dir == 0 ? 64 * n : (n < 4 ? CTXL - 64 * (n + 1) : NPOS - 64 * (n - 3)); }
__device__ __forceinline__ void dn_chunk_phase(const bf16* KB, const bf16* QB, const bf16* KT, const bf16* VT2, const float* G, const float* BETA, bf16* WB, float* UB, bf16* QKM, float* EGb,
                                               LAS unsigned char* lds, int lane, int wave, int gw, int NGW) {
    LAS float* AL = (LAS float*)(lds + wave * 16384);
    LAS unsigned short* T1L = (LAS unsigned short*)AL; LAS unsigned short* T2L = T1L + 4096;
    LAS float* SV = (LAS float*)(lds + RING_BYTES + 1024 + wave * 1024);
    const int q16 = lane & 15, g = lane >> 4;
#pragma unroll 1
    for (int inst = gw; inst < NINST; inst += NGW) {
        const int n = inst % 68, rr = inst / 68, dir = rr & 1, hd = (rr >> 1) & 7, b = rr >> 4;
        const int P0 = chunk_P0(dir, n);
        const int rowi = pos_row(b, dir ? P0 + 63 - lane : P0 + lane);
        const float bi = BETA[(size_t)rowi * 16 + dir * 8 + hd];
        float gc = G[(size_t)rowi * 16 + dir * 8 + hd];
#pragma unroll
        for (int o = 1; o < 64; o <<= 1) { const float t = __shfl_up(gc, o); if (lane >= o) gc += t; }
        asm volatile("s_waitcnt lgkmcnt(0)" ::: "memory");
        SV[lane] = gc; SV[64 + lane] = bi;
        asm volatile("s_waitcnt lgkmcnt(0)" ::: "memory");
        const float gc63 = __shfl(gc, 63);
        EGb[(size_t)inst * 128 + lane] = __expf(gc); EGb[(size_t)inst * 128 + 64 + lane] = __expf(gc63 - gc);
        bf16x8_t kf[4][4];
        const size_t fb0 = ((size_t)(b * 8 + hd) * 68 + (P0 >> 6)) * 4; const int q16p = dir ? 15 - q16 : q16;
#pragma unroll
        for (int blk = 0; blk < 4; ++blk) {
#pragma unroll
            for (int ks = 0; ks < 4; ++ks) kf[blk][ks] = *(const bf16x8_t*)(KB + ((((fb0 + (dir ? 3 - blk : blk)) * 4 + ks) * 4 + g) * 16 + q16p) * 8); }
#pragma unroll
        for (int ib = 0; ib < 4; ++ib) {
            const int i = 16 * ib + q16; const float gci = SV[i], bti = SV[64 + i];
            bf16x8_t qfr[4];
#pragma unroll
            for (int ks = 0; ks < 4; ++ks) qfr[ks] = *(const bf16x8_t*)(QB + ((((fb0 + (dir ? 3 - ib : ib)) * 4 + ks) * 4 + g) * 16 + q16p) * 8);
#pragma unroll
            for (int jb = 0; jb < 4; ++jb) {
                v2u qo = {0u, 0u};
                if (jb <= ib) {
                    f32x4 ck = {0.f, 0.f, 0.f, 0.f}, cq = ck;
#pragma unroll
                    for (int ks = 0; ks < 4; ++ks) { ck = __builtin_amdgcn_mfma_f32_16x16x32_bf16(kf[jb][ks], kf[ib][ks], ck, 0, 0, 0); cq = __builtin_amdgcn_mfma_f32_16x16x32_bf16(kf[jb][ks], qfr[ks], cq, 0, 0, 0); }
                    const f32x4 gcj = *(const LAS f32x4*)(SV + 16 * jb + 4 * g);
                    f32x4 av, qv;
#pragma unroll
                    for (int e = 0; e < 4; ++e) { const int j = 16 * jb + 4 * g + e; const float dec = __expf(gci - gcj[e]);
                        av[e] = (i > j) ? bti * ck[e] * dec : 0.f; qv[e] = (i >= j) ? cq[e] * dec : 0.f; }
                    *(LAS f32x4*)(AL + i * 64 + 16 * jb + 4 * g) = av;
                    qo.x = pk2(qv[0], qv[1]); qo.y = pk2(qv[2], qv[3]);
                }
                *(v2u*)(QKM + ((((size_t)inst * 4 + ib) * 2 + (jb >> 1)) * 64 + (2 * (jb & 1) + (g >> 1)) * 16 + q16) * 8 + 4 * (g & 1)) = qo;
            }
        }
        asm volatile("s_waitcnt lgkmcnt(0)" ::: "memory");
        float T[64];
        {
            T[0] = (lane == 0) ? 1.f : 0.f;
#pragma unroll
            for (int i = 1; i < 64; ++i) {
                float acc0 = (lane == i) ? 1.f : 0.f, acc1 = 0.f;
#pragma unroll
                for (int hb = 0; hb < 2; ++hb) {
                    if (8 * hb < (i + 3) / 4) {
                        f32x4 rowc[8];
#pragma unroll
                        for (int jj = 0; jj < 8; ++jj) rowc[jj] = *(const LAS f32x4*)(AL + i * 64 + 32 * hb + 4 * jj);
#pragma unroll
                        for (int jj = 0; jj < 8; ++jj) {
#pragma unroll
                            for (int e = 0; e < 4; ++e) if (32 * hb + 4 * jj + e < i) { if (jj & 1) acc1 -= rowc[jj][e] * T[32 * hb + 4 * jj + e]; else acc0 -= rowc[jj][e] * T[32 * hb + 4 * jj + e]; } }
                    }
                }
                T[i] = acc0 + acc1;
            }
        }
        asm volatile("s_waitcnt lgkmcnt(0)" ::: "memory");
        { const float s1 = bi, s2 = bi * __expf(gc); const int pc = dir ? 63 - lane : lane;
#pragma unroll
          for (int i = 0; i < 64; ++i) { T1L[i * 64 + pc] = (unsigned short)(pk2(T[i] * s1, 0.f) & 0xffffu); T2L[i * 64 + pc] = (unsigned short)(pk2(T[i] * s2, 0.f) & 0xffffu); } }
        asm volatile("s_waitcnt lgkmcnt(0)" ::: "memory");
        const size_t fb = (((size_t)(b * 8 + hd) * 68 + (P0 >> 6)) * 16 * 64 + lane) * 8;
        const bf16* vtb = VT2 + fb; const bf16* ktb = KT + fb;
#pragma unroll
        for (int half = 0; half < 2; ++half) {
            bf16x8_t xf[8][2];
#pragma unroll
            for (int db = 0; db < 8; ++db)
#pragma unroll
                for (int ks = 0; ks < 2; ++ks) xf[db][ks] = *(const bf16x8_t*)((half ? ktb : vtb) + (2 * db + ks) * 512);
#pragma unroll
            for (int ib = 0; ib < 4; ++ib) {
                bf16x8_t tf[2];
#pragma unroll
                for (int ks = 0; ks < 2; ++ks) tf[ks] = *(const LAS bf16x8_t*)((half ? T2L : T1L) + (16 * ib + q16) * 64 + 32 * ks + 8 * g);
#pragma unroll
                for (int db = 0; db < 8; ++db) {
                    f32x4 c = {0.f, 0.f, 0.f, 0.f};
                    if (half == 0) {
#pragma unroll
                        for (int ks = 0; ks < 2; ++ks) c = __builtin_amdgcn_mfma_f32_16x16x32_bf16(tf[ks], xf[db][ks], c, 0, 0, 0);
                        *(f32x4*)(UB + (((size_t)inst * 8 + db) * 4 + ib) * 256 + lane * 4) = c;
                    } else {
#pragma unroll
                        for (int ks = 0; ks < 2; ++ks) c = __builtin_amdgcn_mfma_f32_16x16x32_bf16(xf[db][ks], tf[ks], c, 0, 0, 0);
                        v2u o; o.x = pk2(c[0], c[1]); o.y = pk2(c[2], c[3]);
                        *(v2u*)(WB + ((((size_t)inst * 4 + ib) * 4 + (db >> 1)) * 64 + (2 * (db & 1) + (g >> 1)) * 16 + q16) * 8 + 4 * (g & 1)) = o;
                    }
                }
            }
        }
        asm volatile("s_waitcnt lgkmcnt(0)" ::: "memory");
    }
}

struct DnStSet { bf16x8_t wf[4], kt[2][2]; f32x4 u4, ek4; float dec; };
struct DnOutSet { bf16x8_t qf[4], qk[2]; f32x4 eg4; int orow[4]; };
__device__ __forceinline__ void dn_scan_phase(const bf16* QB, const bf16* KT, const bf16* WB, const float* UB, const bf16* QKM, const float* EGb, float* OF, float* OB,
                                              LAS unsigned char* lds, int tid, int bid, int G) {
    const int wave = __builtin_amdgcn_readfirstlane(tid >> 6), lane = tid & 63, q16 = lane & 15, g = lane >> 4, rb = wave & 3;
    LAS unsigned short* SbL = (LAS unsigned short*)lds;
    LAS unsigned short* VnL = SbL + 16 * 136;
    LAS unsigned short* Vn2L = VnL + 16 * 72;
#pragma unroll 1
    for (int unit = bid; unit < 256; unit += G) {
        const int dvb = (unit >> 3) & 7, chain = 4 * (unit & 7) + (unit >> 6), dir = chain & 1, hd = (chain >> 1) & 7, b = chain >> 4;
        __syncthreads();
        for (int i = tid; i < 16 * 136 / 2; i += NTHR) ((LAS unsigned*)SbL)[i] = 0u;
        __syncthreads();
        float* od = dir ? OB : OF;
        if (wave < 4) {
            f32x4 s0 = {0.f, 0.f, 0.f, 0.f}, s1 = s0;
            const bf16* ktb = KT + ((size_t)(b * 8 + hd) * 68 * 16 * 64 + (size_t)(4 * rb) * 64 + lane) * 8;
            DnStSet st[3];
#define DN_LOAD_ST(S_, n_) do { const size_t inst_ = (size_t)chain * 68 + (n_); const int P0_ = chunk_P0(dir, (n_)); \
                _Pragma("unroll") for (int ks = 0; ks < 4; ++ks) S_.wf[ks] = *(const bf16x8_t*)(WB + (((inst_ * 4 + rb) * 4 + ks) * 64 + lane) * 8); \
                _Pragma("unroll") for (int t = 0; t < 2; ++t) _Pragma("unroll") for (int ks = 0; ks < 2; ++ks) S_.kt[t][ks] = *(const bf16x8_t*)(ktb + ((size_t)(P0_ >> 6) * 16 + 2 * t + ks) * 512); \
                S_.u4 = *(const f32x4*)(UB + ((inst_ * 8 + dvb) * 4 + rb) * 256 + lane * 4); S_.ek4 = *(const f32x4*)(EGb + inst_ * 128 + 64 + 16 * rb + 4 * g); S_.dec = EGb[inst_ * 128 + 63]; } while (0)
#define DN_STEP_ST(j_, n_) do { if ((n_) + 2 < 68) DN_LOAD_ST(st[((j_) + 2) % 3], (n_) + 2); \
        bf16x8_t sf[4]; \
        _Pragma("unroll") \
        for (int ks = 0; ks < 4; ++ks) sf[ks] = *(const LAS bf16x8_t*)(SbL + q16 * 136 + 32 * ks + 8 * g); \
        f32x4 acc = {0.f, 0.f, 0.f, 0.f}; \
        _Pragma("unroll") \
        for (int ks = 0; ks < 4; ++ks) acc = __builtin_amdgcn_mfma_f32_16x16x32_bf16(st[(j_)].wf[ks], sf[ks], acc, 0, 0, 0); \
        const f32x4 v = st[(j_)].u4 - acc; \
        { v2u o; o.x = pk2(v[0], v[1]); o.y = pk2(v[2], v[3]); *(LAS v2u*)(VnL + q16 * 72 + 16 * rb + 4 * g) = o; \
        const f32x4 vs = v * st[(j_)].ek4; v2u o2; \
        if (dir == 0) { o2.x = pk2(vs[0], vs[1]); o2.y = pk2(vs[2], vs[3]); *(LAS v2u*)(Vn2L + q16 * 72 + 16 * rb + 4 * g) = o2; } \
        else { o2.x = pk2(vs[3], vs[2]); o2.y = pk2(vs[1], vs[0]); *(LAS v2u*)(Vn2L + q16 * 72 + 60 - 16 * rb - 4 * g) = o2; } } \
        __syncthreads(); \
        bf16x8_t vf[2]; \
        _Pragma("unroll") \
        for (int ks = 0; ks < 2; ++ks) vf[ks] = *(const LAS bf16x8_t*)(Vn2L + q16 * 72 + 32 * ks + 8 * g); \
        s0 *= st[(j_)].dec; s1 *= st[(j_)].dec; \
        _Pragma("unroll") \
        for (int ks = 0; ks < 2; ++ks) { s0 = __builtin_amdgcn_mfma_f32_16x16x32_bf16(st[(j_)].kt[0][ks], vf[ks], s0, 0, 0, 0); s1 = __builtin_amdgcn_mfma_f32_16x16x32_bf16(st[(j_)].kt[1][ks], vf[ks], s1, 0, 0, 0); } \
        { v2u o; o.x = pk2(s0[0], s0[1]); o.y = pk2(s0[2], s0[3]); *(LAS v2u*)(SbL + q16 * 136 + 32 * rb + 4 * g) = o; \
        o.x = pk2(s1[0], s1[1]); o.y = pk2(s1[2], s1[3]); *(LAS v2u*)(SbL + q16 * 136 + 32 * rb + 16 + 4 * g) = o; } \
        __syncthreads(); } while (0)
            DN_LOAD_ST(st[0], 0); DN_LOAD_ST(st[1], 1);
#pragma unroll 1
            for (int n3 = 0; n3 < 66; n3 += 3) { DN_STEP_ST(0, n3); DN_STEP_ST(1, n3 + 1); DN_STEP_ST(2, n3 + 2); }
            DN_STEP_ST(0, 66); DN_STEP_ST(1, 67);
#undef DN_STEP_ST
#undef DN_LOAD_ST
        } else {
            DnOutSet os[3];
#define DN_LOAD_OUT(S_, n_) do { const size_t inst_ = (size_t)chain * 68 + (n_); const int P0_ = chunk_P0(dir, (n_)); const int i_ = 16 * rb + q16; \
                const size_t qb_ = (((size_t)(b * 8 + hd) * 68 + (P0_ >> 6)) * 4 + (dir ? 3 - rb : rb)) * 4; (void)i_; \
                _Pragma("unroll") for (int ks = 0; ks < 4; ++ks) S_.qf[ks] = *(const bf16x8_t*)(QB + (((qb_ + ks) * 4 + g) * 16 + (dir ? 15 - q16 : q16)) * 8); \
                _Pragma("unroll") for (int ks = 0; ks < 2; ++ks) S_.qk[ks] = *(const bf16x8_t*)(QKM + (((inst_ * 4 + rb) * 2 + ks) * 64 + lane) * 8); \
                S_.eg4 = *(const f32x4*)(EGb + inst_ * 128 + 16 * rb + 4 * g); \
                _Pragma("unroll") for (int e = 0; e < 4; ++e) { const int io_ = 16 * rb + 4 * g + e; S_.orow[e] = pos_row(b, dir ? P0_ + 63 - io_ : P0_ + io_); } } while (0)
#define DN_STEP_OUT(j_, n_) do { if ((n_) + 2 < 68) DN_LOAD_OUT(os[((j_) + 2) % 3], (n_) + 2); \
        bf16x8_t sf[4]; \
        _Pragma("unroll") \
        for (int ks = 0; ks < 4; ++ks) sf[ks] = *(const LAS bf16x8_t*)(SbL + q16 * 136 + 32 * ks + 8 * g); \
        f32x4 oacc = {0.f, 0.f, 0.f, 0.f}; \
        _Pragma("unroll") \
        for (int ks = 0; ks < 4; ++ks) oacc = __builtin_amdgcn_mfma_f32_16x16x32_bf16(os[(j_)].qf[ks], sf[ks], oacc, 0, 0, 0); \
        oacc *= os[(j_)].eg4; \
        __syncthreads(); \
        bf16x8_t vf[2]; \
        _Pragma("unroll") \
        for (int ks = 0; ks < 2; ++ks) vf[ks] = *(const LAS bf16x8_t*)(VnL + q16 * 72 + 32 * ks + 8 * g); \
        _Pragma("unroll") \
        for (int ks = 0; ks < 2; ++ks) oacc = __builtin_amdgcn_mfma_f32_16x16x32_bf16(os[(j_)].qk[ks], vf[ks], oacc, 0, 0, 0); \
        _Pragma("unroll") \
        for (int e = 0; e < 4; ++e) od[(size_t)os[(j_)].orow[e] * 1024 + hd * 128 + 16 * dvb + q16] = oacc[e]; \
        __syncthreads(); } while (0)
            DN_LOAD_OUT(os[0], 0); DN_LOAD_OUT(os[1], 1);
#pragma unroll 1
            for (int n3 = 0; n3 < 66; n3 += 3) { DN_STEP_OUT(0, n3); DN_STEP_OUT(1, n3 + 1); DN_STEP_OUT(2, n3 + 2); }
            DN_STEP_OUT(0, 66); DN_STEP_OUT(1, 67);
#undef DN_STEP_OUT
#undef DN_LOAD_OUT
        }
    }
}

__device__ __forceinline__ void gm_item2(int chunk, int grp, const bf16* z, const float* vn, const float* __restrict__ sw  , const float* __restrict__ sb  , bf16* ycat, bool stage_w, LAS unsigned char* lds, int tid) {
    LAS unsigned short* WL = (LAS unsigned short*)lds;
    LAS unsigned short* VL = WL + 128 * 136;
    const int row0 = chunk < 64 ? chunk * 128 : TL + (chunk - 64) * 128;
    __syncthreads();
    if (stage_w)
    for (int i = tid; i < 128 * 32; i += NTHR) { const int pp = i >> 5, q4 = (i & 31) * 4;
        const f32x4 w = *(const f32x4*)(sw + (size_t)grp * 16384 + pp * 128 + q4);
        v2u o; o.x = pk2(w[0], w[1]); o.y = pk2(w[2], w[3]); *(LAS v2u*)(WL + pp * 136 + q4) = o; }
    for (int i = tid; i < 128 * 32; i += NTHR) { const int q = i >> 5, c4 = (i & 31) * 4;
        const f32x4 v = *(const f32x4*)(vn + (size_t)(row0 + q) * 1024 + grp * 128 + c4);
        const unsigned a = pk2(v[0], v[1]), b2 = pk2(v[2], v[3]);
        VL[(c4 + 0) * 136 + q] = (unsigned short)(a & 0xffffu); VL[(c4 + 1) * 136 + q] = (unsigned short)(a >> 16);
        VL[(c4 + 2) * 136 + q] = (unsigned short)(b2 & 0xffffu); VL[(c4 + 3) * 136 + q] = (unsigned short)(b2 >> 16); }
    __syncthreads();
    const int wave = __builtin_amdgcn_readfirstlane(tid >> 6), lane = tid & 63, q16 = lane & 15, gq = lane >> 4;
    bf16x8_t af[4];
#pragma unroll
    for (int ks = 0; ks < 4; ++ks) af[ks] = *(const LAS bf16x8_t*)(VL + (16 * wave + q16) * 136 + 32 * ks + 8 * gq);
    const int c = grp * 128 + 16 * wave + 4 * gq;
#pragma unroll
    for (int pb = 0; pb < 8; ++pb) {
        f32x4 acc = {0.f, 0.f, 0.f, 0.f};
#pragma unroll
        for (int ks = 0; ks < 4; ++ks) { const bf16x8_t bfr = *(const LAS bf16x8_t*)(WL + (16 * pb + q16) * 136 + 32 * ks + 8 * gq); acc = __builtin_amdgcn_mfma_f32_16x16x32_bf16(af[ks], bfr, acc, 0, 0, 0); }
        const int pp = 16 * pb + q16; const size_t row = (size_t)(row0 + pp);
        const float bias = sb[grp * 128 + pp];
        const v2u zu = *(const v2u*)(z + row * ZW + Z_GMU + c);
        v2u o; o.x = pk2(gelu_tanh(bflo(zu.x)) * (acc[0] + bias), gelu_tanh(bfhi(zu.x)) * (acc[1] + bias)); o.y = pk2(gelu_tanh(bflo(zu.y)) * (acc[2] + bias), gelu_tanh(bfhi(zu.y)) * (acc[3] + bias));
        *(v2u*)(ycat + row * DM + c) = o;
    }
}


#define MK_ONE_LAUNCH 1

#ifndef MK_ONE_LAUNCH
#define MK_ONE_LAUNCH 1
#endif
constexpr int NPL = 15;
constexpr int NPH = 1 + NLAYER * NPL + 1;
struct Args { const float* in[24]; float* out; unsigned char* ws; int ph_lo, ph_hi; };

__global__ void __launch_bounds__(NTHR, 2) dit_fwd(Args a) {
    extern __shared__ __attribute__((aligned(16))) unsigned char lds_raw[];
    LAS unsigned char* lds = (LAS unsigned char*)lds_raw;
    volatile LAS unsigned* MISC = (volatile LAS unsigned*)(lds + MISC_OFF);
    const int G = gridDim.x, bid = blockIdx.x, NGW = G * NWAVES;
    const int wave0 = __builtin_amdgcn_readfirstlane((int)threadIdx.x >> 6);
#define PHASE_IDS() int tid = wave0 * 64 + (int)__builtin_amdgcn_mbcnt_hi(~0u, __builtin_amdgcn_mbcnt_lo(~0u, 0u)); asm volatile("" : "+v"(tid)); const int lane = tid & 63, wave = __builtin_amdgcn_readfirstlane(tid >> 6), gw = bid * NWAVES + wave; (void)lane; (void)gw
    for (int u = threadIdx.x; u < (LDS_BYTES - RING_BYTES) / 4; u += NTHR) ((LAS unsigned*)(lds + RING_BYTES))[u] = 0u;
    __syncthreads();
    unsigned char* ws0 = a.ws;
    const int lo = a.ph_lo, hi = a.ph_hi;
    XcdBarrier bar; bar.bar = (unsigned*)(ws0 + WS_CTL) + CW_BAR; bar.x = 0; bar.st = nullptr;
    if (hi - lo > 1) bar = xcd_barrier_post((unsigned*)(ws0 + WS_CTL) + CW_BAR, MISC + 8);
#define IN(k) (lo <= (k) && (k) < hi)
#define SEAM(k) do { if (IN(k) && IN((k) + 1)) xcd_barrier(bar); } while (0)

#define SUB_FIRST(b) ((((b) >> 3) & 7) < 4)
#define KAS __attribute__((address_space(4)))
#define PHASE_PTRS() const KAS char* kp_ = (const KAS char*)__builtin_amdgcn_kernarg_segment_ptr(); asm volatile("" : "+s"(kp_)); \
    unsigned char* const ws = *(unsigned char* const KAS*)(kp_ + 200); (void)ws
#define INP(i) (*(const float* const KAS*)(kp_ + 8 * (i)))
#define P_MOD ((float*)(ws + WS_MOD))
#define P_H ((float*)(ws + WS_H))
#define P_XN ((bf16*)(ws + WS_XN))
#define P_HB ((bf16*)(ws + WS_HB))
#define P_Z ((bf16*)(ws + WS_Z))
#define P_ZAB ((float*)(ws + WS_ZAB))
#define P_GG ((float*)(ws + WS_G))
#define P_BETA ((float*)(ws + WS_BETA))
#define P_OF ((float*)(ws + WS_OF))
#define P_OB ((float*)(ws + WS_OB))
#define P_VN ((float*)(ws + WS_VN))
#define P_YCAT ((bf16*)(ws + WS_YCAT))
#define P_YF ((float*)(ws + WS_YF))
#define P_YB ((bf16*)(ws + WS_YB))
#define P_VTL ((bf16*)(ws + WS_VTL))
#define P_VTC ((bf16*)(ws + WS_VTC))
#define P_KB ((bf16*)(ws + WS_KB))
#define P_QB ((bf16*)(ws + WS_QB))
#define P_KT ((bf16*)(ws + WS_KT))
#define P_VT2 ((bf16*)(ws + WS_VT2))
#define P_WB ((bf16*)(ws + WS_WB))
#define P_UB ((float*)(ws + WS_UB))
#define P_QKM ((bf16*)(ws + WS_QKM))
#define P_EG ((float*)(ws + WS_EG))
#define P_ROPE ((float*)(ws + WS_ROPE))

    if (IN(0)) { PHASE_IDS(); PHASE_PTRS();
        LAS float* scr = (LAS float*)(lds + wave * 16384);
        {
            for (int l = 0; l < NLAYER; ++l) {
                for (int s = 0; s < 2; ++s) { const size_t ls = (size_t)l * 2 + s;
                    cvt_matrix<1>(INP(7) + ls * DM * FF, DM, FF, (bf16*)(ws + WS_W13 + ls * SZ_W13), DM, 0, gw, NGW, scr, lane);
                    cvt_matrix<2>(INP(8) + ls * DM * FF, DM, FF, (bf16*)(ws + WS_W13 + ls * SZ_W13), DM, 0, gw, NGW, scr, lane);
                    cvt_matrix<0>(INP(9) + ls * FF * DM, FF, DM, (bf16*)(ws + WS_W2 + ls * SZ_W2), FF, 0, gw, NGW, scr, lane); }
                cvt_matrix<3>(INP(10) + (size_t)l * DM * INW, DM, INW, (bf16*)(ws + WS_WIN + l * SZ_WIN), DM, 0, gw, NGW, scr, lane);
                cvt_matrix<0>(INP(19) + (size_t)l * 1024 * DM, 1024, DM, (bf16*)(ws + WS_PC + l * SZ_SQ), DM, 0, gw, NGW, scr, lane);
                cvt_matrix<0>(INP(20) + (size_t)l * 1024 * DM, 1024, DM, (bf16*)(ws + WS_PC + l * SZ_SQ), DM, 1024, gw, NGW, scr, lane);
                cvt_matrix<0>(INP(21) + (size_t)l * 2048 * DM, 2048, DM, (bf16*)(ws + WS_PC + l * SZ_SQ), DM, 2048, gw, NGW, scr, lane);
                cvt_matrix<0>(INP(22) + (size_t)l * DM * DM, DM, DM, (bf16*)(ws + WS_WO + l * SZ_SQ), DM, 0, gw, NGW, scr, lane);
            }
        }
        rope_table_phase(P_ROPE, lane, gw, NGW);
        __syncthreads();
        mod_phase(INP(1), INP(3), INP(4), INP(5), P_MOD, lds, tid, lane, wave, bid, G, 0, NLAYER);
    }
    SEAM(0);

    for (int l = 0; l < NLAYER; ++l) {
        const int pb = 1 + l * NPL;
        const bool lastl = (l + 1 == NLAYER);
        for (int sub = 0; sub < 2; ++sub) {
            const int p0 = pb + (sub ? 12 : 0), isub = sub ? 2 : 0;
            const bool first = (l == 0 && sub == 0);
            const bool ctxrows = !(lastl && sub == 1);
            const int MRs = ctxrows ? MR : TL;
            if (IN(p0)) { PHASE_IDS(); PHASE_PTRS();
                const bool hasslab = ctxrows && !first;
                const float* gv = sub == 0 ? P_MOD + ((size_t)(l - 1) * 3 + 2) * MODW + (2 * 3 + 2) * DM : P_MOD + ((size_t)l * 3 + 2) * MODW + (1 * 3 + 2) * DM;
                norm_phase(first ? INP(0) : P_H, first ? INP(2) : P_H + (size_t)TL * DM, INP(6) + ((size_t)l * 3 + isub) * DM, P_MOD + (size_t)l * 3 * MODW, isub, P_XN, MRs,
                           hasslab ? (const float*)(ws + WS_SLAB) : nullptr, gv, sub == 0 ? 0.5f : 1.0f, P_H + (size_t)TL * DM, lds, tid, lane, gw, NGW); }
            SEAM(p0);
            if (IN(p0 + 1)) { PHASE_PTRS();
                pg8::Gemm g{P_XN, (const bf16*)(ws + WS_W13 + ((size_t)l * 2 + sub) * SZ_W13), MRs, 2 * FF, DM, DM, DM};
                pg8::SplitOrder S; S.init(MRs, 2 * FF, DM, G, bid, !ctxrows);
                pg8::EpiSwiGLUS E{{P_HB, FF}, (unsigned)WS_SLAB, (unsigned)(WS_CTL + CW_UF * 4)};
                pg8::gemm_phase<pg8::EpiSwiGLUS, pg8::SplitOrder, true, true>(lds, g, S, E, wave0);
            }
            SEAM(p0 + 1);
            if (IN(p0 + 2)) { PHASE_PTRS();
                pg8::Gemm g{P_HB, (const bf16*)(ws + WS_W2 + ((size_t)l * 2 + sub) * SZ_W2), MRs, DM, FF, FF, FF};
                if (lastl && sub == 1) {
                    pg8::PanelOrder S{G, bid};
                    pg8::EpiFinal E{P_H, *(float* const KAS*)(kp_ + 192), P_MOD + (size_t)l * 3 * MODW + (isub * 3 + 2) * DM, MODW, 0.5f, INP(23), (float*)(ws + WS_SLAB), (unsigned*)(ws + WS_CTL) + CW_FN, (LAS float*)(lds + RING_BYTES + 2048)};
                    pg8::gemm_phase<pg8::EpiFinal, pg8::PanelOrder, true, true>(lds, g, S, E, wave0);
                } else {
                pg8::CombOrder S; S.init(TL, DM, G, bid, 1, ctxrows, SUB_FIRST(bid));
                pg8::EpiResidSlab E{{first ? INP(0) : P_H, first ? INP(2) : P_H + (size_t)TL * DM, P_H, P_MOD + (size_t)l * 3 * MODW + (isub * 3 + 2) * DM, MODW, 0.5f}, {(float*)(ws + WS_SLAB)}};
                pg8::gemm_phase<pg8::EpiResidSlab, pg8::CombOrder, true, true>(lds, g, S, E, wave0);
                }
            }
            if (!(lastl && sub == 1)) SEAM(p0 + 2);
            if (sub == 0) {
                if (IN(pb + 3)) { PHASE_IDS(); PHASE_PTRS();
                    norm_phase(P_H, first ? INP(2) : P_H + (size_t)TL * DM, INP(6) + ((size_t)l * 3 + 1) * DM, P_MOD + (size_t)l * 3 * MODW, 1, P_XN, MR,
                               (const float*)(ws + WS_SLAB), P_MOD + ((size_t)l * 3 + 2) * MODW + (0 * 3 + 2) * DM, 0.5f, P_H + (size_t)TL * DM, lds, tid, lane, gw, NGW); }
                SEAM(pb + 3);
                if (IN(pb + 4)) { PHASE_PTRS();
                    pg8::Gemm g{P_XN, (const bf16*)(ws + WS_WIN + l * SZ_WIN), MR, ZN, DM, DM, DM}; pg8::StaticOrder S; S.init(MR, ZN, G, bid);
                    pg8::EpiZ E{P_Z, ZW, P_ZAB, ZW / 256, (bf16*)(ws + WS_GF), Z_GA / 256, (bf16*)P_YF, (bf16*)P_YF + (size_t)16 * 1024 * 1024, Z_NAK / 256, Z_NAQ / 256, P_VTL, Z_NAV / 256};
                    pg8::gemm_phase<pg8::EpiZ, pg8::StaticOrder, true, true>(lds, g, S, E, wave0);
                }
                SEAM(pb + 4);
                if (IN(pb + 5)) { PHASE_IDS(); PHASE_PTRS();
                    dn_prep3_phase(P_Z, P_ZAB, INP(11) + (size_t)l * 5 * 3072, INP(12) + l * 16, INP(13) + l * 16, P_ROPE, P_KB, P_QB, P_KT, P_VT2, P_GG, P_BETA, lane, gw, NGW);
                    gm_prep_phase(P_Z, INP(17) + (size_t)l * 1024, P_VN, lane, gw, NGW);
                    vt_phase(P_Z, P_VTL, P_VTC, lds, lane, wave, gw, NGW);
                }
                SEAM(pb + 5);
                if (IN(pb + 6)) { PHASE_IDS(); PHASE_PTRS();
                    dn_chunk_phase(P_KB, P_QB, P_KT, P_VT2, P_GG, P_BETA, P_WB, P_UB, P_QKM, P_EG, lds, lane, wave, gw, NGW);
                    { unsigned* aq = (unsigned*)(ws + WS_CTL) + CW_AQ + (l * 8 + (bid & 7)) * 32; volatile LAS unsigned* slot = (volatile LAS unsigned*)(lds + RING_BYTES);
                      int last_bh = -1;
                      for (;;) {
                          __syncthreads();
                          if (tid == 0) *slot = __hip_atomic_fetch_add(aq, 1u, __ATOMIC_RELAXED, __HIP_MEMORY_SCOPE_AGENT);
                          __syncthreads();
                          const unsigned j = *slot;
                          if (j >= 128u) break;
                          const int it = (int)(8u * j) + (bid & 7), ibh = attn_item_bh(it);
                          attn_wg(it, P_Z, P_VTL, (const bf16*)P_YF, (const bf16*)P_YF + (size_t)16 * 1024 * 1024, P_VTC, INP(18) + (size_t)l * 16 * 465, P_YCAT, !lastl, ibh != last_bh, lds, tid);
                          last_bh = ibh;
                      } }
                }
                SEAM(pb + 6);
                if (IN(pb + 7)) { PHASE_IDS(); PHASE_PTRS();
                    dn_scan_phase(P_QB, P_KT, P_WB, P_UB, P_QKM, P_EG, P_OF, P_OB, lds, tid, bid, G);
                    { unsigned* gq = (unsigned*)(ws + WS_CTL) + CW_AQ + (16 + l) * 32; volatile LAS unsigned* slot = (volatile LAS unsigned*)(lds + RING_BYTES); const unsigned nit = (lastl ? 64 : 68) * 8; int last_grp = -1;
                      for (;;) {
                          __syncthreads();
                          if (tid == 0) *slot = __hip_atomic_fetch_add(gq, 1u, __ATOMIC_RELAXED, __HIP_MEMORY_SCOPE_AGENT);
                          __syncthreads();
                          const unsigned it = *slot;
                          if (it >= nit) break;
                          gm_item2((int)(it >> 3), (int)(it & 7), P_Z, P_VN, INP(15) + (size_t)l * 8 * 16384, INP(16) + (size_t)l * 1024, P_YCAT, (int)(it & 7) != last_grp, lds, tid);
                          last_grp = (int)(it & 7);
                      } }
                }
                SEAM(pb + 7);
                if (IN(pb + 8)) { PHASE_IDS(); PHASE_PTRS(); dn_out_phase(P_OF, P_OB, P_Z, INP(14) + (size_t)l * 128, P_YCAT, lastl ? TL : MR, lane, gw, NGW); }
                SEAM(pb + 8);
                if (IN(pb + 9)) { PHASE_PTRS();
                    const bf16* pc = (const bf16*)(ws + WS_PC + l * SZ_SQ);
                    pg8::CombOrder S; S.init(TL, DM, G, bid, 0, !lastl, SUB_FIRST(bid)); pg8::Gemm g{P_YCAT, pc, lastl ? TL : MR, DM, DM, DM, DM};
                    pg8::EpiMergeHS E{{(const bf16*)(ws + WS_GF), P_YB}, {(float*)(ws + WS_SLAB)}};
                    pg8::gemm_phase<pg8::EpiMergeHS, pg8::CombOrder, true, true>(lds, g, S, E, wave0);
                }
                SEAM(pb + 9);
                if (IN(pb + 10)) { PHASE_IDS(); PHASE_PTRS(); if (!lastl) merge_ctx_phase((const float*)(ws + WS_SLAB), P_Z, P_YB, lane, gw, NGW); }
                if (!lastl) SEAM(pb + 10);
                if (IN(pb + 11)) { PHASE_PTRS();
                    pg8::Gemm g{P_YB, (const bf16*)(ws + WS_WO + l * SZ_SQ), lastl ? TL : MR, DM, DM, DM, DM};
                    pg8::CombOrder S; S.init(TL, DM, G, bid, 0, !lastl, SUB_FIRST(bid));
                    pg8::EpiResidSlab E{{P_H, P_H + (size_t)TL * DM, P_H, P_MOD + (size_t)l * 3 * MODW + (1 * 3 + 2) * DM, MODW, 1.0f}, {(float*)(ws + WS_SLAB)}};
                    pg8::gemm_phase<pg8::EpiResidSlab, pg8::CombOrder, true, true>(lds, g, S, E, wave0);
                }
                SEAM(pb + 11);
            }
        }
    }
#undef IN
#undef SEAM
}

extern "C" void kernel_launch(void* const* d_in, const int* in_sizes, int n_in, void* d_out, int out_size, void* d_ws, size_t ws_size, hipStream_t stream) {
    static int grid = 0;
    if (grid == 0) {
        if (n_in != 24 || out_size != TL * DM || ws_size < WS_END) { fprintf(stderr, "kernel_launch: unexpected shapes (n_in %d, out %d, ws %zu < %zu); nothing launched\n", n_in, out_size, ws_size, (size_t)WS_END); grid = -1; return; }
        int dev = 0, cus = 0, per_cu = 0;
        if (hipGetDevice(&dev) != hipSuccess || hipDeviceGetAttribute(&cus, hipDeviceAttributeMultiprocessorCount, dev) != hipSuccess) { grid = -1; return; }
        if (hipFuncSetAttribute((const void*)dit_fwd, hipFuncAttributeMaxDynamicSharedMemorySize, LDS_BYTES) != hipSuccess) { fprintf(stderr, "kernel_launch: hipFuncSetAttribute failed\n"); grid = -1; return; }
        if (hipOccupancyMaxActiveBlocksPerMultiprocessor(&per_cu, (const void*)dit_fwd, NTHR, LDS_BYTES) != hipSuccess || per_cu < 1) { fprintf(stderr, "kernel_launch: occupancy query reports %d\n", per_cu); }
        (void)hipGetLastError();
        grid = cus;
        if (grid % 16 != 0) { fprintf(stderr, "kernel_launch: %d CUs: the row-panel exchange of the last GEMM needs a multiple of 16 workgroups; nothing launched\n", grid); grid = -1; return; }
    }
    if (grid < 0) return;
    if (hipMemsetAsync((char*)d_ws + WS_CTL, 0, CTL_ZERO_BYTES, stream) != hipSuccess) return;
    Args a{};
    for (int i = 0; i < 24; ++i) a.in[i] = (const float*)d_in[i];
    a.out = (float*)d_out; a.ws = (unsigned char*)d_ws;
#if MK_ONE_LAUNCH
    a.ph_lo = 0; a.ph_hi = NPH;
    hipLaunchKernelGGL(dit_fwd, dim3(grid), dim3(NTHR), LDS_BYTES, stream, a);
#else
    for (int p = 0; p < NPH; ++p) { a.ph_lo = p; a.ph_hi = p + 1; hipLaunchKernelGGL(dit_fwd, dim3(grid), dim3(NTHR), LDS_BYTES, stream, a); }
#endif
}
```

```cpp
#include <hip/hip_runtime.h>
#include <cstdio>
#include <cstdint>

namespace pg8 {
#define PG8_LAS __attribute__((address_space(3)))
typedef unsigned short bf16_t;
typedef short bf16x8 __attribute__((ext_vector_type(8)));
typedef float f32x4 __attribute__((ext_vector_type(4)));
typedef unsigned u32x4 __attribute__((ext_vector_type(4)));
constexpr int BM = 256, BK = 64, HALF = 128, HTB = HALF * BK * 2  , STAGE_BYTES = 8 * HTB, NXCD = 8, WGM = 8;

__host__ __device__ __forceinline__ int lds_byte(int r, int c) { const int st = (r >> 4) * 2 + (c >> 5), rr = r & 15, cc = c & 31, ob = rr * 64 + cc * 2; return st * 1024 + (ob ^ (((ob >> 9) & 1) << 5)); }
__host__ __device__ __forceinline__ void stage_rc(int b, int& R, int& C) { const int st = b / 1024, sb = b % 1024, swz = sb ^ (((sb >> 9) & 1) << 5); R = (st >> 1) * 16 + swz / 64; C = (st & 1) * 32 + (swz % 64) / 2; }
__host__ __device__ __forceinline__ int perm32(int rho) { const int n = rho >> 4, i = rho & 15; return 8 * (i >> 2) + 4 * n + (i & 3); }

struct Unit { int pm, pn, kt0, nt, ks; };
struct Gemm { const bf16_t* A; const bf16_t* Bt; int M, N, K, lda, ldb; };

struct StaticOrder {
    int nM, nN, nwg, G, c;
    __host__ __device__ void init(int M, int N, int G_, int c_) { nM = M / BM; nN = N / BM; nwg = nM * nN; G = G_; c = c_; }
    __host__ __device__ bool next(int i, Unit& u) const {
        const long L = (long)i * G + c; if (L >= nwg) return false;
        int wgid = (int)L; { const int q = nwg / NXCD, r = nwg % NXCD, xcd = wgid % NXCD, off = wgid / NXCD; wgid = (xcd < r ? xcd * (q + 1) : r * (q + 1) + (xcd - r) * q) + off; }
        const int nig = WGM * nN, gid = wgid / nig, fm = gid * WGM, gsz = (nM - fm) < WGM ? (nM - fm) : WGM;
        u.pm = fm + ((wgid % nig) % gsz); u.pn = (wgid % nig) / gsz; u.kt0 = 0; u.nt = 0; u.ks = -1; return true;
    }
    __device__ __forceinline__ void a_ready(const Unit&) const {}
    __device__ __forceinline__ void done(const Unit&) const {}
};

struct SubOrder {
    int G, c, kmode;
    __device__ __forceinline__ bool next(int i, Unit& u) const {
        const int idx = i * G + c; if (idx >= 256) return false;
        const int tile = idx >> 3, ks = idx & 7; u.pm = 32 + (tile >> 4); u.pn = tile & 15; u.ks = ks;
        if (kmode == 0) { u.kt0 = 8 * ks; u.nt = 8; } else { u.kt0 = ks < 4 ? 12 * ks : 48 + 10 * (ks - 4); u.nt = ks < 4 ? 12 : 10; }
        return true;
    }
    __device__ __forceinline__ void a_ready(const Unit&) const {}
    __device__ __forceinline__ void done(const Unit&) const {}
};

struct CombOrder {
    StaticOrder main; SubOrder sub; int nfirst; bool sub_first;
    __device__ __forceinline__ void init(int M, int N, int G, int c, int kmode, bool has_sub, bool sf) {
        main.init(M, N, G, c); sub = SubOrder{G, c, kmode}; sub_first = sf;
        const int my_main = c < main.nwg ? (main.nwg - c + G - 1) / G : 0, my_sub = (has_sub && c < 256) ? (256 - c + G - 1) / G : 0;
        nfirst = sf ? my_sub : (has_sub ? my_main : (1 << 30));
    }
    __device__ __forceinline__ bool next(int i, Unit& u) const {
        const bool in_first = i < nfirst, use_sub = (sub_first == in_first);
        const int j = in_first ? i : i - nfirst, G = main.G, c = main.c;
        const int idx = j * G + c, idc = idx < 255 ? idx : 255, tile = idc >> 3, ks = idc & 7;
        const int kt0s = sub.kmode == 0 ? 8 * ks : (ks < 4 ? 12 * ks : 48 + 10 * (ks - 4)), nts = sub.kmode == 0 ? 8 : (ks < 4 ? 12 : 10);
        int wgid = idx < main.nwg - 1 ? idx : main.nwg - 1;
        { const int q = main.nwg / NXCD, r = main.nwg % NXCD, xcd = wgid % NXCD, off = wgid / NXCD; wgid = (xcd < r ? xcd * (q + 1) : r * (q + 1) + (xcd - r) * q) + off; }
        const int nig = WGM * main.nN, gid = wgid / nig, fm = gid * WGM, gsz = (main.nM - fm) < WGM ? (main.nM - fm) : WGM;
        const int pmm = fm + ((wgid % nig) % gsz), pnm = (wgid % nig) / gsz;
        u.pm = use_sub ? 32 + (tile >> 4) : pmm; u.pn = use_sub ? (tile & 15) : pnm; u.kt0 = use_sub ? kt0s : 0; u.nt = use_sub ? nts : 0; u.ks = use_sub ? ks : -1;
        return use_sub ? idx < 256 : idx < main.nwg;
    }
    __device__ __forceinline__ void a_ready(const Unit&) const {}
    __device__ __forceinline__ void done(const Unit&) const {}
};

struct SplitOrder {
    int nM, nN, nwg, G, c, nfull, hk; bool split;
    __device__ __forceinline__ void init(int M, int N, int K, int G_, int c_, bool want) { nM = M / BM; nN = N / BM; nwg = nM * nN; G = G_; c = c_; nfull = nwg / G; hk = K / BK / 2;
        split = want && (nwg - nfull * G) * 2 == G && (hk & 1) == 0; }
    __device__ __forceinline__ bool next(int i, Unit& u) const {
        const bool half = split && i >= nfull;
        const int L = half ? nfull * G + (c >> 1) : i * G + c;
        int wgid = L < nwg - 1 ? L : nwg - 1;
        { const int q = nwg / NXCD, r = nwg % NXCD, xcd = wgid % NXCD, off = wgid / NXCD; wgid = (xcd < r ? xcd * (q + 1) : r * (q + 1) + (xcd - r) * q) + off; }
        const int nig = WGM * nN, gid = wgid / nig, fm = gid * WGM, gsz = (nM - fm) < WGM ? (nM - fm) : WGM;
        u.pm = fm + ((wgid % nig) % gsz); u.pn = (wgid % nig) / gsz; u.kt0 = half ? (c & 1) * hk : 0; u.nt = half ? hk : 0; u.ks = half ? c : -1;
        return half ? i == nfull : L < nwg;
    }
    __device__ __forceinline__ void a_ready(const Unit&) const {}
    __device__ __forceinline__ void done(const Unit&) const {}
};

struct PanelOrder {
    int G, c;
    __device__ __forceinline__ bool next(int i, Unit& u) const {
        const int x = c & 7, j = c >> 3, xa = G == 256;
        const int pl = xa ? 4 * (x >> 1) + (j & 3) : (c >> 4), pn = xa ? 8 * (x & 1) + (j >> 2) : (c & 15), ppr = G >> 4;
        u.pm = i * ppr + pl; u.pn = pn; u.kt0 = 0; u.nt = 0; u.ks = -1;
        return u.pm < 32;
    }
    __device__ __forceinline__ void a_ready(const Unit&) const {}
    __device__ __forceinline__ void done(const Unit&) const {}
};

typedef __bf16 pg8_bf16x2 __attribute__((ext_vector_type(2)));
__device__ __forceinline__ unsigned cvt_pk_bf16(float lo, float hi) { pg8_bf16x2 v = {(__bf16)lo, (__bf16)hi}; return __builtin_bit_cast(unsigned, v); }

__device__ __forceinline__ float bf_lo(unsigned u) { return __builtin_bit_cast(float, u << 16); }
__device__ __forceinline__ float bf_hi(unsigned u) { return __builtin_bit_cast(float, u & 0xffff0000u); }
__device__ __forceinline__ float fast_sigmoid(float x) { return __builtin_amdgcn_rcpf(1.0f + __expf(-x)); }
__device__ __forceinline__ float fast_silu(float x) { return x * fast_sigmoid(x); }
__device__ __forceinline__ int rm_src(int lane) { return (((lane >> 2) + 16 * (lane & 3)) << 2); }
__device__ __forceinline__ int mf_src(int lane) { return ((4 * (lane & 15) + (lane >> 4)) << 2); }
typedef int pg8_i32x4 __attribute__((ext_vector_type(4)));
__device__ __forceinline__ pg8_i32x4 lperm_i(const pg8_i32x4 v, int a) { pg8_i32x4 r;
    r.x = __builtin_amdgcn_ds_bpermute(a, v.x); r.y = __builtin_amdgcn_ds_bpermute(a, v.y); r.z = __builtin_amdgcn_ds_bpermute(a, v.z); r.w = __builtin_amdgcn_ds_bpermute(a, v.w); return r; }
__device__ __forceinline__ f32x4 lperm(const f32x4 v, int a) { return __builtin_bit_cast(f32x4, lperm_i(__builtin_bit_cast(pg8_i32x4, v), a)); }
__device__ __forceinline__ u32x4 lperm(const u32x4 v, int a) { return __builtin_bit_cast(u32x4, lperm_i(__builtin_bit_cast(pg8_i32x4, v), a)); }

struct EpiSwiGLU {
    static constexpr bool PERM = true, AFTER_DRAIN = false, MIDK = false;
    bf16_t* H; int ldh;
    __device__ __forceinline__ void operator()(const f32x4 (&acc)[2][2][4][2], const Unit& u, int wr, int wc, int fr, int fq) const {
        const int row0 = u.pm * BM + wr * 64 + fr, col0 = u.pn * HALF + wc * 32 + 8 * fq;
#pragma unroll
        for (int ai = 0; ai < 2; ++ai)
#pragma unroll
            for (int m = 0; m < 4; ++m) { bf16_t* rowp = H + (size_t)(row0 + ai * HALF + m * 16) * ldh + col0;
                const f32x4 a0 = acc[ai][0][m][0], a1 = acc[ai][0][m][1], b0 = acc[ai][1][m][0], b1 = acc[ai][1][m][1];
                u32x4 w; w.x = cvt_pk_bf16(fast_silu(a0[0]) * b0[0], fast_silu(a0[1]) * b0[1]); w.y = cvt_pk_bf16(fast_silu(a0[2]) * b0[2], fast_silu(a0[3]) * b0[3]);
                w.z = cvt_pk_bf16(fast_silu(a1[0]) * b1[0], fast_silu(a1[1]) * b1[1]); w.w = cvt_pk_bf16(fast_silu(a1[2]) * b1[2], fast_silu(a1[3]) * b1[3]);
                *(u32x4*)rowp = w; }
    }
};
struct EpiSwiGLUS {
    static constexpr bool PERM = true, AFTER_DRAIN = false, MIDK = false;
    EpiSwiGLU e; unsigned slab_off, flag_off;
    __device__ __forceinline__ void operator()(const f32x4 (&acc)[2][2][4][2], const Unit& u, int wr, int wc, int fr, int fq) const {
        if (u.ks < 0) { e(acc, u, wr, wc, fr, fq); return; }
        int lane = fr + 16 * fq; asm volatile("" : "+v"(lane));
        const int pair = u.ks >> 1, wid = wr * 4 + wc;
        const __attribute__((address_space(4))) char* kp = (const __attribute__((address_space(4))) char*)__builtin_amdgcn_kernarg_segment_ptr(); asm volatile("" : "+s"(kp));
        char* const wsb = *(char* const __attribute__((address_space(4)))*)(kp + 200);
        float* const slab = (float*)(wsb + slab_off); unsigned* const flags = (unsigned*)(wsb + flag_off);
        const unsigned off0 = (unsigned)(((pair * 8 + wid) * 32) * 64 + lane) * 16u;
        if ((u.ks & 1) == 0) {
            const __amdgpu_buffer_rsrc_t rs = __builtin_amdgcn_make_buffer_rsrc(slab, 0, 128 * 8 * 32 * 64 * 16, 0x00020000);
#pragma unroll
            for (int ai = 0; ai < 2; ++ai)
#pragma unroll
                for (int bj = 0; bj < 2; ++bj)
#pragma unroll
                    for (int m = 0; m < 4; ++m)
#pragma unroll
                        for (int n = 0; n < 2; ++n) __builtin_amdgcn_raw_buffer_store_b128(__builtin_bit_cast(u32x4, acc[ai][bj][m][n]), rs, off0 + (unsigned)((((ai * 2 + bj) * 4 + m) * 2 + n) * 1024), 0, 16);
            asm volatile("s_waitcnt vmcnt(0)" ::: "memory"); __builtin_amdgcn_s_barrier();
            if (wid == 0 && lane == 0) __hip_atomic_store(flags + pair * 32, 1u, __ATOMIC_RELAXED, __HIP_MEMORY_SCOPE_AGENT);
            return;
        }
        if (wid == 0 && lane == 0) { unsigned sp = 0u; while (__hip_atomic_load(flags + pair * 32, __ATOMIC_RELAXED, __HIP_MEMORY_SCOPE_AGENT) == 0u && ++sp < (1u << 21)) __builtin_amdgcn_s_sleep(1);
            __builtin_amdgcn_fence(__ATOMIC_ACQUIRE, "agent"); asm volatile("s_waitcnt vmcnt(0)" ::: "memory"); }
        __builtin_amdgcn_s_barrier();
        const char* sp_ = (const char*)slab + off0;
        const int row0 = u.pm * BM + wr * 64 + (lane & 15), col0 = u.pn * HALF + wc * 32 + 8 * (lane >> 4);
#pragma unroll
        for (int ai = 0; ai < 2; ++ai)
#pragma unroll
            for (int m = 0; m < 4; ++m) {
                const f32x4 a0 = acc[ai][0][m][0] + *(const f32x4*)(sp_ + (((ai * 2 + 0) * 4 + m) * 2 + 0) * 1024), a1 = acc[ai][0][m][1] + *(const f32x4*)(sp_ + (((ai * 2 + 0) * 4 + m) * 2 + 1) * 1024);
                const f32x4 b0 = acc[ai][1][m][0] + *(const f32x4*)(sp_ + (((ai * 2 + 1) * 4 + m) * 2 + 0) * 1024), b1 = acc[ai][1][m][1] + *(const f32x4*)(sp_ + (((ai * 2 + 1) * 4 + m) * 2 + 1) * 1024);
                u32x4 w; w.x = cvt_pk_bf16(fast_silu(a0[0]) * b0[0], fast_silu(a0[1]) * b0[1]); w.y = cvt_pk_bf16(fast_silu(a0[2]) * b0[2], fast_silu(a0[3]) * b0[3]);
                w.z = cvt_pk_bf16(fast_silu(a1[0]) * b1[0], fast_silu(a1[1]) * b1[1]); w.w = cvt_pk_bf16(fast_silu(a1[2]) * b1[2], fast_silu(a1[3]) * b1[3]);
                *(u32x4*)(e.H + (size_t)(row0 + ai * HALF + m * 16) * e.ldh + col0) = w;
                asm volatile("" ::: "memory"); }
    }
};
struct EpiResid {
    static constexpr bool PERM = false, AFTER_DRAIN = false, MIDK = false;
    const float* in_lat; const float* in_ctx; float* out; const float* gate; int gate_vstride; float coef;
    __device__ __forceinline__ void operator()(const f32x4 (&acc)[2][2][4][2], const Unit& u, int wr, int wc, int fr, int fq) const {
        const int v = u.pm < 16 ? 0 : (u.pm < 32 ? 1 : 2);
        const float* gp = gate + (size_t)v * gate_vstride;
        const int lane = fr + 16 * fq, nsel = (lane >> 2) & 1;
        const int pa0 = (((lane >> 3) + 16 * (lane & 3)) << 2), pa1 = pa0 + 32;
        const int row0 = u.pm * BM + wr * 64 + (lane >> 3), col0 = u.pn * BM + wc * 32 + 4 * (lane & 7);
        const float* inb = u.pm < 32 ? in_lat + (size_t)row0 * 4096 : in_ctx + (size_t)(row0 - 8192) * 4096;
        float* outb = out + (size_t)row0 * 4096;
        f32x4 gv[2];
#pragma unroll
        for (int bj = 0; bj < 2; ++bj) gv[bj] = *(const f32x4*)(gp + col0 + bj * HALF) * coef;
        f32x4 xa[2][2], xb[2][2];
#define PG8_RLD(dst, g) do { const size_t ro_ = (size_t)(((g) >> 2) * HALF + ((g) & 3) * 16) * 4096 + col0; _Pragma("unroll") for (int bj = 0; bj < 2; ++bj) _Pragma("unroll") for (int h = 0; h < 2; ++h) \
            dst[bj][h] = *(const f32x4*)(inb + ro_ + (size_t)(8 * h) * 4096 + bj * HALF); } while (0)
#define PG8_RST(src, g) do { const size_t ro_ = (size_t)(((g) >> 2) * HALF + ((g) & 3) * 16) * 4096 + col0; _Pragma("unroll") for (int bj = 0; bj < 2; ++bj) _Pragma("unroll") for (int h = 0; h < 2; ++h) { \
            const f32x4 t0_ = lperm(acc[(g) >> 2][bj][(g) & 3][0], h ? pa1 : pa0), t1_ = lperm(acc[(g) >> 2][bj][(g) & 3][1], h ? pa1 : pa0); \
            *(f32x4*)(outb + ro_ + (size_t)(8 * h) * 4096 + bj * HALF) = src[bj][h] + gv[bj] * (nsel ? t1_ : t0_); } } while (0)
        PG8_RLD(xa, 0);
#pragma unroll
        for (int g = 0; g < 8; g += 2) {
            PG8_RLD(xb, g + 1);
            PG8_RST(xa, g);
            if (g + 2 < 8) PG8_RLD(xa, g + 2);
            PG8_RST(xb, g + 1);
        }
#undef PG8_RLD
#undef PG8_RST
    }
};
struct EpiFinal {
    static constexpr bool PERM = false, AFTER_DRAIN = false, MIDK = false;
    const float* in; float* outp; const float* gate; int gate_vstride; float coef; const float* fw; float* stats  ; unsigned* cnt  ; PG8_LAS float* red  ;
    __device__ __forceinline__ void operator()(f32x4 (&acc)[2][2][4][2], const Unit& u, int wr, int wc, int fr, int fq) const {
        const int v = u.pm < 16 ? 0 : 1;
        const float* gp = gate + (size_t)v * gate_vstride;
        int lane = fr + 16 * fq; asm volatile("" : "+v"(lane));
        const int nsel = (lane >> 2) & 1;
        const int pa0 = (((lane >> 3) + 16 * (lane & 3)) << 2), pa1 = pa0 + 32;
        const int rl = wr * 64 + (lane >> 3);
        const int row0 = u.pm * BM + rl, col0 = u.pn * BM + wc * 32 + 4 * (lane & 7);
        const float* inb = in + (size_t)row0 * 4096;
#pragma unroll
        for (int g = 0; g < 8; ++g) {
            const size_t ro = (size_t)((g >> 2) * HALF + (g & 3) * 16) * 4096 + col0;
            float s0 = 0.f, s1 = 0.f;
#pragma unroll
            for (int bj = 0; bj < 2; ++bj) { f32x4& c0 = acc[g >> 2][bj][g & 3][0]; f32x4& c1 = acc[g >> 2][bj][g & 3][1];
                const f32x4 gvv = *(const f32x4*)(gp + col0 + bj * HALF) * coef;
                const f32x4 x0 = *(const f32x4*)(inb + ro + bj * HALF), x1 = *(const f32x4*)(inb + ro + (size_t)8 * 4096 + bj * HALF);
                const f32x4 t00 = lperm(c0, pa0), t10 = lperm(c1, pa0); const f32x4 h0 = x0 + gvv * (nsel ? t10 : t00);
                const f32x4 t01 = lperm(c0, pa1), t11 = lperm(c1, pa1); const f32x4 h1 = x1 + gvv * (nsel ? t11 : t01);
                c0 = h0; c1 = h1; asm volatile("" : "+v"(c0), "+v"(c1));
                s0 += (h0[0] * h0[0] + h0[1] * h0[1]) + (h0[2] * h0[2] + h0[3] * h0[3]); s1 += (h1[0] * h1[0] + h1[1] * h1[1]) + (h1[2] * h1[2] + h1[3] * h1[3]); }
            s0 += __shfl_xor(s0, 1); s0 += __shfl_xor(s0, 2); s0 += __shfl_xor(s0, 4); s1 += __shfl_xor(s1, 1); s1 += __shfl_xor(s1, 2); s1 += __shfl_xor(s1, 4);
            if ((lane & 7) == 0) { const int tr = (g >> 2) * HALF + (g & 3) * 16 + rl; red[tr * 4 + wc] = s0; red[(tr + 8) * 4 + wc] = s1; }
            asm volatile("" ::: "memory");
        }
        asm volatile("s_waitcnt lgkmcnt(0)" ::: "memory"); __builtin_amdgcn_s_barrier();
        if (wr == 0) { const int r = wc * 64 + lane; const float s = (red[r * 4] + red[r * 4 + 1]) + (red[r * 4 + 2] + red[r * 4 + 3]);
            __hip_atomic_store(stats + ((size_t)u.pm * BM + r) * 16 + u.pn, s, __ATOMIC_RELAXED, __HIP_MEMORY_SCOPE_AGENT); }
        asm volatile("s_waitcnt vmcnt(0) lgkmcnt(0)" ::: "memory"); __builtin_amdgcn_s_barrier();
        if (wr == 0 && wc == 0 && lane == 0) { unsigned* cp = cnt + u.pm * 32;
            (void)__hip_atomic_fetch_add(cp, 1u, __ATOMIC_RELAXED, __HIP_MEMORY_SCOPE_AGENT);
            unsigned sp = 0u; while (__hip_atomic_load(cp, __ATOMIC_RELAXED, __HIP_MEMORY_SCOPE_AGENT) < 16u && ++sp < (1u << 21)) __builtin_amdgcn_s_sleep(1);
            __builtin_amdgcn_fence(__ATOMIC_ACQUIRE, "agent"); asm volatile("s_waitcnt vmcnt(0)" ::: "memory"); }
        __builtin_amdgcn_s_barrier();
        if (wr == 0) { const int r = wc * 64 + lane; const float* sp_ = stats + ((size_t)u.pm * BM + r) * 16; float s = 0.f;
#pragma unroll
            for (int t = 0; t < 16; ++t) s += __hip_atomic_load(sp_ + t, __ATOMIC_RELAXED, __HIP_MEMORY_SCOPE_AGENT);
            red[1024 + r] = 1.0f / sqrtf(s * (1.0f / 4096.0f) + 1e-6f); }
        asm volatile("s_waitcnt vmcnt(0) lgkmcnt(0)" ::: "memory"); __builtin_amdgcn_s_barrier();
        float* outb = outp + (size_t)row0 * 4096;
#pragma unroll
        for (int g = 0; g < 8; ++g) {
#pragma unroll
            for (int bj = 0; bj < 2; ++bj) { const f32x4 fwv = *(const f32x4*)(fw + col0 + bj * HALF);
#pragma unroll
                for (int h = 0; h < 2; ++h) { const float rs = red[1024 + (g >> 2) * HALF + (g & 3) * 16 + 8 * h + rl];
                    *(f32x4*)(outb + (size_t)((g >> 2) * HALF + (g & 3) * 16 + 8 * h) * 4096 + col0 + bj * HALF) = acc[g >> 2][bj][g & 3][h] * rs * fwv; } }
            asm volatile("" ::: "memory"); }
        asm volatile("s_waitcnt lgkmcnt(0)" ::: "memory"); __builtin_amdgcn_s_barrier();
    }
};
struct EpiZ {
    static constexpr bool PERM = true, AFTER_DRAIN = false, MIDK = false;
    bf16_t* Z; int ldz; float* ZAB; int nmain; bf16_t* GF; int ga0; bf16_t* KF; bf16_t* QF; int nk0, nq0; bf16_t* VF; int nv0;
    __device__ __forceinline__ void operator()(const f32x4 (&acc)[2][2][4][2], const Unit& u, int wr, int wc, int fr, int fq) const {
        const int row0 = u.pm * BM + wr * 64 + fr;
        if (u.pn >= ga0 && u.pn < nmain && u.pm < 32) {
            bf16_t* gp = GF + ((((size_t)u.pm * 48 + (u.pn - ga0)) * 8 + (wr * 4 + wc)) * 16 * 64 + (fr + 16 * fq)) * 8;
#pragma unroll
            for (int ai = 0; ai < 2; ++ai)
#pragma unroll
                for (int m = 0; m < 4; ++m)
#pragma unroll
                    for (int bj = 0; bj < 2; ++bj) { f32x4 v0 = acc[ai][bj][m][0], v1 = acc[ai][bj][m][1];
#pragma unroll
                        for (int i = 0; i < 4; ++i) { v0[i] = __expf(-fminf(fmaxf(v0[i], -30.f), 30.f)); v1[i] = __expf(-fminf(fmaxf(v1[i], -30.f), 30.f)); }
                        u32x4 w; w.x = cvt_pk_bf16(v0[0], v0[1]); w.y = cvt_pk_bf16(v0[2], v0[3]); w.z = cvt_pk_bf16(v1[0], v1[1]); w.w = cvt_pk_bf16(v1[2], v1[3]);
                        *(u32x4*)(gp + ((ai * 4 + m) * 2 + bj) * 512) = w; }
        } else if (u.pm < 32 && (unsigned)(u.pn - nk0) < 8u) {
            const int b = u.pm >> 4, t0 = (u.pm & 15) * BM + wr * 64 + fr;
#pragma unroll
            for (int ai = 0; ai < 2; ++ai)
#pragma unroll
                for (int m = 0; m < 4; ++m)
#pragma unroll
                    for (int bj = 0; bj < 2; ++bj) { const f32x4 v0 = acc[ai][bj][m][0], v1 = acc[ai][bj][m][1]; const int t = t0 + ai * HALF + m * 16;
                        u32x4 w; w.x = cvt_pk_bf16(v0[0], v0[1]); w.y = cvt_pk_bf16(v0[2], v0[3]); w.z = cvt_pk_bf16(v1[0], v1[1]); w.w = cvt_pk_bf16(v1[2], v1[3]);
                        *(u32x4*)(KF + (((size_t)(b * 16 + 2 * (u.pn - nk0) + bj) * 1024 + (t >> 2)) * 512) + wc * 128 + fq * 32 + (t & 3) * 8) = w; }
        } else if (u.pm < 32 && (unsigned)(u.pn - nv0) < 8u) {
            const int b = u.pm >> 4, t0 = (u.pm & 15) * BM + wr * 64 + (fr & 8);
            const bool lo4 = (fr & 4) == 0, lo2 = (fr & 2) == 0, lo1 = (fr & 1) == 0;
#pragma unroll
            for (int ai = 0; ai < 2; ++ai)
#pragma unroll
                for (int m = 0; m < 4; ++m)
#pragma unroll
                    for (int bj = 0; bj < 2; ++bj) { const f32x4 v0 = acc[ai][bj][m][0], v1 = acc[ai][bj][m][1];
                        unsigned w0 = cvt_pk_bf16(v0[0], v0[1]), w1 = cvt_pk_bf16(v0[2], v0[3]), w2 = cvt_pk_bf16(v1[0], v1[1]), w3 = cvt_pk_bf16(v1[2], v1[3]);
                        { const unsigned r0 = (unsigned)__shfl_xor((int)(lo4 ? w2 : w0), 4), r1 = (unsigned)__shfl_xor((int)(lo4 ? w3 : w1), 4); w2 = lo4 ? r0 : w2; w3 = lo4 ? r1 : w3; w0 = lo4 ? w0 : r0; w1 = lo4 ? w1 : r1; }
                        { const unsigned r0 = (unsigned)__shfl_xor((int)(lo2 ? w1 : w0), 2), r1 = (unsigned)__shfl_xor((int)(lo2 ? w3 : w2), 2); w1 = lo2 ? r0 : w1; w3 = lo2 ? r1 : w3; w0 = lo2 ? w0 : r0; w2 = lo2 ? w2 : r1; }
                        { const unsigned p0 = (unsigned)__shfl_xor((int)w0, 1), p1 = (unsigned)__shfl_xor((int)w1, 1), p2 = (unsigned)__shfl_xor((int)w2, 1), p3 = (unsigned)__shfl_xor((int)w3, 1);
                          w0 = lo1 ? (w0 & 0xffffu) | (p0 << 16) : (p0 >> 16) | (w0 & 0xffff0000u); w1 = lo1 ? (w1 & 0xffffu) | (p1 << 16) : (p1 >> 16) | (w1 & 0xffff0000u);
                          w2 = lo1 ? (w2 & 0xffffu) | (p2 << 16) : (p2 >> 16) | (w2 & 0xffff0000u); w3 = lo1 ? (w3 & 0xffffu) | (p3 << 16) : (p3 >> 16) | (w3 & 0xffff0000u); }
                        u32x4 w; w.x = w0; w.y = w1; w.z = w2; w.w = w3;
                        *(u32x4*)(VF + ((((size_t)(b * 16 + 2 * (u.pn - nv0) + bj) * 512 + ((t0 + ai * HALF + m * 16) >> 3)) * 128) + wc * 32 + fq * 8 + (fr & 7)) * 8) = w; }
        } else if (u.pm < 32 && (unsigned)(u.pn - nq0) < 8u) {
            const int b = u.pm >> 4, rg0 = (u.pm & 15) * 16 + wr * 4;
#pragma unroll
            for (int ai = 0; ai < 2; ++ai)
#pragma unroll
                for (int m = 0; m < 4; ++m)
#pragma unroll
                    for (int bj = 0; bj < 2; ++bj) { const f32x4 v0 = acc[ai][bj][m][0], v1 = acc[ai][bj][m][1];
                        u32x4 w; w.x = cvt_pk_bf16(v0[0], v0[1]); w.y = cvt_pk_bf16(v0[2], v0[3]); w.z = cvt_pk_bf16(v1[0], v1[1]); w.w = cvt_pk_bf16(v1[2], v1[3]);
                        *(u32x4*)(QF + ((((size_t)(b * 16 + 2 * (u.pn - nq0) + bj) * 256 + rg0 + ai * 8 + m) * 4 + wc) * 64 + (fr + 16 * fq)) * 8) = w; }
        } else if (u.pn < nmain) {
            const int col0 = u.pn * BM + wc * 32 + 8 * fq;
#pragma unroll
            for (int ai = 0; ai < 2; ++ai)
#pragma unroll
                for (int m = 0; m < 4; ++m) { bf16_t* rowp = Z + (size_t)(row0 + ai * HALF + m * 16) * ldz + col0;
#pragma unroll
                    for (int bj = 0; bj < 2; ++bj) { const f32x4 v0 = acc[ai][bj][m][0], v1 = acc[ai][bj][m][1];
                        u32x4 w; w.x = cvt_pk_bf16(v0[0], v0[1]); w.y = cvt_pk_bf16(v0[2], v0[3]); w.z = cvt_pk_bf16(v1[0], v1[1]); w.w = cvt_pk_bf16(v1[2], v1[3]);
                        *(u32x4*)(rowp + bj * HALF) = w; } }
        } else if (wc == 0) {
#pragma unroll
            for (int ai = 0; ai < 2; ++ai)
#pragma unroll
                for (int m = 0; m < 4; ++m) { float* rowp = ZAB + (size_t)(row0 + ai * HALF + m * 16) * 32 + 8 * fq;
                    *(f32x4*)(rowp) = acc[ai][0][m][0]; *(f32x4*)(rowp + 4) = acc[ai][0][m][1]; }
        }
    }
};
template <int S> struct EpiMerge {
    static constexpr bool PERM = true, AFTER_DRAIN = false, MIDK = false;
    const bf16_t* Z; int ldz; int gcol; float* YF; bf16_t* YB;
    __device__ __forceinline__ void operator()(const f32x4 (&acc)[2][2][4][2], const Unit& u, int wr, int wc, int fr, int fq) const {
        const int row0 = u.pm * BM + wr * 64 + fr, col0 = u.pn * BM + wc * 32 + 8 * fq;
#pragma unroll
        for (int ai = 0; ai < 2; ++ai)
#pragma unroll
            for (int m = 0; m < 4; ++m) { const size_t row = (size_t)(row0 + ai * HALF + m * 16);
#pragma unroll
                for (int bj = 0; bj < 2; ++bj) { const int c = col0 + bj * HALF;
                    const u32x4 g = *(const u32x4*)(Z + row * ldz + gcol + c);
                    f32x4 t0 = acc[ai][bj][m][0], t1 = acc[ai][bj][m][1];
                    t0[0] *= fast_sigmoid(bf_lo(g.x)); t0[1] *= fast_sigmoid(bf_hi(g.x)); t0[2] *= fast_sigmoid(bf_lo(g.y)); t0[3] *= fast_sigmoid(bf_hi(g.y));
                    t1[0] *= fast_sigmoid(bf_lo(g.z)); t1[1] *= fast_sigmoid(bf_hi(g.z)); t1[2] *= fast_sigmoid(bf_lo(g.w)); t1[3] *= fast_sigmoid(bf_hi(g.w));
                    float* yf = YF + row * 4096 + c;
                    if (S == 0) { *(f32x4*)yf = t0; *(f32x4*)(yf + 4) = t1; }
                    else { t0 += *(const f32x4*)yf; t1 += *(const f32x4*)(yf + 4);
                        if (S == 1) { *(f32x4*)yf = t0; *(f32x4*)(yf + 4) = t1; }
                        else { u32x4 w; w.x = cvt_pk_bf16(t0[0], t0[1]); w.y = cvt_pk_bf16(t0[2], t0[3]); w.z = cvt_pk_bf16(t1[0], t1[1]); w.w = cvt_pk_bf16(t1[2], t1[3]);
                            *(u32x4*)(YB + row * 4096 + c) = w; } } }
                asm volatile("" ::: "memory"); }
    }
};

struct EpiSlab {
    static constexpr bool PERM = false, AFTER_DRAIN = false, MIDK = false;
    float* slab;
    __device__ __forceinline__ void operator()(const f32x4 (&acc)[2][2][4][2], const Unit& u, int wr, int wc, int fr, int fq) const {
        const int row0 = u.pm * BM + wr * 64 + fr - 8192, col0 = u.pn * BM + wc * 32 + 4 * fq;
        float* outb = slab + ((size_t)u.ks * 512 + row0) * 4096 + col0;
#pragma unroll
        for (int ai = 0; ai < 2; ++ai)
#pragma unroll
            for (int m = 0; m < 4; ++m)
#pragma unroll
                for (int bj = 0; bj < 2; ++bj)
#pragma unroll
                    for (int n = 0; n < 2; ++n) *(f32x4*)(outb + (size_t)(ai * HALF + m * 16) * 4096 + bj * HALF + n * 16) = acc[ai][bj][m][n];
    }
};

struct EpiSlabP {
    static constexpr bool PERM = true, AFTER_DRAIN = false, MIDK = false;
    float* slab;
    __device__ __forceinline__ void operator()(const f32x4 (&acc)[2][2][4][2], const Unit& u, int wr, int wc, int fr, int fq) const {
        const int row0 = u.pm * BM + wr * 64 + fr - 8192, col0 = u.pn * BM + wc * 32 + 8 * fq;
        float* outb = slab + ((size_t)u.ks * 512 + row0) * 4096 + col0;
#pragma unroll
        for (int ai = 0; ai < 2; ++ai)
#pragma unroll
            for (int m = 0; m < 4; ++m)
#pragma unroll
                for (int bj = 0; bj < 2; ++bj) { float* o = outb + (size_t)(ai * HALF + m * 16) * 4096 + bj * HALF; *(f32x4*)o = acc[ai][bj][m][0]; *(f32x4*)(o + 4) = acc[ai][bj][m][1]; }
    }
};
struct EpiResidSlab {
    static constexpr bool PERM = false, AFTER_DRAIN = false, MIDK = false;
    EpiResid r; EpiSlab s;
    __device__ __forceinline__ void operator()(const f32x4 (&acc)[2][2][4][2], const Unit& u, int wr, int wc, int fr, int fq) const { if (u.ks >= 0) s(acc, u, wr, wc, fr, fq); else r(acc, u, wr, wc, fr, fq); }
};
struct EpiMergeH {
    static constexpr bool PERM = true, AFTER_DRAIN = false, MIDK = true;
    static constexpr int T1 = 16, T2 = 32;
    const bf16_t* GF; bf16_t* YB;
    __device__ __forceinline__ void midk(f32x4 (&acc)[2][2][4][2], const Unit& u, int which, int wr, int wc, int fr, int fq) const {
        int lane = fr + 16 * fq; asm volatile("" : "+v"(lane));
        const bf16_t* gn0 = GF + ((((size_t)u.pm * 48 + which * 16 + u.pn) * 8 + (wr * 4 + wc)) * 16 * 64 + lane) * 8;
#pragma unroll
        for (int ai = 0; ai < 2; ++ai)
#pragma unroll
            for (int mp = 0; mp < 4; mp += 2) {
                u32x4 gn[2][2], gd[2][2];
#pragma unroll
                for (int mm = 0; mm < 2; ++mm)
#pragma unroll
                    for (int bj = 0; bj < 2; ++bj) { const int o = ((ai * 4 + mp + mm) * 2 + bj) * 512;
                        gn[mm][bj] = *(const u32x4*)(gn0 + o); gd[mm][bj] = *(const u32x4*)(gn0 + (size_t)16 * 8 * 16 * 64 * 8 + o); }
#pragma unroll
                for (int mm = 0; mm < 2; ++mm)
#pragma unroll
                    for (int bj = 0; bj < 2; ++bj) { const u32x4 a = gn[mm][bj], b = gd[mm][bj]; f32x4& t0 = acc[ai][bj][mp + mm][0]; f32x4& t1 = acc[ai][bj][mp + mm][1];
                        t0[0] *= (1.f + (bf_lo(b.x))) * __builtin_amdgcn_rcpf(1.f + (bf_lo(a.x))); t0[1] *= (1.f + (bf_hi(b.x))) * __builtin_amdgcn_rcpf(1.f + (bf_hi(a.x)));
                        t0[2] *= (1.f + (bf_lo(b.y))) * __builtin_amdgcn_rcpf(1.f + (bf_lo(a.y))); t0[3] *= (1.f + (bf_hi(b.y))) * __builtin_amdgcn_rcpf(1.f + (bf_hi(a.y)));
                        t1[0] *= (1.f + (bf_lo(b.z))) * __builtin_amdgcn_rcpf(1.f + (bf_lo(a.z))); t1[1] *= (1.f + (bf_hi(b.z))) * __builtin_amdgcn_rcpf(1.f + (bf_hi(a.z)));
                        t1[2] *= (1.f + (bf_lo(b.w))) * __builtin_amdgcn_rcpf(1.f + (bf_lo(a.w))); t1[3] *= (1.f + (bf_hi(b.w))) * __builtin_amdgcn_rcpf(1.f + (bf_hi(a.w))); }
                asm volatile("" ::: "memory");
            }
    }
    __device__ __forceinline__ void operator()(const f32x4 (&acc)[2][2][4][2], const Unit& u, int wr, int wc, int fr, int fq) const {
        const int row0 = u.pm * BM + wr * 64 + fr, col0 = u.pn * BM + wc * 32 + 8 * fq;
        const bf16_t* gc0 = GF + ((((size_t)u.pm * 48 + 32 + u.pn) * 8 + (wr * 4 + wc)) * 16 * 64 + (fr + 16 * fq)) * 8;
#pragma unroll
        for (int ai = 0; ai < 2; ++ai)
#pragma unroll
            for (int m = 0; m < 4; ++m) { const size_t row = (size_t)(row0 + ai * HALF + m * 16);
#pragma unroll
                for (int bj = 0; bj < 2; ++bj) { const int c = col0 + bj * HALF;
                    const u32x4 g = *(const u32x4*)(gc0 + ((ai * 4 + m) * 2 + bj) * 512);
                    f32x4 t0 = acc[ai][bj][m][0], t1 = acc[ai][bj][m][1];
                    t0[0] *= __builtin_amdgcn_rcpf(1.f + (bf_lo(g.x))); t0[1] *= __builtin_amdgcn_rcpf(1.f + (bf_hi(g.x))); t0[2] *= __builtin_amdgcn_rcpf(1.f + (bf_lo(g.y))); t0[3] *= __builtin_amdgcn_rcpf(1.f + (bf_hi(g.y)));
                    t1[0] *= __builtin_amdgcn_rcpf(1.f + (bf_lo(g.z))); t1[1] *= __builtin_amdgcn_rcpf(1.f + (bf_hi(g.z))); t1[2] *= __builtin_amdgcn_rcpf(1.f + (bf_lo(g.w))); t1[3] *= __builtin_amdgcn_rcpf(1.f + (bf_hi(g.w)));
                    u32x4 w; w.x = cvt_pk_bf16(t0[0], t0[1]); w.y = cvt_pk_bf16(t0[2], t0[3]); w.z = cvt_pk_bf16(t1[0], t1[1]); w.w = cvt_pk_bf16(t1[2], t1[3]);
                    *(u32x4*)(YB + row * 4096 + c) = w; }
                if (m & 1) asm volatile("" ::: "memory"); }
    }
};
struct EpiMergeHS {
    static constexpr bool PERM = true, AFTER_DRAIN = false, MIDK = true;
    static constexpr int T1 = EpiMergeH::T1, T2 = EpiMergeH::T2;
    EpiMergeH m; EpiSlabP s;
    __device__ __forceinline__ void midk(f32x4 (&acc)[2][2][4][2], const Unit& u, int which, int wr, int wc, int fr, int fq) const { if (u.ks < 0) m.midk(acc, u, which, wr, wc, fr, fq); }
    __device__ __forceinline__ void operator()(const f32x4 (&acc)[2][2][4][2], const Unit& u, int wr, int wc, int fr, int fq) const { if (u.ks >= 0) s(acc, u, wr, wc, fr, fq); else m(acc, u, wr, wc, fr, fq); }
};
template <class Epi, class Sched, bool ALIGN_EPI = false, bool SP2 = false>
__device__ __forceinline__ void gemm_phase(PG8_LAS unsigned char* lds, const Gemm g, const Sched& S, const Epi& E, int wave0) {
    int tid = wave0 * 64 + (int)__builtin_amdgcn_mbcnt_hi(~0u, __builtin_amdgcn_mbcnt_lo(~0u, 0u)); asm volatile("" : "+v"(tid));
    const int wid = __builtin_amdgcn_readfirstlane(tid >> 6), lane = tid & 63, wr = wid >> 2, wc = wid & 3, fr = lane & 15, fq = lane >> 4;
    const int ntdef = g.K / BK;
    unsigned voffA[2], voffB[2];
#pragma unroll
    for (int i = 0; i < 2; ++i) { int R, C; stage_rc(tid * 16 + i * 8192, R, C); const int Rb = Epi::PERM ? ((R & ~31) + perm32(R & 31)) : R;
        voffA[i] = (unsigned)(R * g.lda + C) * 2u; voffB[i] = (unsigned)(Rb * g.ldb + C) * 2u; }
    const size_t kstep = (size_t)(BK * 2);
    const size_t hstepA = (size_t)HALF * g.lda * 2, hstepB = (size_t)HALF * g.ldb * 2;
    const size_t tstepA = 2 * hstepA, tstepB = 2 * hstepB;
    const unsigned ldsw = (unsigned)wid * 1024u;
    const int aoff = lds_byte(wr * 64 + fr, fq * 8), boff = lds_byte(wc * 32 + fr, fq * 8);
#define PG8_SA(b, h) (((b) * 2 + (h)) * HTB)
#define PG8_SB(b, h) ((4 + (b) * 2 + (h)) * HTB)
#define PG8_STAGE(bufoff, gbase, voff) do { _Pragma("unroll") for (int _i = 0; _i < 2; ++_i) \
        __builtin_amdgcn_global_load_lds((const unsigned*)((const char*)(gbase) + (voff)[_i]), (PG8_LAS unsigned*)(lds + (bufoff) + ldsw + _i * 8192), 16, 0, 0); } while (0)
#define PG8_LDA(dst, b, h) do { _Pragma("unroll") for (int m = 0; m < 4; ++m) _Pragma("unroll") for (int k = 0; k < 2; ++k) dst[m][k] = *(const PG8_LAS bf16x8*)(lds + PG8_SA(b, h) + aoff + m * 2048 + k * 1024); } while (0)
#define PG8_LDB(dst, b, h) do { _Pragma("unroll") for (int n = 0; n < 2; ++n) _Pragma("unroll") for (int k = 0; k < 2; ++k) dst[n][k] = *(const PG8_LAS bf16x8*)(lds + PG8_SB(b, h) + boff + n * 2048 + k * 1024); } while (0)
#define PG8_MMA(ai, bj, At, Bt) do { __builtin_amdgcn_s_setprio(1); _Pragma("unroll") for (int m = 0; m < 4; ++m) _Pragma("unroll") for (int n = 0; n < 2; ++n) _Pragma("unroll") for (int k = 0; k < 2; ++k) \
        acc[ai][bj][m][n] = __builtin_amdgcn_mfma_f32_16x16x32_bf16(Bt[n][k], At[m][k], acc[ai][bj][m][n], 0, 0, 0); __builtin_amdgcn_s_setprio(0); } while (0)
#define PG8_WAIT_V(n) asm volatile("s_waitcnt vmcnt(" #n ")" ::: "memory")
#define PG8_WAIT_L(n) asm volatile("s_waitcnt lgkmcnt(" #n ")" ::: "memory")
#define PG8_BAR __builtin_amdgcn_s_barrier()
#define PG8_SCHED __builtin_amdgcn_sched_barrier(0)
    Unit cur, nxt; int ui = 0;
    if (!S.next(0, cur)) return;
    f32x4 acc[2][2][4][2];
#pragma unroll
    for (int a = 0; a < 2; ++a)
#pragma unroll
        for (int b = 0; b < 2; ++b)
#pragma unroll
            for (int m = 0; m < 4; ++m)
#pragma unroll
                for (int n = 0; n < 2; ++n) acc[a][b][m][n] = (f32x4){0.f, 0.f, 0.f, 0.f};
    bf16x8 At[4][2], B0[2][2], B1[2][2];
    const char* cA = (const char*)g.A + (size_t)cur.pm * tstepA + (size_t)cur.kt0 * kstep; const char* cB = (const char*)g.Bt + (size_t)cur.pn * tstepB + (size_t)cur.kt0 * kstep;
    S.a_ready(cur);
    if constexpr (SP2) {
        PG8_STAGE(PG8_SB(0, 0), cB, voffB); PG8_STAGE(PG8_SB(0, 1), cB + hstepB, voffB); PG8_STAGE(PG8_SA(0, 0), cA, voffA); PG8_STAGE(PG8_SA(0, 1), cA + hstepA, voffA);
        if (wr == 1) PG8_BAR;
        PG8_WAIT_V(2); PG8_BAR;
        PG8_STAGE(PG8_SB(1, 0), cB + kstep, voffB); PG8_STAGE(PG8_SA(1, 0), cA + kstep, voffA); PG8_STAGE(PG8_SB(1, 1), cB + hstepB + kstep, voffB);
        PG8_WAIT_V(6); PG8_BAR;
    } else {
        PG8_STAGE(PG8_SB(0, 0), cB, voffB); PG8_STAGE(PG8_SA(0, 0), cA, voffA); PG8_STAGE(PG8_SB(0, 1), cB + hstepB, voffB); PG8_STAGE(PG8_SA(0, 1), cA + hstepA, voffA);
        if (wr == 1) PG8_BAR;
        PG8_WAIT_V(4); PG8_BAR;
        PG8_STAGE(PG8_SB(1, 0), cB + kstep, voffB); PG8_STAGE(PG8_SA(1, 0), cA + kstep, voffA); PG8_STAGE(PG8_SB(1, 1), cB + hstepB + kstep, voffB);
        PG8_WAIT_V(6); PG8_BAR;
    }
    for (;;) {
        const bool has_next = S.next(ui + 1, nxt);
        const char* nA = has_next ? (const char*)g.A + (size_t)nxt.pm * tstepA + (size_t)nxt.kt0 * kstep : cA; const char* nB = has_next ? (const char*)g.Bt + (size_t)nxt.pn * tstepB + (size_t)nxt.kt0 * kstep : cB;
        const int nt = cur.nt > 0 ? cur.nt : ntdef;
        for (int t = 0; t < nt; t += 2) {
            const bool last = (t == nt - 2);
            const char* a1 = cA + (size_t)(t + 1) * kstep;
            const char* a2 = last ? nA : cA + (size_t)(t + 2) * kstep; const char* b2 = last ? nB : cB + (size_t)(t + 2) * kstep;
            const char* a3 = a2 + kstep; const char* b3 = b2 + kstep;
            if (last && has_next) S.a_ready(nxt);
            if constexpr (Epi::MIDK) { if (t == Epi::T1 || t == Epi::T2) E.midk(acc, cur, t == Epi::T1 ? 0 : 1, wr, wc, fr, fq); }
            if constexpr (SP2) {
            PG8_LDB(B0, 0, 0); PG8_LDB(B1, 0, 1); PG8_SCHED; PG8_LDA(At, 0, 0); PG8_STAGE(PG8_SA(1, 1), a1 + hstepA, voffA);
            PG8_WAIT_V(8); PG8_WAIT_L(0); PG8_BAR; PG8_MMA(0, 0, At, B0); PG8_MMA(0, 1, At, B1); PG8_BAR; PG8_SCHED;
            PG8_LDA(At, 0, 1); PG8_STAGE(PG8_SB(0, 0), b2, voffB); PG8_STAGE(PG8_SB(0, 1), b2 + hstepB, voffB); PG8_STAGE(PG8_SA(0, 0), a2, voffA);
            PG8_WAIT_V(8); PG8_WAIT_L(0); PG8_BAR; PG8_MMA(1, 0, At, B0); PG8_MMA(1, 1, At, B1); PG8_BAR; PG8_SCHED;
            PG8_LDB(B0, 1, 0); PG8_LDB(B1, 1, 1); PG8_SCHED; PG8_LDA(At, 1, 0); PG8_STAGE(PG8_SA(0, 1), a2 + hstepA, voffA);
            PG8_WAIT_V(8); PG8_WAIT_L(0); PG8_BAR; PG8_MMA(0, 0, At, B0); PG8_MMA(0, 1, At, B1); PG8_BAR; PG8_SCHED;
            PG8_LDA(At, 1, 1); PG8_STAGE(PG8_SB(1, 0), b3, voffB); PG8_STAGE(PG8_SB(1, 1), b3 + hstepB, voffB); PG8_STAGE(PG8_SA(1, 0), a3, voffA);
            PG8_WAIT_V(8); PG8_WAIT_L(0); PG8_BAR; PG8_MMA(1, 0, At, B0); PG8_MMA(1, 1, At, B1); PG8_BAR; PG8_SCHED;
            } else {
            PG8_LDB(B0, 0, 0); PG8_SCHED; PG8_LDA(At, 0, 0); PG8_STAGE(PG8_SA(1, 1), a1 + hstepA, voffA);
            PG8_WAIT_L(8); PG8_BAR; PG8_WAIT_L(0); PG8_MMA(0, 0, At, B0); PG8_BAR; PG8_SCHED;
            PG8_LDB(B1, 0, 1); PG8_STAGE(PG8_SB(0, 0), b2, voffB);
            PG8_BAR; PG8_WAIT_L(0); PG8_MMA(0, 1, At, B1); PG8_BAR;
            PG8_LDA(At, 0, 1); PG8_STAGE(PG8_SA(0, 0), a2, voffA);
            PG8_BAR; PG8_WAIT_L(0); PG8_MMA(1, 0, At, B0); PG8_BAR; PG8_SCHED;
            PG8_STAGE(PG8_SB(0, 1), b2 + hstepB, voffB);
            PG8_WAIT_V(6); PG8_BAR; PG8_MMA(1, 1, At, B1); PG8_BAR;
            PG8_LDB(B0, 1, 0); PG8_SCHED; PG8_LDA(At, 1, 0); PG8_STAGE(PG8_SA(0, 1), a2 + hstepA, voffA);
            PG8_WAIT_L(8); PG8_BAR; PG8_WAIT_L(0); PG8_MMA(0, 0, At, B0); PG8_BAR; PG8_SCHED;
            PG8_LDB(B1, 1, 1); PG8_STAGE(PG8_SB(1, 0), b3, voffB);
            PG8_BAR; PG8_WAIT_L(0); PG8_MMA(0, 1, At, B1); PG8_BAR;
            PG8_LDA(At, 1, 1); PG8_STAGE(PG8_SA(1, 0), a3, voffA);
            PG8_BAR; PG8_WAIT_L(0); PG8_MMA(1, 0, At, B0); PG8_BAR; PG8_SCHED;
            PG8_STAGE(PG8_SB(1, 1), b3 + hstepB, voffB);
            PG8_WAIT_V(6); PG8_BAR; PG8_MMA(1, 1, At, B1); PG8_BAR;
            }
        }
        if constexpr (ALIGN_EPI) { if (wr == 0) PG8_BAR; }
        if constexpr (!Epi::AFTER_DRAIN) { E(acc, cur, wr, wc, fr, fq); S.done(cur); }
        if (!has_next) break;
#pragma unroll
        for (int a = 0; a < 2; ++a)
#pragma unroll
            for (int b = 0; b < 2; ++b)
#pragma unroll
                for (int m = 0; m < 4; ++m)
#pragma unroll
                    for (int n = 0; n < 2; ++n) acc[a][b][m][n] = (f32x4){0.f, 0.f, 0.f, 0.f};
        cur = nxt; cA = nA; cB = nB; ++ui;
        if constexpr (ALIGN_EPI) { if (wr == 1) PG8_BAR; }
    }
    PG8_WAIT_V(0);
    if constexpr (!ALIGN_EPI) { if (wr == 0) PG8_BAR; }
    PG8_BAR;
    if constexpr (Epi::AFTER_DRAIN) { E.fused(acc, cur, wr, wc, fr, fq, lds, wid, lane); S.done(cur); }
#undef PG8_SA
#undef PG8_SB
#undef PG8_STAGE
#undef PG8_LDA
#undef PG8_LDB
#undef PG8_MMA
#undef PG8_WAIT_V
#undef PG8_WAIT_L
#undef PG8_BAR
#undef PG8_SCHED
}
}

constexpr int DM = 4096, FF = 5632, SEQ = 4096, CTXL = 256, TL = 8192, TC = 512, MR = TL + TC, NLAYER = 2;
constexpr int ZW = 24576, ZN = 24832, INW = 24608, MODW = 36864;
constexpr int Z_DNK = 0, Z_DNV = 1024, Z_NAK = 2048, Z_NAV = 4096, Z_DNQ = 6144, Z_NAQ = 7168, Z_DNG = 9216, Z_GMU = 10240, Z_GMV = 11264, Z_GA = 12288;
constexpr float EPS = 1e-6f;
constexpr int NWAVES = 8, NTHR = 512;
typedef unsigned short bf16;
typedef float f32x4 __attribute__((ext_vector_type(4)));
typedef float f32x2 __attribute__((ext_vector_type(2)));
typedef unsigned v4u __attribute__((ext_vector_type(4)));
typedef unsigned v2u __attribute__((ext_vector_type(2)));
#define GAS __attribute__((address_space(1)))

constexpr size_t al256(size_t x) { return (x + 255) & ~(size_t)255; }
constexpr size_t WS_CTL = 0, CTL_ZERO_BYTES = 1u << 20;
constexpr size_t WS_MOD = CTL_ZERO_BYTES;
constexpr size_t WS_W13 = WS_MOD + al256((size_t)NLAYER * 3 * MODW * 4);
constexpr size_t SZ_W13 = (size_t)2 * FF * DM * 2;
constexpr size_t WS_W2 = WS_W13 + 4 * SZ_W13;
constexpr size_t SZ_W2 = (size_t)DM * FF * 2;
constexpr size_t WS_WIN = WS_W2 + 4 * SZ_W2;
constexpr size_t SZ_WIN = (size_t)ZN * DM * 2;
constexpr size_t WS_PC = WS_WIN + 2 * SZ_WIN;
constexpr size_t SZ_SQ = (size_t)DM * DM * 2;
constexpr size_t WS_WO = WS_PC + 2 * SZ_SQ;
constexpr size_t WS_H = WS_WO + 2 * SZ_SQ;
constexpr size_t WS_XN = WS_H + (size_t)MR * DM * 4;
constexpr size_t WS_HB = WS_XN + (size_t)MR * DM * 2;
constexpr size_t WS_Z = WS_HB + (size_t)MR * FF * 2;
constexpr size_t WS_ZAB = WS_Z + (size_t)MR * ZW * 2;
constexpr size_t SZ_DN = (size_t)MR * 1024 * 4;
constexpr size_t WS_G = WS_ZAB + (size_t)MR * 32 * 4;
constexpr size_t WS_BETA = WS_G + (size_t)MR * 16 * 4;
constexpr size_t WS_OF = WS_BETA + (size_t)MR * 16 * 4, WS_OB = WS_OF + SZ_DN;
constexpr size_t WS_VN = WS_OB + SZ_DN;
constexpr size_t WS_YCAT = WS_VN + SZ_DN;
constexpr size_t WS_YF = WS_YCAT + (size_t)MR * DM * 2;
constexpr size_t WS_YB = WS_YF + (size_t)MR * DM * 4;
constexpr size_t WS_VTL = WS_YB + (size_t)MR * DM * 2;
constexpr size_t WS_VTC = WS_VTL + (size_t)2 * 16 * 128 * SEQ * 2;
constexpr size_t WS_KB = WS_VTC + (size_t)2 * 16 * 128 * CTXL * 2;
constexpr size_t WS_QB = WS_KB + (size_t)MR * 1024 * 2;
constexpr size_t WS_KT = WS_QB + (size_t)MR * 1024 * 2;
constexpr size_t SZ_KT = (size_t)2 * 8 * 128 * (CTXL + SEQ) * 2;
constexpr size_t WS_VT2 = WS_KT + SZ_KT;
constexpr size_t WS_WB = WS_VT2 + SZ_KT;
constexpr size_t WS_UB = WS_WB + (size_t)2176 * 64 * 128 * 2;
constexpr size_t WS_QKM = WS_UB + (size_t)2176 * 64 * 128 * 4;
constexpr size_t WS_EG = WS_QKM + (size_t)2176 * 64 * 64 * 2;
constexpr size_t WS_ROPE = WS_EG + (size_t)2176 * 128 * 4;
constexpr size_t WS_SLAB = WS_ROPE + 2048 * 2 * 4;
constexpr size_t WS_GF = WS_SLAB + (size_t)8 * TC * DM * 4;
constexpr size_t WS_END = WS_GF + (size_t)32 * 48 * 8 * 16 * 64 * 8 * 2;
constexpr int CW_AQ = 1024;
constexpr int CW_FN = 2048;
constexpr int CW_UF = 8192;
constexpr int CW_BAR = 4096;

constexpr int RING_BYTES = 131072, MISC_OFF = RING_BYTES + 320, LDS_BYTES = 147456;

#define LAS __attribute__((address_space(3)))
#define LDS_WAIT() asm volatile("s_waitcnt lgkmcnt(0)" ::: "memory")
#define VM_WAIT() asm volatile("s_waitcnt vmcnt(0)" ::: "memory")
#define XB_TMO      128
#define XB_XCNT(j)  (256  + 64 * (j))
#define XB_XSUB(j)  (1280 + 64 * (j))
#define XB_XGEN(j)  (2304 + 64 * (j))
#define XB_TOP      3328
#define XB_TOPGEN   3392
#define XCD_BAR_WORDS 3456
#define XB_SPIN_CAP (1u << 18)

__device__ __forceinline__ unsigned xb_ld(unsigned* p)              { return __hip_atomic_load(p, __ATOMIC_RELAXED, __HIP_MEMORY_SCOPE_AGENT); }
__device__ __forceinline__ unsigned xb_add(unsigned* p, unsigned v) { return __hip_atomic_fetch_add(p, v, __ATOMIC_RELAXED, __HIP_MEMORY_SCOPE_AGENT); }
__device__ __forceinline__ unsigned xb_xcc_id() { return (unsigned)__builtin_amdgcn_s_getreg((3 << 11) | 20) & 0xFu; }
#define XB_SPIN(cond, bar) do { unsigned _sp = 0; while (cond) { __builtin_amdgcn_s_sleep(1); \
    if ((++_sp & 255u) == 0u) { if (xb_ld(&(bar)[XB_TMO])) break; if (_sp > XB_SPIN_CAP) { atomicAdd(&(bar)[XB_TMO], 1u); break; } } } } while (0)

struct XcdBarrier {
    unsigned* bar; unsigned x;
    volatile LAS unsigned* st;
};

__device__ __forceinline__ XcdBarrier xcd_barrier_post(unsigned* bar, volatile LAS unsigned* st) {
    XcdBarrier b; b.bar = bar; b.x = xb_xcc_id(); b.st = st;
    if (threadIdx.x == 0) (void)xb_add(&bar[XB_XCNT(b.x)], 1u);
    return b;
}
__device__ __forceinline__ void xcd_barrier_complete(unsigned* bar, unsigned x, unsigned& nloc, unsigned& nx) {
    const unsigned G = gridDim.x * gridDim.y * gridDim.z;
    unsigned sum, cnt, mine, sp = 0u;
    for (;;) {
        sum = 0u; cnt = 0u; mine = 0u;
#pragma unroll
        for (unsigned j = 0; j < 16; ++j) { const unsigned c = xb_ld(&bar[XB_XCNT(j)]); sum += c; cnt += (c > 0u) ? 1u : 0u; mine = (j == x) ? c : mine; }
        if (sum == G) break;
        __builtin_amdgcn_s_sleep(1);
        if ((++sp & 255u) == 0u) { if (xb_ld(&bar[XB_TMO])) break; if (sp > XB_SPIN_CAP) { atomicAdd(&bar[XB_TMO], 1u); break; } }
    }
    nloc = mine > 0u ? mine : 1u; nx = cnt > 0u ? cnt : 1u;
}

__device__ __forceinline__ void xcd_barrier(const XcdBarrier& b) {
    asm volatile("s_waitcnt vmcnt(0)" ::: "memory");
    __syncthreads();
    if (threadIdx.x == 0) {
        unsigned* bar = b.bar;
        __builtin_amdgcn_s_waitcnt(0);
        unsigned nloc = b.st[0], nx = b.st[1];
        if (nloc == 0u) { xcd_barrier_complete(bar, b.x, nloc, nx); b.st[0] = nloc; b.st[1] = nx; }
        const unsigned old = xb_add(&bar[XB_XSUB(b.x)], 1u);
        const unsigned gen = old / nloc;
        if (old + 1u == (gen + 1u) * nloc) {
            __builtin_amdgcn_fence(__ATOMIC_RELEASE, "agent");
            asm volatile("s_waitcnt vmcnt(0)" ::: "memory");
            const unsigned og = xb_add(&bar[XB_TOP], 1u);
            const unsigned tg = og / nx;
            if (og + 1u == (tg + 1u) * nx) xb_add(&bar[XB_TOPGEN], 1u);
            else XB_SPIN(xb_ld(&bar[XB_TOPGEN]) == tg, bar);
            __builtin_amdgcn_fence(__ATOMIC_ACQUIRE, "agent");
            xb_add(&bar[XB_XGEN(b.x)], 1u);
            asm volatile("s_waitcnt vmcnt(0)" ::: "memory");
        } else {
            XB_SPIN(xb_ld(&bar[XB_XGEN(b.x)]) == gen, bar);
            __builtin_amdgcn_fence(__ATOMIC_ACQUIRE, "agent");
            asm volatile("s_waitcnt vmcnt(0)" ::: "memory");
        }
    }
    __syncthreads();
}

__device__ __forceinline__ float wave_sum(float v) {
#pragma unroll
    for (int o = 1; o < 64; o <<= 1) v += __shfl_xor(v, o);
    return v;
}
__device__ __forceinline__ float wave_max(float v) {
#pragma unroll
    for (int o = 1; o < 64; o <<= 1) v = fmaxf(v, __shfl_xor(v, o));
    return v;
}
__device__ __forceinline__ float bflo(unsigned u) { return __builtin_bit_cast(float, u << 16); }
__device__ __forceinline__ float bfhi(unsigned u) { return __builtin_bit_cast(float, u & 0xffff0000u); }
typedef __bf16 bf16x2v_t __attribute__((ext_vector_type(2)));
__device__ __forceinline__ unsigned pk2(float lo, float hi) { bf16x2v_t v = {(__bf16)lo, (__bf16)hi}; return __builtin_bit_cast(unsigned, v); }
__device__ __forceinline__ float sigmoidf_(float x) { return 1.0f / (1.0f + __expf(-x)); }
__device__ __forceinline__ float siluf_(float x) { return x * sigmoidf_(x); }
__device__ __forceinline__ float gelu_tanh(float x) { const float u = 1.5957691216057308f * (x + 0.044715f * x * x * x); return x / (1.0f + __expf(-u)); }
__device__ __forceinline__ void row_info(int row, int& base, int& t, int& T, int& v) {
    if (row < TL) { const int b = row >> 12; base = b << 12; t = row & 4095; T = SEQ; v = b; }
    else { const int r = row - TL; const int b = r >> 8; base = TL + (b << 8); t = r & 255; T = CTXL; v = 2; }
}

__device__ __forceinline__ void cvt_item(const float* __restrict__ W, int N, bf16* WT, size_t dpitch, int k0, int n0, size_t dbase, LAS float* scr, int lane) {
#pragma unroll 8
    for (int i = 0; i < 32; ++i) { const int kk = 2 * i + (lane >> 5); scr[kk * 33 + (lane & 31)] = __builtin_nontemporal_load(W + (size_t)(k0 + kk) * N + n0 + (lane & 31)); }
    LDS_WAIT(); asm volatile("" ::: "memory");
    const int c = lane & 7;
#pragma unroll
    for (int j = 0; j < 4; ++j) { const int n = (lane >> 3) + 8 * j; const LAS float* s = scr + (8 * c) * 33 + n;
        v4u o; o.x = pk2(s[0 * 33], s[1 * 33]); o.y = pk2(s[2 * 33], s[3 * 33]); o.z = pk2(s[4 * 33], s[5 * 33]); o.w = pk2(s[6 * 33], s[7 * 33]);
        __builtin_nontemporal_store(o, (GAS v4u*)(WT + dbase + (size_t)n * dpitch + k0 + 8 * c)); }
    LDS_WAIT(); asm volatile("" ::: "memory");
}
template <int MODE> __device__ __forceinline__ void cvt_matrix(const float* __restrict__ W, int K, int N, bf16* WT, size_t dpitch, int koff, int gw, int NGW, LAS float* scr, int lane) {
    const int nblk = N / 32, ngroups = (K / 512) * nblk, wg = gw >> 3, G_ = NGW >> 3, wv = gw & 7;
    for (int gi = wg; gi < ngroups; gi += G_) {
        const int kq = gi / nblk, nb = gi - kq * nblk, kb = 8 * kq + wv, n0 = nb * 32;
        int drow0;
        if (MODE == 0) drow0 = n0;
        else if (MODE == 1) drow0 = (n0 >> 7) * 256 + (n0 & 127);
        else if (MODE == 2) drow0 = (n0 >> 7) * 256 + 128 + (n0 & 127);
        else drow0 = nb < 64 ? n0 : (nb == 64 ? ZW : n0 - 32);
        cvt_item(W, N, WT, dpitch, kb * 64, n0, (size_t)drow0 * dpitch + koff, scr, lane);
    }
}

__device__ __forceinline__ void mod_phase(const float* __restrict__ cvec, const float* __restrict__ cctx, const float* __restrict__ ada_w, const float* __restrict__ ada_b, float* mod,
                                          LAS unsigned char* lds, int tid, int lane, int wave, int bid, int G, int l_lo, int l_hi) {
    LAS float* sc = (LAS float*)lds;
    LAS float* red = (LAS float*)(lds + 49152);
    for (int i = tid; i < 3 * DM; i += NTHR) { const int v = i >> 12, k = i & 4095; const float x = v < 2 ? cvec[v * DM + k] : cctx[k]; sc[i] = siluf_(x); }
    __syncthreads();
    const int cl = lane & 15, kr = lane >> 4;
    for (int item = l_lo * (MODW / 64) + bid; item < l_hi * (MODW / 64); item += G) {
        const int l = item / (MODW / 64), cb = item - l * (MODW / 64), col0 = cb * 64;
        const float* wp = ada_w + (size_t)l * DM * MODW + col0 + 4 * cl;
        f32x4 a0 = {0.f, 0.f, 0.f, 0.f}, a1 = a0, a2 = a0;
#pragma unroll 8
        for (int i = 0; i < 128; ++i) { const int k = wave * 4 + kr + 32 * i;
            const f32x4 w = *(const f32x4*)(wp + (size_t)k * MODW);
            a0 += w * sc[k]; a1 += w * sc[DM + k]; a2 += w * sc[2 * DM + k]; }
#pragma unroll
        for (int e = 0; e < 4; ++e) { a0[e] += __shfl_xor(a0[e], 16); a0[e] += __shfl_xor(a0[e], 32); a1[e] += __shfl_xor(a1[e], 16); a1[e] += __shfl_xor(a1[e], 32); a2[e] += __shfl_xor(a2[e], 16); a2[e] += __shfl_xor(a2[e], 32); }
        if (kr == 0) {
#pragma unroll
            for (int e = 0; e < 4; ++e) { red[(wave * 3 + 0) * 64 + 4 * cl + e] = a0[e]; red[(wave * 3 + 1) * 64 + 4 * cl + e] = a1[e]; red[(wave * 3 + 2) * 64 + 4 * cl + e] = a2[e]; } }
        __syncthreads();
        if (tid < 192) { const int v = tid >> 6, c = tid & 63; float s = 0.f;
#pragma unroll
            for (int w = 0; w < 8; ++w) s += red[(w * 3 + v) * 64 + c];
            mod[((size_t)l * 3 + v) * MODW + col0 + c] = s + ada_b[(size_t)l * MODW + col0 + c]; }
        __syncthreads();
    }
}

__device__ __forceinline__ void norm_phase(const float* in_lat, const float* in_ctx, const float* __restrict__ nw, const float* modl  , int isub, bf16* xn, int nrows,
                                           const float* slab, const float* gatev, float coef, float* hctx_out, LAS unsigned char* lds, int tid, int lane, int gw, int NGW) {
    LAS float* AL = (LAS float*)lds;
    LAS float* SL = AL + 3 * DM;
    __syncthreads();
    for (int i = tid; i < 3 * DM / 4; i += NTHR) { const int v = i >> 10, c = (i & 1023) * 4;
        const f32x4 w = *(const f32x4*)(nw + c), sc = *(const f32x4*)(modl + (size_t)v * MODW + (isub * 3 + 1) * DM + c), sh = *(const f32x4*)(modl + (size_t)v * MODW + (isub * 3 + 0) * DM + c);
        *(LAS f32x4*)(AL + v * DM + c) = w * (sc + 1.0f); *(LAS f32x4*)(SL + v * DM + c) = sh; }
    __syncthreads();
    f32x4 xq[16];
    if (gw < nrows) { const float* s0 = gw < TL ? in_lat + (size_t)gw * DM : in_ctx + (size_t)(gw - TL) * DM;
#pragma unroll
        for (int j = 0; j < 16; ++j) xq[j] = *(const f32x4*)(s0 + 4 * (lane + 64 * j)); }
    for (int row = gw; row < nrows; row += NGW) {
        const int v = row < SEQ ? 0 : (row < TL ? 1 : 2);
        f32x4 x[16]; float ss = 0.f;
#pragma unroll
        for (int j = 0; j < 16; ++j) x[j] = xq[j];
        { const int nr = row + NGW;
          if (nr < nrows) { const float* s1 = nr < TL ? in_lat + (size_t)nr * DM : in_ctx + (size_t)(nr - TL) * DM;
#pragma unroll
            for (int j = 0; j < 16; ++j) xq[j] = *(const f32x4*)(s1 + 4 * (lane + 64 * j)); } }
        if (slab != nullptr && row >= TL) {
            float* ho = hctx_out + (size_t)(row - TL) * DM;
#pragma unroll
            for (int j = 0; j < 16; ++j) { const int c = 4 * (lane + 64 * j); f32x4 s = *(const f32x4*)(slab + (size_t)(row - TL) * DM + c);
#pragma unroll
                for (int k = 1; k < 8; ++k) s += *(const f32x4*)(slab + ((size_t)k * 512 + (row - TL)) * DM + c);
                x[j] += (*(const f32x4*)(gatev + c) * coef) * s; *(f32x4*)(ho + c) = x[j]; }
        }
#pragma unroll
        for (int j = 0; j < 16; ++j) ss += (x[j][0] * x[j][0] + x[j][1] * x[j][1]) + (x[j][2] * x[j][2] + x[j][3] * x[j][3]);
        const float r = 1.0f / sqrtf(wave_sum(ss) * (1.0f / DM) + EPS);
#pragma unroll
        for (int j = 0; j < 16; ++j) { const int c = 4 * (lane + 64 * j);
            const f32x4 a = *(const LAS f32x4*)(AL + v * DM + c), sh = *(const LAS f32x4*)(SL + v * DM + c);
            const f32x4 y = (x[j] * r) * a + sh;
            v2u o; o.x = pk2(y[0], y[1]); o.y = pk2(y[2], y[3]);
            *(v2u*)(xn + (size_t)row * DM + c) = o; }
    }
}
__device__ __forceinline__ void final_norm_phase(const float* h, const float* __restrict__ fw, float* out, int lane, int gw, int NGW) {
    for (int row = gw; row < TL; row += NGW) {
        const float* src = h + (size_t)row * DM;
        f32x4 x[16]; float ss = 0.f;
#pragma unroll
        for (int j = 0; j < 16; ++j) { x[j] = *(const f32x4*)(src + 4 * (lane + 64 * j)); ss += (x[j][0] * x[j][0] + x[j][1] * x[j][1]) + (x[j][2] * x[j][2] + x[j][3] * x[j][3]); }
        const float r = 1.0f / sqrtf(wave_sum(ss) * (1.0f / DM) + EPS);
#pragma unroll
        for (int j = 0; j < 16; ++j) { const int c = 4 * (lane + 64 * j); const f32x4 w = *(const f32x4*)(fw + c);
            *(f32x4*)(out + (size_t)row * DM + c) = (x[j] * r) * w;
            if ((j & 3) == 3) asm volatile("" ::: "memory"); }
    }
}

__device__ __forceinline__ void gm_prep_phase(const bf16* z, const float* __restrict__ snw, float* vn, int lane, int gw, int NGW) {
    v4u pu[2] = {{0u, 0u, 0u, 0u}, {0u, 0u, 0u, 0u}};
    if (gw < MR) { pu[0] = *(const v4u*)(z + (size_t)gw * ZW + Z_GMV + 8 * lane); pu[1] = *(const v4u*)(z + (size_t)gw * ZW + Z_GMV + 8 * lane + 512); }
    for (int row = gw; row < MR; row += NGW) {
        float x[16]; float s = 0.f;
        const v4u cu0 = pu[0], cu1 = pu[1];
        if (row + NGW < MR) { pu[0] = *(const v4u*)(z + (size_t)(row + NGW) * ZW + Z_GMV + 8 * lane); pu[1] = *(const v4u*)(z + (size_t)(row + NGW) * ZW + Z_GMV + 8 * lane + 512); }
#pragma unroll
        for (int j = 0; j < 2; ++j) { const v4u u = j ? cu1 : cu0;
            x[8 * j + 0] = gelu_tanh(bflo(u.x)); x[8 * j + 1] = gelu_tanh(bfhi(u.x)); x[8 * j + 2] = gelu_tanh(bflo(u.y)); x[8 * j + 3] = gelu_tanh(bfhi(u.y));
            x[8 * j + 4] = gelu_tanh(bflo(u.z)); x[8 * j + 5] = gelu_tanh(bfhi(u.z)); x[8 * j + 6] = gelu_tanh(bflo(u.w)); x[8 * j + 7] = gelu_tanh(bfhi(u.w)); }
#pragma unroll
        for (int i = 0; i < 16; ++i) s += x[i];
        const float mu = wave_sum(s) * (1.0f / 1024.0f); float q = 0.f;
#pragma unroll
        for (int i = 0; i < 16; ++i) { x[i] -= mu; q += x[i] * x[i]; }
        const float rs = 1.0f / sqrtf(wave_sum(q) * (1.0f / 1024.0f) + EPS);
#pragma unroll
        for (int j = 0; j < 2; ++j) { const int c = 8 * lane + 512 * j;
            const f32x4 w0 = *(const f32x4*)(snw + c), w1 = *(const f32x4*)(snw + c + 4);
            *(f32x4*)(vn + (size_t)row * 1024 + c) = (f32x4){x[8 * j + 0] * rs * w0[0], x[8 * j + 1] * rs * w0[1], x[8 * j + 2] * rs * w0[2], x[8 * j + 3] * rs * w0[3]};
            *(f32x4*)(vn + (size_t)row * 1024 + c + 4) = (f32x4){x[8 * j + 4] * rs * w1[0], x[8 * j + 5] * rs * w1[1], x[8 * j + 6] * rs * w1[2], x[8 * j + 7] * rs * w1[3]}; }
    }
}

__device__ __forceinline__ void dn_out_phase(const float* of, const float* ob, const bf16* z, const float* __restrict__ dnw, bf16* ycat, int nrows, int lane, int gw, int NGW) {
    const int sub = lane >> 4, l16 = lane & 15;
    const f32x4 w0 = *(const f32x4*)(dnw + 8 * l16), w1 = *(const f32x4*)(dnw + 8 * l16 + 4);
    f32x4 pf0 = {0.f, 0.f, 0.f, 0.f}, pf1 = pf0, pb0 = pf0, pb1 = pf0; v4u pg = {0u, 0u, 0u, 0u};
    { const int it0 = gw * 4 + sub; if (it0 < nrows * 8) { const int row = it0 >> 3, hd = it0 & 7; const size_t o = (size_t)row * 1024 + hd * 128 + 8 * l16;
        pf0 = *(const f32x4*)(of + o); pf1 = *(const f32x4*)(of + o + 4); pb0 = *(const f32x4*)(ob + o); pb1 = *(const f32x4*)(ob + o + 4); pg = *(const v4u*)(z + (size_t)row * ZW + Z_DNG + hd * 128 + 8 * l16); } }
    for (int it = gw * 4 + sub; it < nrows * 8; it += NGW * 4) {
        const int row = it >> 3, hd = it & 7;
        f32x4 a0 = pf0 + pb0, a1 = pf1 + pb1; const v4u gu = pg;
        { const int it2 = it + NGW * 4; if (it2 < nrows * 8) { const int row2 = it2 >> 3, hd2 = it2 & 7; const size_t o2 = (size_t)row2 * 1024 + hd2 * 128 + 8 * l16;
            pf0 = *(const f32x4*)(of + o2); pf1 = *(const f32x4*)(of + o2 + 4); pb0 = *(const f32x4*)(ob + o2); pb1 = *(const f32x4*)(ob + o2 + 4); pg = *(const v4u*)(z + (size_t)row2 * ZW + Z_DNG + hd2 * 128 + 8 * l16); } }
        float ss = (a0[0] * a0[0] + a0[1] * a0[1]) + (a0[2] * a0[2] + a0[3] * a0[3]) + (a1[0] * a1[0] + a1[1] * a1[1]) + (a1[2] * a1[2] + a1[3] * a1[3]);
        ss += __shfl_xor(ss, 1); ss += __shfl_xor(ss, 2); ss += __shfl_xor(ss, 4); ss += __shfl_xor(ss, 8);
        const float r = 1.0f / sqrtf(ss * (1.0f / 128.0f) + EPS);
        v4u out; out.x = pk2(a0[0] * r * w0[0] * siluf_(bflo(gu.x)), a0[1] * r * w0[1] * siluf_(bfhi(gu.x))); out.y = pk2(a0[2] * r * w0[2] * siluf_(bflo(gu.y)), a0[3] * r * w0[3] * siluf_(bfhi(gu.y)));
        out.z = pk2(a1[0] * r * w1[0] * siluf_(bflo(gu.z)), a1[1] * r * w1[1] * siluf_(bfhi(gu.z))); out.w = pk2(a1[2] * r * w1[2] * siluf_(bflo(gu.w)), a1[3] * r * w1[3] * siluf_(bfhi(gu.w)));
        *(v4u*)(ycat + (size_t)row * DM + 1024 + hd * 128 + 8 * l16) = out;
    }
}
__device__ __forceinline__ void merge_ctx_phase(const float* slab, const bf16* z, bf16* yb, int lane, int gw, int NGW) {
    for (int r = gw; r < TC; r += NGW) { const size_t row = (size_t)TL + r;
#pragma unroll 4
        for (int j = 0; j < 16; ++j) { const int c = 4 * (lane + 64 * j); f32x4 y = {0.f, 0.f, 0.f, 0.f};
#pragma unroll
            for (int br = 0; br < 3; ++br) { const v2u gu = *(const v2u*)(z + row * ZW + Z_GA + br * 4096 + c);
                f32x4 s = {0.f, 0.f, 0.f, 0.f};
#pragma unroll
                for (int k = (br == 0 ? 0 : (br == 1 ? 2 : 4)); k < (br == 0 ? 2 : (br == 1 ? 4 : 8)); ++k) s += *(const f32x4*)(slab + ((size_t)k * 512 + r) * DM + c);
                y[0] += sigmoidf_(bflo(gu.x)) * s[0]; y[1] += sigmoidf_(bfhi(gu.x)) * s[1]; y[2] += sigmoidf_(bflo(gu.y)) * s[2]; y[3] += sigmoidf_(bfhi(gu.y)) * s[3]; }
            v2u o; o.x = pk2(y[0], y[1]); o.y = pk2(y[2], y[3]); *(v2u*)(yb + row * DM + c) = o; }
    }
}

__device__ __forceinline__ void vt_phase(const bf16* z, bf16* vf, bf16* vtc, LAS unsigned char* lds, int lane, int wave, int gw, int NGW) {
    LAS unsigned short* T = (LAS unsigned short*)(lds + wave * 8448);
    constexpr int NIT = 2 * 16 * 4 * 2;
    for (int it = gw; it < NIT; it += NGW) {
        const int dh = it & 1; int r = it >> 1; const int tb = 64 + (r & 3); r >>= 2; const int h = r & 15, b = r >> 4;
        const int row0 = tb < 64 ? b * SEQ + tb * 64 : TL + b * CTXL + (tb - 64) * 64;
#pragma unroll
        for (int j = 0; j < 8; ++j) { const int tok = 8 * j + (lane >> 3), ch = lane & 7;
            const v4u v = *(const v4u*)(z + (size_t)(row0 + tok) * ZW + Z_NAV + h * 128 + dh * 64 + 8 * ch);
            LAS unsigned* d = (LAS unsigned*)(T + tok * 66 + 8 * ch); d[0] = v.x; d[1] = v.y; d[2] = v.z; d[3] = v.w; }
        LDS_WAIT(); asm volatile("" ::: "memory");
        unsigned w[32];
#pragma unroll
        for (int t = 0; t < 32; ++t) w[t] = (unsigned)T[(2 * t) * 66 + lane] | ((unsigned)T[(2 * t + 1) * 66 + lane] << 16);
        if (tb < 64) { bf16* dst = vf + (((size_t)(b * 16 + h) * 512 + tb * 8) * 128 + dh * 64 + lane) * 8;
#pragma unroll
            for (int j = 0; j < 8; ++j) *(v4u*)(dst + (size_t)j * 1024) = (v4u){w[4 * j], w[4 * j + 1], w[4 * j + 2], w[4 * j + 3]};
        } else { bf16* dst = vtc + ((size_t)(b * 16 + h) * 128 + dh * 64 + lane) * CTXL + (tb - 64) * 64;
#pragma unroll
            for (int j = 0; j < 8; ++j) *(v4u*)(dst + 8 * j) = (v4u){w[4 * j], w[4 * j + 1], w[4 * j + 2], w[4 * j + 3]}; }
        LDS_WAIT(); asm volatile("" ::: "memory");
    }
}

typedef short bf16x8_t __attribute__((ext_vector_type(8)));
struct AttnState { float mrun, lrun; f32x4 oa[8]; };
template <bool LOC, bool QFR> __device__ __forceinline__ void attn_chunk(AttnState& st, const char* qbase, const char* kbase, const char* vbase,
                                                               const LAS unsigned char* KL, const LAS unsigned char* VL, const LAS float* rpbL, int cc, int drow0, int lo, int cg, int lane) {
    asm volatile("" : "+v"(lane));
    const int q = lane & 15, g = lane >> 4, krl = 8 * (q >> 2) + (q & 3);
    const int c = 16 * cg + q, c0 = min(max(c - 8, 0), 48);
    const unsigned kloff = (unsigned)((q >> 2) * 2048 + g * 64 + (q & 3) * 16), vloff = (unsigned)(g * 2048 + q * 16), qloff = QFR ? (unsigned)lane * 16u : (unsigned)(q * ZW + 8 * g) * 2u;
    const float scale = 0.08838834764831845f;
    f32x4 sX[4], sY[4];
    bf16x8_t fr[LOC ? 4 : 1][8];
    bf16x8_t qf[4];
#pragma unroll
    for (int k = 0; k < 4; ++k) qf[k] = *(const GAS bf16x8_t*)((const GAS char*)qbase + qloff + (QFR ? 1024 : 64) * k);
    if constexpr (LOC) {
#pragma unroll
        for (int i = 0; i < 4; ++i) { const char* pk = kbase + (size_t)i * 16384; asm volatile("" : "+s"(pk));
#pragma unroll
            for (int y = 0; y < 2; ++y)
#pragma unroll
                for (int k = 0; k < 4; ++k) fr[i][4 * y + k] = *(const GAS bf16x8_t*)((const GAS char*)pk + kloff + (1024 * y + 256 * k)); }
        asm volatile("" ::: "memory");
#pragma unroll
        for (int i = 0; i < 4; ++i) { f32x4 ax = {0.f, 0.f, 0.f, 0.f}, ay = ax;
#pragma unroll
            for (int k = 0; k < 4; ++k) { ax = __builtin_amdgcn_mfma_f32_16x16x32_bf16(fr[i][k], qf[k], ax, 0, 0, 0); ay = __builtin_amdgcn_mfma_f32_16x16x32_bf16(fr[i][4 + k], qf[k], ay, 0, 0, 0); }
            sX[i] = ax; sY[i] = ay; }
#pragma unroll
        for (int i = 0; i < 4; ++i) { const char* pv = vbase + (size_t)i * 16384; asm volatile("" : "+s"(pv));
#pragma unroll
            for (int d = 0; d < 8; ++d) fr[i][d] = *(const GAS bf16x8_t*)((const GAS char*)pv + vloff + 256 * d); }
        asm volatile("" ::: "memory");
    } else {
#pragma unroll
        for (int i = 0; i < 4; ++i) { const int keyx = 128 * cc + 32 * i + krl, keyy = keyx + 4;
            const int fx = ((keyx & 15) + 4 * ((keyx >> 4) & 1)) & 15, fy = ((keyy & 15) + 4 * ((keyy >> 4) & 1)) & 15;
            bf16x8_t kx[4], ky[4];
#pragma unroll
            for (int k = 0; k < 4; ++k) { kx[k] = *(const LAS bf16x8_t*)(KL + keyx * 256 + (((4 * k + g) ^ fx) << 4)); ky[k] = *(const LAS bf16x8_t*)(KL + keyy * 256 + (((4 * k + g) ^ fy) << 4)); }
            f32x4 ax = {0.f, 0.f, 0.f, 0.f}, ay = ax;
#pragma unroll
            for (int k = 0; k < 4; ++k) { ax = __builtin_amdgcn_mfma_f32_16x16x32_bf16(kx[k], qf[k], ax, 0, 0, 0); ay = __builtin_amdgcn_mfma_f32_16x16x32_bf16(ky[k], qf[k], ay, 0, 0, 0); }
            sX[i] = ax; sY[i] = ay; }
    }
    float mx = -3.0e38f;
#pragma unroll
    for (int i = 0; i < 4; ++i) {
#pragma unroll
        for (int e = 0; e < 4; ++e) {
            float x = sX[i][e] * scale, y = sY[i][e] * scale;
            if constexpr (LOC) { const int kcx = lo + 8 * g + e, kcy = kcx + 4; const int dr = drow0 + i;
                const bool vx = (kcx >= c0) && (kcx < c0 + 16), vy = (kcy >= c0) && (kcy < c0 + 16);
                const float bx = rpbL[dr * 31 + min(max(kcx - c + 15, 0), 30)], by = rpbL[dr * 31 + min(max(kcy - c + 15, 0), 30)];
                x = vx ? x + bx : -1.0e30f; y = vy ? y + by : -1.0e30f; }
            sX[i][e] = x; sY[i][e] = y; mx = fmaxf(mx, fmaxf(x, y)); }
    }
    mx = fmaxf(mx, __shfl_xor(mx, 16)); mx = fmaxf(mx, __shfl_xor(mx, 32));
    const float mnew = fmaxf(st.mrun, mx), alpha = __expf(st.mrun - mnew);
    st.mrun = mnew;
    float psum = 0.f;
#pragma unroll
    for (int i = 0; i < 4; ++i)
#pragma unroll
        for (int e = 0; e < 4; ++e) { const float x = __expf(sX[i][e] - mnew), y = __expf(sY[i][e] - mnew); sX[i][e] = x; sY[i][e] = y; psum += x + y; }
    st.lrun = st.lrun * alpha + psum;
#pragma unroll
    for (int d = 0; d < 8; ++d) st.oa[d] *= alpha;
#pragma unroll
    for (int i = 0; i < 4; ++i) {
        v4u pu; pu.x = pk2(sX[i][0], sX[i][1]); pu.y = pk2(sX[i][2], sX[i][3]); pu.z = pk2(sY[i][0], sY[i][1]); pu.w = pk2(sY[i][2], sY[i][3]);
        const bf16x8_t pf = __builtin_bit_cast(bf16x8_t, pu);
        if constexpr (LOC) {
#pragma unroll
            for (int d = 0; d < 8; ++d) st.oa[d] = __builtin_amdgcn_mfma_f32_16x16x32_bf16(fr[i][d], pf, st.oa[d], 0, 0, 0);
        } else { const int chn = 16 * cc + 4 * i + g; bf16x8_t vf[8];
#pragma unroll
            for (int d = 0; d < 8; ++d) vf[d] = *(const LAS bf16x8_t*)(VL + (16 * d + q) * 512 + ((chn ^ q) << 4));
#pragma unroll
            for (int d = 0; d < 8; ++d) st.oa[d] = __builtin_amdgcn_mfma_f32_16x16x32_bf16(vf[d], pf, st.oa[d], 0, 0, 0); }
    }
}
template <bool LOCAL> __device__ __forceinline__ void attn_unit(const bf16* z, const bf16* qfb, const bf16* vtl  , const bf16* kf, const LAS unsigned char* KL, const LAS unsigned char* VL, const LAS float* rpbL, bf16* ycat, int b, int r, int cg, int qb, int h, int lane) {
    const int qrow0 = LOCAL ? (b * SEQ + r * 64 + 16 * cg) : (TL + b * CTXL + 16 * qb);
    const int r0 = min(max(r - 4, 0), 56), lo = min(max(16 * cg - 8, 0), 32);
    const char* qbase = LOCAL ? (const char*)qfb + (((size_t)(b * 16 + h) * 256 + r * 4 + cg) * 4) * 1024 : (const char*)(z + (size_t)qrow0 * ZW + Z_NAQ + h * 128);
    AttnState st; st.mrun = -3.0e38f; st.lrun = 0.f;
#pragma unroll
    for (int d = 0; d < 8; ++d) st.oa[d] = (f32x4){0.f, 0.f, 0.f, 0.f};
    if constexpr (LOCAL) {
#pragma unroll 1
        for (int ck = 0; ck < 2; ++ck) {
            const int tok0 = (r0 + 4 * ck) * 64 + lo;
            const char* kbase = (const char*)kf + ((size_t)(b * 16 + h) * 1024 + (tok0 >> 2)) * 1024;
            const char* vbase = (const char*)vtl + ((size_t)(b * 16 + h) * 512 + (tok0 >> 3)) * 2048;
            attn_chunk<true, true>(st, qbase, kbase, vbase, KL, VL, rpbL, 0, r0 + 4 * ck - r + 7, lo, cg, lane);
        }
    }
#pragma unroll 1
    for (int cc = 0; cc < 2; ++cc) attn_chunk<false, LOCAL>(st, qbase, nullptr, nullptr, KL, VL, rpbL, cc, 0, 0, 0, lane);
    asm volatile("" : "+v"(lane));
    const int q = lane & 15, g = lane >> 4;
    float lrun = st.lrun;
    lrun += __shfl_xor(lrun, 16); lrun += __shfl_xor(lrun, 32);
    const float inv = 1.0f / lrun;
    bf16* op = ycat + (size_t)(qrow0 + q) * DM + 2048 + h * 128 + 4 * g;
#pragma unroll
    for (int d = 0; d < 8; ++d) { v2u o; o.x = pk2(st.oa[d][0] * inv, st.oa[d][1] * inv); o.y = pk2(st.oa[d][2] * inv, st.oa[d][3] * inv); *(v2u*)(op + 16 * d) = o; }
}

__device__ __forceinline__ int attn_item_bh(int it) { return (it & 7) + 8 * ((it >> 3) & 3); }
__device__ __forceinline__ void attn_wg(int it, const bf16* z, const bf16* vtl  , const bf16* kf, const bf16* qfb, const bf16* vtc, const float* __restrict__ rpb  , bf16* ycat, bool ctxq, bool stage, LAS unsigned char* lds, int tid) {
    const int bh = attn_item_bh(it), rp = it >> 5, b = bh >> 4, h = bh & 15;
    LAS unsigned char* KL = lds; LAS unsigned char* VL = lds + 65536; LAS float* rpbL = (LAS float*)(lds + RING_BYTES + 1024);
    asm volatile("" : "+v"(tid));
    __syncthreads();
    if (stage) {
#pragma unroll
    for (int j = 0; j < 8; ++j) { const int i = tid + NTHR * j; const int key = i >> 4, ch = i & 15; const int fk = ((key & 15) + 4 * ((key >> 4) & 1)) & 15;
        *(LAS v4u*)(KL + key * 256 + ((ch ^ fk) << 4)) = *(const v4u*)(z + (size_t)(TL + b * CTXL + key) * ZW + Z_NAK + h * 128 + 8 * ch); }
#pragma unroll
    for (int j = 0; j < 8; ++j) { const int i = tid + NTHR * j; const int dim = i >> 5, ch = i & 31;
        *(LAS v4u*)(VL + dim * 512 + ((ch ^ (dim & 15)) << 4)) = *(const v4u*)(vtc + ((size_t)(b * 16 + h) * 128 + dim) * CTXL + 8 * ch); }
    for (int i = tid; i < 465; i += NTHR) rpbL[i] = rpb[h * 465 + i];
    }
    __syncthreads();
    asm volatile("" : "+v"(tid));
    const int wave = __builtin_amdgcn_readfirstlane(tid >> 6), lane = tid & 63;
    attn_unit<true>(z, qfb, vtl, kf, KL, VL, rpbL, ycat, b, 2 * rp + (wave >> 2), wave & 3, 0, h, lane);
    if (ctxq && wave == 0 && (rp & 1) == 0) attn_unit<false>(z, qfb, vtl, kf, KL, VL, rpbL, ycat, b, 0, 0, rp >> 1, h, lane);
}

constexpr int NPOS = CTXL + SEQ;
__device__ __forceinline__ int pos_row(int b, int P) { return P < CTXL ? TL + b * CTXL + P : b * SEQ + (P - CTXL); }

__device__ __forceinline__ void rope_table_phase(float* rope, int lane, int gw, int NGW) {
    for (int i = gw * 64 + lane; i < 2048; i += NGW * 64) { const int pos = i >> 5, fi = i & 31; const float f = powf(10000.0f, -(float)fi * (1.0f / 32.0f)); float s, c; sincosf((float)pos * f, &s, &c); rope[2 * i] = c; rope[2 * i + 1] = s; }
}
__device__ __forceinline__ void dn_prep3_phase(const bf16* z, const float* zab, const float* __restrict__ convw, const float* __restrict__ a_log, const float* __restrict__ dt_bias, const float* rope,
                                               bf16* KB, bf16* QB, bf16* KT, bf16* VT2, float* gout, float* bout, int lane, int gw, int NGW) {
    const int i0 = (2 * lane) & 31; const bool second = (lane & 16) != 0;
#define DN_LOADZ(dst, itx) do { const int tb_ = (itx) >> 3, ch_ = ((itx) & 7) * 128 + 2 * lane; int t0_, T_, base_; \
        if (tb_ < 1024) { t0_ = (tb_ & 511) * 8; T_ = SEQ; base_ = (tb_ >> 9) * SEQ; } else { const int cb_ = tb_ - 1024; t0_ = (cb_ & 31) * 8; T_ = CTXL; base_ = TL + (cb_ >> 5) * CTXL; } \
        _Pragma("unroll") for (int w = 0; w < 3; ++w) { const int zc_ = (w == 0 ? Z_DNK : (w == 1 ? Z_DNV : Z_DNQ)) + ch_; \
            _Pragma("unroll") for (int r = 0; r < 12; ++r) { const int tt_ = t0_ - 2 + r; dst[w][r] = (tt_ >= 0 && tt_ < T_) ? *(const unsigned*)(z + (size_t)(base_ + tt_) * ZW + zc_) : 0u; } } } while (0)
    unsigned zn[3][12];
    if (gw < 1088 * 8) DN_LOADZ(zn, gw);
#pragma unroll 1
    for (int it = gw; it < 1088 * 8; it += NGW) {
        const int tb = it >> 3, hd = it & 7;
        int row0, b, t0, T, base, P0;
        if (tb < 1024) { row0 = tb * 8; b = tb >> 9; t0 = (tb & 511) * 8; T = SEQ; base = b * SEQ; P0 = CTXL + t0; }
        else { const int cb = tb - 1024; row0 = TL + cb * 8; b = cb >> 5; t0 = (cb & 31) * 8; T = CTXL; base = TL + b * CTXL; P0 = t0; }
        (void)T; (void)base;
        const int ch = hd * 128 + 2 * lane;
        unsigned zz[3][12]; f32x2 wv[3][5];
#pragma unroll
        for (int w = 0; w < 3; ++w) { const int wc = (w == 0 ? 0 : (w == 1 ? 1024 : 2048)) + ch;
#pragma unroll
            for (int r = 0; r < 12; ++r) zz[w][r] = zn[w][r];
#pragma unroll
            for (int j = 0; j < 5; ++j) wv[w][j] = *(const f32x2*)(convw + j * 3072 + wc); }
        if (it + NGW < 1088 * 8) DN_LOADZ(zn, it + NGW);
        f32x4 cs[8];
        if (tb < 1024) {
#pragma unroll
            for (int tk = 0; tk < 8; ++tk) { const int t = t0 + tk; const int pos = (lane < 32) ? (t >> 6) : (t & 63); cs[tk] = *(const f32x4*)(rope + (size_t)(pos * 32 + i0) * 2); }
        }
        float y[3][8][2]; float ssq[16];
#pragma unroll
        for (int w = 0; w < 3; ++w)
#pragma unroll
            for (int tk = 0; tk < 8; ++tk) { float a0 = 0.f, a1 = 0.f;
#pragma unroll
                for (int j = 0; j < 5; ++j) { a0 += wv[w][j][0] * bflo(zz[w][tk + j]); a1 += wv[w][j][1] * bfhi(zz[w][tk + j]); }
                y[w][tk][0] = siluf_(a0); y[w][tk][1] = siluf_(a1); }
#pragma unroll
        for (int tk = 0; tk < 8; ++tk) { ssq[tk] = y[0][tk][0] * y[0][tk][0] + y[0][tk][1] * y[0][tk][1]; ssq[8 + tk] = y[2][tk][0] * y[2][tk][0] + y[2][tk][1] * y[2][tk][1]; }
#pragma unroll
        for (int st = 0; st < 4; ++st) { const int msk = 1 << st; const bool up = (lane & msk) != 0;
#pragma unroll
            for (int j = 0; j < (8 >> st); ++j) { const float a = ssq[2 * j], c2 = ssq[2 * j + 1]; const float keep = up ? c2 : a, send = up ? a : c2; ssq[j] = keep + __shfl_xor(send, msk); } }
        float tot = ssq[0]; tot += __shfl_xor(tot, 16); tot += __shfl_xor(tot, 32);
        const float rnl = 1.0f / sqrtf(tot + EPS);
        unsigned kd[8], qd[8];
#pragma unroll
        for (int tk = 0; tk < 8; ++tk) {
            const float rk = __builtin_bit_cast(float, __builtin_amdgcn_readlane(__builtin_bit_cast(int, rnl), tk)), rq = __builtin_bit_cast(float, __builtin_amdgcn_readlane(__builtin_bit_cast(int, rnl), 8 + tk));
            float k0 = y[0][tk][0] * rk, k1 = y[0][tk][1] * rk, q0 = y[2][tk][0] * rq, q1 = y[2][tk][1] * rq;
            if (tb < 1024) { const f32x4 c4 = cs[tk];
                const float pk0 = __shfl_xor(k0, 16), pk1 = __shfl_xor(k1, 16), pq0 = __shfl_xor(q0, 16), pq1 = __shfl_xor(q1, 16);
                if (!second) { k0 = k0 * c4[0] - pk0 * c4[1]; k1 = k1 * c4[2] - pk1 * c4[3]; q0 = q0 * c4[0] - pq0 * c4[1]; q1 = q1 * c4[2] - pq1 * c4[3]; }
                else { k0 = k0 * c4[0] + pk0 * c4[1]; k1 = k1 * c4[2] + pk1 * c4[3]; q0 = q0 * c4[0] + pq0 * c4[1]; q1 = q1 * c4[2] + pq1 * c4[3]; } }
            q0 *= 0.08838834764831845f; q1 *= 0.08838834764831845f;
            y[0][tk][0] = k0; y[0][tk][1] = k1; y[2][tk][0] = q0; y[2][tk][1] = q1;
            kd[tk] = pk2(k0, k1); qd[tk] = pk2(q0, q1);
        }
        { const bool l2 = (lane & 2) == 0, l1 = (lane & 1) == 0;
#define DN_QT4(d) do { unsigned r0_ = (unsigned)__shfl_xor((int)(l2 ? d[2] : d[0]), 2), r1_ = (unsigned)__shfl_xor((int)(l2 ? d[3] : d[1]), 2); d[2] = l2 ? r0_ : d[2]; d[3] = l2 ? r1_ : d[3]; d[0] = l2 ? d[0] : r0_; d[1] = l2 ? d[1] : r1_; \
            r0_ = (unsigned)__shfl_xor((int)(l1 ? d[1] : d[0]), 1); r1_ = (unsigned)__shfl_xor((int)(l1 ? d[3] : d[2]), 1); d[1] = l1 ? r0_ : d[1]; d[3] = l1 ? r1_ : d[3]; d[0] = l1 ? d[0] : r0_; d[2] = l1 ? d[2] : r1_; } while (0)
          unsigned ka[4] = {kd[0], kd[1], kd[2], kd[3]}, kb2[4] = {kd[4], kd[5], kd[6], kd[7]}, qa[4] = {qd[0], qd[1], qd[2], qd[3]}, qb2[4] = {qd[4], qd[5], qd[6], qd[7]};
          DN_QT4(ka); DN_QT4(kb2); DN_QT4(qa); DN_QT4(qb2);
#undef DN_QT4
          const size_t fo2 = ((((((size_t)(b * 8 + hd) * 68 + (P0 >> 6)) * 4 + ((P0 >> 4) & 3)) * 4 + (lane >> 4)) * 4 + ((lane >> 2) & 3)) * 16 + (P0 & 15) + (lane & 3)) * 8;
          *(v4u*)(KB + fo2) = (v4u){ka[0], ka[1], ka[2], ka[3]}; *(v4u*)(KB + fo2 + 32) = (v4u){kb2[0], kb2[1], kb2[2], kb2[3]};
          *(v4u*)(QB + fo2) = (v4u){qa[0], qa[1], qa[2], qa[3]}; *(v4u*)(QB + fo2 + 32) = (v4u){qb2[0], qb2[1], qb2[2], qb2[3]}; }
        const size_t fo = (((((size_t)(b * 8 + hd) * 68 + (P0 >> 6)) * 8 + (lane >> 3)) * 2 + ((P0 >> 5) & 1)) * 64 + ((P0 >> 3) & 3) * 16 + 2 * (lane & 7)) * 8;
        bf16* ktp = KT + fo; bf16* vtp = VT2 + fo;
        *(v4u*)(ktp) = (v4u){pk2(y[0][0][0], y[0][1][0]), pk2(y[0][2][0], y[0][3][0]), pk2(y[0][4][0], y[0][5][0]), pk2(y[0][6][0], y[0][7][0])};
        *(v4u*)(ktp + 8) = (v4u){pk2(y[0][0][1], y[0][1][1]), pk2(y[0][2][1], y[0][3][1]), pk2(y[0][4][1], y[0][5][1]), pk2(y[0][6][1], y[0][7][1])};
        *(v4u*)(vtp) = (v4u){pk2(y[1][0][0], y[1][1][0]), pk2(y[1][2][0], y[1][3][0]), pk2(y[1][4][0], y[1][5][0]), pk2(y[1][6][0], y[1][7][0])};
        *(v4u*)(vtp + 8) = (v4u){pk2(y[1][0][1], y[1][1][1]), pk2(y[1][2][1], y[1][3][1]), pk2(y[1][4][1], y[1][5][1]), pk2(y[1][6][1], y[1][7][1])};
        if (lane < 16) { const int row = row0 + (lane & 7), dir = lane >> 3;
            const float alpha = zab[(size_t)row * 32 + dir * 8 + hd], bz = zab[(size_t)row * 32 + 16 + dir * 8 + hd];
            const float xs = alpha + dt_bias[dir * 8 + hd]; const float sp = xs > 20.f ? xs : log1pf(expf(xs));
            gout[(size_t)row * 16 + dir * 8 + hd] = -expf(a_log[dir * 8 + hd]) * sp;
            bout[(size_t)row * 16 + dir * 8 + hd] = 1.0f / (1.0f + expf(-bz)); }
    }
}
#undef DN_LOADZ


constexpr int NINST = 2 * 8 * 2 * 68;
__device__ __forceinline__ int chunk_P0(int dir, int n) { return dir == 0 ? 64 * n : (n < 4 ? CTXL - 64 * (n + 1) : NPOS - 64 * (n - 3)); }
__device__ __forceinline__ void dn_chunk_phase(const bf16* KB, const bf16* QB, const bf16* KT, const bf16* VT2, const float* G, const float* BETA, bf16* WB, float* UB, bf16* QKM, float* EGb,
                                               LAS unsigned char* lds, int lane, int wave, int gw, int NGW) {
    LAS float* AL = (LAS float*)(lds + wave * 16384);
    LAS unsigned short* T1L = (LAS unsigned short*)AL; LAS unsigned short* T2L = T1L + 4096;
    LAS float* SV = (LAS float*)(lds + RING_BYTES + 1024 + wave * 1024);
    const int q16 = lane & 15, g = lane >> 4;
#pragma unroll 1
    for (int inst = gw; inst < NINST; inst += NGW) {
        const int n = inst % 68, rr = inst / 68, dir = rr & 1, hd = (rr >> 1) & 7, b = rr >> 4;
        const int P0 = chunk_P0(dir, n);
        const int rowi = pos_row(b, dir ? P0 + 63 - lane : P0 + lane);
        const float bi = BETA[(size_t)rowi * 16 + dir * 8 + hd];
        float gc = G[(size_t)rowi * 16 + dir * 8 + hd];
#pragma unroll
        for (int o = 1; o < 64; o <<= 1) { const float t = __shfl_up(gc, o); if (lane >= o) gc += t; }
        asm volatile("s_waitcnt lgkmcnt(0)" ::: "memory");
        SV[lane] = gc; SV[64 + lane] = bi;
        asm volatile("s_waitcnt lgkmcnt(0)" ::: "memory");
        const float gc63 = __shfl(gc, 63);
        EGb[(size_t)inst * 128 + lane] = __expf(gc); EGb[(size_t)inst * 128 + 64 + lane] = __expf(gc63 - gc);
        bf16x8_t kf[4][4];
        const size_t fb0 = ((size_t)(b * 8 + hd) * 68 + (P0 >> 6)) * 4; const int q16p = dir ? 15 - q16 : q16;
#pragma unroll
        for (int blk = 0; blk < 4; ++blk) {
#pragma unroll
            for (int ks = 0; ks < 4; ++ks) kf[blk][ks] = *(const bf16x8_t*)(KB + ((((fb0 + (dir ? 3 - blk : blk)) * 4 + ks) * 4 + g) * 16 + q16p) * 8); }
#pragma unroll
        for (int ib = 0; ib < 4; ++ib) {
            const int i = 16 * ib + q16; const float gci = SV[i], bti = SV[64 + i];
            bf16x8_t qfr[4];
#pragma unroll
            for (int ks = 0; ks < 4; ++ks) qfr[ks] = *(const bf16x8_t*)(QB + ((((fb0 + (dir ? 3 - ib : ib)) * 4 + ks) * 4 + g) * 16 + q16p) * 8);
#pragma unroll
            for (int jb = 0; jb < 4; ++jb) {
                v2u qo = {0u, 0u};
                if (jb <= ib) {
                    f32x4 ck = {0.f, 0.f, 0.f, 0.f}, cq = ck;
#pragma unroll
                    for (int ks = 0; ks < 4; ++ks) { ck = __builtin_amdgcn_mfma_f32_16x16x32_bf16(kf[jb][ks], kf[ib][ks], ck, 0, 0, 0); cq = __builtin_amdgcn_mfma_f32_16x16x32_bf16(kf[jb][ks], qfr[ks], cq, 0, 0, 0); }
                    const f32x4 gcj = *(const LAS f32x4*)(SV + 16 * jb + 4 * g);
                    f32x4 av, qv;
#pragma unroll
                    for (int e = 0; e < 4; ++e) { const int j = 16 * jb + 4 * g + e; const float dec = __expf(gci - gcj[e]);
                        av[e] = (i > j) ? bti * ck[e] * dec : 0.f; qv[e] = (i >= j) ? cq[e] * dec : 0.f; }
                    *(LAS f32x4*)(AL + i * 64 + 16 * jb + 4 * g) = av;
                    qo.x = pk2(qv[0], qv[1]); qo.y = pk2(qv[2], qv[3]);
                }
                *(v2u*)(QKM + ((((size_t)inst * 4 + ib) * 2 + (jb >> 1)) * 64 + (2 * (jb & 1) + (g >> 1)) * 16 + q16) * 8 + 4 * (g & 1)) = qo;
            }
        }
        asm volatile("s_waitcnt lgkmcnt(0)" ::: "memory");
        float T[64];
        {
            T[0] = (lane == 0) ? 1.f : 0.f;
#pragma unroll
            for (int i = 1; i < 64; ++i) {
                float acc0 = (lane == i) ? 1.f : 0.f, acc1 = 0.f;
#pragma unroll
                for (int hb = 0; hb < 2; ++hb) {
                    if (8 * hb < (i + 3) / 4) {
                        f32x4 rowc[8];
#pragma unroll
                        for (int jj = 0; jj < 8; ++jj) rowc[jj] = *(const LAS f32x4*)(AL + i * 64 + 32 * hb + 4 * jj);
#pragma unroll
                        for (int jj = 0; jj < 8; ++jj) {
#pragma unroll
                            for (int e = 0; e < 4; ++e) if (32 * hb + 4 * jj + e < i) { if (jj & 1) acc1 -= rowc[jj][e] * T[32 * hb + 4 * jj + e]; else acc0 -= rowc[jj][e] * T[32 * hb + 4 * jj + e]; } }
                    }
                }
                T[i] = acc0 + acc1;
            }
        }
        asm volatile("s_waitcnt lgkmcnt(0)" ::: "memory");
        { const float s1 = bi, s2 = bi * __expf(gc); const int pc = dir ? 63 - lane : lane;
#pragma unroll
          for (int i = 0; i < 64; ++i) { T1L[i * 64 + pc] = (unsigned short)(pk2(T[i] * s1, 0.f) & 0xffffu); T2L[i * 64 + pc] = (unsigned short)(pk2(T[i] * s2, 0.f) & 0xffffu); } }
        asm volatile("s_waitcnt lgkmcnt(0)" ::: "memory");
        const size_t fb = (((size_t)(b * 8 + hd) * 68 + (P0 >> 6)) * 16 * 64 + lane) * 8;
        const bf16* vtb = VT2 + fb; const bf16* ktb = KT + fb;
#pragma unroll
        for (int half = 0; half < 2; ++half) {
            bf16x8_t xf[8][2];
#pragma unroll
            for (int db = 0; db < 8; ++db)
#pragma unroll
                for (int ks = 0; ks < 2; ++ks) xf[db][ks] = *(const bf16x8_t*)((half ? ktb : vtb) + (2 * db + ks) * 512);
#pragma unroll
            for (int ib = 0; ib < 4; ++ib) {
                bf16x8_t tf[2];
#pragma unroll
                for (int ks = 0; ks < 2; ++ks) tf[ks] = *(const LAS bf16x8_t*)((half ? T2L : T1L) + (16 * ib + q16) * 64 + 32 * ks + 8 * g);
#pragma unroll
                for (int db = 0; db < 8; ++db) {
                    f32x4 c = {0.f, 0.f, 0.f, 0.f};
                    if (half == 0) {
#pragma unroll
                        for (int ks = 0; ks < 2; ++ks) c = __builtin_amdgcn_mfma_f32_16x16x32_bf16(tf[ks], xf[db][ks], c, 0, 0, 0);
                        *(f32x4*)(UB + (((size_t)inst * 8 + db) * 4 + ib) * 256 + lane * 4) = c;
                    } else {
#pragma unroll
                        for (int ks = 0; ks < 2; ++ks) c = __builtin_amdgcn_mfma_f32_16x16x32_bf16(xf[db][ks], tf[ks], c, 0, 0, 0);
                        v2u o; o.x = pk2(c[0], c[1]); o.y = pk2(c[2], c[3]);
                        *(v2u*)(WB + ((((size_t)inst * 4 + ib) * 4 + (db >> 1)) * 64 + (2 * (db & 1) + (g >> 1)) * 16 + q16) * 8 + 4 * (g & 1)) = o;
                    }
                }
            }
        }
        asm volatile("s_waitcnt lgkmcnt(0)" ::: "memory");
    }
}

struct DnStSet { bf16x8_t wf[4], kt[2][2]; f32x4 u4, ek4; float dec; };
struct DnOutSet { bf16x8_t qf[4], qk[2]; f32x4 eg4; int orow[4]; };
__device__ __forceinline__ void dn_scan_phase(const bf16* QB, const bf16* KT, const bf16* WB, const float* UB, const bf16* QKM, const float* EGb, float* OF, float* OB,
                                              LAS unsigned char* lds, int tid, int bid, int G) {
    const int wave = __builtin_amdgcn_readfirstlane(tid >> 6), lane = tid & 63, q16 = lane & 15, g = lane >> 4, rb = wave & 3;
    LAS unsigned short* SbL = (LAS unsigned short*)lds;
    LAS unsigned short* VnL = SbL + 16 * 136;
    LAS unsigned short* Vn2L = VnL + 16 * 72;
#pragma unroll 1
    for (int unit = bid; unit < 256; unit += G) {
        const int dvb = (unit >> 3) & 7, chain = 4 * (unit & 7) + (unit >> 6), dir = chain & 1, hd = (chain >> 1) & 7, b = chain >> 4;
        __syncthreads();
        for (int i = tid; i < 16 * 136 / 2; i += NTHR) ((LAS unsigned*)SbL)[i] = 0u;
        __syncthreads();
        float* od = dir ? OB : OF;
        if (wave < 4) {
            f32x4 s0 = {0.f, 0.f, 0.f, 0.f}, s1 = s0;
            const bf16* ktb = KT + ((size_t)(b * 8 + hd) * 68 * 16 * 64 + (size_t)(4 * rb) * 64 + lane) * 8;
            DnStSet st[3];
#define DN_LOAD_ST(S_, n_) do { const size_t inst_ = (size_t)chain * 68 + (n_); const int P0_ = chunk_P0(dir, (n_)); \
                _Pragma("unroll") for (int ks = 0; ks < 4; ++ks) S_.wf[ks] = *(const bf16x8_t*)(WB + (((inst_ * 4 + rb) * 4 + ks) * 64 + lane) * 8); \
                _Pragma("unroll") for (int t = 0; t < 2; ++t) _Pragma("unroll") for (int ks = 0; ks < 2; ++ks) S_.kt[t][ks] = *(const bf16x8_t*)(ktb + ((size_t)(P0_ >> 6) * 16 + 2 * t + ks) * 512); \
                S_.u4 = *(const f32x4*)(UB + ((inst_ * 8 + dvb) * 4 + rb) * 256 + lane * 4); S_.ek4 = *(const f32x4*)(EGb + inst_ * 128 + 64 + 16 * rb + 4 * g); S_.dec = EGb[inst_ * 128 + 63]; } while (0)
#define DN_STEP_ST(j_, n_) do { if ((n_) + 2 < 68) DN_LOAD_ST(st[((j_) + 2) % 3], (n_) + 2); \
        bf16x8_t sf[4]; \
        _Pragma("unroll") \
        for (int ks = 0; ks < 4; ++ks) sf[ks] = *(const LAS bf16x8_t*)(SbL + q16 * 136 + 32 * ks + 8 * g); \
        f32x4 acc = {0.f, 0.f, 0.f, 0.f}; \
        _Pragma("unroll") \
        for (int ks = 0; ks < 4; ++ks) acc = __builtin_amdgcn_mfma_f32_16x16x32_bf16(st[(j_)].wf[ks], sf[ks], acc, 0, 0, 0); \
        const f32x4 v = st[(j_)].u4 - acc; \
        { v2u o; o.x = pk2(v[0], v[1]); o.y = pk2(v[2], v[3]); *(LAS v2u*)(VnL + q16 * 72 + 16 * rb + 4 * g) = o; \
        const f32x4 vs = v * st[(j_)].ek4; v2u o2; \
        if (dir == 0) { o2.x = pk2(vs[0], vs[1]); o2.y = pk2(vs[2], vs[3]); *(LAS v2u*)(Vn2L + q16 * 72 + 16 * rb + 4 * g) = o2; } \
        else { o2.x = pk2(vs[3], vs[2]); o2.y = pk2(vs[1], vs[0]); *(LAS v2u*)(Vn2L + q16 * 72 + 60 - 16 * rb - 4 * g) = o2; } } \
        __syncthreads(); \
        bf16x8_t vf[2]; \
        _Pragma("unroll") \
        for (int ks = 0; ks < 2; ++ks) vf[ks] = *(const LAS bf16x8_t*)(Vn2L + q16 * 72 + 32 * ks + 8 * g); \
        s0 *= st[(j_)].dec; s1 *= st[(j_)].dec; \
        _Pragma("unroll") \
        for (int ks = 0; ks < 2; ++ks) { s0 = __builtin_amdgcn_mfma_f32_16x16x32_bf16(st[(j_)].kt[0][ks], vf[ks], s0, 0, 0, 0); s1 = __builtin_amdgcn_mfma_f32_16x16x32_bf16(st[(j_)].kt[1][ks], vf[ks], s1, 0, 0, 0); } \
        { v2u o; o.x = pk2(s0[0], s0[1]); o.y = pk2(s0[2], s0[3]); *(LAS v2u*)(SbL + q16 * 136 + 32 * rb + 4 * g) = o; \
        o.x = pk2(s1[0], s1[1]); o.y = pk2(s1[2], s1[3]); *(LAS v2u*)(SbL + q16 * 136 + 32 * rb + 16 + 4 * g) = o; } \
        __syncthreads(); } while (0)
            DN_LOAD_ST(st[0], 0); DN_LOAD_ST(st[1], 1);
#pragma unroll 1
            for (int n3 = 0; n3 < 66; n3 += 3) { DN_STEP_ST(0, n3); DN_STEP_ST(1, n3 + 1); DN_STEP_ST(2, n3 + 2); }
            DN_STEP_ST(0, 66); DN_STEP_ST(1, 67);
#undef DN_STEP_ST
#undef DN_LOAD_ST
        } else {
            DnOutSet os[3];
#define DN_LOAD_OUT(S_, n_) do { const size_t inst_ = (size_t)chain * 68 + (n_); const int P0_ = chunk_P0(dir, (n_)); const int i_ = 16 * rb + q16; \
                const size_t qb_ = (((size_t)(b * 8 + hd) * 68 + (P0_ >> 6)) * 4 + (dir ? 3 - rb : rb)) * 4; (void)i_; \
                _Pragma("unroll") for (int ks = 0; ks < 4; ++ks) S_.qf[ks] = *(const bf16x8_t*)(QB + (((qb_ + ks) * 4 + g) * 16 + (dir ? 15 - q16 : q16)) * 8); \
                _Pragma("unroll") for (int ks = 0; ks < 2; ++ks) S_.qk[ks] = *(const bf16x8_t*)(QKM + (((inst_ * 4 + rb) * 2 + ks) * 64 + lane) * 8); \
                S_.eg4 = *(const f32x4*)(EGb + inst_ * 128 + 16 * rb + 4 * g); \
                _Pragma("unroll") for (int e = 0; e < 4; ++e) { const int io_ = 16 * rb + 4 * g + e; S_.orow[e] = pos_row(b, dir ? P0_ + 63 - io_ : P0_ + io_); } } while (0)
#define DN_STEP_OUT(j_, n_) do { if ((n_) + 2 < 68) DN_LOAD_OUT(os[((j_) + 2) % 3], (n_) + 2); \
        bf16x8_t sf[4]; \
        _Pragma("unroll") \
        for (int ks = 0; ks < 4; ++ks) sf[ks] = *(const LAS bf16x8_t*)(SbL + q16 * 136 + 32 * ks + 8 * g); \
        f32x4 oacc = {0.f, 0.f, 0.f, 0.f}; \
        _Pragma("unroll") \
        for (int ks = 0; ks < 4; ++ks) oacc = __builtin_amdgcn_mfma_f32_16x16x32_bf16(os[(j_)].qf[ks], sf[ks], oacc, 0, 0, 0); \
        oacc *= os[(j_)].eg4; \
        __syncthreads(); \
        bf16x8_t vf[2]; \
        _Pragma("unroll") \
        for (int ks = 0; ks < 2; ++ks) vf[ks] = *(const LAS bf16x8_t*)(VnL + q16 * 72 + 32 * ks + 8 * g); \
        _Pragma("unroll") \
        for (int ks = 0; ks < 2; ++ks) oacc = __builtin_amdgcn_mfma_f32_16x16x32_bf16(os[(j_)].qk[ks], vf[ks], oacc, 0, 0, 0); \
        _Pragma("unroll") \
        for (int e = 0; e < 4; ++e) od[(size_t)os[(j_)].orow[e] * 1024 + hd * 128 + 16 * dvb + q16] = oacc[e]; \
        __syncthreads(); } while (0)
            DN_LOAD_OUT(os[0], 0); DN_LOAD_OUT(os[1], 1);
#pragma unroll 1
            for (int n3 = 0; n3 < 66; n3 += 3) { DN_STEP_OUT(0, n3); DN_STEP_OUT(1, n3 + 1); DN_STEP_OUT(2, n3 + 2); }
            DN_STEP_OUT(0, 66); DN_STEP_OUT(1, 67);
#undef DN_STEP_OUT
#undef DN_LOAD_OUT
        }
    }
}

__device__ __forceinline__ void gm_item2(int chunk, int grp, const bf16* z, const float* vn, const float* __restrict__ sw  , const float* __restrict__ sb  , bf16* ycat, bool stage_w, LAS unsigned char* lds, int tid) {
    LAS unsigned short* WL = (LAS unsigned short*)lds;
    LAS unsigned short* VL = WL + 128 * 136;
    const int row0 = chunk < 64 ? chunk * 128 : TL + (chunk - 64) * 128;
    __syncthreads();
    if (stage_w)
    for (int i = tid; i < 128 * 32; i += NTHR) { const int pp = i >> 5, q4 = (i & 31) * 4;
        const f32x4 w = *(const f32x4*)(sw + (size_t)grp * 16384 + pp * 128 + q4);
        v2u o; o.x = pk2(w[0], w[1]); o.y = pk2(w[2], w[3]); *(LAS v2u*)(WL + pp * 136 + q4) = o; }
    for (int i = tid; i < 128 * 32; i += NTHR) { const int q = i >> 5, c4 = (i & 31) * 4;
        const f32x4 v = *(const f32x4*)(vn + (size_t)(row0 + q) * 1024 + grp * 128 + c4);
        const unsigned a = pk2(v[0], v[1]), b2 = pk2(v[2], v[3]);
        VL[(c4 + 0) * 136 + q] = (unsigned short)(a & 0xffffu); VL[(c4 + 1) * 136 + q] = (unsigned short)(a >> 16);
        VL[(c4 + 2) * 136 + q] = (unsigned short)(b2 & 0xffffu); VL[(c4 + 3) * 136 + q] = (unsigned short)(b2 >> 16); }
    __syncthreads();
    const int wave = __builtin_amdgcn_readfirstlane(tid >> 6), lane = tid & 63, q16 = lane & 15, gq = lane >> 4;
    bf16x8_t af[4];
#pragma unroll
    for (int ks = 0; ks < 4; ++ks) af[ks] = *(const LAS bf16x8_t*)(VL + (16 * wave + q16) * 136 + 32 * ks + 8 * gq);
    const int c = grp * 128 + 16 * wave + 4 * gq;
#pragma unroll
    for (int pb = 0; pb < 8; ++pb) {
        f32x4 acc = {0.f, 0.f, 0.f, 0.f};
#pragma unroll
        for (int ks = 0; ks < 4; ++ks) { const bf16x8_t bfr = *(const LAS bf16x8_t*)(WL + (16 * pb + q16) * 136 + 32 * ks + 8 * gq); acc = __builtin_amdgcn_mfma_f32_16x16x32_bf16(af[ks], bfr, acc, 0, 0, 0); }
        const int pp = 16 * pb + q16; const size_t row = (size_t)(row0 + pp);
        const float bias = sb[grp * 128 + pp];
        const v2u zu = *(const v2u*)(z + row * ZW + Z_GMU + c);
        v2u o; o.x = pk2(gelu_tanh(bflo(zu.x)) * (acc[0] + bias), gelu_tanh(bfhi(zu.x)) * (acc[1] + bias)); o.y = pk2(gelu_tanh(bflo(zu.y)) * (acc[2] + bias), gelu_tanh(bfhi(zu.y)) * (acc[3] + bias));
        *(v2u*)(ycat + row * DM + c) = o;
    }
}


#define MK_ONE_LAUNCH 1

#ifndef MK_ONE_LAUNCH
#define MK_ONE_LAUNCH 1
#endif
constexpr int NPL = 15;
constexpr int NPH = 1 + NLAYER * NPL + 1;
struct Args { const float* in[24]; float* out; unsigned char* ws; int ph_lo, ph_hi; };

__global__ void __launch_bounds__(NTHR, 2) dit_fwd(Args a) {
    extern __shared__ __attribute__((aligned(16))) unsigned char lds_raw[];
    LAS unsigned char* lds = (LAS unsigned char*)lds_raw;
    volatile LAS unsigned* MISC = (volatile LAS unsigned*)(lds + MISC_OFF);
    const int G = gridDim.x, bid = blockIdx.x, NGW = G * NWAVES;
    const int wave0 = __builtin_amdgcn_readfirstlane((int)threadIdx.x >> 6);
#define PHASE_IDS() int tid = wave0 * 64 + (int)__builtin_amdgcn_mbcnt_hi(~0u, __builtin_amdgcn_mbcnt_lo(~0u, 0u)); asm volatile("" : "+v"(tid)); const int lane = tid & 63, wave = __builtin_amdgcn_readfirstlane(tid >> 6), gw = bid * NWAVES + wave; (void)lane; (void)gw
    for (int u = threadIdx.x; u < (LDS_BYTES - RING_BYTES) / 4; u += NTHR) ((LAS unsigned*)(lds + RING_BYTES))[u] = 0u;
    __syncthreads();
    unsigned char* ws0 = a.ws;
    const int lo = a.ph_lo, hi = a.ph_hi;
    XcdBarrier bar; bar.bar = (unsigned*)(ws0 + WS_CTL) + CW_BAR; bar.x = 0; bar.st = nullptr;
    if (hi - lo > 1) bar = xcd_barrier_post((unsigned*)(ws0 + WS_CTL) + CW_BAR, MISC + 8);
#define IN(k) (lo <= (k) && (k) < hi)
#define SEAM(k) do { if (IN(k) && IN((k) + 1)) xcd_barrier(bar); } while (0)

#define SUB_FIRST(b) ((((b) >> 3) & 7) < 4)
#define KAS __attribute__((address_space(4)))
#define PHASE_PTRS() const KAS char* kp_ = (const KAS char*)__builtin_amdgcn_kernarg_segment_ptr(); asm volatile("" : "+s"(kp_)); \
    unsigned char* const ws = *(unsigned char* const KAS*)(kp_ + 200); (void)ws
#define INP(i) (*(const float* const KAS*)(kp_ + 8 * (i)))
#define P_MOD ((float*)(ws + WS_MOD))
#define P_H ((float*)(ws + WS_H))
#define P_XN ((bf16*)(ws + WS_XN))
#define P_HB ((bf16*)(ws + WS_HB))
#define P_Z ((bf16*)(ws + WS_Z))
#define P_ZAB ((float*)(ws + WS_ZAB))
#define P_GG ((float*)(ws + WS_G))
#define P_BETA ((float*)(ws + WS_BETA))
#define P_OF ((float*)(ws + WS_OF))
#define P_OB ((float*)(ws + WS_OB))
#define P_VN ((float*)(ws + WS_VN))
#define P_YCAT ((bf16*)(ws + WS_YCAT))
#define P_YF ((float*)(ws + WS_YF))
#define P_YB ((bf16*)(ws + WS_YB))
#define P_VTL ((bf16*)(ws + WS_VTL))
#define P_VTC ((bf16*)(ws + WS_VTC))
#define P_KB ((bf16*)(ws + WS_KB))
#define P_QB ((bf16*)(ws + WS_QB))
#define P_KT ((bf16*)(ws + WS_KT))
#define P_VT2 ((bf16*)(ws + WS_VT2))
#define P_WB ((bf16*)(ws + WS_WB))
#define P_UB ((float*)(ws + WS_UB))
#define P_QKM ((bf16*)(ws + WS_QKM))
#define P_EG ((float*)(ws + WS_EG))
#define P_ROPE ((float*)(ws + WS_ROPE))

    if (IN(0)) { PHASE_IDS(); PHASE_PTRS();
        LAS float* scr = (LAS float*)(lds + wave * 16384);
        {
            for (int l = 0; l < NLAYER; ++l) {
                for (int s = 0; s < 2; ++s) { const size_t ls = (size_t)l * 2 + s;
                    cvt_matrix<1>(INP(7) + ls * DM * FF, DM, FF, (bf16*)(ws + WS_W13 + ls * SZ_W13), DM, 0, gw, NGW, scr, lane);
                    cvt_matrix<2>(INP(8) + ls * DM * FF, DM, FF, (bf16*)(ws + WS_W13 + ls * SZ_W13), DM, 0, gw, NGW, scr, lane);
                    cvt_matrix<0>(INP(9) + ls * FF * DM, FF, DM, (bf16*)(ws + WS_W2 + ls * SZ_W2), FF, 0, gw, NGW, scr, lane); }
                cvt_matrix<3>(INP(10) + (size_t)l * DM * INW, DM, INW, (bf16*)(ws + WS_WIN + l * SZ_WIN), DM, 0, gw, NGW, scr, lane);
                cvt_matrix<0>(INP(19) + (size_t)l * 1024 * DM, 1024, DM, (bf16*)(ws + WS_PC + l * SZ_SQ), DM, 0, gw, NGW, scr, lane);
                cvt_matrix<0>(INP(20) + (size_t)l * 1024 * DM, 1024, DM, (bf16*)(ws + WS_PC + l * SZ_SQ), DM, 1024, gw, NGW, scr, lane);
                cvt_matrix<0>(INP(21) + (size_t)l * 2048 * DM, 2048, DM, (bf16*)(ws + WS_PC + l * SZ_SQ), DM, 2048, gw, NGW, scr, lane);
                cvt_matrix<0>(INP(22) + (size_t)l * DM * DM, DM, DM, (bf16*)(ws + WS_WO + l * SZ_SQ), DM, 0, gw, NGW, scr, lane);
            }
        }
        rope_table_phase(P_ROPE, lane, gw, NGW);
        __syncthreads();
        mod_phase(INP(1), INP(3), INP(4), INP(5), P_MOD, lds, tid, lane, wave, bid, G, 0, NLAYER);
    }
    SEAM(0);

    for (int l = 0; l < NLAYER; ++l) {
        const int pb = 1 + l * NPL;
        const bool lastl = (l + 1 == NLAYER);
        for (int sub = 0; sub < 2; ++sub) {
            const int p0 = pb + (sub ? 12 : 0), isub = sub ? 2 : 0;
            const bool first = (l == 0 && sub == 0);
            const bool ctxrows = !(lastl && sub == 1);
            const int MRs = ctxrows ? MR : TL;
            if (IN(p0)) { PHASE_IDS(); PHASE_PTRS();
                const bool hasslab = ctxrows && !first;
                const float* gv = sub == 0 ? P_MOD + ((size_t)(l - 1) * 3 + 2) * MODW + (2 * 3 + 2) * DM : P_MOD + ((size_t)l * 3 + 2) * MODW + (1 * 3 + 2) * DM;
                norm_phase(first ? INP(0) : P_H, first ? INP(2) : P_H + (size_t)TL * DM, INP(6) + ((size_t)l * 3 + isub) * DM, P_MOD + (size_t)l * 3 * MODW, isub, P_XN, MRs,
                           hasslab ? (const float*)(ws + WS_SLAB) : nullptr, gv, sub == 0 ? 0.5f : 1.0f, P_H + (size_t)TL * DM, lds, tid, lane, gw, NGW); }
            SEAM(p0);
            if (IN(p0 + 1)) { PHASE_PTRS();
                pg8::Gemm g{P_XN, (const bf16*)(ws + WS_W13 + ((size_t)l * 2 + sub) * SZ_W13), MRs, 2 * FF, DM, DM, DM};
                pg8::SplitOrder S; S.init(MRs, 2 * FF, DM, G, bid, !ctxrows);
                pg8::EpiSwiGLUS E{{P_HB, FF}, (unsigned)WS_SLAB, (unsigned)(WS_CTL + CW_UF * 4)};
                pg8::gemm_phase<pg8::EpiSwiGLUS, pg8::SplitOrder, true, true>(lds, g, S, E, wave0);
            }
            SEAM(p0 + 1);
            if (IN(p0 + 2)) { PHASE_PTRS();
                pg8::Gemm g{P_HB, (const bf16*)(ws + WS_W2 + ((size_t)l * 2 + sub) * SZ_W2), MRs, DM, FF, FF, FF};
                if (lastl && sub == 1) {
                    pg8::PanelOrder S{G, bid};
                    pg8::EpiFinal E{P_H, *(float* const KAS*)(kp_ + 192), P_MOD + (size_t)l * 3 * MODW + (isub * 3 + 2) * DM, MODW, 0.5f, INP(23), (float*)(ws + WS_SLAB), (unsigned*)(ws + WS_CTL) + CW_FN, (LAS float*)(lds + RING_BYTES + 2048)};
                    pg8::gemm_phase<pg8::EpiFinal, pg8::PanelOrder, true, true>(lds, g, S, E, wave0);
                } else {
                pg8::CombOrder S; S.init(TL, DM, G, bid, 1, ctxrows, SUB_FIRST(bid));
                pg8::EpiResidSlab E{{first ? INP(0) : P_H, first ? INP(2) : P_H + (size_t)TL * DM, P_H, P_MOD + (size_t)l * 3 * MODW + (isub * 3 + 2) * DM, MODW, 0.5f}, {(float*)(ws + WS_SLAB)}};
                pg8::gemm_phase<pg8::EpiResidSlab, pg8::CombOrder, true, true>(lds, g, S, E, wave0);
                }
            }
            if (!(lastl && sub == 1)) SEAM(p0 + 2);
            if (sub == 0) {
                if (IN(pb + 3)) { PHASE_IDS(); PHASE_PTRS();
                    norm_phase(P_H, first ? INP(2) : P_H + (size_t)TL * DM, INP(6) + ((size_t)l * 3 + 1) * DM, P_MOD + (size_t)l * 3 * MODW, 1, P_XN, MR,
                               (const float*)(ws + WS_SLAB), P_MOD + ((size_t)l * 3 + 2) * MODW + (0 * 3 + 2) * DM, 0.5f, P_H + (size_t)TL * DM, lds, tid, lane, gw, NGW); }
                SEAM(pb + 3);
                if (IN(pb + 4)) { PHASE_PTRS();
                    pg8::Gemm g{P_XN, (const bf16*)(ws + WS_WIN + l * SZ_WIN), MR, ZN, DM, DM, DM}; pg8::StaticOrder S; S.init(MR, ZN, G, bid);
                    pg8::EpiZ E{P_Z, ZW, P_ZAB, ZW / 256, (bf16*)(ws + WS_GF), Z_GA / 256, (bf16*)P_YF, (bf16*)P_YF + (size_t)16 * 1024 * 1024, Z_NAK / 256, Z_NAQ / 256, P_VTL, Z_NAV / 256};
                    pg8::gemm_phase<pg8::EpiZ, pg8::StaticOrder, true, true>(lds, g, S, E, wave0);
                }
                SEAM(pb + 4);
                if (IN(pb + 5)) { PHASE_IDS(); PHASE_PTRS();
                    dn_prep3_phase(P_Z, P_ZAB, INP(11) + (size_t)l * 5 * 3072, INP(12) + l * 16, INP(13) + l * 16, P_ROPE, P_KB, P_QB, P_KT, P_VT2, P_GG, P_BETA, lane, gw, NGW);
                    gm_prep_phase(P_Z, INP(17) + (size_t)l * 1024, P_VN, lane, gw, NGW);
                    vt_phase(P_Z, P_VTL, P_VTC, lds, lane, wave, gw, NGW);
                }
                SEAM(pb + 5);
                if (IN(pb + 6)) { PHASE_IDS(); PHASE_PTRS();
                    dn_chunk_phase(P_KB, P_QB, P_KT, P_VT2, P_GG, P_BETA, P_WB, P_UB, P_QKM, P_EG, lds, lane, wave, gw, NGW);
                    { unsigned* aq = (unsigned*)(ws + WS_CTL) + CW_AQ + (l * 8 + (bid & 7)) * 32; volatile LAS unsigned* slot = (volatile LAS unsigned*)(lds + RING_BYTES);
                      int last_bh = -1;
                      for (;;) {
                          __syncthreads();
                          if (tid == 0) *slot = __hip_atomic_fetch_add(aq, 1u, __ATOMIC_RELAXED, __HIP_MEMORY_SCOPE_AGENT);
                          __syncthreads();
                          const unsigned j = *slot;
                          if (j >= 128u) break;
                          const int it = (int)(8u * j) + (bid & 7), ibh = attn_item_bh(it);
                          attn_wg(it, P_Z, P_VTL, (const bf16*)P_YF, (const bf16*)P_YF + (size_t)16 * 1024 * 1024, P_VTC, INP(18) + (size_t)l * 16 * 465, P_YCAT, !lastl, ibh != last_bh, lds, tid);
                          last_bh = ibh;
                      } }
                }
                SEAM(pb + 6);
                if (IN(pb + 7)) { PHASE_IDS(); PHASE_PTRS();
                    dn_scan_phase(P_QB, P_KT, P_WB, P_UB, P_QKM, P_EG, P_OF, P_OB, lds, tid, bid, G);
                    { unsigned* gq = (unsigned*)(ws + WS_CTL) + CW_AQ + (16 + l) * 32; volatile LAS unsigned* slot = (volatile LAS unsigned*)(lds + RING_BYTES); const unsigned nit = (lastl ? 64 : 68) * 8; int last_grp = -1;
                      for (;;) {
                          __syncthreads();
                          if (tid == 0) *slot = __hip_atomic_fetch_add(gq, 1u, __ATOMIC_RELAXED, __HIP_MEMORY_SCOPE_AGENT);
                          __syncthreads();
                          const unsigned it = *slot;
                          if (it >= nit) break;
                          gm_item2((int)(it >> 3), (int)(it & 7), P_Z, P_VN, INP(15) + (size_t)l * 8 * 16384, INP(16) + (size_t)l * 1024, P_YCAT, (int)(it & 7) != last_grp, lds, tid);
                          last_grp = (int)(it & 7);
                      } }
                }
                SEAM(pb + 7);
                if (IN(pb + 8)) { PHASE_IDS(); PHASE_PTRS(); dn_out_phase(P_OF, P_OB, P_Z, INP(14) + (size_t)l * 128, P_YCAT, lastl ? TL : MR, lane, gw, NGW); }
                SEAM(pb + 8);
                if (IN(pb + 9)) { PHASE_PTRS();
                    const bf16* pc = (const bf16*)(ws + WS_PC + l * SZ_SQ);
                    pg8::CombOrder S; S.init(TL, DM, G, bid, 0, !lastl, SUB_FIRST(bid)); pg8::Gemm g{P_YCAT, pc, lastl ? TL : MR, DM, DM, DM, DM};
                    pg8::EpiMergeHS E{{(const bf16*)(ws + WS_GF), P_YB}, {(float*)(ws + WS_SLAB)}};
                    pg8::gemm_phase<pg8::EpiMergeHS, pg8::CombOrder, true, true>(lds, g, S, E, wave0);
                }
                SEAM(pb + 9);
                if (IN(pb + 10)) { PHASE_IDS(); PHASE_PTRS(); if (!lastl) merge_ctx_phase((const float*)(ws + WS_SLAB), P_Z, P_YB, lane, gw, NGW); }
                if (!lastl) SEAM(pb + 10);
                if (IN(pb + 11)) { PHASE_PTRS();
                    pg8::Gemm g{P_YB, (const bf16*)(ws + WS_WO + l * SZ_SQ), lastl ? TL : MR, DM, DM, DM, DM};
                    pg8::CombOrder S; S.init(TL, DM, G, bid, 0, !lastl, SUB_FIRST(bid));
                    pg8::EpiResidSlab E{{P_H, P_H + (size_t)TL * DM, P_H, P_MOD + (size_t)l * 3 * MODW + (1 * 3 + 2) * DM, MODW, 1.0f}, {(float*)(ws + WS_SLAB)}};
                    pg8::gemm_phase<pg8::EpiResidSlab, pg8::CombOrder, true, true>(lds, g, S, E, wave0);
                }
                SEAM(pb + 11);
            }
        }
    }
#undef IN
#undef SEAM
}

extern "C" void kernel_launch(void* const* d_in, const int* in_sizes, int n_in, void* d_out, int out_size, void* d_ws, size_t ws_size, hipStream_t stream) {
    static int grid = 0;
    if (grid == 0) {
        if (n_in != 24 || out_size != TL * DM || ws_size < WS_END) { fprintf(stderr, "kernel_launch: unexpected shapes (n_in %d, out %d, ws %zu < %zu); nothing launched\n", n_in, out_size, ws_size, (size_t)WS_END); grid = -1; return; }
        int dev = 0, cus = 0, per_cu = 0;
        if (hipGetDevice(&dev) != hipSuccess || hipDeviceGetAttribute(&cus, hipDeviceAttributeMultiprocessorCount, dev) != hipSuccess) { grid = -1; return; }
        if (hipFuncSetAttribute((const void*)dit_fwd, hipFuncAttributeMaxDynamicSharedMemorySize, LDS_BYTES) != hipSuccess) { fprintf(stderr, "kernel_launch: hipFuncSetAttribute failed\n"); grid = -1; return; }
        if (hipOccupancyMaxActiveBlocksPerMultiprocessor(&per_cu, (const void*)dit_fwd, NTHR, LDS_BYTES) != hipSuccess || per_cu < 1) { fprintf(stderr, "kernel_launch: occupancy query reports %d\n", per_cu); }
        (void)hipGetLastError();
        grid = cus;
        if (grid % 16 != 0) { fprintf(stderr, "kernel_launch: %d CUs: the row-panel exchange of the last GEMM needs a multiple of 16 workgroups; nothing launched\n", grid); grid = -1; return; }
    }
    if (grid < 0) return;
    if (hipMemsetAsync((char*)d_ws + WS_CTL, 0, CTL_ZERO_BYTES, stream) != hipSuccess) return;
    Args a{};
    for (int i = 0; i < 24; ++i) a.in[i] = (const float*)d_in[i];
    a.out = (float*)d_out; a.ws = (unsigned char*)d_ws;
#if MK_ONE_LAUNCH
    a.ph_lo = 0; a.ph_hi = NPH;
    hipLaunchKernelGGL(dit_fwd, dim3(grid), dim3(NTHR), LDS_BYTES, stream, a);
#else
    for (int p = 0; p < NPH; ++p) { a.ph_lo = p; a.ph_hi = p + 1; hipLaunchKernelGGL(dit_fwd, dim3(grid), dim3(NTHR), LDS_BYTES, stream, a); }
#endif
}
```

```cpp
#include <hip/hip_runtime.h>
#include <cstdio>
#include <cstdint>

namespace pg8 {
#define PG8_LAS __attribute__((address_space(3)))
typedef unsigned short bf16_t;
typedef short bf16x8 __attribute__((ext_vector_type(8)));
typedef float f32x4 __attribute__((ext_vector_type(4)));
typedef unsigned u32x4 __attribute__((ext_vector_type(4)));
constexpr int BM = 256, BK = 64, HALF = 128, HTB = HALF * BK * 2  , STAGE_BYTES = 8 * HTB, NXCD = 8, WGM = 8;

__host__ __device__ __forceinline__ int lds_byte(int r, int c) { const int st = (r >> 4) * 2 + (c >> 5), rr = r & 15, cc = c & 31, ob = rr * 64 + cc * 2; return st * 1024 + (ob ^ (((ob >> 9) & 1) << 5)); }
__host__ __device__ __forceinline__ void stage_rc(int b, int& R, int& C) { const int st = b / 1024, sb = b % 1024, swz = sb ^ (((sb >> 9) & 1) << 5); R = (st >> 1) * 16 + swz / 64; C = (st & 1) * 32 + (swz % 64) / 2; }
__host__ __device__ __forceinline__ int perm32(int rho) { const int n = rho >> 4, i = rho & 15; return 8 * (i >> 2) + 4 * n + (i & 3); }

struct Unit { int pm, pn, kt0, nt, ks; };
struct Gemm { const bf16_t* A; const bf16_t* Bt; int M, N, K, lda, ldb; };

struct StaticOrder {
    int nM, nN, nwg, G, c;
    __host__ __device__ void init(int M, int N, int G_, int c_) { nM = M / BM; nN = N / BM; nwg = nM * nN; G = G_; c = c_; }
    __host__ __device__ bool next(int i, Unit& u) const {
        const long L = (long)i * G + c; if (L >= nwg) return false;
        int wgid = (int)L; { const int q = nwg / NXCD, r = nwg % NXCD, xcd = wgid % NXCD, off = wgid / NXCD; wgid = (xcd < r ? xcd * (q + 1) : r * (q + 1) + (xcd - r) * q) + off; }
        const int nig = WGM * nN, gid = wgid / nig, fm = gid * WGM, gsz = (nM - fm) < WGM ? (nM - fm) : WGM;
        u.pm = fm + ((wgid % nig) % gsz); u.pn = (wgid % nig) / gsz; u.kt0 = 0; u.nt = 0; u.ks = -1; return true;
    }
    __device__ __forceinline__ void a_ready(const Unit&) const {}
    __device__ __forceinline__ void done(const Unit&) const {}
};

struct SubOrder {
    int G, c, kmode;
    __device__ __forceinline__ bool next(int i, Unit& u) const {
        const int idx = i * G + c; if (idx >= 256) return false;
        const int tile = idx >> 3, ks = idx & 7; u.pm = 32 + (tile >> 4); u.pn = tile & 15; u.ks = ks;
        if (kmode == 0) { u.kt0 = 8 * ks; u.nt = 8; } else { u.kt0 = ks < 4 ? 12 * ks : 48 + 10 * (ks - 4); u.nt = ks < 4 ? 12 : 10; }
        return true;
    }
    __device__ __forceinline__ void a_ready(const Unit&) const {}
    __device__ __forceinline__ void done(const Unit&) const {}
};

struct CombOrder {
    StaticOrder main; SubOrder sub; int nfirst; bool sub_first;
    __device__ __forceinline__ void init(int M, int N, int G, int c, int kmode, bool has_sub, bool sf) {
        main.init(M, N, G, c); sub = SubOrder{G, c, kmode}; sub_first = sf;
        const int my_main = c < main.nwg ? (main.nwg - c + G - 1) / G : 0, my_sub = (has_sub && c < 256) ? (256 - c + G - 1) / G : 0;
        nfirst = sf ? my_sub : (has_sub ? my_main : (1 << 30));
    }
    __device__ __forceinline__ bool next(int i, Unit& u) const {
        const bool in_first = i < nfirst, use_sub = (sub_first == in_first);
        const int j = in_first ? i : i - nfirst, G = main.G, c = main.c;
        const int idx = j * G + c, idc = idx < 255 ? idx : 255, tile = idc >> 3, ks = idc & 7;
        const int kt0s = sub.kmode == 0 ? 8 * ks : (ks < 4 ? 12 * ks : 48 + 10 * (ks - 4)), nts = sub.kmode == 0 ? 8 : (ks < 4 ? 12 : 10);
        int wgid = idx < main.nwg - 1 ? idx : main.nwg - 1;
        { const int q = main.nwg / NXCD, r = main.nwg % NXCD, xcd = wgid % NXCD, off = wgid / NXCD; wgid = (xcd < r ? xcd * (q + 1) : r * (q + 1) + (xcd - r) * q) + off; }
        const int nig = WGM * main.nN, gid = wgid / nig, fm = gid * WGM, gsz = (main.nM - fm) < WGM ? (main.nM - fm) : WGM;
        const int pmm = fm + ((wgid % nig) % gsz), pnm = (wgid % nig) / gsz;
        u.pm = use_sub ? 32 + (tile >> 4) : pmm; u.pn = use_sub ? (tile & 15) : pnm; u.kt0 = use_sub ? kt0s : 0; u.nt = use_sub ? nts : 0; u.ks = use_sub ? ks : -1;
        return use_sub ? idx < 256 : idx < main.nwg;
    }
    __device__ __forceinline__ void a_ready(const Unit&) const {}
    __device__ __forceinline__ void done(const Unit&) const {}
};

struct SplitOrder {
    int nM, nN, nwg, G, c, nfull, hk; bool split;
    __device__ __forceinline__ void init(int M, int N, int K, int G_, int c_, bool want) { nM = M / BM; nN = N / BM; nwg = nM * nN; G = G_; c = c_; nfull = nwg / G; hk = K / BK / 2;
        split = want && (nwg - nfull * G) * 2 == G && (hk & 1) == 0; }
    __device__ __forceinline__ bool next(int i, Unit& u) const {
        const bool half = split && i >= nfull;
        const int L = half ? nfull * G + (c >> 1) : i * G + c;
        int wgid = L < nwg - 1 ? L : nwg - 1;
        { const int q = nwg / NXCD, r = nwg % NXCD, xcd = wgid % NXCD, off = wgid / NXCD; wgid = (xcd < r ? xcd * (q + 1) : r * (q + 1) + (xcd - r) * q) + off; }
        const int nig = WGM * nN, gid = wgid / nig, fm = gid * WGM, gsz = (nM - fm) < WGM ? (nM - fm) : WGM;
        u.pm = fm + ((wgid % nig) % gsz); u.pn = (wgid % nig) / gsz; u.kt0 = half ? (c & 1) * hk : 0; u.nt = half ? hk : 0; u.ks = half ? c : -1;
        return half ? i == nfull : L < nwg;
    }
    __device__ __forceinline__ void a_ready(const Unit&) const {}
    __device__ __forceinline__ void done(const Unit&) const {}
};

struct PanelOrder {
    int G, c;
    __device__ __forceinline__ bool next(int i, Unit& u) const {
        const int x = c & 7, j = c >> 3, xa = G == 256;
        const int pl = xa ? 4 * (x >> 1) + (j & 3) : (c >> 4), pn = xa ? 8 * (x & 1) + (j >> 2) : (c & 15), ppr = G >> 4;
        u.pm = i * ppr + pl; u.pn = pn; u.kt0 = 0; u.nt = 0; u.ks = -1;
        return u.pm < 32;
    }
    __device__ __forceinline__ void a_ready(const Unit&) const {}
    __device__ __forceinline__ void done(const Unit&) const {}
};

typedef __bf16 pg8_bf16x2 __attribute__((ext_vector_type(2)));
__device__ __forceinline__ unsigned cvt_pk_bf16(float lo, float hi) { pg8_bf16x2 v = {(__bf16)lo, (__bf16)hi}; return __builtin_bit_cast(unsigned, v); }

__device__ __forceinline__ float bf_lo(unsigned u) { return __builtin_bit_cast(float, u << 16); }
__device__ __forceinline__ float bf_hi(unsigned u) { return __builtin_bit_cast(float, u & 0xffff0000u); }
__device__ __forceinline__ float fast_sigmoid(float x) { return __builtin_amdgcn_rcpf(1.0f + __expf(-x)); }
__device__ __forceinline__ float fast_silu(float x) { return x * fast_sigmoid(x); }
__device__ __forceinline__ int rm_src(int lane) { return (((lane >> 2) + 16 * (lane & 3)) << 2); }
__device__ __forceinline__ int mf_src(int lane) { return ((4 * (lane & 15) + (lane >> 4)) << 2); }
typedef int pg8_i32x4 __attribute__((ext_vector_type(4)));
__device__ __forceinline__ pg8_i32x4 lperm_i(const pg8_i32x4 v, int a) { pg8_i32x4 r;
    r.x = __builtin_amdgcn_ds_bpermute(a, v.x); r.y = __builtin_amdgcn_ds_bpermute(a, v.y); r.z = __builtin_amdgcn_ds_bpermute(a, v.z); r.w = __builtin_amdgcn_ds_bpermute(a, v.w); return r; }
__device__ __forceinline__ f32x4 lperm(const f32x4 v, int a) { return __builtin_bit_cast(f32x4, lperm_i(__builtin_bit_cast(pg8_i32x4, v), a)); }
__device__ __forceinline__ u32x4 lperm(const u32x4 v, int a) { return __builtin_bit_cast(u32x4, lperm_i(__builtin_bit_cast(pg8_i32x4, v), a)); }

struct EpiSwiGLU {
    static constexpr bool PERM = true, AFTER_DRAIN = false, MIDK = false;
    bf16_t* H; int ldh;
    __device__ __forceinline__ void operator()(const f32x4 (&acc)[2][2][4][2], const Unit& u, int wr, int wc, int fr, int fq) const {
        const int row0 = u.pm * BM + wr * 64 + fr, col0 = u.pn * HALF + wc * 32 + 8 * fq;
#pragma unroll
        for (int ai = 0; ai < 2; ++ai)
#pragma unroll
            for (int m = 0; m < 4; ++m) { bf16_t* rowp = H + (size_t)(row0 + ai * HALF + m * 16) * ldh + col0;
                const f32x4 a0 = acc[ai][0][m][0], a1 = acc[ai][0][m][1], b0 = acc[ai][1][m][0], b1 = acc[ai][1][m][1];
                u32x4 w; w.x = cvt_pk_bf16(fast_silu(a0[0]) * b0[0], fast_silu(a0[1]) * b0[1]); w.y = cvt_pk_bf16(fast_silu(a0[2]) * b0[2], fast_silu(a0[3]) * b0[3]);
                w.z = cvt_pk_bf16(fast_silu(a1[0]) * b1[0], fast_silu(a1[1]) * b1[1]); w.w = cvt_pk_bf16(fast_silu(a1[2]) * b1[2], fast_silu(a1[3]) * b1[3]);
                *(u32x4*)rowp = w; }
    }
};
struct EpiSwiGLUS {
    static constexpr bool PERM = true, AFTER_DRAIN = false, MIDK = false;
    EpiSwiGLU e; unsigned slab_off, flag_off;
    __device__ __forceinline__ void operator()(const f32x4 (&acc)[2][2][4][2], const Unit& u, int wr, int wc, int fr, int fq) const {
        if (u.ks < 0) { e(acc, u, wr, wc, fr, fq); return; }
        int lane = fr + 16 * fq; asm volatile("" : "+v"(lane));
        const int pair = u.ks >> 1, wid = wr * 4 + wc;
        const __attribute__((address_space(4))) char* kp = (const __attribute__((address_space(4))) char*)__builtin_amdgcn_kernarg_segment_ptr(); asm volatile("" : "+s"(kp));
        char* const wsb = *(char* const __attribute__((address_space(4)))*)(kp + 200);
        float* const slab = (float*)(wsb + slab_off); unsigned* const flags = (unsigned*)(wsb + flag_off);
        const unsigned off0 = (unsigned)(((pair * 8 + wid) * 32) * 64 + lane) * 16u;
        if ((u.ks & 1) == 0) {
            const __amdgpu_buffer_rsrc_t rs = __builtin_amdgcn_make_buffer_rsrc(slab, 0, 128 * 8 * 32 * 64 * 16, 0x00020000);
#pragma unroll
            for (int ai = 0; ai < 2; ++ai)
#pragma unroll
                for (int bj = 0; bj < 2; ++bj)
#pragma unroll
                    for (int m = 0; m < 4; ++m)
#pragma unroll
                        for (int n = 0; n < 2; ++n) __builtin_amdgcn_raw_buffer_store_b128(__builtin_bit_cast(u32x4, acc[ai][bj][m][n]), rs, off0 + (unsigned)((((ai * 2 + bj) * 4 + m) * 2 + n) * 1024), 0, 16);
            asm volatile("s_waitcnt vmcnt(0)" ::: "memory"); __builtin_amdgcn_s_barrier();
            if (wid == 0 && lane == 0) __hip_atomic_store(flags + pair * 32, 1u, __ATOMIC_RELAXED, __HIP_MEMORY_SCOPE_AGENT);
            return;
        }
        if (wid == 0 && lane == 0) { unsigned sp = 0u; while (__hip_atomic_load(flags + pair * 32, __ATOMIC_RELAXED, __HIP_MEMORY_SCOPE_AGENT) == 0u && ++sp < (1u << 21)) __builtin_amdgcn_s_sleep(1);
            __builtin_amdgcn_fence(__ATOMIC_ACQUIRE, "agent"); asm volatile("s_waitcnt vmcnt(0)" ::: "memory"); }
        __builtin_amdgcn_s_barrier();
        const char* sp_ = (const char*)slab + off0;
        const int row0 = u.pm * BM + wr * 64 + (lane & 15), col0 = u.pn * HALF + wc * 32 + 8 * (lane >> 4);
#pragma unroll
        for (int ai = 0; ai < 2; ++ai)
#pragma unroll
            for (int m = 0; m < 4; ++m) {
                const f32x4 a0 = acc[ai][0][m][0] + *(const f32x4*)(sp_ + (((ai * 2 + 0) * 4 + m) * 2 + 0) * 1024), a1 = acc[ai][0][m][1] + *(const f32x4*)(sp_ + (((ai * 2 + 0) * 4 + m) * 2 + 1) * 1024);
                const f32x4 b0 = acc[ai][1][m][0] + *(const f32x4*)(sp_ + (((ai * 2 + 1) * 4 + m) * 2 + 0) * 1024), b1 = acc[ai][1][m][1] + *(const f32x4*)(sp_ + (((ai * 2 + 1) * 4 + m) * 2 + 1) * 1024);
                u32x4 w; w.x = cvt_pk_bf16(fast_silu(a0[0]) * b0[0], fast_silu(a0[1]) * b0[1]); w.y = cvt_pk_bf16(fast_silu(a0[2]) * b0[2], fast_silu(a0[3]) * b0[3]);
                w.z = cvt_pk_bf16(fast_silu(a1[0]) * b1[0], fast_silu(a1[1]) * b1[1]); w.w = cvt_pk_bf16(fast_silu(a1[2]) * b1[2], fast_silu(a1[3]) * b1[3]);
                *(u32x4*)(e.H + (size_t)(row0 + ai * HALF + m * 16) * e.ldh + col0) = w;
                asm volatile("" ::: "memory"); }
    }
};
struct EpiResid {
    static constexpr bool PERM = false, AFTER_DRAIN = false, MIDK = false;
    const float* in_lat; const float* in_ctx; float* out; const float* gate; int gate_vstride; float coef;
    __device__ __forceinline__ void operator()(const f32x4 (&acc)[2][2][4][2], const Unit& u, int wr, int wc, int fr, int fq) const {
        const int v = u.pm < 16 ? 0 : (u.pm < 32 ? 1 : 2);
        const float* gp = gate + (size_t)v * gate_vstride;
        const int lane = fr + 16 * fq, nsel = (lane >> 2) & 1;
        const int pa0 = (((lane >> 3) + 16 * (lane & 3)) << 2), pa1 = pa0 + 32;
        const int row0 = u.pm * BM + wr * 64 + (lane >> 3), col0 = u.pn * BM + wc * 32 + 4 * (lane & 7);
        const float* inb = u.pm < 32 ? in_lat + (size_t)row0 * 4096 : in_ctx + (size_t)(row0 - 8192) * 4096;
        float* outb = out + (size_t)row0 * 4096;
        f32x4 gv[2];
#pragma unroll
        for (int bj = 0; bj < 2; ++bj) gv[bj] = *(const f32x4*)(gp + col0 + bj * HALF) * coef;
        f32x4 xa[2][2], xb[2][2];
#define PG8_RLD(dst, g) do { const size_t ro_ = (size_t)(((g) >> 2) * HALF + ((g) & 3) * 16) * 4096 + col0; _Pragma("unroll") for (int bj = 0; bj < 2; ++bj) _Pragma("unroll") for (int h = 0; h < 2; ++h) \
            dst[bj][h] = *(const f32x4*)(inb + ro_ + (size_t)(8 * h) * 4096 + bj * HALF); } while (0)
#define PG8_RST(src, g) do { const size_t ro_ = (size_t)(((g) >> 2) * HALF + ((g) & 3) * 16) * 4096 + col0; _Pragma("unroll") for (int bj = 0; bj < 2; ++bj) _Pragma("unroll") for (int h = 0; h < 2; ++h) { \
            const f32x4 t0_ = lperm(acc[(g) >> 2][bj][(g) & 3][0], h ? pa1 : pa0), t1_ = lperm(acc[(g) >> 2][bj][(g) & 3][1], h ? pa1 : pa0); \
            *(f32x4*)(outb + ro_ + (size_t)(8 * h) * 4096 + bj * HALF) = src[bj][h] + gv[bj] * (nsel ? t1_ : t0_); } } while (0)
        PG8_RLD(xa, 0);
#pragma unroll
        for (int g = 0; g < 8; g += 2) {
            PG8_RLD(xb, g + 1);
            PG8_RST(xa, g);
            if (g + 2 < 8) PG8_RLD(xa, g + 2);
            PG8_RST(xb, g + 1);
        }
#undef PG8_RLD
#undef PG8_RST
    }
};
struct EpiFinal {
    static constexpr bool PERM = false, AFTER_DRAIN = false, MIDK = false;
    const float* in; float* outp; const float* gate; int gate_vstride; float coef; const float* fw; float* stats  ; unsigned* cnt  ; PG8_LAS float* red  ;
    __device__ __forceinline__ void operator()(f32x4 (&acc)[2][2][4][2], const Unit& u, int wr, int wc, int fr, int fq) const {
        const int v = u.pm < 16 ? 0 : 1;
        const float* gp = gate + (size_t)v * gate_vstride;
        int lane = fr + 16 * fq; asm volatile("" : "+v"(lane));
        const int nsel = (lane >> 2) & 1;
        const int pa0 = (((lane >> 3) + 16 * (lane & 3)) << 2), pa1 = pa0 + 32;
        const int rl = wr * 64 + (lane >> 3);
        const int row0 = u.pm * BM + rl, col0 = u.pn * BM + wc * 32 + 4 * (lane & 7);
        const float* inb = in + (size_t)row0 * 4096;
#pragma unroll
        for (int g = 0; g < 8; ++g) {
            const size_t ro = (size_t)((g >> 2) * HALF + (g & 3) * 16) * 4096 + col0;
            float s0 = 0.f, s1 = 0.f;
#pragma unroll
            for (int bj = 0; bj < 2; ++bj) { f32x4& c0 = acc[g >> 2][bj][g & 3][0]; f32x4& c1 = acc[g >> 2][bj][g & 3][1];
                const f32x4 gvv = *(const f32x4*)(gp + col0 + bj * HALF) * coef;
                const f32x4 x0 = *(const f32x4*)(inb + ro + bj * HALF), x1 = *(const f32x4*)(inb + ro + (size_t)8 * 4096 + bj * HALF);
                const f32x4 t00 = lperm(c0, pa0), t10 = lperm(c1, pa0); const f32x4 h0 = x0 + gvv * (nsel ? t10 : t00);
                const f32x4 t01 = lperm(c0, pa1), t11 = lperm(c1, pa1); const f32x4 h1 = x1 + gvv * (nsel ? t11 : t01);
                c0 = h0; c1 = h1; asm volatile("" : "+v"(c0), "+v"(c1));
                s0 += (h0[0] * h0[0] + h0[1] * h0[1]) + (h0[2] * h0[2] + h0[3] * h0[3]); s1 += (h1[0] * h1[0] + h1[1] * h1[1]) + (h1[2] * h1[2] + h1[3] * h1[3]); }
            s0 += __shfl_xor(s0, 1); s0 += __shfl_xor(s0, 2); s0 += __shfl_xor(s0, 4); s1 += __shfl_xor(s1, 1); s1 += __shfl_xor(s1, 2); s1 += __shfl_xor(s1, 4);
            if ((lane & 7) == 0) { const int tr = (g >> 2) * HALF + (g & 3) * 16 + rl; red[tr * 4 + wc] = s0; red[(tr + 8) * 4 + wc] = s1; }
            asm volatile("" ::: "memory");
        }
        asm volatile("s_waitcnt lgkmcnt(0)" ::: "memory"); __builtin_amdgcn_s_barrier();
        if (wr == 0) { const int r = wc * 64 + lane; const float s = (red[r * 4] + red[r * 4 + 1]) + (red[r * 4 + 2] + red[r * 4 + 3]);
            __hip_atomic_store(stats + ((size_t)u.pm * BM + r) * 16 + u.pn, s, __ATOMIC_RELAXED, __HIP_MEMORY_SCOPE_AGENT); }
        asm volatile("s_waitcnt vmcnt(0) lgkmcnt(0)" ::: "memory"); __builtin_amdgcn_s_barrier();
        if (wr == 0 && wc == 0 && lane == 0) { unsigned* cp = cnt + u.pm * 32;
            (void)__hip_atomic_fetch_add(cp, 1u, __ATOMIC_RELAXED, __HIP_MEMORY_SCOPE_AGENT);
            unsigned sp = 0u; while (__hip_atomic_load(cp, __ATOMIC_RELAXED, __HIP_MEMORY_SCOPE_AGENT) < 16u && ++sp < (1u << 21)) __builtin_amdgcn_s_sleep(1);
            __builtin_amdgcn_fence(__ATOMIC_ACQUIRE, "agent"); asm volatile("s_waitcnt vmcnt(0)" ::: "memory"); }
        __builtin_amdgcn_s_barrier();
        if (wr == 0) { const int r = wc * 64 + lane; const float* sp_ = stats + ((size_t)u.pm * BM + r) * 16; float s = 0.f;
#pragma unroll
            for (int t = 0; t < 16; ++t) s += __hip_atomic_load(sp_ + t, __ATOMIC_RELAXED, __HIP_MEMORY_SCOPE_AGENT);
            red[1024 + r] = 1.0f / sqrtf(s * (1.0f / 4096.0f) + 1e-6f); }
        asm volatile("s_waitcnt vmcnt(0) lgkmcnt(0)" ::: "memory"); __builtin_amdgcn_s_barrier();
        float* outb = outp + (size_t)row0 * 4096;
#pragma unroll
        for (int g = 0; g < 8; ++g) {
#pragma unroll
            for (int bj = 0; bj < 2; ++bj) { const f32x4 fwv = *(const f32x4*)(fw + col0 + bj * HALF);
#pragma unroll
                for (int h = 0; h < 2; ++h) { const float rs = red[1024 + (g >> 2) * HALF + (g & 3) * 16 + 8 * h + rl];
                    *(f32x4*)(outb + (size_t)((g >> 2) * HALF + (g & 3) * 16 + 8 * h) * 4096 + col0 + bj * HALF) = acc[g >> 2][bj][g & 3][h] * rs * fwv; } }
            asm volatile("" ::: "memory"); }
        asm volatile("s_waitcnt lgkmcnt(0)" ::: "memory"); __builtin_amdgcn_s_barrier();
    }
};
struct EpiZ {
    static constexpr bool PERM = true, AFTER_DRAIN = false, MIDK = false;
    bf16_t* Z; int ldz; float* ZAB; int nmain; bf16_t* GF; int ga0; bf16_t* KF; bf16_t* QF; int nk0, nq0; bf16_t* VF; int nv0;
    __device__ __forceinline__ void operator()(const f32x4 (&acc)[2][2][4][2], const Unit& u, int wr, int wc, int fr, int fq) const {
        const int row0 = u.pm * BM + wr * 64 + fr;
        if (u.pn >= ga0 && u.pn < nmain && u.pm < 32) {
            bf16_t* gp = GF + ((((size_t)u.pm * 48 + (u.pn - ga0)) * 8 + (wr * 4 + wc)) * 16 * 64 + (fr + 16 * fq)) * 8;
#pragma unroll
            for (int ai = 0; ai < 2; ++ai)
#pragma unroll
                for (int m = 0; m < 4; ++m)
#pragma unroll
                    for (int bj = 0; bj < 2; ++bj) { f32x4 v0 = acc[ai][bj][m][0], v1 = acc[ai][bj][m][1];
#pragma unroll
                        for (int i = 0; i < 4; ++i) { v0[i] = __expf(-fminf(fmaxf(v0[i], -30.f), 30.f)); v1[i] = __expf(-fminf(fmaxf(v1[i], -30.f), 30.f)); }
                        u32x4 w; w.x = cvt_pk_bf16(v0[0], v0[1]); w.y = cvt_pk_bf16(v0[2], v0[3]); w.z = cvt_pk_bf16(v1[0], v1[1]); w.w = cvt_pk_bf16(v1[2], v1[3]);
                        *(u32x4*)(gp + ((ai * 4 + m) * 2 + bj) * 512) = w; }
        } else if (u.pm < 32 && (unsigned)(u.pn - nk0) < 8u) {
            const int b = u.pm >> 4, t0 = (u.pm & 15) * BM + wr * 64 + fr;
#pragma unroll
            for (int ai = 0; ai < 2; ++ai)
#pragma unroll
                for (int m = 0; m < 4; ++m)
#pragma unroll
                    for (int bj = 0; bj < 2; ++bj) { const f32x4 v0 = acc[ai][bj][m][0], v1 = acc[ai][bj][m][1]; const int t = t0 + ai * HALF + m * 16;
                        u32x4 w; w.x = cvt_pk_bf16(v0[0], v0[1]); w.y = cvt_pk_bf16(v0[2], v0[3]); w.z = cvt_pk_bf16(v1[0], v1[1]); w.w = cvt_pk_bf16(v1[2], v1[3]);
                        *(u32x4*)(KF + (((size_t)(b * 16 + 2 * (u.pn - nk0) + bj) * 1024 + (t >> 2)) * 512) + wc * 128 + fq * 32 + (t & 3) * 8) = w; }
        } else if (u.pm < 32 && (unsigned)(u.pn - nv0) < 8u) {
            const int b = u.pm >> 4, t0 = (u.pm & 15) * BM + wr * 64 + (fr & 8);
            const bool lo4 = (fr & 4) == 0, lo2 = (fr & 2) == 0, lo1 = (fr & 1) == 0;
#pragma unroll
            for (int ai = 0; ai < 2; ++ai)
#pragma unroll
                for (int m = 0; m < 4; ++m)
#pragma unroll
                    for (int bj = 0; bj < 2; ++bj) { const f32x4 v0 = acc[ai][bj][m][0], v1 = acc[ai][bj][m][1];
                        unsigned w0 = cvt_pk_bf16(v0[0], v0[1]), w1 = cvt_pk_bf16(v0[2], v0[3]), w2 = cvt_pk_bf16(v1[0], v1[1]), w3 = cvt_pk_bf16(v1[2], v1[3]);
                        { const unsigned r0 = (unsigned)__shfl_xor((int)(lo4 ? w2 : w0), 4), r1 = (unsigned)__shfl_xor((int)(lo4 ? w3 : w1), 4); w2 = lo4 ? r0 : w2; w3 = lo4 ? r1 : w3; w0 = lo4 ? w0 : r0; w1 = lo4 ? w1 : r1; }
                        { const unsigned r0 = (unsigned)__shfl_xor((int)(lo2 ? w1 : w0), 2), r1 = (unsigned)__shfl_xor((int)(lo2 ? w3 : w2), 2); w1 = lo2 ? r0 : w1; w3 = lo2 ? r1 : w3; w0 = lo2 ? w0 : r0; w2 = lo2 ? w2 : r1; }
                        { const unsigned p0 = (unsigned)__shfl_xor((int)w0, 1), p1 = (unsigned)__shfl_xor((int)w1, 1), p2 = (unsigned)__shfl_xor((int)w2, 1), p3 = (unsigned)__shfl_xor((int)w3, 1);
                          w0 = lo1 ? (w0 & 0xffffu) | (p0 << 16) : (p0 >> 16) | (w0 & 0xffff0000u); w1 = lo1 ? (w1 & 0xffffu) | (p1 << 16) : (p1 >> 16) | (w1 & 0xffff0000u);
                          w2 = lo1 ? (w2 & 0xffffu) | (p2 << 16) : (p2 >> 16) | (w2 & 0xffff0000u); w3 = lo1 ? (w3 & 0xffffu) | (p3 << 16) : (p3 >> 16) | (w3 & 0xffff0000u); }
                        u32x4 w; w.x = w0; w.y = w1; w.z = w2; w.w = w3;
                        *(u32x4*)(VF + ((((size_t)(b * 16 + 2 * (u.pn - nv0) + bj) * 512 + ((t0 + ai * HALF + m * 16) >> 3)) * 128) + wc * 32 + fq * 8 + (fr & 7)) * 8) = w; }
        } else if (u.pm < 32 && (unsigned)(u.pn - nq0) < 8u) {
            const int b = u.pm >> 4, rg0 = (u.pm & 15) * 16 + wr * 4;
#pragma unroll
            for (int ai = 0; ai < 2; ++ai)
#pragma unroll
                for (int m = 0; m < 4; ++m)
#pragma unroll
                    for (int bj = 0; bj < 2; ++bj) { const f32x4 v0 = acc[ai][bj][m][0], v1 = acc[ai][bj][m][1];
                        u32x4 w; w.x = cvt_pk_bf16(v0[0], v0[1]); w.y = cvt_pk_bf16(v0[2], v0[3]); w.z = cvt_pk_bf16(v1[0], v1[1]); w.w = cvt_pk_bf16(v1[2], v1[3]);
                        *(u32x4*)(QF + ((((size_t)(b * 16 + 2 * (u.pn - nq0) + bj) * 256 + rg0 + ai * 8 + m) * 4 + wc) * 64 + (fr + 16 * fq)) * 8) = w; }
        } else if (u.pn < nmain) {
            const int col0 = u.pn * BM + wc * 32 + 8 * fq;
#pragma unroll
            for (int ai = 0; ai < 2; ++ai)
#pragma unroll
                for (int m = 0; m < 4; ++m) { bf16_t* rowp = Z + (size_t)(row0 + ai * HALF + m * 16) * ldz + col0;
#pragma unroll
                    for (int bj = 0; bj < 2; ++bj) { const f32x4 v0 = acc[ai][bj][m][0], v1 = acc[ai][bj][m][1];
                        u32x4 w; w.x = cvt_pk_bf16(v0[0], v0[1]); w.y = cvt_pk_bf16(v0[2], v0[3]); w.z = cvt_pk_bf16(v1[0], v1[1]); w.w = cvt_pk_bf16(v1[2], v1[3]);
                        *(u32x4*)(rowp + bj * HALF) = w; } }
        } else if (wc == 0) {
#pragma unroll
            for (int ai = 0; ai < 2; ++ai)
#pragma unroll
                for (int m = 0; m < 4; ++m) { float* rowp = ZAB + (size_t)(row0 + ai * HALF + m * 16) * 32 + 8 * fq;
                    *(f32x4*)(rowp) = acc[ai][0][m][0]; *(f32x4*)(rowp + 4) = acc[ai][0][m][1]; }
        }
    }
};
template <int S> struct EpiMerge {
    static constexpr bool PERM = true, AFTER_DRAIN = false, MIDK = false;
    const bf16_t* Z; int ldz; int gcol; float* YF; bf16_t* YB;
    __device__ __forceinline__ void operator()(const f32x4 (&acc)[2][2][4][2], const Unit& u, int wr, int wc, int fr, int fq) const {
        const int row0 = u.pm * BM + wr * 64 + fr, col0 = u.pn * BM + wc * 32 + 8 * fq;
#pragma unroll
        for (int ai = 0; ai < 2; ++ai)
#pragma unroll
            for (int m = 0; m < 4; ++m) { const size_t row = (size_t)(row0 + ai * HALF + m * 16);
#pragma unroll
                for (int bj = 0; bj < 2; ++bj) { const int c = col0 + bj * HALF;
                    const u32x4 g = *(const u32x4*)(Z + row * ldz + gcol + c);
                    f32x4 t0 = acc[ai][bj][m][0], t1 = acc[ai][bj][m][1];
                    t0[0] *= fast_sigmoid(bf_lo(g.x)); t0[1] *= fast_sigmoid(bf_hi(g.x)); t0[2] *= fast_sigmoid(bf_lo(g.y)); t0[3] *= fast_sigmoid(bf_hi(g.y));
                    t1[0] *= fast_sigmoid(bf_lo(g.z)); t1[1] *= fast_sigmoid(bf_hi(g.z)); t1[2] *= fast_sigmoid(bf_lo(g.w)); t1[3] *= fast_sigmoid(bf_hi(g.w));
                    float* yf = YF + row * 4096 + c;
                    if (S == 0) { *(f32x4*)yf = t0; *(f32x4*)(yf + 4) = t1; }
                    else { t0 += *(const f32x4*)yf; t1 += *(const f32x4*)(yf + 4);
                        if (S == 1) { *(f32x4*)yf = t0; *(f32x4*)(yf + 4) = t1; }
                        else { u32x4 w; w.x = cvt_pk_bf16(t0[0], t0[1]); w.y = cvt_pk_bf16(t0[2], t0[3]); w.z = cvt_pk_bf16(t1[0], t1[1]); w.w = cvt_pk_bf16(t1[2], t1[3]);
                            *(u32x4*)(YB + row * 4096 + c) = w; } } }
                asm volatile("" ::: "memory"); }
    }
};

struct EpiSlab {
    static constexpr bool PERM = false, AFTER_DRAIN = false, MIDK = false;
    float* slab;
    __device__ __forceinline__ void operator()(const f32x4 (&acc)[2][2][4][2], const Unit& u, int wr, int wc, int fr, int fq) const {
        const int row0 = u.pm * BM + wr * 64 + fr - 8192, col0 = u.pn * BM + wc * 32 + 4 * fq;
        float* outb = slab + ((size_t)u.ks * 512 + row0) * 4096 + col0;
#pragma unroll
        for (int ai = 0; ai < 2; ++ai)
#pragma unroll
            for (int m = 0; m < 4; ++m)
#pragma unroll
                for (int bj = 0; bj < 2; ++bj)
#pragma unroll
                    for (int n = 0; n < 2; ++n) *(f32x4*)(outb + (size_t)(ai * HALF + m * 16) * 4096 + bj * HALF + n * 16) = acc[ai][bj][m][n];
    }
};

struct EpiSlabP {
    static constexpr bool PERM = true, AFTER_DRAIN = false, MIDK = false;
    float* slab;
    __device__ __forceinline__ void operator()(const f32x4 (&acc)[2][2][4][2], const Unit& u, int wr, int wc, int fr, int fq) const {
        const int row0 = u.pm * BM + wr * 64 + fr - 8192, col0 = u.pn * BM + wc * 32 + 8 * fq;
        float* outb = slab + ((size_t)u.ks * 512 + row0) * 4096 + col0;
#pragma unroll
        for (int ai = 0; ai < 2; ++ai)
#pragma unroll
            for (int m = 0; m < 4; ++m)
#pragma unroll
                for (int bj = 0; bj < 2; ++bj) { float* o = outb + (size_t)(ai * HALF + m * 16) * 4096 + bj * HALF; *(f32x4*)o = acc[ai][bj][m][0]; *(f32x4*)(o + 4) = acc[ai][bj][m][1]; }
    }
};
struct EpiResidSlab {
    static constexpr bool PERM = false, AFTER_DRAIN = false, MIDK = false;
    EpiResid r; EpiSlab s;
    __device__ __forceinline__ void operator()(const f32x4 (&acc)[2][2][4][2], const Unit& u, int wr, int wc, int fr, int fq) const { if (u.ks >= 0) s(acc, u, wr, wc, fr, fq); else r(acc, u, wr, wc, fr, fq); }
};
struct EpiMergeH {
    static constexpr bool PERM = true, AFTER_DRAIN = false, MIDK = true;
    static constexpr int T1 = 16, T2 = 32;
    const bf16_t* GF; bf16_t* YB;
    __device__ __forceinline__ void midk(f32x4 (&acc)[2][2][4][2], const Unit& u, int which, int wr, int wc, int fr, int fq) const {
        int lane = fr + 16 * fq; asm volatile("" : "+v"(lane));
        const bf16_t* gn0 = GF + ((((size_t)u.pm * 48 + which * 16 + u.pn) * 8 + (wr * 4 + wc)) * 16 * 64 + lane) * 8;
#pragma unroll
        for (int ai = 0; ai < 2; ++ai)
#pragma unroll
            for (int mp = 0; mp < 4; mp += 2) {
                u32x4 gn[2][2], gd[2][2];
#pragma unroll
                for (int mm = 0; mm < 2; ++mm)
#pragma unroll
                    for (int bj = 0; bj < 2; ++bj) { const int o = ((ai * 4 + mp + mm) * 2 + bj) * 512;
                        gn[mm][bj] = *(const u32x4*)(gn0 + o); gd[mm][bj] = *(const u32x4*)(gn0 + (size_t)16 * 8 * 16 * 64 * 8 + o); }
#pragma unroll
                for (int mm = 0; mm < 2; ++mm)
#pragma unroll
                    for (int bj = 0; bj < 2; ++bj) { const u32x4 a = gn[mm][bj], b = gd[mm][bj]; f32x4& t0 = acc[ai][bj][mp + mm][0]; f32x4& t1 = acc[ai][bj][mp + mm][1];
                        t0[0] *= (1.f + (bf_lo(b.x))) * __builtin_amdgcn_rcpf(1.f + (bf_lo(a.x))); t0[1] *= (1.f + (bf_hi(b.x))) * __builtin_amdgcn_rcpf(1.f + (bf_hi(a.x)));
                        t0[2] *= (1.f + (bf_lo(b.y))) * __builtin_amdgcn_rcpf(1.f + (bf_lo(a.y))); t0[3] *= (1.f + (bf_hi(b.y))) * __builtin_amdgcn_rcpf(1.f + (bf_hi(a.y)));
                        t1[0] *= (1.f + (bf_lo(b.z))) * __builtin_amdgcn_rcpf(1.f + (bf_lo(a.z))); t1[1] *= (1.f + (bf_hi(b.z))) * __builtin_amdgcn_rcpf(1.f + (bf_hi(a.z)));
                        t1[2] *= (1.f + (bf_lo(b.w))) * __builtin_amdgcn_rcpf(1.f + (bf_lo(a.w))); t1[3] *= (1.f + (bf_hi(b.w))) * __builtin_amdgcn_rcpf(1.f + (bf_hi(a.w))); }
                asm volatile("" ::: "memory");
            }
    }
    __device__ __forceinline__ void operator()(const f32x4 (&acc)[2][2][4][2], const Unit& u, int wr, int wc, int fr, int fq) const {
        const int row0 = u.pm * BM + wr * 64 + fr, col0 = u.pn * BM + wc * 32 + 8 * fq;
        const bf16_t* gc0 = GF + ((((size_t)u.pm * 48 + 32 + u.pn) * 8 + (wr * 4 + wc)) * 16 * 64 + (fr + 16 * fq)) * 8;
#pragma unroll
        for (int ai = 0; ai < 2; ++ai)
#pragma unroll
            for (int m = 0; m < 4; ++m) { const size_t row = (size_t)(row0 + ai * HALF + m * 16);
#pragma unroll
                for (int bj = 0; bj < 2; ++bj) { const int c = col0 + bj * HALF;
                    const u32x4 g = *(const u32x4*)(gc0 + ((ai * 4 + m) * 2 + bj) * 512);
                    f32x4 t0 = acc[ai][bj][m][0], t1 = acc[ai][bj][m][1];
                    t0[0] *= __builtin_amdgcn_rcpf(1.f + (bf_lo(g.x))); t0[1] *= __builtin_amdgcn_rcpf(1.f + (bf_hi(g.x))); t0[2] *= __builtin_amdgcn_rcpf(1.f + (bf_lo(g.y))); t0[3] *= __builtin_amdgcn_rcpf(1.f + (bf_hi(g.y)));
                    t1[0] *= __builtin_amdgcn_rcpf(1.f + (bf_lo(g.z))); t1[1] *= __builtin_amdgcn_rcpf(1.f + (bf_hi(g.z))); t1[2] *= __builtin_amdgcn_rcpf(1.f + (bf_lo(g.w))); t1[3] *= __builtin_amdgcn_rcpf(1.f + (bf_hi(g.w)));
                    u32x4 w; w.x = cvt_pk_bf16(t0[0], t0[1]); w.y = cvt_pk_bf16(t0[2], t0[3]); w.z = cvt_pk_bf16(t1[0], t1[1]); w.w = cvt_pk_bf16(t1[2], t1[3]);
                    *(u32x4*)(YB + row * 4096 + c) = w; }
                if (m & 1) asm volatile("" ::: "memory"); }
    }
};
struct EpiMergeHS {
    static constexpr bool PERM = true, AFTER_DRAIN = false, MIDK = true;
    static constexpr int T1 = EpiMergeH::T1, T2 = EpiMergeH::T2;
    EpiMergeH m; EpiSlabP s;
    __device__ __forceinline__ void midk(f32x4 (&acc)[2][2][4][2], const Unit& u, int which, int wr, int wc, int fr, int fq) const { if (u.ks < 0) m.midk(acc, u, which, wr, wc, fr, fq); }
    __device__ __forceinline__ void operator()(const f32x4 (&acc)[2][2][4][2], const Unit& u, int wr, int wc, int fr, int fq) const { if (u.ks >= 0) s(acc, u, wr, wc, fr, fq); else m(acc, u, wr, wc, fr, fq); }
};
template <class Epi, class Sched, bool ALIGN_EPI = false, bool SP2 = false>
__device__ __forceinline__ void gemm_phase(PG8_LAS unsigned char* lds, const Gemm g, const Sched& S, const Epi& E, int wave0) {
    int tid = wave0 * 64 + (int)__builtin_amdgcn_mbcnt_hi(~0u, __builtin_amdgcn_mbcnt_lo(~0u, 0u)); asm volatile("" : "+v"(tid));
    const int wid = __builtin_amdgcn_readfirstlane(tid >> 6), lane = tid & 63, wr = wid >> 2, wc = wid & 3, fr = lane & 15, fq = lane >> 4;
    const int ntdef = g.K / BK;
    unsigned voffA[2], voffB[2];
#pragma unroll
    for (int i = 0; i < 2; ++i) { int R, C; stage_rc(tid * 16 + i * 8192, R, C); const int Rb = Epi::PERM ? ((R & ~31) + perm32(R & 31)) : R;
        voffA[i] = (unsigned)(R * g.lda + C) * 2u; voffB[i] = (unsigned)(Rb * g.ldb + C) * 2u; }
    const size_t kstep = (size_t)(BK * 2);
    const size_t hstepA = (size_t)HALF * g.lda * 2, hstepB = (size_t)HALF * g.ldb * 2;
    const size_t tstepA = 2 * hstepA, tstepB = 2 * hstepB;
    const unsigned ldsw = (unsigned)wid * 1024u;
    const int aoff = lds_byte(wr * 64 + fr, fq * 8), boff = lds_byte(wc * 32 + fr, fq * 8);
#define PG8_SA(b, h) (((b) * 2 + (h)) * HTB)
#define PG8_SB(b, h) ((4 + (b) * 2 + (h)) * HTB)
#define PG8_STAGE(bufoff, gbase, voff) do { _Pragma("unroll") for (int _i = 0; _i < 2; ++_i) \
        __builtin_amdgcn_global_load_lds((const unsigned*)((const char*)(gbase) + (voff)[_i]), (PG8_LAS unsigned*)(lds + (bufoff) + ldsw + _i * 8192), 16, 0, 0); } while (0)
#define PG8_LDA(dst, b, h) do { _Pragma("unroll") for (int m = 0; m < 4; ++m) _Pragma("unroll") for (int k = 0; k < 2; ++k) dst[m][k] = *(const PG8_LAS bf16x8*)(lds + PG8_SA(b, h) + aoff + m * 2048 + k * 1024); } while (0)
#define PG8_LDB(dst, b, h) do { _Pragma("unroll") for (int n = 0; n < 2; ++n) _Pragma("unroll") for (int k = 0; k < 2; ++k) dst[n][k] = *(const PG8_LAS bf16x8*)(lds + PG8_SB(b, h) + boff + n * 2048 + k * 1024); } while (0)
#define PG8_MMA(ai, bj, At, Bt) do { __builtin_amdgcn_s_setprio(1); _Pragma("unroll") for (int m = 0; m < 4; ++m) _Pragma("unroll") for (int n = 0; n < 2; ++n) _Pragma("unroll") for (int k = 0; k < 2; ++k) \
        acc[ai][bj][m][n] = __builtin_amdgcn_mfma_f32_16x16x32_bf16(Bt[n][k], At[m][k], acc[ai][bj][m][n], 0, 0, 0); __builtin_amdgcn_s_setprio(0); } while (0)
#define PG8_WAIT_V(n) asm volatile("s_waitcnt vmcnt(" #n ")" ::: "memory")
#define PG8_WAIT_L(n) asm volatile("s_waitcnt lgkmcnt(" #n ")" ::: "memory")
#define PG8_BAR __builtin_amdgcn_s_barrier()
#define PG8_SCHED __builtin_amdgcn_sched_barrier(0)
    Unit cur, nxt; int ui = 0;
    if (!S.next(0, cur)) return;
    f32x4 acc[2][2][4][2];
#pragma unroll
    for (int a = 0; a < 2; ++a)
#pragma unroll
        for (int b = 0; b < 2; ++b)
#pragma unroll
            for (int m = 0; m < 4; ++m)
#pragma unroll
                for (int n = 0; n < 2; ++n) acc[a][b][m][n] = (f32x4){0.f, 0.f, 0.f, 0.f};
    bf16x8 At[4][2], B0[2][2], B1[2][2];
    const char* cA = (const char*)g.A + (size_t)cur.pm * tstepA + (size_t)cur.kt0 * kstep; const char* cB = (const char*)g.Bt + (size_t)cur.pn * tstepB + (size_t)cur.kt0 * kstep;
    S.a_ready(cur);
    if constexpr (SP2) {
        PG8_STAGE(PG8_SB(0, 0), cB, voffB); PG8_STAGE(PG8_SB(0, 1), cB + hstepB, voffB); PG8_STAGE(PG8_SA(0, 0), cA, voffA); PG8_STAGE(PG8_SA(0, 1), cA + hstepA, voffA);
        if (wr == 1) PG8_BAR;
        PG8_WAIT_V(2); PG8_BAR;
        PG8_STAGE(PG8_SB(1, 0), cB + kstep, voffB); PG8_STAGE(PG8_SA(1, 0), cA + kstep, voffA); PG8_STAGE(PG8_SB(1, 1), cB + hstepB + kstep, voffB);
        PG8_WAIT_V(6); PG8_BAR;
    } else {
        PG8_STAGE(PG8_SB(0, 0), cB, voffB); PG8_STAGE(PG8_SA(0, 0), cA, voffA); PG8_STAGE(PG8_SB(0, 1), cB + hstepB, voffB); PG8_STAGE(PG8_SA(0, 1), cA + hstepA, voffA);
        if (wr == 1) PG8_BAR;
        PG8_WAIT_V(4); PG8_BAR;
        PG8_STAGE(PG8_SB(1, 0), cB + kstep, voffB); PG8_STAGE(PG8_SA(1, 0), cA + kstep, voffA); PG8_STAGE(PG8_SB(1, 1), cB + hstepB + kstep, voffB);
        PG8_WAIT_V(6); PG8_BAR;
    }
    for (;;) {
        const bool has_next = S.next(ui + 1, nxt);
        const char* nA = has_next ? (const char*)g.A + (size_t)nxt.pm * tstepA + (size_t)nxt.kt0 * kstep : cA; const char* nB = has_next ? (const char*)g.Bt + (size_t)nxt.pn * tstepB + (size_t)nxt.kt0 * kstep : cB;
        const int nt = cur.nt > 0 ? cur.nt : ntdef;
        for (int t = 0; t < nt; t += 2) {
            const bool last = (t == nt - 2);
            const char* a1 = cA + (size_t)(t + 1) * kstep;
            const char* a2 = last ? nA : cA + (size_t)(t + 2) * kstep; const char* b2 = last ? nB : cB + (size_t)(t + 2) * kstep;
            const char* a3 = a2 + kstep; const char* b3 = b2 + kstep;
            if (last && has_next) S.a_ready(nxt);
            if constexpr (Epi::MIDK) { if (t == Epi::T1 || t == Epi::T2) E.midk(acc, cur, t == Epi::T1 ? 0 : 1, wr, wc, fr, fq); }
            if constexpr (SP2) {
            PG8_LDB(B0, 0, 0); PG8_LDB(B1, 0, 1); PG8_SCHED; PG8_LDA(At, 0, 0); PG8_STAGE(PG8_SA(1, 1), a1 + hstepA, voffA);
            PG8_WAIT_V(8); PG8_WAIT_L(0); PG8_BAR; PG8_MMA(0, 0, At, B0); PG8_MMA(0, 1, At, B1); PG8_BAR; PG8_SCHED;
            PG8_LDA(At, 0, 1); PG8_STAGE(PG8_SB(0, 0), b2, voffB); PG8_STAGE(PG8_SB(0, 1), b2 + hstepB, voffB); PG8_STAGE(PG8_SA(0, 0), a2, voffA);
            PG8_WAIT_V(8); PG8_WAIT_L(0); PG8_BAR; PG8_MMA(1, 0, At, B0); PG8_MMA(1, 1, At, B1); PG8_BAR; PG8_SCHED;
            PG8_LDB(B0, 1, 0); PG8_LDB(B1, 1, 1); PG8_SCHED; PG8_LDA(At, 1, 0); PG8_STAGE(PG8_SA(0, 1), a2 + hstepA, voffA);
            PG8_WAIT_V(8); PG8_WAIT_L(0); PG8_BAR; PG8_MMA(0, 0, At, B0); PG8_MMA(0, 1, At, B1); PG8_BAR; PG8_SCHED;
            PG8_LDA(At, 1, 1); PG8_STAGE(PG8_SB(1, 0), b3, voffB); PG8_STAGE(PG8_SB(1, 1), b3 + hstepB, voffB); PG8_STAGE(PG8_SA(1, 0), a3, voffA);
            PG8_WAIT_V(8); PG8_WAIT_L(0); PG8_BAR; PG8_MMA(1, 0, At, B0); PG8_MMA(1, 1, At, B1); PG8_BAR; PG8_SCHED;
            } else {
            PG8_LDB(B0, 0, 0); PG8_SCHED; PG8_LDA(At, 0, 0); PG8_STAGE(PG8_SA(1, 1), a1 + hstepA, voffA);
            PG8_WAIT_L(8); PG8_BAR; PG8_WAIT_L(0); PG8_MMA(0, 0, At, B0); PG8_BAR; PG8_SCHED;
            PG8_LDB(B1, 0, 1); PG8_STAGE(PG8_SB(0, 0), b2, voffB);
            PG8_BAR; PG8_WAIT_L(0); PG8_MMA(0, 1, At, B1); PG8_BAR;
            PG8_LDA(At, 0, 1); PG8_STAGE(PG8_SA(0, 0), a2, voffA);
            PG8_BAR; PG8_WAIT_L(0); PG8_MMA(1, 0, At, B0); PG8_BAR; PG8_SCHED;
            PG8_STAGE(PG8_SB(0, 1), b2 + hstepB, voffB);
            PG8_WAIT_V(6); PG8_BAR; PG8_MMA(1, 1, At, B1); PG8_BAR;
            PG8_LDB(B0, 1, 0); PG8_SCHED; PG8_LDA(At, 1, 0); PG8_STAGE(PG8_SA(0, 1), a2 + hstepA, voffA);
            PG8_WAIT_L(8); PG8_BAR; PG8_WAIT_L(0); PG8_MMA(0, 0, At, B0); PG8_BAR; PG8_SCHED;
            PG8_LDB(B1, 1, 1); PG8_STAGE(PG8_SB(1, 0), b3, voffB);
            PG8_BAR; PG8_WAIT_L(0); PG8_MMA(0, 1, At, B1); PG8_BAR;
            PG8_LDA(At, 1, 1); PG8_STAGE(PG8_SA(1, 0), a3, voffA);
            PG8_BAR; PG8_WAIT_L(0); PG8_MMA(1, 0, At, B0); PG8_BAR; PG8_SCHED;
            PG8_STAGE(PG8_SB(1, 1), b3 + hstepB, voffB);
            PG8_WAIT_V(6); PG8_BAR; PG8_MMA(1, 1, At, B1); PG8_BAR;
            }
        }
        if constexpr (ALIGN_EPI) { if (wr == 0) PG8_BAR; }
        if constexpr (!Epi::AFTER_DRAIN) { E(acc, cur, wr, wc, fr, fq); S.done(cur); }
        if (!has_next) break;
#pragma unroll
        for (int a = 0; a < 2; ++a)
#pragma unroll
            for (int b = 0; b < 2; ++b)
#pragma unroll
                for (int m = 0; m < 4; ++m)
#pragma unroll
                    for (int n = 0; n < 2; ++n) acc[a][b][m][n] = (f32x4){0.f, 0.f, 0.f, 0.f};
        cur = nxt; cA = nA; cB = nB; ++ui;
        if constexpr (ALIGN_EPI) { if (wr == 1) PG8_BAR; }
    }
    PG8_WAIT_V(0);
    if constexpr (!ALIGN_EPI) { if (wr == 0) PG8_BAR; }
    PG8_BAR;
    if constexpr (Epi::AFTER_DRAIN) { E.fused(acc, cur, wr, wc, fr, fq, lds, wid, lane); S.done(cur); }
#undef PG8_SA
#undef PG8_SB
#undef PG8_STAGE
#undef PG8_LDA
#undef PG8_LDB
#undef PG8_MMA
#undef PG8_WAIT_V
#undef PG8_WAIT_L
#undef PG8_BAR
#undef PG8_SCHED
}
}

constexpr int DM = 4096, FF = 5632, SEQ = 4096, CTXL = 256, TL = 8192, TC = 512, MR = TL + TC, NLAYER = 2;
constexpr int ZW = 24576, ZN = 24832, INW = 24608, MODW = 36864;
constexpr int Z_DNK = 0, Z_DNV = 1024, Z_NAK = 2048, Z_NAV = 4096, Z_DNQ = 6144, Z_NAQ = 7168, Z_DNG = 9216, Z_GMU = 10240, Z_GMV = 11264, Z_GA = 12288;
constexpr float EPS = 1e-6f;
constexpr int NWAVES = 8, NTHR = 512;
typedef unsigned short bf16;
typedef float f32x4 __attribute__((ext_vector_type(4)));
typedef float f32x2 __attribute__((ext_vector_type(2)));
typedef unsigned v4u __attribute__((ext_vector_type(4)));
typedef unsigned v2u __attribute__((ext_vector_type(2)));
#define GAS __attribute__((address_space(1)))

constexpr size_t al256(size_t x) { return (x + 255) & ~(size_t)255; }
constexpr size_t WS_CTL = 0, CTL_ZERO_BYTES = 1u << 20;
constexpr size_t WS_MOD = CTL_ZERO_BYTES;
constexpr size_t WS_W13 = WS_MOD + al256((size_t)NLAYER * 3 * MODW * 4);
constexpr size_t SZ_W13 = (size_t)2 * FF * DM * 2;
constexpr size_t WS_W2 = WS_W13 + 4 * SZ_W13;
constexpr size_t SZ_W2 = (size_t)DM * FF * 2;
constexpr size_t WS_WIN = WS_W2 + 4 * SZ_W2;
constexpr size_t SZ_WIN = (size_t)ZN * DM * 2;
constexpr size_t WS_PC = WS_WIN + 2 * SZ_WIN;
constexpr size_t SZ_SQ = (size_t)DM * DM * 2;
constexpr size_t WS_WO = WS_PC + 2 * SZ_SQ;
constexpr size_t WS_H = WS_WO + 2 * SZ_SQ;
constexpr size_t WS_XN = WS_H + (size_t)MR * DM * 4;
constexpr size_t WS_HB = WS_XN + (size_t)MR * DM * 2;
constexpr size_t WS_Z = WS_HB + (size_t)MR * FF * 2;
constexpr size_t WS_ZAB = WS_Z + (size_t)MR * ZW * 2;
constexpr size_t SZ_DN = (size_t)MR * 1024 * 4;
constexpr size_t WS_G = WS_ZAB + (size_t)MR * 32 * 4;
constexpr size_t WS_BETA = WS_G + (size_t)MR * 16 * 4;
constexpr size_t WS_OF = WS_BETA + (size_t)MR * 16 * 4, WS_OB = WS_OF + SZ_DN;
constexpr size_t WS_VN = WS_OB + SZ_DN;
constexpr size_t WS_YCAT = WS_VN + SZ_DN;
constexpr size_t WS_YF = WS_YCAT + (size_t)MR * DM * 2;
constexpr size_t WS_YB = WS_YF + (size_t)MR * DM * 4;
constexpr size_t WS_VTL = WS_YB + (size_t)MR * DM * 2;
constexpr size_t WS_VTC = WS_VTL + (size_t)2 * 16 * 128 * SEQ * 2;
constexpr size_t WS_KB = WS_VTC + (size_t)2 * 16 * 128 * CTXL * 2;
constexpr size_t WS_QB = WS_KB + (size_t)MR * 1024 * 2;
constexpr size_t WS_KT = WS_QB + (size_t)MR * 1024 * 2;
constexpr size_t SZ_KT = (size_t)2 * 8 * 128 * (CTXL + SEQ) * 2;
constexpr size_t WS_VT2 = WS_KT + SZ_KT;
constexpr size_t WS_WB = WS_VT2 + SZ_KT;
constexpr size_t WS_UB = WS_WB + (size_t)2176 * 64 * 128 * 2;
constexpr size_t WS_QKM = WS_UB + (size_t)2176 * 64 * 128 * 4;
constexpr size_t WS_EG = WS_QKM + (size_t)2176 * 64 * 64 * 2;
constexpr size_t WS_ROPE = WS_EG + (size_t)2176 * 128 * 4;
constexpr size_t WS_SLAB = WS_ROPE + 2048 * 2 * 4;
constexpr size_t WS_GF = WS_SLAB + (size_t)8 * TC * DM * 4;
constexpr size_t WS_END = WS_GF + (size_t)32 * 48 * 8 * 16 * 64 * 8 * 2;
constexpr int CW_AQ = 1024;
constexpr int CW_FN = 2048;
constexpr int CW_UF = 8192;
constexpr int CW_BAR = 4096;

constexpr int RING_BYTES = 131072, MISC_OFF = RING_BYTES + 320, LDS_BYTES = 147456;

#define LAS __attribute__((address_space(3)))
#define LDS_WAIT() asm volatile("s_waitcnt lgkmcnt(0)" ::: "memory")
#define VM_WAIT() asm volatile("s_waitcnt vmcnt(0)" ::: "memory")
#define XB_TMO      128
#define XB_XCNT(j)  (256  + 64 * (j))
#define XB_XSUB(j)  (1280 + 64 * (j))
#define XB_XGEN(j)  (2304 + 64 * (j))
#define XB_TOP      3328
#define XB_TOPGEN   3392
#define XCD_BAR_WORDS 3456
#define XB_SPIN_CAP (1u << 18)

__device__ __forceinline__ unsigned xb_ld(unsigned* p)              { return __hip_atomic_load(p, __ATOMIC_RELAXED, __HIP_MEMORY_SCOPE_AGENT); }
__device__ __forceinline__ unsigned xb_add(unsigned* p, unsigned v) { return __hip_atomic_fetch_add(p, v, __ATOMIC_RELAXED, __HIP_MEMORY_SCOPE_AGENT); }
__device__ __forceinline__ unsigned xb_xcc_id() { return (unsigned)__builtin_amdgcn_s_getreg((3 << 11) | 20) & 0xFu; }
#define XB_SPIN(cond, bar) do { unsigned _sp = 0; while (cond) { __builtin_amdgcn_s_sleep(1); \
    if ((++_sp & 255u) == 0u) { if (xb_ld(&(bar)[XB_TMO])) break; if (_sp > XB_SPIN_CAP) { atomicAdd(&(bar)[XB_TMO], 1u); break; } } } } while (0)

struct XcdBarrier {
    unsigned* bar; unsigned x;
    volatile LAS unsigned* st;
};

__device__ __forceinline__ XcdBarrier xcd_barrier_post(unsigned* bar, volatile LAS unsigned* st) {
    XcdBarrier b; b.bar = bar; b.x = xb_xcc_id(); b.st = st;
    if (threadIdx.x == 0) (void)xb_add(&bar[XB_XCNT(b.x)], 1u);
    return b;
}
__device__ __forceinline__ void xcd_barrier_complete(unsigned* bar, unsigned x, unsigned& nloc, unsigned& nx) {
    const unsigned G = gridDim.x * gridDim.y * gridDim.z;
    unsigned sum, cnt, mine, sp = 0u;
    for (;;) {
        sum = 0u; cnt = 0u; mine = 0u;
#pragma unroll
        for (unsigned j = 0; j < 16; ++j) { const unsigned c = xb_ld(&bar[XB_XCNT(j)]); sum += c; cnt += (c > 0u) ? 1u : 0u; mine = (j == x) ? c : mine; }
        if (sum == G) break;
        __builtin_amdgcn_s_sleep(1);
        if ((++sp & 255u) == 0u) { if (xb_ld(&bar[XB_TMO])) break; if (sp > XB_SPIN_CAP) { atomicAdd(&bar[XB_TMO], 1u); break; } }
    }
    nloc = mine > 0u ? mine : 1u; nx = cnt > 0u ? cnt : 1u;
}

__device__ __forceinline__ void xcd_barrier(const XcdBarrier& b) {
    asm volatile("s_waitcnt vmcnt(0)" ::: "memory");
    __syncthreads();
    if (threadIdx.x == 0) {
        unsigned* bar = b.bar;
        __builtin_amdgcn_s_waitcnt(0);
        unsigned nloc = b.st[0], nx = b.st[1];
        if (nloc == 0u) { xcd_barrier_complete(bar, b.x, nloc, nx); b.st[0] = nloc; b.st[1] = nx; }
        const unsigned old = xb_add(&bar[XB_XSUB(b.x)], 1u);
        const unsigned gen = old / nloc;
        if (old + 1u == (gen + 1u) * nloc) {
            __builtin_amdgcn_fence(__ATOMIC_RELEASE, "agent");
            asm volatile("s_waitcnt vmcnt(0)" ::: "memory");
            const unsigned og = xb_add(&bar[XB_TOP], 1u);
            const unsigned tg = og / nx;
            if (og + 1u == (tg + 1u) * nx) xb_add(&bar[XB_TOPGEN], 1u);
            else XB_SPIN(xb_ld(&bar[XB_TOPGEN]) == tg, bar);
            __builtin_amdgcn_fence(__ATOMIC_ACQUIRE, "agent");
            xb_add(&bar[XB_XGEN(b.x)], 1u);
            asm volatile("s_waitcnt vmcnt(0)" ::: "memory");
        } else {
            XB_SPIN(xb_ld(&bar[XB_XGEN(b.x)]) == gen, bar);
            __builtin_amdgcn_fence(__ATOMIC_ACQUIRE, "agent");
            asm volatile("s_waitcnt vmcnt(0)" ::: "memory");
        }
    }
    __syncthreads();
}

__device__ __forceinline__ float wave_sum(float v) {
#pragma unroll
    for (int o = 1; o < 64; o <<= 1) v += __shfl_xor(v, o);
    return v;
}
__device__ __forceinline__ float wave_max(float v) {
#pragma unroll
    for (int o = 1; o < 64; o <<= 1) v = fmaxf(v, __shfl_xor(v, o));
    return v;
}
__device__ __forceinline__ float bflo(unsigned u) { return __builtin_bit_cast(float, u << 16); }
__device__ __forceinline__ float bfhi(unsigned u) { return __builtin_bit_cast(float, u & 0xffff0000u); }
typedef __bf16 bf16x2v_t __attribute__((ext_vector_type(2)));
__device__ __forceinline__ unsigned pk2(float lo, float hi) { bf16x2v_t v = {(__bf16)lo, (__bf16)hi}; return __builtin_bit_cast(unsigned, v); }
__device__ __forceinline__ float sigmoidf_(float x) { return 1.0f / (1.0f + __expf(-x)); }
__device__ __forceinline__ float siluf_(float x) { return x * sigmoidf_(x); }
__device__ __forceinline__ float gelu_tanh(float x) { const float u = 1.5957691216057308f * (x + 0.044715f * x * x * x); return x / (1.0f + __expf(-u)); }
__device__ __forceinline__ void row_info(int row, int& base, int& t, int& T, int& v) {
    if (row < TL) { const int b = row >> 12; base = b << 12; t = row & 4095; T = SEQ; v = b; }
    else { const int r = row - TL; const int b = r >> 8; base = TL + (b << 8); t = r & 255; T = CTXL; v = 2; }
}

__device__ __forceinline__ void cvt_item(const float* __restrict__ W, int N, bf16* WT, size_t dpitch, int k0, int n0, size_t dbase, LAS float* scr, int lane) {
#pragma unroll 8
    for (int i = 0; i < 32; ++i) { const int kk = 2 * i + (lane >> 5); scr[kk * 33 + (lane & 31)] = __builtin_nontemporal_load(W + (size_t)(k0 + kk) * N + n0 + (lane & 31)); }
    LDS_WAIT(); asm volatile("" ::: "memory");
    const int c = lane & 7;
#pragma unroll
    for (int j = 0; j < 4; ++j) { const int n = (lane >> 3) + 8 * j; const LAS float* s = scr + (8 * c) * 33 + n;
        v4u o; o.x = pk2(s[0 * 33], s[1 * 33]); o.y = pk2(s[2 * 33], s[3 * 33]); o.z = pk2(s[4 * 33], s[5 * 33]); o.w = pk2(s[6 * 33], s[7 * 33]);
        __builtin_nontemporal_store(o, (GAS v4u*)(WT + dbase + (size_t)n * dpitch + k0 + 8 * c)); }
    LDS_WAIT(); asm volatile("" ::: "memory");
}
template <int MODE> __device__ __forceinline__ void cvt_matrix(const float* __restrict__ W, int K, int N, bf16* WT, size_t dpitch, int koff, int gw, int NGW, LAS float* scr, int lane) {
    const int nblk = N / 32, ngroups = (K / 512) * nblk, wg = gw >> 3, G_ = NGW >> 3, wv = gw & 7;
    for (int gi = wg; gi < ngroups; gi += G_) {
        const int kq = gi / nblk, nb = gi - kq * nblk, kb = 8 * kq + wv, n0 = nb * 32;
        int drow0;
        if (MODE == 0) drow0 = n0;
        else if (MODE == 1) drow0 = (n0 >> 7) * 256 + (n0 & 127);
        else if (MODE == 2) drow0 = (n0 >> 7) * 256 + 128 + (n0 & 127);
        else drow0 = nb < 64 ? n0 : (nb == 64 ? ZW : n0 - 32);
        cvt_item(W, N, WT, dpitch, kb * 64, n0, (size_t)drow0 * dpitch + koff, scr, lane);
    }
}

__device__ __forceinline__ void mod_phase(const float* __restrict__ cvec, const float* __restrict__ cctx, const float* __restrict__ ada_w, const float* __restrict__ ada_b, float* mod,
                                          LAS unsigned char* lds, int tid, int lane, int wave, int bid, int G, int l_lo, int l_hi) {
    LAS float* sc = (LAS float*)lds;
    LAS float* red = (LAS float*)(lds + 49152);
    for (int i = tid; i < 3 * DM; i += NTHR) { const int v = i >> 12, k = i & 4095; const float x = v < 2 ? cvec[v * DM + k] : cctx[k]; sc[i] = siluf_(x); }
    __syncthreads();
    const int cl = lane & 15, kr = lane >> 4;
    for (int item = l_lo * (MODW / 64) + bid; item < l_hi * (MODW / 64); item += G) {
        const int l = item / (MODW / 64), cb = item - l * (MODW / 64), col0 = cb * 64;
        const float* wp = ada_w + (size_t)l * DM * MODW + col0 + 4 * cl;
        f32x4 a0 = {0.f, 0.f, 0.f, 0.f}, a1 = a0, a2 = a0;
#pragma unroll 8
        for (int i = 0; i < 128; ++i) { const int k = wave * 4 + kr + 32 * i;
            const f32x4 w = *(const f32x4*)(wp + (size_t)k * MODW);
            a0 += w * sc[k]; a1 += w * sc[DM + k]; a2 += w * sc[2 * DM + k]; }
#pragma unroll
        for (int e = 0; e < 4; ++e) { a0[e] += __shfl_xor(a0[e], 16); a0[e] += __shfl_xor(a0[e], 32); a1[e] += __shfl_xor(a1[e], 16); a1[e] += __shfl_xor(a1[e], 32); a2[e] += __shfl_xor(a2[e], 16); a2[e] += __shfl_xor(a2[e], 32); }
        if (kr == 0) {
#pragma unroll
            for (int e = 0; e < 4; ++e) { red[(wave * 3 + 0) * 64 + 4 * cl + e] = a0[e]; red[(wave * 3 + 1) * 64 + 4 * cl + e] = a1[e]; red[(wave * 3 + 2) * 64 + 4 * cl + e] = a2[e]; } }
        __syncthreads();
        if (tid < 192) { const int v = tid >> 6, c = tid & 63; float s = 0.f;
#pragma unroll
            for (int w = 0; w < 8; ++w) s += red[(w * 3 + v) * 64 + c];
            mod[((size_t)l * 3 + v) * MODW + col0 + c] = s + ada_b[(size_t)l * MODW + col0 + c]; }
        __syncthreads();
    }
}

__device__ __forceinline__ void norm_phase(const float* in_lat, const float* in_ctx, const float* __restrict__ nw, const float* modl  , int isub, bf16* xn, int nrows,
                                           const float* slab, const float* gatev, float coef, float* hctx_out, LAS unsigned char* lds, int tid, int lane, int gw, int NGW) {
    LAS float* AL = (LAS float*)lds;
    LAS float* SL = AL + 3 * DM;
    __syncthreads();
    for (int i = tid; i < 3 * DM / 4; i += NTHR) { const int v = i >> 10, c = (i & 1023) * 4;
        const f32x4 w = *(const f32x4*)(nw + c), sc = *(const f32x4*)(modl + (size_t)v * MODW + (isub * 3 + 1) * DM + c), sh = *(const f32x4*)(modl + (size_t)v * MODW + (isub * 3 + 0) * DM + c);
        *(LAS f32x4*)(AL + v * DM + c) = w * (sc + 1.0f); *(LAS f32x4*)(SL + v * DM + c) = sh; }
    __syncthreads();
    if (slab != nullptr) { const int wave_ = gw & 7, bid_ = gw >> 3, G_ = NGW >> 3; LAS float* red = (LAS float*)(lds + 98304);
        for (int r = bid_; r < nrows - TL; r += G_) {
            const int c0 = 512 * wave_ + 4 * lane; const size_t ro = (size_t)r * DM;
            f32x4 xh[2], sp[8][2];
#pragma unroll
            for (int jj = 0; jj < 2; ++jj) { xh[jj] = *(const f32x4*)(in_ctx + ro + c0 + 256 * jj);
#pragma unroll
                for (int k = 0; k < 8; ++k) sp[k][jj] = *(const f32x4*)(slab + ((size_t)k * 512 + r) * DM + c0 + 256 * jj); }
            float ss = 0.f;
#pragma unroll
            for (int jj = 0; jj < 2; ++jj) { f32x4 s = sp[0][jj];
#pragma unroll
                for (int k = 1; k < 8; ++k) s += sp[k][jj];
                xh[jj] += (*(const f32x4*)(gatev + c0 + 256 * jj) * coef) * s; *(f32x4*)(hctx_out + ro + c0 + 256 * jj) = xh[jj];
                ss += (xh[jj][0] * xh[jj][0] + xh[jj][1] * xh[jj][1]) + (xh[jj][2] * xh[jj][2] + xh[jj][3] * xh[jj][3]); }
            ss = wave_sum(ss);
            __syncthreads();
            if (lane == 0) red[wave_] = ss;
            __syncthreads();
            float tot = 0.f;
#pragma unroll
            for (int w = 0; w < 8; ++w) tot += red[w];
            const float rr = 1.0f / sqrtf(tot * (1.0f / DM) + EPS);
#pragma unroll
            for (int jj = 0; jj < 2; ++jj) { const int c = c0 + 256 * jj;
                const f32x4 a = *(const LAS f32x4*)(AL + 2 * DM + c), sh = *(const LAS f32x4*)(SL + 2 * DM + c);
                const f32x4 y = (xh[jj] * rr) * a + sh;
                v2u o; o.x = pk2(y[0], y[1]); o.y = pk2(y[2], y[3]);
                *(v2u*)(xn + (size_t)(TL + r) * DM + c) = o; }
        }
        nrows = TL;
    }
    f32x4 xq[16];
    if (gw < nrows) { const float* s0 = gw < TL ? in_lat + (size_t)gw * DM : in_ctx + (size_t)(gw - TL) * DM;
#pragma unroll
        for (int j = 0; j < 16; ++j) xq[j] = *(const f32x4*)(s0 + 4 * (lane + 64 * j)); }
    for (int row = gw; row < nrows; row += NGW) {
        const int v = row < SEQ ? 0 : (row < TL ? 1 : 2);
        f32x4 x[16]; float ss = 0.f;
#pragma unroll
        for (int j = 0; j < 16; ++j) x[j] = xq[j];
        { const int nr = row + NGW;
          if (nr < nrows) { const float* s1 = nr < TL ? in_lat + (size_t)nr * DM : in_ctx + (size_t)(nr - TL) * DM;
#pragma unroll
            for (int j = 0; j < 16; ++j) xq[j] = *(const f32x4*)(s1 + 4 * (lane + 64 * j)); } }
#pragma unroll
        for (int j = 0; j < 16; ++j) ss += (x[j][0] * x[j][0] + x[j][1] * x[j][1]) + (x[j][2] * x[j][2] + x[j][3] * x[j][3]);
        const float r = 1.0f / sqrtf(wave_sum(ss) * (1.0f / DM) + EPS);
#pragma unroll
        for (int j = 0; j < 16; ++j) { const int c = 4 * (lane + 64 * j);
            const f32x4 a = *(const LAS f32x4*)(AL + v * DM + c), sh = *(const LAS f32x4*)(SL + v * DM + c);
            const f32x4 y = (x[j] * r) * a + sh;
            v2u o; o.x = pk2(y[0], y[1]); o.y = pk2(y[2], y[3]);
            *(v2u*)(xn + (size_t)row * DM + c) = o; }
    }
}
__device__ __forceinline__ void final_norm_phase(const float* h, const float* __restrict__ fw, float* out, int lane, int gw, int NGW) {
    for (int row = gw; row < TL; row += NGW) {
        const float* src = h + (size_t)row * DM;
        f32x4 x[16]; float ss = 0.f;
#pragma unroll
        for (int j = 0; j < 16; ++j) { x[j] = *(const f32x4*)(src + 4 * (lane + 64 * j)); ss += (x[j][0] * x[j][0] + x[j][1] * x[j][1]) + (x[j][2] * x[j][2] + x[j][3] * x[j][3]); }
        const float r = 1.0f / sqrtf(wave_sum(ss) * (1.0f / DM) + EPS);
#pragma unroll
        for (int j = 0; j < 16; ++j) { const int c = 4 * (lane + 64 * j); const f32x4 w = *(const f32x4*)(fw + c);
            *(f32x4*)(out + (size_t)row * DM + c) = (x[j] * r) * w;
            if ((j & 3) == 3) asm volatile("" ::: "memory"); }
    }
}

__device__ __forceinline__ void gm_prep_phase(const bf16* z, const float* __restrict__ snw, float* vn, int lane, int gw, int NGW) {
    v4u pu[2] = {{0u, 0u, 0u, 0u}, {0u, 0u, 0u, 0u}};
    if (gw < MR) { pu[0] = *(const v4u*)(z + (size_t)gw * ZW + Z_GMV + 8 * lane); pu[1] = *(const v4u*)(z + (size_t)gw * ZW + Z_GMV + 8 * lane + 512); }
    for (int row = gw; row < MR; row += NGW) {
        float x[16]; float s = 0.f;
        const v4u cu0 = pu[0], cu1 = pu[1];
        if (row + NGW < MR) { pu[0] = *(const v4u*)(z + (size_t)(row + NGW) * ZW + Z_GMV + 8 * lane); pu[1] = *(const v4u*)(z + (size_t)(row + NGW) * ZW + Z_GMV + 8 * lane + 512); }
#pragma unroll
        for (int j = 0; j < 2; ++j) { const v4u u = j ? cu1 : cu0;
            x[8 * j + 0] = gelu_tanh(bflo(u.x)); x[8 * j + 1] = gelu_tanh(bfhi(u.x)); x[8 * j + 2] = gelu_tanh(bflo(u.y)); x[8 * j + 3] = gelu_tanh(bfhi(u.y));
            x[8 * j + 4] = gelu_tanh(bflo(u.z)); x[8 * j + 5] = gelu_tanh(bfhi(u.z)); x[8 * j + 6] = gelu_tanh(bflo(u.w)); x[8 * j + 7] = gelu_tanh(bfhi(u.w)); }
#pragma unroll
        for (int i = 0; i < 16; ++i) s += x[i];
        const float mu = wave_sum(s) * (1.0f / 1024.0f); float q = 0.f;
#pragma unroll
        for (int i = 0; i < 16; ++i) { x[i] -= mu; q += x[i] * x[i]; }
        const float rs = 1.0f / sqrtf(wave_sum(q) * (1.0f / 1024.0f) + EPS);
#pragma unroll
        for (int j = 0; j < 2; ++j) { const int c = 8 * lane + 512 * j;
            const f32x4 w0 = *(const f32x4*)(snw + c), w1 = *(const f32x4*)(snw + c + 4);
            *(f32x4*)(vn + (size_t)row * 1024 + c) = (f32x4){x[8 * j + 0] * rs * w0[0], x[8 * j + 1] * rs * w0[1], x[8 * j + 2] * rs * w0[2], x[8 * j + 3] * rs * w0[3]};
            *(f32x4*)(vn + (size_t)row * 1024 + c + 4) = (f32x4){x[8 * j + 4] * rs * w1[0], x[8 * j + 5] * rs * w1[1], x[8 * j + 6] * rs * w1[2], x[8 * j + 7] * rs * w1[3]}; }
    }
}

__device__ __forceinline__ void dn_out_phase(const float* of, const float* ob, const bf16* z, const float* __restrict__ dnw, bf16* ycat, int nrows, int lane, int gw, int NGW) {
    const int sub = lane >> 4, l16 = lane & 15;
    const f32x4 w0 = *(const f32x4*)(dnw + 8 * l16), w1 = *(const f32x4*)(dnw + 8 * l16 + 4);
    f32x4 pf0 = {0.f, 0.f, 0.f, 0.f}, pf1 = pf0, pb0 = pf0, pb1 = pf0; v4u pg = {0u, 0u, 0u, 0u};
    { const int it0 = gw * 4 + sub; if (it0 < nrows * 8) { const int row = it0 >> 3, hd = it0 & 7; const size_t o = (size_t)row * 1024 + hd * 128 + 8 * l16;
        pf0 = *(const f32x4*)(of + o); pf1 = *(const f32x4*)(of + o + 4); pb0 = *(const f32x4*)(ob + o); pb1 = *(const f32x4*)(ob + o + 4); pg = *(const v4u*)(z + (size_t)row * ZW + Z_DNG + hd * 128 + 8 * l16); } }
    for (int it = gw * 4 + sub; it < nrows * 8; it += NGW * 4) {
        const int row = it >> 3, hd = it & 7;
        f32x4 a0 = pf0 + pb0, a1 = pf1 + pb1; const v4u gu = pg;
        { const int it2 = it + NGW * 4; if (it2 < nrows * 8) { const int row2 = it2 >> 3, hd2 = it2 & 7; const size_t o2 = (size_t)row2 * 1024 + hd2 * 128 + 8 * l16;
            pf0 = *(const f32x4*)(of + o2); pf1 = *(const f32x4*)(of + o2 + 4); pb0 = *(const f32x4*)(ob + o2); pb1 = *(const f32x4*)(ob + o2 + 4); pg = *(const v4u*)(z + (size_t)row2 * ZW + Z_DNG + hd2 * 128 + 8 * l16); } }
        float ss = (a0[0] * a0[0] + a0[1] * a0[1]) + (a0[2] * a0[2] + a0[3] * a0[3]) + (a1[0] * a1[0] + a1[1] * a1[1]) + (a1[2] * a1[2] + a1[3] * a1[3]);
        ss += __shfl_xor(ss, 1); ss += __shfl_xor(ss, 2); ss += __shfl_xor(ss, 4); ss += __shfl_xor(ss, 8);
        const float r = 1.0f / sqrtf(ss * (1.0f / 128.0f) + EPS);
        v4u out; out.x = pk2(a0[0] * r * w0[0] * siluf_(bflo(gu.x)), a0[1] * r * w0[1] * siluf_(bfhi(gu.x))); out.y = pk2(a0[2] * r * w0[2] * siluf_(bflo(gu.y)), a0[3] * r * w0[3] * siluf_(bfhi(gu.y)));
        out.z = pk2(a1[0] * r * w1[0] * siluf_(bflo(gu.z)), a1[1] * r * w1[1] * siluf_(bfhi(gu.z))); out.w = pk2(a1[2] * r * w1[2] * siluf_(bflo(gu.w)), a1[3] * r * w1[3] * siluf_(bfhi(gu.w)));
        *(v4u*)(ycat + (size_t)row * DM + 1024 + hd * 128 + 8 * l16) = out;
    }
}
__device__ __forceinline__ void merge_ctx_phase(const float* slab, const bf16* z, bf16* yb, int lane, int gw, int NGW) {
    for (int r = gw; r < TC; r += NGW) { const size_t row = (size_t)TL + r;
#pragma unroll 4
        for (int j = 0; j < 16; ++j) { const int c = 4 * (lane + 64 * j); f32x4 y = {0.f, 0.f, 0.f, 0.f};
#pragma unroll
            for (int br = 0; br < 3; ++br) { const v2u gu = *(const v2u*)(z + row * ZW + Z_GA + br * 4096 + c);
                f32x4 s = {0.f, 0.f, 0.f, 0.f};
#pragma unroll
                for (int k = (br == 0 ? 0 : (br == 1 ? 2 : 4)); k < (br == 0 ? 2 : (br == 1 ? 4 : 8)); ++k) s += *(const f32x4*)(slab + ((size_t)k * 512 + r) * DM + c);
                y[0] += sigmoidf_(bflo(gu.x)) * s[0]; y[1] += sigmoidf_(bfhi(gu.x)) * s[1]; y[2] += sigmoidf_(bflo(gu.y)) * s[2]; y[3] += sigmoidf_(bfhi(gu.y)) * s[3]; }
            v2u o; o.x = pk2(y[0], y[1]); o.y = pk2(y[2], y[3]); *(v2u*)(yb + row * DM + c) = o; }
    }
}

__device__ __forceinline__ void vt_phase(const bf16* z, bf16* vf, bf16* vtc, LAS unsigned char* lds, int lane, int wave, int gw, int NGW) {
    LAS unsigned short* T = (LAS unsigned short*)(lds + wave * 8448);
    constexpr int NIT = 2 * 16 * 4 * 2;
    for (int it = gw; it < NIT; it += NGW) {
        const int dh = it & 1; int r = it >> 1; const int tb = 64 + (r & 3); r >>= 2; const int h = r & 15, b = r >> 4;
        const int row0 = tb < 64 ? b * SEQ + tb * 64 : TL + b * CTXL + (tb - 64) * 64;
#pragma unroll
        for (int j = 0; j < 8; ++j) { const int tok = 8 * j + (lane >> 3), ch = lane & 7;
            const v4u v = *(const v4u*)(z + (size_t)(row0 + tok) * ZW + Z_NAV + h * 128 + dh * 64 + 8 * ch);
            LAS unsigned* d = (LAS unsigned*)(T + tok * 66 + 8 * ch); d[0] = v.x; d[1] = v.y; d[2] = v.z; d[3] = v.w; }
        LDS_WAIT(); asm volatile("" ::: "memory");
        unsigned w[32];
#pragma unroll
        for (int t = 0; t < 32; ++t) w[t] = (unsigned)T[(2 * t) * 66 + lane] | ((unsigned)T[(2 * t + 1) * 66 + lane] << 16);
        if (tb < 64) { bf16* dst = vf + (((size_t)(b * 16 + h) * 512 + tb * 8) * 128 + dh * 64 + lane) * 8;
#pragma unroll
            for (int j = 0; j < 8; ++j) *(v4u*)(dst + (size_t)j * 1024) = (v4u){w[4 * j], w[4 * j + 1], w[4 * j + 2], w[4 * j + 3]};
        } else { bf16* dst = vtc + ((size_t)(b * 16 + h) * 128 + dh * 64 + lane) * CTXL + (tb - 64) * 64;
#pragma unroll
            for (int j = 0; j < 8; ++j) *(v4u*)(dst + 8 * j) = (v4u){w[4 * j], w[4 * j + 1], w[4 * j + 2], w[4 * j + 3]}; }
        LDS_WAIT(); asm volatile("" ::: "memory");
    }
}

typedef short bf16x8_t __attribute__((ext_vector_type(8)));
struct AttnState { float mrun, lrun; f32x4 oa[8]; };
template <bool LOC, bool QFR> __device__ __forceinline__ void attn_chunk(AttnState& st, const char* qbase, const char* kbase, const char* vbase,
                                                               const LAS unsigned char* KL, const LAS unsigned char* VL, const LAS float* rpbL, int cc, int drow0, int lo, int cg, int lane) {
    asm volatile("" : "+v"(lane));
    const int q = lane & 15, g = lane >> 4, krl = 8 * (q >> 2) + (q & 3);
    const int c = 16 * cg + q, c0 = min(max(c - 8, 0), 48);
    const unsigned kloff = (unsigned)((q >> 2) * 2048 + g * 64 + (q & 3) * 16), vloff = (unsigned)(g * 2048 + q * 16), qloff = QFR ? (unsigned)lane * 16u : (unsigned)(q * ZW + 8 * g) * 2u;
    const float scale = 0.08838834764831845f;
    f32x4 sX[4], sY[4];
    bf16x8_t fr[LOC ? 4 : 1][8];
    bf16x8_t qf[4];
#pragma unroll
    for (int k = 0; k < 4; ++k) qf[k] = *(const GAS bf16x8_t*)((const GAS char*)qbase + qloff + (QFR ? 1024 : 64) * k);
    if constexpr (LOC) {
#pragma unroll
        for (int i = 0; i < 4; ++i) { const char* pk = kbase + (size_t)i * 16384; asm volatile("" : "+s"(pk));
#pragma unroll
            for (int y = 0; y < 2; ++y)
#pragma unroll
                for (int k = 0; k < 4; ++k) fr[i][4 * y + k] = *(const GAS bf16x8_t*)((const GAS char*)pk + kloff + (1024 * y + 256 * k)); }
        asm volatile("" ::: "memory");
#pragma unroll
        for (int i = 0; i < 4; ++i) { f32x4 ax = {0.f, 0.f, 0.f, 0.f}, ay = ax;
#pragma unroll
            for (int k = 0; k < 4; ++k) { ax = __builtin_amdgcn_mfma_f32_16x16x32_bf16(fr[i][k], qf[k], ax, 0, 0, 0); ay = __builtin_amdgcn_mfma_f32_16x16x32_bf16(fr[i][4 + k], qf[k], ay, 0, 0, 0); }
            sX[i] = ax; sY[i] = ay; }
#pragma unroll
        for (int i = 0; i < 4; ++i) { const char* pv = vbase + (size_t)i * 16384; asm volatile("" : "+s"(pv));
#pragma unroll
            for (int d = 0; d < 8; ++d) fr[i][d] = *(const GAS bf16x8_t*)((const GAS char*)pv + vloff + 256 * d); }
        asm volatile("" ::: "memory");
    } else {
#pragma unroll
        for (int i = 0; i < 4; ++i) { const int keyx = 128 * cc + 32 * i + krl, keyy = keyx + 4;
            const int fx = ((keyx & 15) + 4 * ((keyx >> 4) & 1)) & 15, fy = ((keyy & 15) + 4 * ((keyy >> 4) & 1)) & 15;
            bf16x8_t kx[4], ky[4];
#pragma unroll
            for (int k = 0; k < 4; ++k) { kx[k] = *(const LAS bf16x8_t*)(KL + keyx * 256 + (((4 * k + g) ^ fx) << 4)); ky[k] = *(const LAS bf16x8_t*)(KL + keyy * 256 + (((4 * k + g) ^ fy) << 4)); }
            f32x4 ax = {0.f, 0.f, 0.f, 0.f}, ay = ax;
#pragma unroll
            for (int k = 0; k < 4; ++k) { ax = __builtin_amdgcn_mfma_f32_16x16x32_bf16(kx[k], qf[k], ax, 0, 0, 0); ay = __builtin_amdgcn_mfma_f32_16x16x32_bf16(ky[k], qf[k], ay, 0, 0, 0); }
            sX[i] = ax; sY[i] = ay; }
    }
    float mx = -3.0e38f;
#pragma unroll
    for (int i = 0; i < 4; ++i) {
#pragma unroll
        for (int e = 0; e < 4; ++e) {
            float x = sX[i][e] * scale, y = sY[i][e] * scale;
            if constexpr (LOC) { const int kcx = lo + 8 * g + e, kcy = kcx + 4; const int dr = drow0 + i;
                const bool vx = (kcx >= c0) && (kcx < c0 + 16), vy = (kcy >= c0) && (kcy < c0 + 16);
                const float bx = rpbL[dr * 31 + min(max(kcx - c + 15, 0), 30)], by = rpbL[dr * 31 + min(max(kcy - c + 15, 0), 30)];
                x = vx ? x + bx : -1.0e30f; y = vy ? y + by : -1.0e30f; }
            sX[i][e] = x; sY[i][e] = y; mx = fmaxf(mx, fmaxf(x, y)); }
    }
    mx = fmaxf(mx, __shfl_xor(mx, 16)); mx = fmaxf(mx, __shfl_xor(mx, 32));
    const float mnew = fmaxf(st.mrun, mx), alpha = __expf(st.mrun - mnew);
    st.mrun = mnew;
    float psum = 0.f;
#pragma unroll
    for (int i = 0; i < 4; ++i)
#pragma unroll
        for (int e = 0; e < 4; ++e) { const float x = __expf(sX[i][e] - mnew), y = __expf(sY[i][e] - mnew); sX[i][e] = x; sY[i][e] = y; psum += x + y; }
    st.lrun = st.lrun * alpha + psum;
#pragma unroll
    for (int d = 0; d < 8; ++d) st.oa[d] *= alpha;
#pragma unroll
    for (int i = 0; i < 4; ++i) {
        v4u pu; pu.x = pk2(sX[i][0], sX[i][1]); pu.y = pk2(sX[i][2], sX[i][3]); pu.z = pk2(sY[i][0], sY[i][1]); pu.w = pk2(sY[i][2], sY[i][3]);
        const bf16x8_t pf = __builtin_bit_cast(bf16x8_t, pu);
        if constexpr (LOC) {
#pragma unroll
            for (int d = 0; d < 8; ++d) st.oa[d] = __builtin_amdgcn_mfma_f32_16x16x32_bf16(fr[i][d], pf, st.oa[d], 0, 0, 0);
        } else { const int chn = 16 * cc + 4 * i + g; bf16x8_t vf[8];
#pragma unroll
            for (int d = 0; d < 8; ++d) vf[d] = *(const LAS bf16x8_t*)(VL + (16 * d + q) * 512 + ((chn ^ q) << 4));
#pragma unroll
            for (int d = 0; d < 8; ++d) st.oa[d] = __builtin_amdgcn_mfma_f32_16x16x32_bf16(vf[d], pf, st.oa[d], 0, 0, 0); }
    }
}
template <bool LOCAL> __device__ __forceinline__ void attn_unit(const bf16* z, const bf16* qfb, const bf16* vtl  , const bf16* kf, const LAS unsigned char* KL, const LAS unsigned char* VL, const LAS float* rpbL, bf16* ycat, int b, int r, int cg, int qb, int h, int lane) {
    const int qrow0 = LOCAL ? (b * SEQ + r * 64 + 16 * cg) : (TL + b * CTXL + 16 * qb);
    const int r0 = min(max(r - 4, 0), 56), lo = min(max(16 * cg - 8, 0), 32);
    const char* qbase = LOCAL ? (const char*)qfb + (((size_t)(b * 16 + h) * 256 + r * 4 + cg) * 4) * 1024 : (const char*)(z + (size_t)qrow0 * ZW + Z_NAQ + h * 128);
    AttnState st; st.mrun = -3.0e38f; st.lrun = 0.f;
#pragma unroll
    for (int d = 0; d < 8; ++d) st.oa[d] = (f32x4){0.f, 0.f, 0.f, 0.f};
    if constexpr (LOCAL) {
#pragma unroll 1
        for (int ck = 0; ck < 2; ++ck) {
            const int tok0 = (r0 + 4 * ck) * 64 + lo;
            const char* kbase = (const char*)kf + ((size_t)(b * 16 + h) * 1024 + (tok0 >> 2)) * 1024;
            const char* vbase = (const char*)vtl + ((size_t)(b * 16 + h) * 512 + (tok0 >> 3)) * 2048;
            attn_chunk<true, true>(st, qbase, kbase, vbase, KL, VL, rpbL, 0, r0 + 4 * ck - r + 7, lo, cg, lane);
        }
    }
#pragma unroll 1
    for (int cc = 0; cc < 2; ++cc) attn_chunk<false, LOCAL>(st, qbase, nullptr, nullptr, KL, VL, rpbL, cc, 0, 0, 0, lane);
    asm volatile("" : "+v"(lane));
    const int q = lane & 15, g = lane >> 4;
    float lrun = st.lrun;
    lrun += __shfl_xor(lrun, 16); lrun += __shfl_xor(lrun, 32);
    const float inv = 1.0f / lrun;
    bf16* op = ycat + (size_t)(qrow0 + q) * DM + 2048 + h * 128 + 4 * g;
#pragma unroll
    for (int d = 0; d < 8; ++d) { v2u o; o.x = pk2(st.oa[d][0] * inv, st.oa[d][1] * inv); o.y = pk2(st.oa[d][2] * inv, st.oa[d][3] * inv); *(v2u*)(op + 16 * d) = o; }
}

__device__ __forceinline__ int attn_item_bh(int it) { return (it & 7) + 8 * ((it >> 3) & 3); }
__device__ __forceinline__ void attn_wg(int it, const bf16* z, const bf16* vtl  , const bf16* kf, const bf16* qfb, const bf16* vtc, const float* __restrict__ rpb  , bf16* ycat, bool ctxq, bool stage, LAS unsigned char* lds, int tid) {
    const int bh = attn_item_bh(it), rp = it >> 5, b = bh >> 4, h = bh & 15;
    LAS unsigned char* KL = lds; LAS unsigned char* VL = lds + 65536; LAS float* rpbL = (LAS float*)(lds + RING_BYTES + 1024);
    asm volatile("" : "+v"(tid));
    __syncthreads();
    if (stage) {
#pragma unroll
    for (int j = 0; j < 8; ++j) { const int i = tid + NTHR * j; const int key = i >> 4, ch = i & 15; const int fk = ((key & 15) + 4 * ((key >> 4) & 1)) & 15;
        *(LAS v4u*)(KL + key * 256 + ((ch ^ fk) << 4)) = *(const v4u*)(z + (size_t)(TL + b * CTXL + key) * ZW + Z_NAK + h * 128 + 8 * ch); }
#pragma unroll
    for (int j = 0; j < 8; ++j) { const int i = tid + NTHR * j; const int dim = i >> 5, ch = i & 31;
        *(LAS v4u*)(VL + dim * 512 + ((ch ^ (dim & 15)) << 4)) = *(const v4u*)(vtc + ((size_t)(b * 16 + h) * 128 + dim) * CTXL + 8 * ch); }
    for (int i = tid; i < 465; i += NTHR) rpbL[i] = rpb[h * 465 + i];
    }
    __syncthreads();
    asm volatile("" : "+v"(tid));
    const int wave = __builtin_amdgcn_readfirstlane(tid >> 6), lane = tid & 63;
    attn_unit<true>(z, qfb, vtl, kf, KL, VL, rpbL, ycat, b, 2 * rp + (wave >> 2), wave & 3, 0, h, lane);
    if (ctxq && wave == 0 && (rp & 1) == 0) attn_unit<false>(z, qfb, vtl, kf, KL, VL, rpbL, ycat, b, 0, 0, rp >> 1, h, lane);
}

constexpr int NPOS = CTXL + SEQ;
__device__ __forceinline__ int pos_row(int b, int P) { return P < CTXL ? TL + b * CTXL + P : b * SEQ + (P - CTXL); }

__device__ __forceinline__ void rope_table_phase(float* rope, int lane, int gw, int NGW) {
    for (int i = gw * 64 + lane; i < 2048; i += NGW * 64) { const int pos = i >> 5, fi = i & 31; const float f = powf(10000.0f, -(float)fi * (1.0f / 32.0f)); float s, c; sincosf((float)pos * f, &s, &c); rope[2 * i] = c; rope[2 * i + 1] = s; }
}
__device__ __forceinline__ void dn_prep3_phase(const bf16* z, const float* zab, const float* __restrict__ convw, const float* __restrict__ a_log, const float* __restrict__ dt_bias, const float* rope,
                                               bf16* KB, bf16* QB, bf16* KT, bf16* VT2, float* gout, float* bout, int lane, int gw, int NGW) {
    const int i0 = (2 * lane) & 31; const bool second = (lane & 16) != 0;
#define DN_LOADZ(dst, itx) do { const int tb_ = (itx) >> 3, ch_ = ((itx) & 7) * 128 + 2 * lane; int t0_, T_, base_; \
        if (tb_ < 1024) { t0_ = (tb_ & 511) * 8; T_ = SEQ; base_ = (tb_ >> 9) * SEQ; } else { const int cb_ = tb_ - 1024; t0_ = (cb_ & 31) * 8; T_ = CTXL; base_ = TL + (cb_ >> 5) * CTXL; } \
        _Pragma("unroll") for (int w = 0; w < 3; ++w) { const int zc_ = (w == 0 ? Z_DNK : (w == 1 ? Z_DNV : Z_DNQ)) + ch_; \
            _Pragma("unroll") for (int r = 0; r < 12; ++r) { const int tt_ = t0_ - 2 + r; dst[w][r] = (tt_ >= 0 && tt_ < T_) ? *(const unsigned*)(z + (size_t)(base_ + tt_) * ZW + zc_) : 0u; } } } while (0)
    unsigned zn[3][12];
    if (gw < 1088 * 8) DN_LOADZ(zn, gw);
#pragma unroll 1
    for (int it = gw; it < 1088 * 8; it += NGW) {
        const int tb = it >> 3, hd = it & 7;
        int row0, b, t0, T, base, P0;
        if (tb < 1024) { row0 = tb * 8; b = tb >> 9; t0 = (tb & 511) * 8; T = SEQ; base = b * SEQ; P0 = CTXL + t0; }
        else { const int cb = tb - 1024; row0 = TL + cb * 8; b = cb >> 5; t0 = (cb & 31) * 8; T = CTXL; base = TL + b * CTXL; P0 = t0; }
        (void)T; (void)base;
        const int ch = hd * 128 + 2 * lane;
        unsigned zz[3][12]; f32x2 wv[3][5];
#pragma unroll
        for (int w = 0; w < 3; ++w) { const int wc = (w == 0 ? 0 : (w == 1 ? 1024 : 2048)) + ch;
#pragma unroll
            for (int r = 0; r < 12; ++r) zz[w][r] = zn[w][r];
#pragma unroll
            for (int j = 0; j < 5; ++j) wv[w][j] = *(const f32x2*)(convw + j * 3072 + wc); }
        if (it + NGW < 1088 * 8) DN_LOADZ(zn, it + NGW);
        f32x4 cs[8];
        if (tb < 1024) {
#pragma unroll
            for (int tk = 0; tk < 8; ++tk) { const int t = t0 + tk; const int pos = (lane < 32) ? (t >> 6) : (t & 63); cs[tk] = *(const f32x4*)(rope + (size_t)(pos * 32 + i0) * 2); }
        }
        float y[3][8][2]; float ssq[16];
#pragma unroll
        for (int w = 0; w < 3; ++w)
#pragma unroll
            for (int tk = 0; tk < 8; ++tk) { float a0 = 0.f, a1 = 0.f;
#pragma unroll
                for (int j = 0; j < 5; ++j) { a0 += wv[w][j][0] * bflo(zz[w][tk + j]); a1 += wv[w][j][1] * bfhi(zz[w][tk + j]); }
                y[w][tk][0] = siluf_(a0); y[w][tk][1] = siluf_(a1); }
#pragma unroll
        for (int tk = 0; tk < 8; ++tk) { ssq[tk] = y[0][tk][0] * y[0][tk][0] + y[0][tk][1] * y[0][tk][1]; ssq[8 + tk] = y[2][tk][0] * y[2][tk][0] + y[2][tk][1] * y[2][tk][1]; }
#pragma unroll
        for (int st = 0; st < 4; ++st) { const int msk = 1 << st; const bool up = (lane & msk) != 0;
#pragma unroll
            for (int j = 0; j < (8 >> st); ++j) { const float a = ssq[2 * j], c2 = ssq[2 * j + 1]; const float keep = up ? c2 : a, send = up ? a : c2; ssq[j] = keep + __shfl_xor(send, msk); } }
        float tot = ssq[0]; tot += __shfl_xor(tot, 16); tot += __shfl_xor(tot, 32);
        const float rnl = 1.0f / sqrtf(tot + EPS);
        unsigned kd[8], qd[8];
#pragma unroll
        for (int tk = 0; tk < 8; ++tk) {
            const float rk = __builtin_bit_cast(float, __builtin_amdgcn_readlane(__builtin_bit_cast(int, rnl), tk)), rq = __builtin_bit_cast(float, __builtin_amdgcn_readlane(__builtin_bit_cast(int, rnl), 8 + tk));
            float k0 = y[0][tk][0] * rk, k1 = y[0][tk][1] * rk, q0 = y[2][tk][0] * rq, q1 = y[2][tk][1] * rq;
            if (tb < 1024) { const f32x4 c4 = cs[tk];
                const float pk0 = __shfl_xor(k0, 16), pk1 = __shfl_xor(k1, 16), pq0 = __shfl_xor(q0, 16), pq1 = __shfl_xor(q1, 16);
                if (!second) { k0 = k0 * c4[0] - pk0 * c4[1]; k1 = k1 * c4[2] - pk1 * c4[3]; q0 = q0 * c4[0] - pq0 * c4[1]; q1 = q1 * c4[2] - pq1 * c4[3]; }
                else { k0 = k0 * c4[0] + pk0 * c4[1]; k1 = k1 * c4[2] + pk1 * c4[3]; q0 = q0 * c4[0] + pq0 * c4[1]; q1 = q1 * c4[2] + pq1 * c4[3]; } }
            q0 *= 0.08838834764831845f; q1 *= 0.08838834764831845f;
            y[0][tk][0] = k0; y[0][tk][1] = k1; y[2][tk][0] = q0; y[2][tk][1] = q1;
            kd[tk] = pk2(k0, k1); qd[tk] = pk2(q0, q1);
        }
        { const bool l2 = (lane & 2) == 0, l1 = (lane & 1) == 0;
#define DN_QT4(d) do { unsigned r0_ = (unsigned)__shfl_xor((int)(l2 ? d[2] : d[0]), 2), r1_ = (unsigned)__shfl_xor((int)(l2 ? d[3] : d[1]), 2); d[2] = l2 ? r0_ : d[2]; d[3] = l2 ? r1_ : d[3]; d[0] = l2 ? d[0] : r0_; d[1] = l2 ? d[1] : r1_; \
            r0_ = (unsigned)__shfl_xor((int)(l1 ? d[1] : d[0]), 1); r1_ = (unsigned)__shfl_xor((int)(l1 ? d[3] : d[2]), 1); d[1] = l1 ? r0_ : d[1]; d[3] = l1 ? r1_ : d[3]; d[0] = l1 ? d[0] : r0_; d[2] = l1 ? d[2] : r1_; } while (0)
          unsigned ka[4] = {kd[0], kd[1], kd[2], kd[3]}, kb2[4] = {kd[4], kd[5], kd[6], kd[7]}, qa[4] = {qd[0], qd[1], qd[2], qd[3]}, qb2[4] = {qd[4], qd[5], qd[6], qd[7]};
          DN_QT4(ka); DN_QT4(kb2); DN_QT4(qa); DN_QT4(qb2);
#undef DN_QT4
          const size_t fo2 = ((((((size_t)(b * 8 + hd) * 68 + (P0 >> 6)) * 4 + ((P0 >> 4) & 3)) * 4 + (lane >> 4)) * 4 + ((lane >> 2) & 3)) * 16 + (P0 & 15) + (lane & 3)) * 8;
          *(v4u*)(KB + fo2) = (v4u){ka[0], ka[1], ka[2], ka[3]}; *(v4u*)(KB + fo2 + 32) = (v4u){kb2[0], kb2[1], kb2[2], kb2[3]};
          *(v4u*)(QB + fo2) = (v4u){qa[0], qa[1], qa[2], qa[3]}; *(v4u*)(QB + fo2 + 32) = (v4u){qb2[0], qb2[1], qb2[2], qb2[3]}; }
        const size_t fo = (((((size_t)(b * 8 + hd) * 68 + (P0 >> 6)) * 8 + (lane >> 3)) * 2 + ((P0 >> 5) & 1)) * 64 + ((P0 >> 3) & 3) * 16 + 2 * (lane & 7)) * 8;
        bf16* ktp = KT + fo; bf16* vtp = VT2 + fo;
        *(v4u*)(ktp) = (v4u){pk2(y[0][0][0], y[0][1][0]), pk2(y[0][2][0], y[0][3][0]), pk2(y[0][4][0], y[0][5][0]), pk2(y[0][6][0], y[0][7][0])};
        *(v4u*)(ktp + 8) = (v4u){pk2(y[0][0][1], y[0][1][1]), pk2(y[0][2][1], y[0][3][1]), pk2(y[0][4][1], y[0][5][1]), pk2(y[0][6][1], y[0][7][1])};
        *(v4u*)(vtp) = (v4u){pk2(y[1][0][0], y[1][1][0]), pk2(y[1][2][0], y[1][3][0]), pk2(y[1][4][0], y[1][5][0]), pk2(y[1][6][0], y[1][7][0])};
        *(v4u*)(vtp + 8) = (v4u){pk2(y[1][0][1], y[1][1][1]), pk2(y[1][2][1], y[1][3][1]), pk2(y[1][4][1], y[1][5][1]), pk2(y[1][6][1], y[1][7][1])};
        if (lane < 16) { const int row = row0 + (lane & 7), dir = lane >> 3;
            const float alpha = zab[(size_t)row * 32 + dir * 8 + hd], bz = zab[(size_t)row * 32 + 16 + dir * 8 + hd];
            const float xs = alpha + dt_bias[dir * 8 + hd]; const float sp = xs > 20.f ? xs : log1pf(expf(xs));
            gout[(size_t)row * 16 + dir * 8 + hd] = -expf(a_log[dir * 8 + hd]) * sp;
            bout[(size_t)row * 16 + dir * 8 + hd] = 1.0f / (1.0f + expf(-bz)); }
    }
}
#undef DN_LOADZ


constexpr int NINST = 2 * 8 * 2 * 68;
__device__ __forceinline__ int chunk_P0(int dir, int n) { return dir == 0 ? 64 * n : (n < 4 ? CTXL - 64 * (n + 1) : NPOS - 64 * (n - 3)); }
__device__ __forceinline__ void dn_chunk_phase(const bf16* KB, const bf16* QB, const bf16* KT, const bf16* VT2, const float* G, const float* BETA, bf16* WB, float* UB, bf16* QKM, float* EGb,
                                               LAS unsigned char* lds, int lane, int wave, int gw, int NGW) {
    LAS float* AL = (LAS float*)(lds + wave * 16384);
    LAS unsigned short* T1L = (LAS unsigned short*)AL; LAS unsigned short* T2L = T1L + 4096;
    LAS float* SV = (LAS float*)(lds + RING_BYTES + 1024 + wave * 1024);
    const int q16 = lane & 15, g = lane >> 4;
#pragma unroll 1
    for (int inst = gw; inst < NINST; inst += NGW) {
        const int n = inst % 68, rr = inst / 68, dir = rr & 1, hd = (rr >> 1) & 7, b = rr >> 4;
        const int P0 = chunk_P0(dir, n);
        const int rowi = pos_row(b, dir ? P0 + 63 - lane : P0 + lane);
        const float bi = BETA[(size_t)rowi * 16 + dir * 8 + hd];
        float gc = G[(size_t)rowi * 16 + dir * 8 + hd];
#pragma unroll
        for (int o = 1; o < 64; o <<= 1) { const float t = __shfl_up(gc, o); if (lane >= o) gc += t; }
        asm volatile("s_waitcnt lgkmcnt(0)" ::: "memory");
        SV[lane] = gc; SV[64 + lane] = bi;
        asm volatile("s_waitcnt lgkmcnt(0)" ::: "memory");
        const float gc63 = __shfl(gc, 63);
        EGb[(size_t)inst * 128 + lane] = __expf(gc); EGb[(size_t)inst * 128 + 64 + lane] = __expf(gc63 - gc);
        bf16x8_t kf[4][4];
        const size_t fb0 = ((size_t)(b * 8 + hd) * 68 + (P0 >> 6)) * 4; const int q16p = dir ? 15 - q16 : q16;
#pragma unroll
        for (int blk = 0; blk < 4; ++blk) {
#pragma unroll
            for (int ks = 0; ks < 4; ++ks) kf[blk][ks] = *(const bf16x8_t*)(KB + ((((fb0 + (dir ? 3 - blk : blk)) * 4 + ks) * 4 + g) * 16 + q16p) * 8); }
#pragma unroll
        for (int ib = 0; ib < 4; ++ib) {
            const int i = 16 * ib + q16; const float gci = SV[i], bti = SV[64 + i];
            bf16x8_t qfr[4];
#pragma unroll
            for (int ks = 0; ks < 4; ++ks) qfr[ks] = *(const bf16x8_t*)(QB + ((((fb0 + (dir ? 3 - ib : ib)) * 4 + ks) * 4 + g) * 16 + q16p) * 8);
#pragma unroll
            for (int jb = 0; jb < 4; ++jb) {
                v2u qo = {0u, 0u};
                if (jb <= ib) {
                    f32x4 ck = {0.f, 0.f, 0.f, 0.f}, cq = ck;
#pragma unroll
                    for (int ks = 0; ks < 4; ++ks) { ck = __builtin_amdgcn_mfma_f32_16x16x32_bf16(kf[jb][ks], kf[ib][ks], ck, 0, 0, 0); cq = __builtin_amdgcn_mfma_f32_16x16x32_bf16(kf[jb][ks], qfr[ks], cq, 0, 0, 0); }
                    const f32x4 gcj = *(const LAS f32x4*)(SV + 16 * jb + 4 * g);
                    f32x4 av, qv;
#pragma unroll
                    for (int e = 0; e < 4; ++e) { const int j = 16 * jb + 4 * g + e; const float dec = __expf(gci - gcj[e]);
                        av[e] = (i > j) ? bti * ck[e] * dec : 0.f; qv[e] = (i >= j) ? cq[e] * dec : 0.f; }
                    *(LAS f32x4*)(AL + i * 64 + 16 * jb + 4 * g) = av;
                    qo.x = pk2(qv[0], qv[1]); qo.y = pk2(qv[2], qv[3]);
                }
                *(v2u*)(QKM + ((((size_t)inst * 4 + ib) * 2 + (jb >> 1)) * 64 + (2 * (jb & 1) + (g >> 1)) * 16 + q16) * 8 + 4 * (g & 1)) = qo;
            }
        }
        asm volatile("s_waitcnt lgkmcnt(0)" ::: "memory");
        float T[64];
        {
            T[0] = (lane == 0) ? 1.f : 0.f;
#pragma unroll
            for (int i = 1; i < 64; ++i) {
                float acc0 = (lane == i) ? 1.f : 0.f, acc1 = 0.f;
#pragma unroll
                for (int hb = 0; hb < 2; ++hb) {
                    if (8 * hb < (i + 3) / 4) {
                        f32x4 rowc[8];
#pragma unroll
                        for (int jj = 0; jj < 8; ++jj) rowc[jj] = *(const LAS f32x4*)(AL + i * 64 + 32 * hb + 4 * jj);
#pragma unroll
                        for (int jj = 0; jj < 8; ++jj) {
#pragma unroll
                            for (int e = 0; e < 4; ++e) if (32 * hb + 4 * jj + e < i) { if (jj & 1) acc1 -= rowc[jj][e] * T[32 * hb + 4 * jj + e]; else acc0 -= rowc[jj][e] * T[32 * hb + 4 * jj + e]; } }
                    }
                }
                T[i] = acc0 + acc1;
            }
        }
        asm volatile("s_waitcnt lgkmcnt(0)" ::: "memory");
        { const float s1 = bi, s2 = bi * __expf(gc); const int pc = dir ? 63 - lane : lane;
#pragma unroll
          for (int i = 0; i < 64; ++i) { T1L[i * 64 + pc] = (unsigned short)(pk2(T[i] * s1, 0.f) & 0xffffu); T2L[i * 64 + pc] = (unsigned short)(pk2(T[i] * s2, 0.f) & 0xffffu); } }
        asm volatile("s_waitcnt lgkmcnt(0)" ::: "memory");
        const size_t fb = (((size_t)(b * 8 + hd) * 68 + (P0 >> 6)) * 16 * 64 + lane) * 8;
        const bf16* vtb = VT2 + fb; const bf16* ktb = KT + fb;
#pragma unroll
        for (int half = 0; half < 2; ++half) {
            bf16x8_t xf[8][2];
#pragma unroll
            for (int db = 0; db < 8; ++db)
#pragma unroll
                for (int ks = 0; ks < 2; ++ks) xf[db][ks] = *(const bf16x8_t*)((half ? ktb : vtb) + (2 * db + ks) * 512);
#pragma unroll
            for (int ib = 0; ib < 4; ++ib) {
                bf16x8_t tf[2];
#pragma unroll
                for (int ks = 0; ks < 2; ++ks) tf[ks] = *(const LAS bf16x8_t*)((half ? T2L : T1L) + (16 * ib + q16) * 64 + 32 * ks + 8 * g);
#pragma unroll
                for (int db = 0; db < 8; ++db) {
                    f32x4 c = {0.f, 0.f, 0.f, 0.f};
                    if (half == 0) {
#pragma unroll
                        for (int ks = 0; ks < 2; ++ks) c = __builtin_amdgcn_mfma_f32_16x16x32_bf16(tf[ks], xf[db][ks], c, 0, 0, 0);
                        *(f32x4*)(UB + (((size_t)inst * 8 + db) * 4 + ib) * 256 + lane * 4) = c;
                    } else {
#pragma unroll
                        for (int ks = 0; ks < 2; ++ks) c = __builtin_amdgcn_mfma_f32_16x16x32_bf16(xf[db][ks], tf[ks], c, 0, 0, 0);
                        v2u o; o.x = pk2(c[0], c[1]); o.y = pk2(c[2], c[3]);
                        *(v2u*)(WB + ((((size_t)inst * 4 + ib) * 4 + (db >> 1)) * 64 + (2 * (db & 1) + (g >> 1)) * 16 + q16) * 8 + 4 * (g & 1)) = o;
                    }
                }
            }
        }
        asm volatile("s_waitcnt lgkmcnt(0)" ::: "memory");
    }
}

struct DnStSet { bf16x8_t wf[4], kt[2][2]; f32x4 u4, ek4; float dec; };
struct DnOutSet { bf16x8_t qf[4], qk[2]; f32x4 eg4; int orow[4]; };
__device__ __forceinline__ void dn_scan_phase(const bf16* QB, const bf16* KT, const bf16* WB, const float* UB, const bf16* QKM, const float* EGb, float* OF, float* OB,
                                              LAS unsigned char* lds, int tid, int bid, int G) {
    const int wave = __builtin_amdgcn_readfirstlane(tid >> 6), lane = tid & 63, q16 = lane & 15, g = lane >> 4, rb = wave & 3;
    LAS unsigned short* SbL = (LAS unsigned short*)lds;
    LAS unsigned short* VnL = SbL + 16 * 136;
    LAS unsigned short* Vn2L = VnL + 16 * 72;
#pragma unroll 1
    for (int unit = bid; unit < 256; unit += G) {
        const int dvb = (unit >> 3) & 7, chain = 4 * (unit & 7) + (unit >> 6), dir = chain & 1, hd = (chain >> 1) & 7, b = chain >> 4;
        __syncthreads();
        for (int i = tid; i < 16 * 136 / 2; i += NTHR) ((LAS unsigned*)SbL)[i] = 0u;
        __syncthreads();
        float* od = dir ? OB : OF;
        if (wave < 4) {
            f32x4 s0 = {0.f, 0.f, 0.f, 0.f}, s1 = s0;
            const bf16* ktb = KT + ((size_t)(b * 8 + hd) * 68 * 16 * 64 + (size_t)(4 * rb) * 64 + lane) * 8;
            DnStSet st[3];
#define DN_LOAD_ST(S_, n_) do { const size_t inst_ = (size_t)chain * 68 + (n_); const int P0_ = chunk_P0(dir, (n_)); \
                _Pragma("unroll") for (int ks = 0; ks < 4; ++ks) S_.wf[ks] = *(const bf16x8_t*)(WB + (((inst_ * 4 + rb) * 4 + ks) * 64 + lane) * 8); \
                _Pragma("unroll") for (int t = 0; t < 2; ++t) _Pragma("unroll") for (int ks = 0; ks < 2; ++ks) S_.kt[t][ks] = *(const bf16x8_t*)(ktb + ((size_t)(P0_ >> 6) * 16 + 2 * t + ks) * 512); \
                S_.u4 = *(const f32x4*)(UB + ((inst_ * 8 + dvb) * 4 + rb) * 256 + lane * 4); S_.ek4 = *(const f32x4*)(EGb + inst_ * 128 + 64 + 16 * rb + 4 * g); S_.dec = EGb[inst_ * 128 + 63]; } while (0)
#define DN_STEP_ST(j_, n_) do { if ((n_) + 2 < 68) DN_LOAD_ST(st[((j_) + 2) % 3], (n_) + 2); \
        bf16x8_t sf[4]; \
        _Pragma("unroll") \
        for (int ks = 0; ks < 4; ++ks) sf[ks] = *(const LAS bf16x8_t*)(SbL + q16 * 136 + 32 * ks + 8 * g); \
        f32x4 acc = {0.f, 0.f, 0.f, 0.f}; \
        _Pragma("unroll") \
        for (int ks = 0; ks < 4; ++ks) acc = __builtin_amdgcn_mfma_f32_16x16x32_bf16(st[(j_)].wf[ks], sf[ks], acc, 0, 0, 0); \
        const f32x4 v = st[(j_)].u4 - acc; \
        { v2u o; o.x = pk2(v[0], v[1]); o.y = pk2(v[2], v[3]); *(LAS v2u*)(VnL + q16 * 72 + 16 * rb + 4 * g) = o; \
        const f32x4 vs = v * st[(j_)].ek4; v2u o2; \
        if (dir == 0) { o2.x = pk2(vs[0], vs[1]); o2.y = pk2(vs[2], vs[3]); *(LAS v2u*)(Vn2L + q16 * 72 + 16 * rb + 4 * g) = o2; } \
        else { o2.x = pk2(vs[3], vs[2]); o2.y = pk2(vs[1], vs[0]); *(LAS v2u*)(Vn2L + q16 * 72 + 60 - 16 * rb - 4 * g) = o2; } } \
        __syncthreads(); \
        bf16x8_t vf[2]; \
        _Pragma("unroll") \
        for (int ks = 0; ks < 2; ++ks) vf[ks] = *(const LAS bf16x8_t*)(Vn2L + q16 * 72 + 32 * ks + 8 * g); \
        s0 *= st[(j_)].dec; s1 *= st[(j_)].dec; \
        _Pragma("unroll") \
        for (int ks = 0; ks < 2; ++ks) { s0 = __builtin_amdgcn_mfma_f32_16x16x32_bf16(st[(j_)].kt[0][ks], vf[ks], s0, 0, 0, 0); s1 = __builtin_amdgcn_mfma_f32_16x16x32_bf16(st[(j_)].kt[1][ks], vf[ks], s1, 0, 0, 0); } \
        { v2u o; o.x = pk2(s0[0], s0[1]); o.y = pk2(s0[2], s0[3]); *(LAS v2u*)(SbL + q16 * 136 + 32 * rb + 4 * g) = o; \
        o.x = pk2(s1[0], s1[1]); o.y = pk2(s1[2], s1[3]); *(LAS v2u*)(SbL + q16 * 136 + 32 * rb + 16 + 4 * g) = o; } \
        __syncthreads(); } while (0)
            DN_LOAD_ST(st[0], 0); DN_LOAD_ST(st[1], 1);
#pragma unroll 1
            for (int n3 = 0; n3 < 66; n3 += 3) { DN_STEP_ST(0, n3); DN_STEP_ST(1, n3 + 1); DN_STEP_ST(2, n3 + 2); }
            DN_STEP_ST(0, 66); DN_STEP_ST(1, 67);
#undef DN_STEP_ST
#undef DN_LOAD_ST
        } else {
            DnOutSet os[3];
#define DN_LOAD_OUT(S_, n_) do { const size_t inst_ = (size_t)chain * 68 + (n_); const int P0_ = chunk_P0(dir, (n_)); const int i_ = 16 * rb + q16; \
                const size_t qb_ = (((size_t)(b * 8 + hd) * 68 + (P0_ >> 6)) * 4 + (dir ? 3 - rb : rb)) * 4; (void)i_; \
                _Pragma("unroll") for (int ks = 0; ks < 4; ++ks) S_.qf[ks] = *(const bf16x8_t*)(QB + (((qb_ + ks) * 4 + g) * 16 + (dir ? 15 - q16 : q16)) * 8); \
                _Pragma("unroll") for (int ks = 0; ks < 2; ++ks) S_.qk[ks] = *(const bf16x8_t*)(QKM + (((inst_ * 4 + rb) * 2 + ks) * 64 + lane) * 8); \
                S_.eg4 = *(const f32x4*)(EGb + inst_ * 128 + 16 * rb + 4 * g); \
                _Pragma("unroll") for (int e = 0; e < 4; ++e) { const int io_ = 16 * rb + 4 * g + e; S_.orow[e] = pos_row(b, dir ? P0_ + 63 - io_ : P0_ + io_); } } while (0)
#define DN_STEP_OUT(j_, n_) do { if ((n_) + 2 < 68) DN_LOAD_OUT(os[((j_) + 2) % 3], (n_) + 2); \
        bf16x8_t sf[4]; \
        _Pragma("unroll") \
        for (int ks = 0; ks < 4; ++ks) sf[ks] = *(const LAS bf16x8_t*)(SbL + q16 * 136 + 32 * ks + 8 * g); \
        f32x4 oacc = {0.f, 0.f, 0.f, 0.f}; \
        _Pragma("unroll") \
        for (int ks = 0; ks < 4; ++ks) oacc = __builtin_amdgcn_mfma_f32_16x16x32_bf16(os[(j_)].qf[ks], sf[ks], oacc, 0, 0, 0); \
        oacc *= os[(j_)].eg4; \
        __syncthreads(); \
        bf16x8_t vf[2]; \
        _Pragma("unroll") \
        for (int ks = 0; ks < 2; ++ks) vf[ks] = *(const LAS bf16x8_t*)(VnL + q16 * 72 + 32 * ks + 8 * g); \
        _Pragma("unroll") \
        for (int ks = 0; ks < 2; ++ks) oacc = __builtin_amdgcn_mfma_f32_16x16x32_bf16(os[(j_)].qk[ks], vf[ks], oacc, 0, 0, 0); \
        _Pragma("unroll") \
        for (int e = 0; e < 4; ++e) od[(size_t)os[(j_)].orow[e] * 1024 + hd * 128 + 16 * dvb + q16] = oacc[e]; \
        __syncthreads(); } while (0)
            DN_LOAD_OUT(os[0], 0); DN_LOAD_OUT(os[1], 1);
#pragma unroll 1
            for (int n3 = 0; n3 < 66; n3 += 3) { DN_STEP_OUT(0, n3); DN_STEP_OUT(1, n3 + 1); DN_STEP_OUT(2, n3 + 2); }
            DN_STEP_OUT(0, 66); DN_STEP_OUT(1, 67);
#undef DN_STEP_OUT
#undef DN_LOAD_OUT
        }
    }
}

__device__ __forceinline__ void gm_item2(int chunk, int grp, const bf16* z, const float* vn, const float* __restrict__ sw  , const float* __restrict__ sb  , bf16* ycat, bool stage_w, LAS unsigned char* lds, int tid) {
    LAS unsigned short* WL = (LAS unsigned short*)lds;
    LAS unsigned short* VL = WL + 128 * 136;
    const int row0 = chunk < 64 ? chunk * 128 : TL + (chunk - 64) * 128;
    __syncthreads();
    if (stage_w)
    for (int i = tid; i < 128 * 32; i += NTHR) { const int pp = i >> 5, q4 = (i & 31) * 4;
        const f32x4 w = *(const f32x4*)(sw + (size_t)grp * 16384 + pp * 128 + q4);
        v2u o; o.x = pk2(w[0], w[1]); o.y = pk2(w[2], w[3]); *(LAS v2u*)(WL + pp * 136 + q4) = o; }
    for (int i = tid; i < 128 * 32; i += NTHR) { const int q = i >> 5, c4 = (i & 31) * 4;
        const f32x4 v = *(const f32x4*)(vn + (size_t)(row0 + q) * 1024 + grp * 128 + c4);
        const unsigned a = pk2(v[0], v[1]), b2 = pk2(v[2], v[3]);
        VL[(c4 + 0) * 136 + q] = (unsigned short)(a & 0xffffu); VL[(c4 + 1) * 136 + q] = (unsigned short)(a >> 16);
        VL[(c4 + 2) * 136 + q] = (unsigned short)(b2 & 0xffffu); VL[(c4 + 3) * 136 + q] = (unsigned short)(b2 >> 16); }
    __syncthreads();
    const int wave = __builtin_amdgcn_readfirstlane(tid >> 6), lane = tid & 63, q16 = lane & 15, gq = lane >> 4;
    bf16x8_t af[4];
#pragma unroll
    for (int ks = 0; ks < 4; ++ks) af[ks] = *(const LAS bf16x8_t*)(VL + (16 * wave + q16) * 136 + 32 * ks + 8 * gq);
    const int c = grp * 128 + 16 * wave + 4 * gq;
#pragma unroll
    for (int pb = 0; pb < 8; ++pb) {
        f32x4 acc = {0.f, 0.f, 0.f, 0.f};
#pragma unroll
        for (int ks = 0; ks < 4; ++ks) { const bf16x8_t bfr = *(const LAS bf16x8_t*)(WL + (16 * pb + q16) * 136 + 32 * ks + 8 * gq); acc = __builtin_amdgcn_mfma_f32_16x16x32_bf16(af[ks], bfr, acc, 0, 0, 0); }
        const int pp = 16 * pb + q16; const size_t row = (size_t)(row0 + pp);
        const float bias = sb[grp * 128 + pp];
        const v2u zu = *(const v2u*)(z + row * ZW + Z_GMU + c);
        v2u o; o.x = pk2(gelu_tanh(bflo(zu.x)) * (acc[0] + bias), gelu_tanh(bfhi(zu.x)) * (acc[1] + bias)); o.y = pk2(gelu_tanh(bflo(zu.y)) * (acc[2] + bias), gelu_tanh(bfhi(zu.y)) * (acc[3] + bias));
        *(v2u*)(ycat + row * DM + c) = o;
    }
}


#define MK_ONE_LAUNCH 1

#ifndef MK_ONE_LAUNCH
#define MK_ONE_LAUNCH 1
#endif
constexpr int NPL = 15;
constexpr int NPH = 1 + NLAYER * NPL + 1;
struct Args { const float* in[24]; float* out; unsigned char* ws; int ph_lo, ph_hi; };

__global__ void __launch_bounds__(NTHR, 2) dit_fwd(Args a) {
    extern __shared__ __attribute__((aligned(16))) unsigned char lds_raw[];
    LAS unsigned char* lds = (LAS unsigned char*)lds_raw;
    volatile LAS unsigned* MISC = (volatile LAS unsigned*)(lds + MISC_OFF);
    const int G = gridDim.x, bid = blockIdx.x, NGW = G * NWAVES;
    const int wave0 = __builtin_amdgcn_readfirstlane((int)threadIdx.x >> 6);
#define PHASE_IDS() int tid = wave0 * 64 + (int)__builtin_amdgcn_mbcnt_hi(~0u, __builtin_amdgcn_mbcnt_lo(~0u, 0u)); asm volatile("" : "+v"(tid)); const int lane = tid & 63, wave = __builtin_amdgcn_readfirstlane(tid >> 6), gw = bid * NWAVES + wave; (void)lane; (void)gw
    for (int u = threadIdx.x; u < (LDS_BYTES - RING_BYTES) / 4; u += NTHR) ((LAS unsigned*)(lds + RING_BYTES))[u] = 0u;
    __syncthreads();
    unsigned char* ws0 = a.ws;
    const int lo = a.ph_lo, hi = a.ph_hi;
    XcdBarrier bar; bar.bar = (unsigned*)(ws0 + WS_CTL) + CW_BAR; bar.x = 0; bar.st = nullptr;
    if (hi - lo > 1) bar = xcd_barrier_post((unsigned*)(ws0 + WS_CTL) + CW_BAR, MISC + 8);
#define IN(k) (lo <= (k) && (k) < hi)
#define SEAM(k) do { if (IN(k) && IN((k) + 1)) xcd_barrier(bar); } while (0)

#define SUB_FIRST(b) ((((b) >> 3) & 7) < 4)
#define KAS __attribute__((address_space(4)))
#define PHASE_PTRS() const KAS char* kp_ = (const KAS char*)__builtin_amdgcn_kernarg_segment_ptr(); asm volatile("" : "+s"(kp_)); \
    unsigned char* const ws = *(unsigned char* const KAS*)(kp_ + 200); (void)ws
#define INP(i) (*(const float* const KAS*)(kp_ + 8 * (i)))
#define P_MOD ((float*)(ws + WS_MOD))
#define P_H ((float*)(ws + WS_H))
#define P_XN ((bf16*)(ws + WS_XN))
#define P_HB ((bf16*)(ws + WS_HB))
#define P_Z ((bf16*)(ws + WS_Z))
#define P_ZAB ((float*)(ws + WS_ZAB))
#define P_GG ((float*)(ws + WS_G))
#define P_BETA ((float*)(ws + WS_BETA))
#define P_OF ((float*)(ws + WS_OF))
#define P_OB ((float*)(ws + WS_OB))
#define P_VN ((float*)(ws + WS_VN))
#define P_YCAT ((bf16*)(ws + WS_YCAT))
#define P_YF ((float*)(ws + WS_YF))
#define P_YB ((bf16*)(ws + WS_YB))
#define P_VTL ((bf16*)(ws + WS_VTL))
#define P_VTC ((bf16*)(ws + WS_VTC))
#define P_KB ((bf16*)(ws + WS_KB))
#define P_QB ((bf16*)(ws + WS_QB))
#define P_KT ((bf16*)(ws + WS_KT))
#define P_VT2 ((bf16*)(ws + WS_VT2))
#define P_WB ((bf16*)(ws + WS_WB))
#define P_UB ((float*)(ws + WS_UB))
#define P_QKM ((bf16*)(ws + WS_QKM))
#define P_EG ((float*)(ws + WS_EG))
#define P_ROPE ((float*)(ws + WS_ROPE))

    if (IN(0)) { PHASE_IDS(); PHASE_PTRS();
        LAS float* scr = (LAS float*)(lds + wave * 16384);
        {
            for (int l = 0; l < NLAYER; ++l) {
                for (int s = 0; s < 2; ++s) { const size_t ls = (size_t)l * 2 + s;
                    cvt_matrix<1>(INP(7) + ls * DM * FF, DM, FF, (bf16*)(ws + WS_W13 + ls * SZ_W13), DM, 0, gw, NGW, scr, lane);
                    cvt_matrix<2>(INP(8) + ls * DM * FF, DM, FF, (bf16*)(ws + WS_W13 + ls * SZ_W13), DM, 0, gw, NGW, scr, lane);
                    cvt_matrix<0>(INP(9) + ls * FF * DM, FF, DM, (bf16*)(ws + WS_W2 + ls * SZ_W2), FF, 0, gw, NGW, scr, lane); }
                cvt_matrix<3>(INP(10) + (size_t)l * DM * INW, DM, INW, (bf16*)(ws + WS_WIN + l * SZ_WIN), DM, 0, gw, NGW, scr, lane);
                cvt_matrix<0>(INP(19) + (size_t)l * 1024 * DM, 1024, DM, (bf16*)(ws + WS_PC + l * SZ_SQ), DM, 0, gw, NGW, scr, lane);
                cvt_matrix<0>(INP(20) + (size_t)l * 1024 * DM, 1024, DM, (bf16*)(ws + WS_PC + l * SZ_SQ), DM, 1024, gw, NGW, scr, lane);
                cvt_matrix<0>(INP(21) + (size_t)l * 2048 * DM, 2048, DM, (bf16*)(ws + WS_PC + l * SZ_SQ), DM, 2048, gw, NGW, scr, lane);
                cvt_matrix<0>(INP(22) + (size_t)l * DM * DM, DM, DM, (bf16*)(ws + WS_WO + l * SZ_SQ), DM, 0, gw, NGW, scr, lane);
            }
        }
        rope_table_phase(P_ROPE, lane, gw, NGW);
        __syncthreads();
        mod_phase(INP(1), INP(3), INP(4), INP(5), P_MOD, lds, tid, lane, wave, bid, G, 0, NLAYER);
    }
    SEAM(0);

    for (int l = 0; l < NLAYER; ++l) {
        const int pb = 1 + l * NPL;
        const bool lastl = (l + 1 == NLAYER);
        for (int sub = 0; sub < 2; ++sub) {
            const int p0 = pb + (sub ? 12 : 0), isub = sub ? 2 : 0;
            const bool first = (l == 0 && sub == 0);
            const bool ctxrows = !(lastl && sub == 1);
            const int MRs = ctxrows ? MR : TL;
            if (IN(p0)) { PHASE_IDS(); PHASE_PTRS();
                const bool hasslab = ctxrows && !first;
                const float* gv = sub == 0 ? P_MOD + ((size_t)(l - 1) * 3 + 2) * MODW + (2 * 3 + 2) * DM : P_MOD + ((size_t)l * 3 + 2) * MODW + (1 * 3 + 2) * DM;
                norm_phase(first ? INP(0) : P_H, first ? INP(2) : P_H + (size_t)TL * DM, INP(6) + ((size_t)l * 3 + isub) * DM, P_MOD + (size_t)l * 3 * MODW, isub, P_XN, MRs,
                           hasslab ? (const float*)(ws + WS_SLAB) : nullptr, gv, sub == 0 ? 0.5f : 1.0f, P_H + (size_t)TL * DM, lds, tid, lane, gw, NGW); }
            SEAM(p0);
            if (IN(p0 + 1)) { PHASE_PTRS();
                pg8::Gemm g{P_XN, (const bf16*)(ws + WS_W13 + ((size_t)l * 2 + sub) * SZ_W13), MRs, 2 * FF, DM, DM, DM};
                pg8::SplitOrder S; S.init(MRs, 2 * FF, DM, G, bid, !ctxrows);
                pg8::EpiSwiGLUS E{{P_HB, FF}, (unsigned)WS_SLAB, (unsigned)(WS_CTL + CW_UF * 4)};
                pg8::gemm_phase<pg8::EpiSwiGLUS, pg8::SplitOrder, true, true>(lds, g, S, E, wave0);
            }
            SEAM(p0 + 1);
            if (IN(p0 + 2)) { PHASE_PTRS();
                pg8::Gemm g{P_HB, (const bf16*)(ws + WS_W2 + ((size_t)l * 2 + sub) * SZ_W2), MRs, DM, FF, FF, FF};
                if (lastl && sub == 1) {
                    pg8::PanelOrder S{G, bid};
                    pg8::EpiFinal E{P_H, *(float* const KAS*)(kp_ + 192), P_MOD + (size_t)l * 3 * MODW + (isub * 3 + 2) * DM, MODW, 0.5f, INP(23), (float*)(ws + WS_SLAB), (unsigned*)(ws + WS_CTL) + CW_FN, (LAS float*)(lds + RING_BYTES + 2048)};
                    pg8::gemm_phase<pg8::EpiFinal, pg8::PanelOrder, true, true>(lds, g, S, E, wave0);
                } else {
                pg8::CombOrder S; S.init(TL, DM, G, bid, 1, ctxrows, SUB_FIRST(bid));
                pg8::EpiResidSlab E{{first ? INP(0) : P_H, first ? INP(2) : P_H + (size_t)TL * DM, P_H, P_MOD + (size_t)l * 3 * MODW + (isub * 3 + 2) * DM, MODW, 0.5f}, {(float*)(ws + WS_SLAB)}};
                pg8::gemm_phase<pg8::EpiResidSlab, pg8::CombOrder, true, true>(lds, g, S, E, wave0);
                }
            }
            if (!(lastl && sub == 1)) SEAM(p0 + 2);
            if (sub == 0) {
                if (IN(pb + 3)) { PHASE_IDS(); PHASE_PTRS();
                    norm_phase(P_H, first ? INP(2) : P_H + (size_t)TL * DM, INP(6) + ((size_t)l * 3 + 1) * DM, P_MOD + (size_t)l * 3 * MODW, 1, P_XN, MR,
                               (const float*)(ws + WS_SLAB), P_MOD + ((size_t)l * 3 + 2) * MODW + (0 * 3 + 2) * DM, 0.5f, P_H + (size_t)TL * DM, lds, tid, lane, gw, NGW); }
                SEAM(pb + 3);
                if (IN(pb + 4)) { PHASE_PTRS();
                    pg8::Gemm g{P_XN, (const bf16*)(ws + WS_WIN + l * SZ_WIN), MR, ZN, DM, DM, DM}; pg8::StaticOrder S; S.init(MR, ZN, G, bid);
                    pg8::EpiZ E{P_Z, ZW, P_ZAB, ZW / 256, (bf16*)(ws + WS_GF), Z_GA / 256, (bf16*)P_YF, (bf16*)P_YF + (size_t)16 * 1024 * 1024, Z_NAK / 256, Z_NAQ / 256, P_VTL, Z_NAV / 256};
                    pg8::gemm_phase<pg8::EpiZ, pg8::StaticOrder, true, true>(lds, g, S, E, wave0);
                }
                SEAM(pb + 4);
                if (IN(pb + 5)) { PHASE_IDS(); PHASE_PTRS();
                    dn_prep3_phase(P_Z, P_ZAB, INP(11) + (size_t)l * 5 * 3072, INP(12) + l * 16, INP(13) + l * 16, P_ROPE, P_KB, P_QB, P_KT, P_VT2, P_GG, P_BETA, lane, gw, NGW);
                    gm_prep_phase(P_Z, INP(17) + (size_t)l * 1024, P_VN, lane, gw, NGW);
                    vt_phase(P_Z, P_VTL, P_VTC, lds, lane, wave, gw, NGW);
                }
                SEAM(pb + 5);
                if (IN(pb + 6)) { PHASE_IDS(); PHASE_PTRS();
                    dn_chunk_phase(P_KB, P_QB, P_KT, P_VT2, P_GG, P_BETA, P_WB, P_UB, P_QKM, P_EG, lds, lane, wave, gw, NGW);
                    { unsigned* aq = (unsigned*)(ws + WS_CTL) + CW_AQ + (l * 8 + (bid & 7)) * 32; volatile LAS unsigned* slot = (volatile LAS unsigned*)(lds + RING_BYTES);
                      int last_bh = -1;
                      for (;;) {
                          __syncthreads();
                          if (tid == 0) *slot = __hip_atomic_fetch_add(aq, 1u, __ATOMIC_RELAXED, __HIP_MEMORY_SCOPE_AGENT);
                          __syncthreads();
                          const unsigned j = *slot;
                          if (j >= 128u) break;
                          const int it = (int)(8u * j) + (bid & 7), ibh = attn_item_bh(it);
                          attn_wg(it, P_Z, P_VTL, (const bf16*)P_YF, (const bf16*)P_YF + (size_t)16 * 1024 * 1024, P_VTC, INP(18) + (size_t)l * 16 * 465, P_YCAT, !lastl, ibh != last_bh, lds, tid);
                          last_bh = ibh;
                      } }
                }
                SEAM(pb + 6);
                if (IN(pb + 7)) { PHASE_IDS(); PHASE_PTRS();
                    dn_scan_phase(P_QB, P_KT, P_WB, P_UB, P_QKM, P_EG, P_OF, P_OB, lds, tid, bid, G);
                    { unsigned* gq = (unsigned*)(ws + WS_CTL) + CW_AQ + (16 + l) * 32; volatile LAS unsigned* slot = (volatile LAS unsigned*)(lds + RING_BYTES); const unsigned nit = (lastl ? 64 : 68) * 8; int last_grp = -1;
                      for (;;) {
                          __syncthreads();
                          if (tid == 0) *slot = __hip_atomic_fetch_add(gq, 1u, __ATOMIC_RELAXED, __HIP_MEMORY_SCOPE_AGENT);
                          __syncthreads();
                          const unsigned it = *slot;
                          if (it >= nit) break;
                          gm_item2((int)(it >> 3), (int)(it & 7), P_Z, P_VN, INP(15) + (size_t)l * 8 * 16384, INP(16) + (size_t)l * 1024, P_YCAT, (int)(it & 7) != last_grp, lds, tid);
                          last_grp = (int)(it & 7);
                      } }
                }
                SEAM(pb + 7);
                if (IN(pb + 8)) { PHASE_IDS(); PHASE_PTRS(); dn_out_phase(P_OF, P_OB, P_Z, INP(14) + (size_t)l * 128, P_YCAT, lastl ? TL : MR, lane, gw, NGW); }
                SEAM(pb + 8);
                if (IN(pb + 9)) { PHASE_PTRS();
                    const bf16* pc = (const bf16*)(ws + WS_PC + l * SZ_SQ);
                    pg8::CombOrder S; S.init(TL, DM, G, bid, 0, !lastl, SUB_FIRST(bid)); pg8::Gemm g{P_YCAT, pc, lastl ? TL : MR, DM, DM, DM, DM};
                    pg8::EpiMergeHS E{{(const bf16*)(ws + WS_GF), P_YB}, {(float*)(ws + WS_SLAB)}};
                    pg8::gemm_phase<pg8::EpiMergeHS, pg8::CombOrder, true, true>(lds, g, S, E, wave0);
                }
                SEAM(pb + 9);
                if (IN(pb + 10)) { PHASE_IDS(); PHASE_PTRS(); if (!lastl) merge_ctx_phase((const float*)(ws + WS_SLAB), P_Z, P_YB, lane, gw, NGW); }
                if (!lastl) SEAM(pb + 10);
                if (IN(pb + 11)) { PHASE_PTRS();
                    pg8::Gemm g{P_YB, (const bf16*)(ws + WS_WO + l * SZ_SQ), lastl ? TL : MR, DM, DM, DM, DM};
                    pg8::CombOrder S; S.init(TL, DM, G, bid, 0, !lastl, SUB_FIRST(bid));
                    pg8::EpiResidSlab E{{P_H, P_H + (size_t)TL * DM, P_H, P_MOD + (size_t)l * 3 * MODW + (1 * 3 + 2) * DM, MODW, 1.0f}, {(float*)(ws + WS_SLAB)}};
                    pg8::gemm_phase<pg8::EpiResidSlab, pg8::CombOrder, true, true>(lds, g, S, E, wave0);
                }
                SEAM(pb + 11);
            }
        }
    }
#undef IN
#undef SEAM
}

extern "C" void kernel_launch(void* const* d_in, const int* in_sizes, int n_in, void* d_out, int out_size, void* d_ws, size_t ws_size, hipStream_t stream) {
    static int grid = 0;
    if (grid == 0) {
        if (n_in != 24 || out_size != TL * DM || ws_size < WS_END) { fprintf(stderr, "kernel_launch: unexpected shapes (n_in %d, out %d, ws %zu < %zu); nothing launched\n", n_in, out_size, ws_size, (size_t)WS_END); grid = -1; return; }
        int dev = 0, cus = 0, per_cu = 0;
        if (hipGetDevice(&dev) != hipSuccess || hipDeviceGetAttribute(&cus, hipDeviceAttributeMultiprocessorCount, dev) != hipSuccess) { grid = -1; return; }
        if (hipFuncSetAttribute((const void*)dit_fwd, hipFuncAttributeMaxDynamicSharedMemorySize, LDS_BYTES) != hipSuccess) { fprintf(stderr, "kernel_launch: hipFuncSetAttribute failed\n"); grid = -1; return; }
        if (hipOccupancyMaxActiveBlocksPerMultiprocessor(&per_cu, (const void*)dit_fwd, NTHR, LDS_BYTES) != hipSuccess || per_cu < 1) { fprintf(stderr, "kernel_launch: occupancy query reports %d\n", per_cu); }
        (void)hipGetLastError();
        grid = cus;
        if (grid % 16 != 0) { fprintf(stderr, "kernel_launch: %d CUs: the row-panel exchange of the last GEMM needs a multiple of 16 workgroups; nothing launched\n", grid); grid = -1; return; }
    }
    if (grid < 0) return;
    if (hipMemsetAsync((char*)d_ws + WS_CTL, 0, CTL_ZERO_BYTES, stream) != hipSuccess) return;
    Args a{};
    for (int i = 0; i < 24; ++i) a.in[i] = (const float*)d_in[i];
    a.out = (float*)d_out; a.ws = (unsigned char*)d_ws;
#if MK_ONE_LAUNCH
    a.ph_lo = 0; a.ph_hi = NPH;
    hipLaunchKernelGGL(dit_fwd, dim3(grid), dim3(NTHR), LDS_BYTES, stream, a);
#else
    for (int p = 0; p < NPH; ++p) { a.ph_lo = p; a.ph_hi = p + 1; hipLaunchKernelGGL(dit_fwd, dim3(grid), dim3(NTHR), LDS_BYTES, stream, a); }
#endif
}
```

```cpp
#include <hip/hip_runtime.h>
#include <cstdio>
#include <cstdint>

namespace pg8 {
#define PG8_LAS __attribute__((address_space(3)))
typedef unsigned short bf16_t;
typedef short bf16x8 __attribute__((ext_vector_type(8)));
typedef float f32x4 __attribute__((ext_vector_type(4)));
typedef unsigned u32x4 __attribute__((ext_vector_type(4)));
constexpr int BM = 256, BK = 64, HALF = 128, HTB = HALF * BK * 2  , STAGE_BYTES = 8 * HTB, NXCD = 8, WGM = 8;

__host__ __device__ __forceinline__ int lds_byte(int r, int c) { const int st = (r >> 4) * 2 + (c >> 5), rr = r & 15, cc = c & 31, ob = rr * 64 + cc * 2; return st * 1024 + (ob ^ (((ob >> 9) & 1) << 5)); }
__host__ __device__ __forceinline__ void stage_rc(int b, int& R, int& C) { const int st = b / 1024, sb = b % 1024, swz = sb ^ (((sb >> 9) & 1) << 5); R = (st >> 1) * 16 + swz / 64; C = (st & 1) * 32 + (swz % 64) / 2; }
__host__ __device__ __forceinline__ int perm32(int rho) { const int n = rho >> 4, i = rho & 15; return 8 * (i >> 2) + 4 * n + (i & 3); }

struct Unit { int pm, pn, kt0, nt, ks; };
struct Gemm { const bf16_t* A; const bf16_t* Bt; int M, N, K, lda, ldb; };

struct StaticOrder {
    int nM, nN, nwg, G, c;
    __host__ __device__ void init(int M, int N, int G_, int c_) { nM = M / BM; nN = N / BM; nwg = nM * nN; G = G_; c = c_; }
    __host__ __device__ bool next(int i, Unit& u) const {
        const long L = (long)i * G + c; if (L >= nwg) return false;
        int wgid = (int)L; { const int q = nwg / NXCD, r = nwg % NXCD, xcd = wgid % NXCD, off = wgid / NXCD; wgid = (xcd < r ? xcd * (q + 1) : r * (q + 1) + (xcd - r) * q) + off; }
        const int nig = WGM * nN, gid = wgid / nig, fm = gid * WGM, gsz = (nM - fm) < WGM ? (nM - fm) : WGM;
        u.pm = fm + ((wgid % nig) % gsz); u.pn = (wgid % nig) / gsz; u.kt0 = 0; u.nt = 0; u.ks = -1; return true;
    }
    __device__ __forceinline__ void a_ready(const Unit&) const {}
    __device__ __forceinline__ void done(const Unit&) const {}
};

struct SubOrder {
    int G, c, kmode;
    __device__ __forceinline__ bool next(int i, Unit& u) const {
        const int idx = i * G + c; if (idx >= 256) return false;
        const int tile = idx >> 3, ks = idx & 7; u.pm = 32 + (tile >> 4); u.pn = tile & 15; u.ks = ks;
        if (kmode == 0) { u.kt0 = 8 * ks; u.nt = 8; } else { u.kt0 = ks < 4 ? 12 * ks : 48 + 10 * (ks - 4); u.nt = ks < 4 ? 12 : 10; }
        return true;
    }
    __device__ __forceinline__ void a_ready(const Unit&) const {}
    __device__ __forceinline__ void done(const Unit&) const {}
};

struct CombOrder {
    StaticOrder main; SubOrder sub; int nfirst; bool sub_first;
    __device__ __forceinline__ void init(int M, int N, int G, int c, int kmode, bool has_sub, bool sf) {
        main.init(M, N, G, c); sub = SubOrder{G, c, kmode}; sub_first = sf;
        const int my_main = c < main.nwg ? (main.nwg - c + G - 1) / G : 0, my_sub = (has_sub && c < 256) ? (256 - c + G - 1) / G : 0;
        nfirst = sf ? my_sub : (has_sub ? my_main : (1 << 30));
    }
    __device__ __forceinline__ bool next(int i, Unit& u) const {
        const bool in_first = i < nfirst, use_sub = (sub_first == in_first);
        const int j = in_first ? i : i - nfirst, G = main.G, c = main.c;
        const int idx = j * G + c, idc = idx < 255 ? idx : 255, tile = idc >> 3, ks = idc & 7;
        const int kt0s = sub.kmode == 0 ? 8 * ks : (ks < 4 ? 12 * ks : 48 + 10 * (ks - 4)), nts = sub.kmode == 0 ? 8 : (ks < 4 ? 12 : 10);
        int wgid = idx < main.nwg - 1 ? idx : main.nwg - 1;
        { const int q = main.nwg / NXCD, r = main.nwg % NXCD, xcd = wgid % NXCD, off = wgid / NXCD; wgid = (xcd < r ? xcd * (q + 1) : r * (q + 1) + (xcd - r) * q) + off; }
        const int nig = WGM * main.nN, gid = wgid / nig, fm = gid * WGM, gsz = (main.nM - fm) < WGM ? (main.nM - fm) : WGM;
        const int pmm = fm + ((wgid % nig) % gsz), pnm = (wgid % nig) / gsz;
        u.pm = use_sub ? 32 + (tile >> 4) : pmm; u.pn = use_sub ? (tile & 15) : pnm; u.kt0 = use_sub ? kt0s : 0; u.nt = use_sub ? nts : 0; u.ks = use_sub ? ks : -1;
        return use_sub ? idx < 256 : idx < main.nwg;
    }
    __device__ __forceinline__ void a_ready(const Unit&) const {}
    __device__ __forceinline__ void done(const Unit&) const {}
};

struct SplitOrder {
    int nM, nN, nwg, G, c, nfull, hk; bool split;
    __device__ __forceinline__ void init(int M, int N, int K, int G_, int c_, bool want) { nM = M / BM; nN = N / BM; nwg = nM * nN; G = G_; c = c_; nfull = nwg / G; hk = K / BK / 2;
        split = want && (nwg - nfull * G) * 2 == G && (hk & 1) == 0; }
    __device__ __forceinline__ bool next(int i, Unit& u) const {
        const bool half = split && i >= nfull;
        const int L = half ? nfull * G + (c >> 1) : i * G + c;
        int wgid = L < nwg - 1 ? L : nwg - 1;
        { const int q = nwg / NXCD, r = nwg % NXCD, xcd = wgid % NXCD, off = wgid / NXCD; wgid = (xcd < r ? xcd * (q + 1) : r * (q + 1) + (xcd - r) * q) + off; }
        const int nig = WGM * nN, gid = wgid / nig, fm = gid * WGM, gsz = (nM - fm) < WGM ? (nM - fm) : WGM;
        u.pm = fm + ((wgid % nig) % gsz); u.pn = (wgid % nig) / gsz; u.kt0 = half ? (c & 1) * hk : 0; u.nt = half ? hk : 0; u.ks = half ? c : -1;
        return half ? i == nfull : L < nwg;
    }
    __device__ __forceinline__ void a_ready(const Unit&) const {}
    __device__ __forceinline__ void done(const Unit&) const {}
};

struct PanelOrder {
    int G, c;
    __device__ __forceinline__ bool next(int i, Unit& u) const {
        const int x = c & 7, j = c >> 3, xa = G == 256;
        const int pl = xa ? 4 * (x >> 1) + (j & 3) : (c >> 4), pn = xa ? 8 * (x & 1) + (j >> 2) : (c & 15), ppr = G >> 4;
        u.pm = i * ppr + pl; u.pn = pn; u.kt0 = 0; u.nt = 0; u.ks = -1;
        return u.pm < 32;
    }
    __device__ __forceinline__ void a_ready(const Unit&) const {}
    __device__ __forceinline__ void done(const Unit&) const {}
};

typedef __bf16 pg8_bf16x2 __attribute__((ext_vector_type(2)));
__device__ __forceinline__ unsigned cvt_pk_bf16(float lo, float hi) { pg8_bf16x2 v = {(__bf16)lo, (__bf16)hi}; return __builtin_bit_cast(unsigned, v); }

__device__ __forceinline__ float bf_lo(unsigned u) { return __builtin_bit_cast(float, u << 16); }
__device__ __forceinline__ float bf_hi(unsigned u) { return __builtin_bit_cast(float, u & 0xffff0000u); }
__device__ __forceinline__ float fast_sigmoid(float x) { return __builtin_amdgcn_rcpf(1.0f + __expf(-x)); }
__device__ __forceinline__ float fast_silu(float x) { return x * fast_sigmoid(x); }
__device__ __forceinline__ int rm_src(int lane) { return (((lane >> 2) + 16 * (lane & 3)) << 2); }
__device__ __forceinline__ int mf_src(int lane) { return ((4 * (lane & 15) + (lane >> 4)) << 2); }
typedef int pg8_i32x4 __attribute__((ext_vector_type(4)));
__device__ __forceinline__ pg8_i32x4 lperm_i(const pg8_i32x4 v, int a) { pg8_i32x4 r;
    r.x = __builtin_amdgcn_ds_bpermute(a, v.x); r.y = __builtin_amdgcn_ds_bpermute(a, v.y); r.z = __builtin_amdgcn_ds_bpermute(a, v.z); r.w = __builtin_amdgcn_ds_bpermute(a, v.w); return r; }
__device__ __forceinline__ f32x4 lperm(const f32x4 v, int a) { return __builtin_bit_cast(f32x4, lperm_i(__builtin_bit_cast(pg8_i32x4, v), a)); }
__device__ __forceinline__ u32x4 lperm(const u32x4 v, int a) { return __builtin_bit_cast(u32x4, lperm_i(__builtin_bit_cast(pg8_i32x4, v), a)); }

struct EpiSwiGLU {
    static constexpr bool PERM = true, AFTER_DRAIN = false, MIDK = false;
    bf16_t* H; int ldh;
    __device__ __forceinline__ void operator()(const f32x4 (&acc)[2][2][4][2], const Unit& u, int wr, int wc, int fr, int fq) const {
        const int row0 = u.pm * BM + wr * 64 + fr, col0 = u.pn * HALF + wc * 32 + 8 * fq;
#pragma unroll
        for (int ai = 0; ai < 2; ++ai)
#pragma unroll
            for (int m = 0; m < 4; ++m) { bf16_t* rowp = H + (size_t)(row0 + ai * HALF + m * 16) * ldh + col0;
                const f32x4 a0 = acc[ai][0][m][0], a1 = acc[ai][0][m][1], b0 = acc[ai][1][m][0], b1 = acc[ai][1][m][1];
                u32x4 w; w.x = cvt_pk_bf16(fast_silu(a0[0]) * b0[0], fast_silu(a0[1]) * b0[1]); w.y = cvt_pk_bf16(fast_silu(a0[2]) * b0[2], fast_silu(a0[3]) * b0[3]);
                w.z = cvt_pk_bf16(fast_silu(a1[0]) * b1[0], fast_silu(a1[1]) * b1[1]); w.w = cvt_pk_bf16(fast_silu(a1[2]) * b1[2], fast_silu(a1[3]) * b1[3]);
                *(u32x4*)rowp = w; }
    }
};
struct EpiSwiGLUS {
    static constexpr bool PERM = true, AFTER_DRAIN = false, MIDK = false;
    EpiSwiGLU e; unsigned slab_off, flag_off;
    __device__ __forceinline__ void operator()(const f32x4 (&acc)[2][2][4][2], const Unit& u, int wr, int wc, int fr, int fq) const {
        if (u.ks < 0) { e(acc, u, wr, wc, fr, fq); return; }
        int lane = fr + 16 * fq; asm volatile("" : "+v"(lane));
        const int pair = u.ks >> 1, wid = wr * 4 + wc;
        const __attribute__((address_space(4))) char* kp = (const __attribute__((address_space(4))) char*)__builtin_amdgcn_kernarg_segment_ptr(); asm volatile("" : "+s"(kp));
        char* const wsb = *(char* const __attribute__((address_space(4)))*)(kp + 200);
        float* const slab = (float*)(wsb + slab_off); unsigned* const flags = (unsigned*)(wsb + flag_off);
        const unsigned off0 = (unsigned)(((pair * 8 + wid) * 32) * 64 + lane) * 16u;
        if ((u.ks & 1) == 0) {
            const __amdgpu_buffer_rsrc_t rs = __builtin_amdgcn_make_buffer_rsrc(slab, 0, 128 * 8 * 32 * 64 * 16, 0x00020000);
#pragma unroll
            for (int ai = 0; ai < 2; ++ai)
#pragma unroll
                for (int bj = 0; bj < 2; ++bj)
#pragma unroll
                    for (int m = 0; m < 4; ++m)
#pragma unroll
                        for (int n = 0; n < 2; ++n) __builtin_amdgcn_raw_buffer_store_b128(__builtin_bit_cast(u32x4, acc[ai][bj][m][n]), rs, off0 + (unsigned)((((ai * 2 + bj) * 4 + m) * 2 + n) * 1024), 0, 16);
            asm volatile("s_waitcnt vmcnt(0)" ::: "memory"); __builtin_amdgcn_s_barrier();
            if (wid == 0 && lane == 0) __hip_atomic_store(flags + pair * 32, 1u, __ATOMIC_RELAXED, __HIP_MEMORY_SCOPE_AGENT);
            return;
        }
        if (wid == 0 && lane == 0) { unsigned sp = 0u; while (__hip_atomic_load(flags + pair * 32, __ATOMIC_RELAXED, __HIP_MEMORY_SCOPE_AGENT) == 0u && ++sp < (1u << 21)) __builtin_amdgcn_s_sleep(1);
            __builtin_amdgcn_fence(__ATOMIC_ACQUIRE, "agent"); asm volatile("s_waitcnt vmcnt(0)" ::: "memory"); }
        __builtin_amdgcn_s_barrier();
        const char* sp_ = (const char*)slab + off0;
        const int row0 = u.pm * BM + wr * 64 + (lane & 15), col0 = u.pn * HALF + wc * 32 + 8 * (lane >> 4);
#pragma unroll
        for (int ai = 0; ai < 2; ++ai)
#pragma unroll
            for (int m = 0; m < 4; ++m) {
                const f32x4 a0 = acc[ai][0][m][0] + *(const f32x4*)(sp_ + (((ai * 2 + 0) * 4 + m) * 2 + 0) * 1024), a1 = acc[ai][0][m][1] + *(const f32x4*)(sp_ + (((ai * 2 + 0) * 4 + m) * 2 + 1) * 1024);
                const f32x4 b0 = acc[ai][1][m][0] + *(const f32x4*)(sp_ + (((ai * 2 + 1) * 4 + m) * 2 + 0) * 1024), b1 = acc[ai][1][m][1] + *(const f32x4*)(sp_ + (((ai * 2 + 1) * 4 + m) * 2 + 1) * 1024);
                u32x4 w; w.x = cvt_pk_bf16(fast_silu(a0[0]) * b0[0], fast_silu(a0[1]) * b0[1]); w.y = cvt_pk_bf16(fast_silu(a0[2]) * b0[2], fast_silu(a0[3]) * b0[3]);
                w.z = cvt_pk_bf16(fast_silu(a1[0]) * b1[0], fast_silu(a1[1]) * b1[1]); w.w = cvt_pk_bf16(fast_silu(a1[2]) * b1[2], fast_silu(a1[3]) * b1[3]);
                *(u32x4*)(e.H + (size_t)(row0 + ai * HALF + m * 16) * e.ldh + col0) = w;
                asm volatile("" ::: "memory"); }
    }
};
struct EpiResid {
    static constexpr bool PERM = false, AFTER_DRAIN = false, MIDK = false;
    const float* in_lat; const float* in_ctx; float* out; const float* gate; int gate_vstride; float coef;
    __device__ __forceinline__ void operator()(const f32x4 (&acc)[2][2][4][2], const Unit& u, int wr, int wc, int fr, int fq) const {
        const int v = u.pm < 16 ? 0 : (u.pm < 32 ? 1 : 2);
        const float* gp = gate + (size_t)v * gate_vstride;
        const int lane = fr + 16 * fq, nsel = (lane >> 2) & 1;
        const int pa0 = (((lane >> 3) + 16 * (lane & 3)) << 2), pa1 = pa0 + 32;
        const int row0 = u.pm * BM + wr * 64 + (lane >> 3), col0 = u.pn * BM + wc * 32 + 4 * (lane & 7);
        const float* inb = u.pm < 32 ? in_lat + (size_t)row0 * 4096 : in_ctx + (size_t)(row0 - 8192) * 4096;
        float* outb = out + (size_t)row0 * 4096;
        f32x4 gv[2];
#pragma unroll
        for (int bj = 0; bj < 2; ++bj) gv[bj] = *(const f32x4*)(gp + col0 + bj * HALF) * coef;
        f32x4 xa[2][2], xb[2][2];
#define PG8_RLD(dst, g) do { const size_t ro_ = (size_t)(((g) >> 2) * HALF + ((g) & 3) * 16) * 4096 + col0; _Pragma("unroll") for (int bj = 0; bj < 2; ++bj) _Pragma("unroll") for (int h = 0; h < 2; ++h) \
            dst[bj][h] = *(const f32x4*)(inb + ro_ + (size_t)(8 * h) * 4096 + bj * HALF); } while (0)
#define PG8_RST(src, g) do { const size_t ro_ = (size_t)(((g) >> 2) * HALF + ((g) & 3) * 16) * 4096 + col0; _Pragma("unroll") for (int bj = 0; bj < 2; ++bj) _Pragma("unroll") for (int h = 0; h < 2; ++h) { \
            const f32x4 t0_ = lperm(acc[(g) >> 2][bj][(g) & 3][0], h ? pa1 : pa0), t1_ = lperm(acc[(g) >> 2][bj][(g) & 3][1], h ? pa1 : pa0); \
            *(f32x4*)(outb + ro_ + (size_t)(8 * h) * 4096 + bj * HALF) = src[bj][h] + gv[bj] * (nsel ? t1_ : t0_); } } while (0)
        PG8_RLD(xa, 0);
#pragma unroll
        for (int g = 0; g < 8; g += 2) {
            PG8_RLD(xb, g + 1);
            PG8_RST(xa, g);
            if (g + 2 < 8) PG8_RLD(xa, g + 2);
            PG8_RST(xb, g + 1);
        }
#undef PG8_RLD
#undef PG8_RST
    }
};
struct EpiFinal {
    static constexpr bool PERM = false, AFTER_DRAIN = false, MIDK = false;
    const float* in; float* outp; const float* gate; int gate_vstride; float coef; const float* fw; float* stats  ; unsigned* cnt  ; PG8_LAS float* red  ;
    __device__ __forceinline__ void operator()(f32x4 (&acc)[2][2][4][2], const Unit& u, int wr, int wc, int fr, int fq) const {
        const int v = u.pm < 16 ? 0 : 1;
        const float* gp = gate + (size_t)v * gate_vstride;
        int lane = fr + 16 * fq; asm volatile("" : "+v"(lane));
        const int nsel = (lane >> 2) & 1;
        const int pa0 = (((lane >> 3) + 16 * (lane & 3)) << 2), pa1 = pa0 + 32;
        const int rl = wr * 64 + (lane >> 3);
        const int row0 = u.pm * BM + rl, col0 = u.pn * BM + wc * 32 + 4 * (lane & 7);
        const float* inb = in + (size_t)row0 * 4096;
#pragma unroll
        for (int g = 0; g < 8; ++g) {
            const size_t ro = (size_t)((g >> 2) * HALF + (g & 3) * 16) * 4096 + col0;
            float s0 = 0.f, s1 = 0.f;
#pragma unroll
            for (int bj = 0; bj < 2; ++bj) { f32x4& c0 = acc[g >> 2][bj][g & 3][0]; f32x4& c1 = acc[g >> 2][bj][g & 3][1];
                const f32x4 gvv = *(const f32x4*)(gp + col0 + bj * HALF) * coef;
                const f32x4 x0 = *(const f32x4*)(inb + ro + bj * HALF), x1 = *(const f32x4*)(inb + ro + (size_t)8 * 4096 + bj * HALF);
                const f32x4 t00 = lperm(c0, pa0), t10 = lperm(c1, pa0); const f32x4 h0 = x0 + gvv * (nsel ? t10 : t00);
                const f32x4 t01 = lperm(c0, pa1), t11 = lperm(c1, pa1); const f32x4 h1 = x1 + gvv * (nsel ? t11 : t01);
                c0 = h0; c1 = h1; asm volatile("" : "+v"(c0), "+v"(c1));
                s0 += (h0[0] * h0[0] + h0[1] * h0[1]) + (h0[2] * h0[2] + h0[3] * h0[3]); s1 += (h1[0] * h1[0] + h1[1] * h1[1]) + (h1[2] * h1[2] + h1[3] * h1[3]); }
            s0 += __shfl_xor(s0, 1); s0 += __shfl_xor(s0, 2); s0 += __shfl_xor(s0, 4); s1 += __shfl_xor(s1, 1); s1 += __shfl_xor(s1, 2); s1 += __shfl_xor(s1, 4);
            if ((lane & 7) == 0) { const int tr = (g >> 2) * HALF + (g & 3) * 16 + rl; red[tr * 4 + wc] = s0; red[(tr + 8) * 4 + wc] = s1; }
            asm volatile("" ::: "memory");
        }
        asm volatile("s_waitcnt lgkmcnt(0)" ::: "memory"); __builtin_amdgcn_s_barrier();
        if (wr == 0) { const int r = wc * 64 + lane; const float s = (red[r * 4] + red[r * 4 + 1]) + (red[r * 4 + 2] + red[r * 4 + 3]);
            __hip_atomic_store(stats + ((size_t)u.pm * BM + r) * 16 + u.pn, s, __ATOMIC_RELAXED, __HIP_MEMORY_SCOPE_AGENT); }
        asm volatile("s_waitcnt vmcnt(0) lgkmcnt(0)" ::: "memory"); __builtin_amdgcn_s_barrier();
        if (wr == 0 && wc == 0 && lane == 0) { unsigned* cp = cnt + u.pm * 32;
            (void)__hip_atomic_fetch_add(cp, 1u, __ATOMIC_RELAXED, __HIP_MEMORY_SCOPE_AGENT);
            unsigned sp = 0u; while (__hip_atomic_load(cp, __ATOMIC_RELAXED, __HIP_MEMORY_SCOPE_AGENT) < 16u && ++sp < (1u << 21)) __builtin_amdgcn_s_sleep(1);
            __builtin_amdgcn_fence(__ATOMIC_ACQUIRE, "agent"); asm volatile("s_waitcnt vmcnt(0)" ::: "memory"); }
        __builtin_amdgcn_s_barrier();
        if (wr == 0) { const int r = wc * 64 + lane; const float* sp_ = stats + ((size_t)u.pm * BM + r) * 16; float s = 0.f;
#pragma unroll
            for (int t = 0; t < 16; ++t) s += __hip_atomic_load(sp_ + t, __ATOMIC_RELAXED, __HIP_MEMORY_SCOPE_AGENT);
            red[1024 + r] = 1.0f / sqrtf(s * (1.0f / 4096.0f) + 1e-6f); }
        asm volatile("s_waitcnt vmcnt(0) lgkmcnt(0)" ::: "memory"); __builtin_amdgcn_s_barrier();
        float* outb = outp + (size_t)row0 * 4096;
#pragma unroll
        for (int g = 0; g < 8; ++g) {
#pragma unroll
            for (int bj = 0; bj < 2; ++bj) { const f32x4 fwv = *(const f32x4*)(fw + col0 + bj * HALF);
#pragma unroll
                for (int h = 0; h < 2; ++h) { const float rs = red[1024 + (g >> 2) * HALF + (g & 3) * 16 + 8 * h + rl];
                    *(f32x4*)(outb + (size_t)((g >> 2) * HALF + (g & 3) * 16 + 8 * h) * 4096 + col0 + bj * HALF) = acc[g >> 2][bj][g & 3][h] * rs * fwv; } }
            asm volatile("" ::: "memory"); }
        asm volatile("s_waitcnt lgkmcnt(0)" ::: "memory"); __builtin_amdgcn_s_barrier();
    }
};
struct EpiZ {
    static constexpr bool PERM = true, AFTER_DRAIN = false, MIDK = false;
    bf16_t* Z; int ldz; float* ZAB; int nmain; bf16_t* GF; int ga0; bf16_t* KF; bf16_t* QF; int nk0, nq0; bf16_t* VF; int nv0;
    __device__ __forceinline__ void operator()(const f32x4 (&acc)[2][2][4][2], const Unit& u, int wr, int wc, int fr, int fq) const {
        const int row0 = u.pm * BM + wr * 64 + fr;
        if (u.pn >= ga0 && u.pn < nmain && u.pm < 32) {
            bf16_t* gp = GF + ((((size_t)u.pm * 48 + (u.pn - ga0)) * 8 + (wr * 4 + wc)) * 16 * 64 + (fr + 16 * fq)) * 8;
#pragma unroll
            for (int ai = 0; ai < 2; ++ai)
#pragma unroll
                for (int m = 0; m < 4; ++m)
#pragma unroll
                    for (int bj = 0; bj < 2; ++bj) { f32x4 v0 = acc[ai][bj][m][0], v1 = acc[ai][bj][m][1];
#pragma unroll
                        for (int i = 0; i < 4; ++i) { v0[i] = __expf(-fminf(fmaxf(v0[i], -30.f), 30.f)); v1[i] = __expf(-fminf(fmaxf(v1[i], -30.f), 30.f)); }
                        u32x4 w; w.x = cvt_pk_bf16(v0[0], v0[1]); w.y = cvt_pk_bf16(v0[2], v0[3]); w.z = cvt_pk_bf16(v1[0], v1[1]); w.w = cvt_pk_bf16(v1[2], v1[3]);
                        *(u32x4*)(gp + ((ai * 4 + m) * 2 + bj) * 512) = w; }
        } else if (u.pm < 32 && (unsigned)(u.pn - nk0) < 8u) {
            const int b = u.pm >> 4, t0 = (u.pm & 15) * BM + wr * 64 + fr;
#pragma unroll
            for (int ai = 0; ai < 2; ++ai)
#pragma unroll
                for (int m = 0; m < 4; ++m)
#pragma unroll
                    for (int bj = 0; bj < 2; ++bj) { const f32x4 v0 = acc[ai][bj][m][0], v1 = acc[ai][bj][m][1]; const int t = t0 + ai * HALF + m * 16;
                        u32x4 w; w.x = cvt_pk_bf16(v0[0], v0[1]); w.y = cvt_pk_bf16(v0[2], v0[3]); w.z = cvt_pk_bf16(v1[0], v1[1]); w.w = cvt_pk_bf16(v1[2], v1[3]);
                        *(u32x4*)(KF + (((size_t)(b * 16 + 2 * (u.pn - nk0) + bj) * 1024 + (t >> 2)) * 512) + wc * 128 + fq * 32 + (t & 3) * 8) = w; }
        } else if (u.pm < 32 && (unsigned)(u.pn - nv0) < 8u) {
            const int b = u.pm >> 4, t0 = (u.pm & 15) * BM + wr * 64 + (fr & 8);
            const bool lo4 = (fr & 4) == 0, lo2 = (fr & 2) == 0, lo1 = (fr & 1) == 0;
#pragma unroll
            for (int ai = 0; ai < 2; ++ai)
#pragma unroll
                for (int m = 0; m < 4; ++m)
#pragma unroll
                    for (int bj = 0; bj < 2; ++bj) { const f32x4 v0 = acc[ai][bj][m][0], v1 = acc[ai][bj][m][1];
                        unsigned w0 = cvt_pk_bf16(v0[0], v0[1]), w1 = cvt_pk_bf16(v0[2], v0[3]), w2 = cvt_pk_bf16(v1[0], v1[1]), w3 = cvt_pk_bf16(v1[2], v1[3]);
                        { const unsigned r0 = (unsigned)__shfl_xor((int)(lo4 ? w2 : w0), 4), r1 = (unsigned)__shfl_xor((int)(lo4 ? w3 : w1), 4); w2 = lo4 ? r0 : w2; w3 = lo4 ? r1 : w3; w0 = lo4 ? w0 : r0; w1 = lo4 ? w1 : r1; }
                        { const unsigned r0 = (unsigned)__shfl_xor((int)(lo2 ? w1 : w0), 2), r1 = (unsigned)__shfl_xor((int)(lo2 ? w3 : w2), 2); w1 = lo2 ? r0 : w1; w3 = lo2 ? r1 : w3; w0 = lo2 ? w0 : r0; w2 = lo2 ? w2 : r1; }
                        { const unsigned p0 = (unsigned)__shfl_xor((int)w0, 1), p1 = (unsigned)__shfl_xor((int)w1, 1), p2 = (unsigned)__shfl_xor((int)w2, 1), p3 = (unsigned)__shfl_xor((int)w3, 1);
                          w0 = lo1 ? (w0 & 0xffffu) | (p0 << 16) : (p0 >> 16) | (w0 & 0xffff0000u); w1 = lo1 ? (w1 & 0xffffu) | (p1 << 16) : (p1 >> 16) | (w1 & 0xffff0000u);
                          w2 = lo1 ? (w2 & 0xffffu) | (p2 << 16) : (p2 >> 16) | (w2 & 0xffff0000u); w3 = lo1 ? (w3 & 0xffffu) | (p3 << 16) : (p3 >> 16) | (w3 & 0xffff0000u); }
                        u32x4 w; w.x = w0; w.y = w1; w.z = w2; w.w = w3;
                        *(u32x4*)(VF + ((((size_t)(b * 16 + 2 * (u.pn - nv0) + bj) * 512 + ((t0 + ai * HALF + m * 16) >> 3)) * 128) + wc * 32 + fq * 8 + (fr & 7)) * 8) = w; }
        } else if (u.pm < 32 && (unsigned)(u.pn - nq0) < 8u) {
            const int b = u.pm >> 4, rg0 = (u.pm & 15) * 16 + wr * 4;
#pragma unroll
            for (int ai = 0; ai < 2; ++ai)
#pragma unroll
                for (int m = 0; m < 4; ++m)
#pragma unroll
                    for (int bj = 0; bj < 2; ++bj) { const f32x4 v0 = acc[ai][bj][m][0], v1 = acc[ai][bj][m][1];
                        u32x4 w; w.x = cvt_pk_bf16(v0[0], v0[1]); w.y = cvt_pk_bf16(v0[2], v0[3]); w.z = cvt_pk_bf16(v1[0], v1[1]); w.w = cvt_pk_bf16(v1[2], v1[3]);
                        *(u32x4*)(QF + ((((size_t)(b * 16 + 2 * (u.pn - nq0) + bj) * 256 + rg0 + ai * 8 + m) * 4 + wc) * 64 + (fr + 16 * fq)) * 8) = w; }
        } else if (u.pn < nmain) {
            const int col0 = u.pn * BM + wc * 32 + 8 * fq;
#pragma unroll
            for (int ai = 0; ai < 2; ++ai)
#pragma unroll
                for (int m = 0; m < 4; ++m) { bf16_t* rowp = Z + (size_t)(row0 + ai * HALF + m * 16) * ldz + col0;
#pragma unroll
                    for (int bj = 0; bj < 2; ++bj) { const f32x4 v0 = acc[ai][bj][m][0], v1 = acc[ai][bj][m][1];
                        u32x4 w; w.x = cvt_pk_bf16(v0[0], v0[1]); w.y = cvt_pk_bf16(v0[2], v0[3]); w.z = cvt_pk_bf16(v1[0], v1[1]); w.w = cvt_pk_bf16(v1[2], v1[3]);
                        *(u32x4*)(rowp + bj * HALF) = w; } }
        } else if (wc == 0) {
#pragma unroll
            for (int ai = 0; ai < 2; ++ai)
#pragma unroll
                for (int m = 0; m < 4; ++m) { float* rowp = ZAB + (size_t)(row0 + ai * HALF + m * 16) * 32 + 8 * fq;
                    *(f32x4*)(rowp) = acc[ai][0][m][0]; *(f32x4*)(rowp + 4) = acc[ai][0][m][1]; }
        }
    }
};
template <int S> struct EpiMerge {
    static constexpr bool PERM = true, AFTER_DRAIN = false, MIDK = false;
    const bf16_t* Z; int ldz; int gcol; float* YF; bf16_t* YB;
    __device__ __forceinline__ void operator()(const f32x4 (&acc)[2][2][4][2], const Unit& u, int wr, int wc, int fr, int fq) const {
        const int row0 = u.pm * BM + wr * 64 + fr, col0 = u.pn * BM + wc * 32 + 8 * fq;
#pragma unroll
        for (int ai = 0; ai < 2; ++ai)
#pragma unroll
            for (int m = 0; m < 4; ++m) { const size_t row = (size_t)(row0 + ai * HALF + m * 16);
#pragma unroll
                for (int bj = 0; bj < 2; ++bj) { const int c = col0 + bj * HALF;
                    const u32x4 g = *(const u32x4*)(Z + row * ldz + gcol + c);
                    f32x4 t0 = acc[ai][bj][m][0], t1 = acc[ai][bj][m][1];
                    t0[0] *= fast_sigmoid(bf_lo(g.x)); t0[1] *= fast_sigmoid(bf_hi(g.x)); t0[2] *= fast_sigmoid(bf_lo(g.y)); t0[3] *= fast_sigmoid(bf_hi(g.y));
                    t1[0] *= fast_sigmoid(bf_lo(g.z)); t1[1] *= fast_sigmoid(bf_hi(g.z)); t1[2] *= fast_sigmoid(bf_lo(g.w)); t1[3] *= fast_sigmoid(bf_hi(g.w));
                    float* yf = YF + row * 4096 + c;
                    if (S == 0) { *(f32x4*)yf = t0; *(f32x4*)(yf + 4) = t1; }
                    else { t0 += *(const f32x4*)yf; t1 += *(const f32x4*)(yf + 4);
                        if (S == 1) { *(f32x4*)yf = t0; *(f32x4*)(yf + 4) = t1; }
                        else { u32x4 w; w.x = cvt_pk_bf16(t0[0], t0[1]); w.y = cvt_pk_bf16(t0[2], t0[3]); w.z = cvt_pk_bf16(t1[0], t1[1]); w.w = cvt_pk_bf16(t1[2], t1[3]);
                            *(u32x4*)(YB + row * 4096 + c) = w; } } }
                asm volatile("" ::: "memory"); }
    }
};

struct EpiSlab {
    static constexpr bool PERM = false, AFTER_DRAIN = false, MIDK = false;
    float* slab;
    __device__ __forceinline__ void operator()(const f32x4 (&acc)[2][2][4][2], const Unit& u, int wr, int wc, int fr, int fq) const {
        const int row0 = u.pm * BM + wr * 64 + fr - 8192, col0 = u.pn * BM + wc * 32 + 4 * fq;
        float* outb = slab + ((size_t)u.ks * 512 + row0) * 4096 + col0;
#pragma unroll
        for (int ai = 0; ai < 2; ++ai)
#pragma unroll
            for (int m = 0; m < 4; ++m)
#pragma unroll
                for (int bj = 0; bj < 2; ++bj)
#pragma unroll
                    for (int n = 0; n < 2; ++n) *(f32x4*)(outb + (size_t)(ai * HALF + m * 16) * 4096 + bj * HALF + n * 16) = acc[ai][bj][m][n];
    }
};

struct EpiSlabP {
    static constexpr bool PERM = true, AFTER_DRAIN = false, MIDK = false;
    float* slab;
    __device__ __forceinline__ void operator()(const f32x4 (&acc)[2][2][4][2], const Unit& u, int wr, int wc, int fr, int fq) const {
        const int row0 = u.pm * BM + wr * 64 + fr - 8192, col0 = u.pn * BM + wc * 32 + 8 * fq;
        float* outb = slab + ((size_t)u.ks * 512 + row0) * 4096 + col0;
#pragma unroll
        for (int ai = 0; ai < 2; ++ai)
#pragma unroll
            for (int m = 0; m < 4; ++m)
#pragma unroll
                for (int bj = 0; bj < 2; ++bj) { float* o = outb + (size_t)(ai * HALF + m * 16) * 4096 + bj * HALF; *(f32x4*)o = acc[ai][bj][m][0]; *(f32x4*)(o + 4) = acc[ai][bj][m][1]; }
    }
};
struct EpiResidSlab {
    static constexpr bool PERM = false, AFTER_DRAIN = false, MIDK = false;
    EpiResid r; EpiSlab s;
    __device__ __forceinline__ void operator()(const f32x4 (&acc)[2][2][4][2], const Unit& u, int wr, int wc, int fr, int fq) const { if (u.ks >= 0) s(acc, u, wr, wc, fr, fq); else r(acc, u, wr, wc, fr, fq); }
};
struct EpiMergeH {
    static constexpr bool PERM = true, AFTER_DRAIN = false, MIDK = true;
    static constexpr int T1 = 16, T2 = 32;
    const bf16_t* GF; bf16_t* YB;
    __device__ __forceinline__ void midk(f32x4 (&acc)[2][2][4][2], const Unit& u, int which, int wr, int wc, int fr, int fq) const {
        int lane = fr + 16 * fq; asm volatile("" : "+v"(lane));
        const bf16_t* gn0 = GF + ((((size_t)u.pm * 48 + which * 16 + u.pn) * 8 + (wr * 4 + wc)) * 16 * 64 + lane) * 8;
#pragma unroll
        for (int ai = 0; ai < 2; ++ai)
#pragma unroll
            for (int mp = 0; mp < 4; mp += 2) {
                u32x4 gn[2][2], gd[2][2];
#pragma unroll
                for (int mm = 0; mm < 2; ++mm)
#pragma unroll
                    for (int bj = 0; bj < 2; ++bj) { const int o = ((ai * 4 + mp + mm) * 2 + bj) * 512;
                        gn[mm][bj] = *(const u32x4*)(gn0 + o); gd[mm][bj] = *(const u32x4*)(gn0 + (size_t)16 * 8 * 16 * 64 * 8 + o); }
#pragma unroll
                for (int mm = 0; mm < 2; ++mm)
#pragma unroll
                    for (int bj = 0; bj < 2; ++bj) { const u32x4 a = gn[mm][bj], b = gd[mm][bj]; f32x4& t0 = acc[ai][bj][mp + mm][0]; f32x4& t1 = acc[ai][bj][mp + mm][1];
                        t0[0] *= (1.f + (bf_lo(b.x))) * __builtin_amdgcn_rcpf(1.f + (bf_lo(a.x))); t0[1] *= (1.f + (bf_hi(b.x))) * __builtin_amdgcn_rcpf(1.f + (bf_hi(a.x)));
                        t0[2] *= (1.f + (bf_lo(b.y))) * __builtin_amdgcn_rcpf(1.f + (bf_lo(a.y))); t0[3] *= (1.f + (bf_hi(b.y))) * __builtin_amdgcn_rcpf(1.f + (bf_hi(a.y)));
                        t1[0] *= (1.f + (bf_lo(b.z))) * __builtin_amdgcn_rcpf(1.f + (bf_lo(a.z))); t1[1] *= (1.f + (bf_hi(b.z))) * __builtin_amdgcn_rcpf(1.f + (bf_hi(a.z)));
                        t1[2] *= (1.f + (bf_lo(b.w))) * __builtin_amdgcn_rcpf(1.f + (bf_lo(a.w))); t1[3] *= (1.f + (bf_hi(b.w))) * __builtin_amdgcn_rcpf(1.f + (bf_hi(a.w))); }
                asm volatile("" ::: "memory");
            }
    }
    __device__ __forceinline__ void operator()(const f32x4 (&acc)[2][2][4][2], const Unit& u, int wr, int wc, int fr, int fq) const {
        const int row0 = u.pm * BM + wr * 64 + fr, col0 = u.pn * BM + wc * 32 + 8 * fq;
        const bf16_t* gc0 = GF + ((((size_t)u.pm * 48 + 32 + u.pn) * 8 + (wr * 4 + wc)) * 16 * 64 + (fr + 16 * fq)) * 8;
#pragma unroll
        for (int ai = 0; ai < 2; ++ai)
#pragma unroll
            for (int m = 0; m < 4; ++m) { const size_t row = (size_t)(row0 + ai * HALF + m * 16);
#pragma unroll
                for (int bj = 0; bj < 2; ++bj) { const int c = col0 + bj * HALF;
                    const u32x4 g = *(const u32x4*)(gc0 + ((ai * 4 + m) * 2 + bj) * 512);
                    f32x4 t0 = acc[ai][bj][m][0], t1 = acc[ai][bj][m][1];
                    t0[0] *= __builtin_amdgcn_rcpf(1.f + (bf_lo(g.x))); t0[1] *= __builtin_amdgcn_rcpf(1.f + (bf_hi(g.x))); t0[2] *= __builtin_amdgcn_rcpf(1.f + (bf_lo(g.y))); t0[3] *= __builtin_amdgcn_rcpf(1.f + (bf_hi(g.y)));
                    t1[0] *= __builtin_amdgcn_rcpf(1.f + (bf_lo(g.z))); t1[1] *= __builtin_amdgcn_rcpf(1.f + (bf_hi(g.z))); t1[2] *= __builtin_amdgcn_rcpf(1.f + (bf_lo(g.w))); t1[3] *= __builtin_amdgcn_rcpf(1.f + (bf_hi(g.w)));
                    u32x4 w; w.x = cvt_pk_bf16(t0[0], t0[1]); w.y = cvt_pk_bf16(t0[2], t0[3]); w.z = cvt_pk_bf16(t1[0], t1[1]); w.w = cvt_pk_bf16(t1[2], t1[3]);
                    *(u32x4*)(YB + row * 4096 + c) = w; }
                if (m & 1) asm volatile("" ::: "memory"); }
    }
};
struct EpiMergeHS {
    static constexpr bool PERM = true, AFTER_DRAIN = false, MIDK = true;
    static constexpr int T1 = EpiMergeH::T1, T2 = EpiMergeH::T2;
    EpiMergeH m; EpiSlabP s;
    __device__ __forceinline__ void midk(f32x4 (&acc)[2][2][4][2], const Unit& u, int which, int wr, int wc, int fr, int fq) const { if (u.ks < 0) m.midk(acc, u, which, wr, wc, fr, fq); }
    __device__ __forceinline__ void operator()(const f32x4 (&acc)[2][2][4][2], const Unit& u, int wr, int wc, int fr, int fq) const { if (u.ks >= 0) s(acc, u, wr, wc, fr, fq); else m(acc, u, wr, wc, fr, fq); }
};
template <class Epi, class Sched, bool ALIGN_EPI = false, bool SP2 = false>
__device__ __forceinline__ void gemm_phase(PG8_LAS unsigned char* lds, const Gemm g, const Sched& S, const Epi& E, int wave0) {
    int tid = wave0 * 64 + (int)__builtin_amdgcn_mbcnt_hi(~0u, __builtin_amdgcn_mbcnt_lo(~0u, 0u)); asm volatile("" : "+v"(tid));
    const int wid = __builtin_amdgcn_readfirstlane(tid >> 6), lane = tid & 63, wr = wid >> 2, wc = wid & 3, fr = lane & 15, fq = lane >> 4;
    const int ntdef = g.K / BK;
    unsigned voffA[2], voffB[2];
#pragma unroll
    for (int i = 0; i < 2; ++i) { int R, C; stage_rc(tid * 16 + i * 8192, R, C); const int Rb = Epi::PERM ? ((R & ~31) + perm32(R & 31)) : R;
        voffA[i] = (unsigned)(R * g.lda + C) * 2u; voffB[i] = (unsigned)(Rb * g.ldb + C) * 2u; }
    const size_t kstep = (size_t)(BK * 2);
    const size_t hstepA = (size_t)HALF * g.lda * 2, hstepB = (size_t)HALF * g.ldb * 2;
    const size_t tstepA = 2 * hstepA, tstepB = 2 * hstepB;
    const unsigned ldsw = (unsigned)wid * 1024u;
    const int aoff = lds_byte(wr * 64 + fr, fq * 8), boff = lds_byte(wc * 32 + fr, fq * 8);
#define PG8_SA(b, h) (((b) * 2 + (h)) * HTB)
#define PG8_SB(b, h) ((4 + (b) * 2 + (h)) * HTB)
#define PG8_STAGE(bufoff, gbase, voff) do { _Pragma("unroll") for (int _i = 0; _i < 2; ++_i) \
        __builtin_amdgcn_global_load_lds((const unsigned*)((const char*)(gbase) + (voff)[_i]), (PG8_LAS unsigned*)(lds + (bufoff) + ldsw + _i * 8192), 16, 0, 0); } while (0)
#define PG8_LDA(dst, b, h) do { _Pragma("unroll") for (int m = 0; m < 4; ++m) _Pragma("unroll") for (int k = 0; k < 2; ++k) dst[m][k] = *(const PG8_LAS bf16x8*)(lds + PG8_SA(b, h) + aoff + m * 2048 + k * 1024); } while (0)
#define PG8_LDB(dst, b, h) do { _Pragma("unroll") for (int n = 0; n < 2; ++n) _Pragma("unroll") for (int k = 0; k < 2; ++k) dst[n][k] = *(const PG8_LAS bf16x8*)(lds + PG8_SB(b, h) + boff + n * 2048 + k * 1024); } while (0)
#define PG8_MMA(ai, bj, At, Bt) do { __builtin_amdgcn_s_setprio(1); _Pragma("unroll") for (int m = 0; m < 4; ++m) _Pragma("unroll") for (int n = 0; n < 2; ++n) _Pragma("unroll") for (int k = 0; k < 2; ++k) \
        acc[ai][bj][m][n] = __builtin_amdgcn_mfma_f32_16x16x32_bf16(Bt[n][k], At[m][k], acc[ai][bj][m][n], 0, 0, 0); __builtin_amdgcn_s_setprio(0); } while (0)
#define PG8_WAIT_V(n) asm volatile("s_waitcnt vmcnt(" #n ")" ::: "memory")
#define PG8_WAIT_L(n) asm volatile("s_waitcnt lgkmcnt(" #n ")" ::: "memory")
#define PG8_BAR __builtin_amdgcn_s_barrier()
#define PG8_SCHED __builtin_amdgcn_sched_barrier(0)
    Unit cur, nxt; int ui = 0;
    if (!S.next(0, cur)) return;
    f32x4 acc[2][2][4][2];
#pragma unroll
    for (int a = 0; a < 2; ++a)
#pragma unroll
        for (int b = 0; b < 2; ++b)
#pragma unroll
            for (int m = 0; m < 4; ++m)
#pragma unroll
                for (int n = 0; n < 2; ++n) acc[a][b][m][n] = (f32x4){0.f, 0.f, 0.f, 0.f};
    bf16x8 At[4][2], B0[2][2], B1[2][2];
    const char* cA = (const char*)g.A + (size_t)cur.pm * tstepA + (size_t)cur.kt0 * kstep; const char* cB = (const char*)g.Bt + (size_t)cur.pn * tstepB + (size_t)cur.kt0 * kstep;
    S.a_ready(cur);
    if constexpr (SP2) {
        PG8_STAGE(PG8_SB(0, 0), cB, voffB); PG8_STAGE(PG8_SB(0, 1), cB + hstepB, voffB); PG8_STAGE(PG8_SA(0, 0), cA, voffA); PG8_STAGE(PG8_SA(0, 1), cA + hstepA, voffA);
        if (wr == 1) PG8_BAR;
        PG8_WAIT_V(2); PG8_BAR;
        PG8_STAGE(PG8_SB(1, 0), cB + kstep, voffB); PG8_STAGE(PG8_SA(1, 0), cA + kstep, voffA); PG8_STAGE(PG8_SB(1, 1), cB + hstepB + kstep, voffB);
        PG8_WAIT_V(6); PG8_BAR;
    } else {
        PG8_STAGE(PG8_SB(0, 0), cB, voffB); PG8_STAGE(PG8_SA(0, 0), cA, voffA); PG8_STAGE(PG8_SB(0, 1), cB + hstepB, voffB); PG8_STAGE(PG8_SA(0, 1), cA + hstepA, voffA);
        if (wr == 1) PG8_BAR;
        PG8_WAIT_V(4); PG8_BAR;
        PG8_STAGE(PG8_SB(1, 0), cB + kstep, voffB); PG8_STAGE(PG8_SA(1, 0), cA + kstep, voffA); PG8_STAGE(PG8_SB(1, 1), cB + hstepB + kstep, voffB);
        PG8_WAIT_V(6); PG8_BAR;
    }
    for (;;) {
        const bool has_next = S.next(ui + 1, nxt);
        const char* nA = has_next ? (const char*)g.A + (size_t)nxt.pm * tstepA + (size_t)nxt.kt0 * kstep : cA; const char* nB = has_next ? (const char*)g.Bt + (size_t)nxt.pn * tstepB + (size_t)nxt.kt0 * kstep : cB;
        const int nt = cur.nt > 0 ? cur.nt : ntdef;
        for (int t = 0; t < nt; t += 2) {
            const bool last = (t == nt - 2);
            const char* a1 = cA + (size_t)(t + 1) * kstep;
            const char* a2 = last ? nA : cA + (size_t)(t + 2) * kstep; const char* b2 = last ? nB : cB + (size_t)(t + 2) * kstep;
            const char* a3 = a2 + kstep; const char* b3 = b2 + kstep;
            if (last && has_next) S.a_ready(nxt);
            if constexpr (Epi::MIDK) { if (t == Epi::T1 || t == Epi::T2) E.midk(acc, cur, t == Epi::T1 ? 0 : 1, wr, wc, fr, fq); }
            if constexpr (SP2) {
            PG8_LDB(B0, 0, 0); PG8_LDB(B1, 0, 1); PG8_SCHED; PG8_LDA(At, 0, 0); PG8_STAGE(PG8_SA(1, 1), a1 + hstepA, voffA);
            PG8_WAIT_V(8); PG8_WAIT_L(0); PG8_BAR; PG8_MMA(0, 0, At, B0); PG8_MMA(0, 1, At, B1); PG8_BAR; PG8_SCHED;
            PG8_LDA(At, 0, 1); PG8_STAGE(PG8_SB(0, 0), b2, voffB); PG8_STAGE(PG8_SB(0, 1), b2 + hstepB, voffB); PG8_STAGE(PG8_SA(0, 0), a2, voffA);
            PG8_WAIT_V(8); PG8_WAIT_L(0); PG8_BAR; PG8_MMA(1, 0, At, B0); PG8_MMA(1, 1, At, B1); PG8_BAR; PG8_SCHED;
            PG8_LDB(B0, 1, 0); PG8_LDB(B1, 1, 1); PG8_SCHED; PG8_LDA(At, 1, 0); PG8_STAGE(PG8_SA(0, 1), a2 + hstepA, voffA);
            PG8_WAIT_V(8); PG8_WAIT_L(0); PG8_BAR; PG8_MMA(0, 0, At, B0); PG8_MMA(0, 1, At, B1); PG8_BAR; PG8_SCHED;
            PG8_LDA(At, 1, 1); PG8_STAGE(PG8_SB(1, 0), b3, voffB); PG8_STAGE(PG8_SB(1, 1), b3 + hstepB, voffB); PG8_STAGE(PG8_SA(1, 0), a3, voffA);
            PG8_WAIT_V(8); PG8_WAIT_L(0); PG8_BAR; PG8_MMA(1, 0, At, B0); PG8_MMA(1, 1, At, B1); PG8_BAR; PG8_SCHED;
            } else {
            PG8_LDB(B0, 0, 0); PG8_SCHED; PG8_LDA(At, 0, 0); PG8_STAGE(PG8_SA(1, 1), a1 + hstepA, voffA);
            PG8_WAIT_L(8); PG8_BAR; PG8_WAIT_L(0); PG8_MMA(0, 0, At, B0); PG8_BAR; PG8_SCHED;
            PG8_LDB(B1, 0, 1); PG8_STAGE(PG8_SB(0, 0), b2, voffB);
            PG8_BAR; PG8_WAIT_L(0); PG8_MMA(0, 1, At, B1); PG8_BAR;
            PG8_LDA(At, 0, 1); PG8_STAGE(PG8_SA(0, 0), a2, voffA);
            PG8_BAR; PG8_WAIT_L(0); PG8_MMA(1, 0, At, B0); PG8_BAR; PG8_SCHED;
            PG8_STAGE(PG8_SB(0, 1), b2 + hstepB, voffB);
            PG8_WAIT_V(6); PG8_BAR; PG8_MMA(1, 1, At, B1); PG8_BAR;
            PG8_LDB(B0, 1, 0); PG8_SCHED; PG8_LDA(At, 1, 0); PG8_STAGE(PG8_SA(0, 1), a2 + hstepA, voffA);
            PG8_WAIT_L(8); PG8_BAR; PG8_WAIT_L(0); PG8_MMA(0, 0, At, B0); PG8_BAR; PG8_SCHED;
            PG8_LDB(B1, 1, 1); PG8_STAGE(PG8_SB(1, 0), b3, voffB);
            PG8_BAR; PG8_WAIT_L(0); PG8_MMA(0, 1, At, B1); PG8_BAR;
            PG8_LDA(At, 1, 1); PG8_STAGE(PG8_SA(1, 0), a3, voffA);
            PG8_BAR; PG8_WAIT_L(0); PG8_MMA(1, 0, At, B0); PG8_BAR; PG8_SCHED;
            PG8_STAGE(PG8_SB(1, 1), b3 + hstepB, voffB);
            PG8_WAIT_V(6); PG8_BAR; PG8_MMA(1, 1, At, B1); PG8_BAR;
            }
        }
        if constexpr (ALIGN_EPI) { if (wr == 0) PG8_BAR; }
        if constexpr (!Epi::AFTER_DRAIN) { E(acc, cur, wr, wc, fr, fq); S.done(cur); }
        if (!has_next) break;
#pragma unroll
        for (int a = 0; a < 2; ++a)
#pragma unroll
            for (int b = 0; b < 2; ++b)
#pragma unroll
                for (int m = 0; m < 4; ++m)
#pragma unroll
                    for (int n = 0; n < 2; ++n) acc[a][b][m][n] = (f32x4){0.f, 0.f, 0.f, 0.f};
        cur = nxt; cA = nA; cB = nB; ++ui;
        if constexpr (ALIGN_EPI) { if (wr == 1) PG8_BAR; }
    }
    PG8_WAIT_V(0);
    if constexpr (!ALIGN_EPI) { if (wr == 0) PG8_BAR; }
    PG8_BAR;
    if constexpr (Epi::AFTER_DRAIN) { E.fused(acc, cur, wr, wc, fr, fq, lds, wid, lane); S.done(cur); }
#undef PG8_SA
#undef PG8_SB
#undef PG8_STAGE
#undef PG8_LDA
#undef PG8_LDB
#undef PG8_MMA
#undef PG8_WAIT_V
#undef PG8_WAIT_L
#undef PG8_BAR
#undef PG8_SCHED
}
}

constexpr int DM = 4096, FF = 5632, SEQ = 4096, CTXL = 256, TL = 8192, TC = 512, MR = TL + TC, NLAYER = 2;
constexpr int ZW = 24576, ZN = 24832, INW = 24608, MODW = 36864;
constexpr int Z_DNK = 0, Z_DNV = 1024, Z_NAK = 2048, Z_NAV = 4096, Z_DNQ = 6144, Z_NAQ = 7168, Z_DNG = 9216, Z_GMU = 10240, Z_GMV = 11264, Z_GA = 12288;
constexpr float EPS = 1e-6f;
constexpr int NWAVES = 8, NTHR = 512;
typedef unsigned short bf16;
typedef float f32x4 __attribute__((ext_vector_type(4)));
typedef float f32x2 __attribute__((ext_vector_type(2)));
typedef unsigned v4u __attribute__((ext_vector_type(4)));
typedef unsigned v2u __attribute__((ext_vector_type(2)));
#define GAS __attribute__((address_space(1)))

constexpr size_t al256(size_t x) { return (x + 255) & ~(size_t)255; }
constexpr size_t WS_CTL = 0, CTL_ZERO_BYTES = 1u << 20;
constexpr size_t WS_MOD = CTL_ZERO_BYTES;
constexpr size_t WS_W13 = WS_MOD + al256((size_t)NLAYER * 3 * MODW * 4);
constexpr size_t SZ_W13 = (size_t)2 * FF * DM * 2;
constexpr size_t WS_W2 = WS_W13 + 4 * SZ_W13;
constexpr size_t SZ_W2 = (size_t)DM * FF * 2;
constexpr size_t WS_WIN = WS_W2 + 4 * SZ_W2;
constexpr size_t SZ_WIN = (size_t)ZN * DM * 2;
constexpr size_t WS_PC = WS_WIN + 2 * SZ_WIN;
constexpr size_t SZ_SQ = (size_t)DM * DM * 2;
constexpr size_t WS_WO = WS_PC + 2 * SZ_SQ;
constexpr size_t WS_H = WS_WO + 2 * SZ_SQ;
constexpr size_t WS_XN = WS_H + (size_t)MR * DM * 4;
constexpr size_t WS_HB = WS_XN + (size_t)MR * DM * 2;
constexpr size_t WS_Z = WS_HB + (size_t)MR * FF * 2;
constexpr size_t WS_ZAB = WS_Z + (size_t)MR * ZW * 2;
constexpr size_t SZ_DN = (size_t)MR * 1024 * 4;
constexpr size_t WS_G = WS_ZAB + (size_t)MR * 32 * 4;
constexpr size_t WS_BETA = WS_G + (size_t)MR * 16 * 4;
constexpr size_t WS_OF = WS_BETA + (size_t)MR * 16 * 4, WS_OB = WS_OF + SZ_DN;
constexpr size_t WS_VN = WS_OB + SZ_DN;
constexpr size_t WS_YCAT = WS_VN + SZ_DN;
constexpr size_t WS_YF = WS_YCAT + (size_t)MR * DM * 2;
constexpr size_t WS_YB = WS_YF + (size_t)MR * DM * 4;
constexpr size_t WS_VTL = WS_YB + (size_t)MR * DM * 2;
constexpr size_t WS_VTC = WS_VTL + (size_t)2 * 16 * 128 * SEQ * 2;
constexpr size_t WS_KB = WS_VTC + (size_t)2 * 16 * 128 * CTXL * 2;
constexpr size_t WS_QB = WS_KB + (size_t)MR * 1024 * 2;
constexpr size_t WS_KT = WS_QB + (size_t)MR * 1024 * 2;
constexpr size_t SZ_KT = (size_t)2 * 8 * 128 * (CTXL + SEQ) * 2;
constexpr size_t WS_VT2 = WS_KT + SZ_KT;
constexpr size_t WS_WB = WS_VT2 + SZ_KT;
constexpr size_t WS_UB = WS_WB + (size_t)2176 * 64 * 128 * 2;
constexpr size_t WS_QKM = WS_UB + (size_t)2176 * 64 * 128 * 4;
constexpr size_t WS_EG = WS_QKM + (size_t)2176 * 64 * 64 * 2;
constexpr size_t WS_ROPE = WS_EG + (size_t)2176 * 128 * 4;
constexpr size_t WS_SLAB = WS_ROPE + 2048 * 2 * 4;
constexpr size_t WS_GF = WS_SLAB + (size_t)8 * TC * DM * 4;
constexpr size_t WS_END = WS_GF + (size_t)32 * 48 * 8 * 16 * 64 * 8 * 2;
constexpr int CW_AQ = 1024;
constexpr int CW_FN = 2048;
constexpr int CW_UF = 8192;
constexpr int CW_BAR = 4096;

constexpr int RING_BYTES = 131072, MISC_OFF = RING_BYTES + 320, LDS_BYTES = 147456;

#define LAS __attribute__((address_space(3)))
#define LDS_WAIT() asm volatile("s_waitcnt lgkmcnt(0)" ::: "memory")
#define VM_WAIT() asm volatile("s_waitcnt vmcnt(0)" ::: "memory")
#define XB_TMO      128
#define XB_XCNT(j)  (256  + 64 * (j))
#define XB_XSUB(j)  (1280 + 64 * (j))
#define XB_XGEN(j)  (2304 + 64 * (j))
#define XB_TOP      3328
#define XB_TOPGEN   3392
#define XCD_BAR_WORDS 3456
#define XB_SPIN_CAP (1u << 18)

__device__ __forceinline__ unsigned xb_ld(unsigned* p)              { return __hip_atomic_load(p, __ATOMIC_RELAXED, __HIP_MEMORY_SCOPE_AGENT); }
__device__ __forceinline__ unsigned xb_add(unsigned* p, unsigned v) { return __hip_atomic_fetch_add(p, v, __ATOMIC_RELAXED, __HIP_MEMORY_SCOPE_AGENT); }
__device__ __forceinline__ unsigned xb_xcc_id() { return (unsigned)__builtin_amdgcn_s_getreg((3 << 11) | 20) & 0xFu; }
#define XB_SPIN(cond, bar) do { unsigned _sp = 0; while (cond) { __builtin_amdgcn_s_sleep(1); \
    if ((++_sp & 255u) == 0u) { if (xb_ld(&(bar)[XB_TMO])) break; if (_sp > XB_SPIN_CAP) { atomicAdd(&(bar)[XB_TMO], 1u); break; } } } } while (0)

struct XcdBarrier {
    unsigned* bar; unsigned x;
    volatile LAS unsigned* st;
};

__device__ __forceinline__ XcdBarrier xcd_barrier_post(unsigned* bar, volatile LAS unsigned* st) {
    XcdBarrier b; b.bar = bar; b.x = xb_xcc_id(); b.st = st;
    if (threadIdx.x == 0) (void)xb_add(&bar[XB_XCNT(b.x)], 1u);
    return b;
}
__device__ __forceinline__ void xcd_barrier_complete(unsigned* bar, unsigned x, unsigned& nloc, unsigned& nx) {
    const unsigned G = gridDim.x * gridDim.y * gridDim.z;
    unsigned sum, cnt, mine, sp = 0u;
    for (;;) {
        sum = 0u; cnt = 0u; mine = 0u;
#pragma unroll
        for (unsigned j = 0; j < 16; ++j) { const unsigned c = xb_ld(&bar[XB_XCNT(j)]); sum += c; cnt += (c > 0u) ? 1u : 0u; mine = (j == x) ? c : mine; }
        if (sum == G) break;
        __builtin_amdgcn_s_sleep(1);
        if ((++sp & 255u) == 0u) { if (xb_ld(&bar[XB_TMO])) break; if (sp > XB_SPIN_CAP) { atomicAdd(&bar[XB_TMO], 1u); break; } }
    }
    nloc = mine > 0u ? mine : 1u; nx = cnt > 0u ? cnt : 1u;
}

__device__ __forceinline__ void xcd_barrier(const XcdBarrier& b) {
    asm volatile("s_waitcnt vmcnt(0)" ::: "memory");
    __syncthreads();
    if (threadIdx.x == 0) {
        unsigned* bar = b.bar;
        __builtin_amdgcn_s_waitcnt(0);
        unsigned nloc = b.st[0], nx = b.st[1];
        if (nloc == 0u) { xcd_barrier_complete(bar, b.x, nloc, nx); b.st[0] = nloc; b.st[1] = nx; }
        const unsigned old = xb_add(&bar[XB_XSUB(b.x)], 1u);
        const unsigned gen = old / nloc;
        if (old + 1u == (gen + 1u) * nloc) {
            __builtin_amdgcn_fence(__ATOMIC_RELEASE, "agent");
            asm volatile("s_waitcnt vmcnt(0)" ::: "memory");
            const unsigned og = xb_add(&bar[XB_TOP], 1u);
            const unsigned tg = og / nx;
            if (og + 1u == (tg + 1u) * nx) xb_add(&bar[XB_TOPGEN], 1u);
            else XB_SPIN(xb_ld(&bar[XB_TOPGEN]) == tg, bar);
            __builtin_amdgcn_fence(__ATOMIC_ACQUIRE, "agent");
            xb_add(&bar[XB_XGEN(b.x)], 1u);
            asm volatile("s_waitcnt vmcnt(0)" ::: "memory");
        } else {
            XB_SPIN(xb_ld(&bar[XB_XGEN(b.x)]) == gen, bar);
            __builtin_amdgcn_fence(__ATOMIC_ACQUIRE, "agent");
            asm volatile("s_waitcnt vmcnt(0)" ::: "memory");
        }
    }
    __syncthreads();
}

__device__ __forceinline__ float wave_sum(float v) {
#pragma unroll
    for (int o = 1; o < 64; o <<= 1) v += __shfl_xor(v, o);
    return v;
}
__device__ __forceinline__ float wave_max(float v) {
#pragma unroll
    for (int o = 1; o < 64; o <<= 1) v = fmaxf(v, __shfl_xor(v, o));
    return v;
}
__device__ __forceinline__ float bflo(unsigned u) { return __builtin_bit_cast(float, u << 16); }
__device__ __forceinline__ float bfhi(unsigned u) { return __builtin_bit_cast(float, u & 0xffff0000u); }
typedef __bf16 bf16x2v_t __attribute__((ext_vector_type(2)));
__device__ __forceinline__ unsigned pk2(float lo, float hi) { bf16x2v_t v = {(__bf16)lo, (__bf16)hi}; return __builtin_bit_cast(unsigned, v); }
__device__ __forceinline__ float sigmoidf_(float x) { return 1.0f / (1.0f + __expf(-x)); }
__device__ __forceinline__ float siluf_(float x) { return x * sigmoidf_(x); }
__device__ __forceinline__ float gelu_tanh(float x) { const float u = 1.5957691216057308f * (x + 0.044715f * x * x * x); return x / (1.0f + __expf(-u)); }
__device__ __forceinline__ void row_info(int row, int& base, int& t, int& T, int& v) {
    if (row < TL) { const int b = row >> 12; base = b << 12; t = row & 4095; T = SEQ; v = b; }
    else { const int r = row - TL; const int b = r >> 8; base = TL + (b << 8); t = r & 255; T = CTXL; v = 2; }
}

__device__ __forceinline__ void cvt_item(const float* __restrict__ W, int N, bf16* WT, size_t dpitch, int k0, int n0, size_t dbase, LAS float* scr, int lane) {
#pragma unroll 8
    for (int i = 0; i < 32; ++i) { const int kk = 2 * i + (lane >> 5); scr[kk * 33 + (lane & 31)] = __builtin_nontemporal_load(W + (size_t)(k0 + kk) * N + n0 + (lane & 31)); }
    LDS_WAIT(); asm volatile("" ::: "memory");
    const int c = lane & 7;
#pragma unroll
    for (int j = 0; j < 4; ++j) { const int n = (lane >> 3) + 8 * j; const LAS float* s = scr + (8 * c) * 33 + n;
        v4u o; o.x = pk2(s[0 * 33], s[1 * 33]); o.y = pk2(s[2 * 33], s[3 * 33]); o.z = pk2(s[4 * 33], s[5 * 33]); o.w = pk2(s[6 * 33], s[7 * 33]);
        __builtin_nontemporal_store(o, (GAS v4u*)(WT + dbase + (size_t)n * dpitch + k0 + 8 * c)); }
    LDS_WAIT(); asm volatile("" ::: "memory");
}
template <int MODE> __device__ __forceinline__ void cvt_matrix(const float* __restrict__ W, int K, int N, bf16* WT, size_t dpitch, int koff, int gw, int NGW, LAS float* scr, int lane) {
    const int nblk = N / 32, ngroups = (K / 512) * nblk, wg = gw >> 3, G_ = NGW >> 3, wv = gw & 7;
    for (int gi = wg; gi < ngroups; gi += G_) {
        const int kq = gi / nblk, nb = gi - kq * nblk, kb = 8 * kq + wv, n0 = nb * 32;
        int drow0;
        if (MODE == 0) drow0 = n0;
        else if (MODE == 1) drow0 = (n0 >> 7) * 256 + (n0 & 127);
        else if (MODE == 2) drow0 = (n0 >> 7) * 256 + 128 + (n0 & 127);
        else drow0 = nb < 64 ? n0 : (nb == 64 ? ZW : n0 - 32);
        cvt_item(W, N, WT, dpitch, kb * 64, n0, (size_t)drow0 * dpitch + koff, scr, lane);
    }
}

__device__ __forceinline__ void mod_phase(const float* __restrict__ cvec, const float* __restrict__ cctx, const float* __restrict__ ada_w, const float* __restrict__ ada_b, float* mod,
                                          LAS unsigned char* lds, int tid, int lane, int wave, int bid, int G, int l_lo, int l_hi) {
    LAS float* sc = (LAS float*)lds;
    LAS float* red = (LAS float*)(lds + 49152);
    for (int i = tid; i < 3 * DM; i += NTHR) { const int v = i >> 12, k = i & 4095; const float x = v < 2 ? cvec[v * DM + k] : cctx[k]; sc[i] = siluf_(x); }
    __syncthreads();
    const int cl = lane & 15, kr = lane >> 4;
    for (int item = l_lo * (MODW / 64) + bid; item < l_hi * (MODW / 64); item += G) {
        const int l = item / (MODW / 64), cb = item - l * (MODW / 64), col0 = cb * 64;
        const float* wp = ada_w + (size_t)l * DM * MODW + col0 + 4 * cl;
        f32x4 a0 = {0.f, 0.f, 0.f, 0.f}, a1 = a0, a2 = a0;
#pragma unroll 8
        for (int i = 0; i < 128; ++i) { const int k = wave * 4 + kr + 32 * i;
            const f32x4 w = *(const f32x4*)(wp + (size_t)k * MODW);
            a0 += w * sc[k]; a1 += w * sc[DM + k]; a2 += w * sc[2 * DM + k]; }
#pragma unroll
        for (int e = 0; e < 4; ++e) { a0[e] += __shfl_xor(a0[e], 16); a0[e] += __shfl_xor(a0[e], 32); a1[e] += __shfl_xor(a1[e], 16); a1[e] += __shfl_xor(a1[e], 32); a2[e] += __shfl_xor(a2[e], 16); a2[e] += __shfl_xor(a2[e], 32); }
        if (kr == 0) {
#pragma unroll
            for (int e = 0; e < 4; ++e) { red[(wave * 3 + 0) * 64 + 4 * cl + e] = a0[e]; red[(wave * 3 + 1) * 64 + 4 * cl + e] = a1[e]; red[(wave * 3 + 2) * 64 + 4 * cl + e] = a2[e]; } }
        __syncthreads();
        if (tid < 192) { const int v = tid >> 6, c = tid & 63; float s = 0.f;
#pragma unroll
            for (int w = 0; w < 8; ++w) s += red[(w * 3 + v) * 64 + c];
            mod[((size_t)l * 3 + v) * MODW + col0 + c] = s + ada_b[(size_t)l * MODW + col0 + c]; }
        __syncthreads();
    }
}

__device__ __forceinline__ void norm_phase(const float* in_lat, const float* in_ctx, const float* __restrict__ nw, const float* modl  , int isub, bf16* xn, int nrows,
                                           const float* slab, const float* gatev, float coef, float* hctx_out, LAS unsigned char* lds, int tid, int lane, int gw, int NGW) {
    LAS float* AL = (LAS float*)lds;
    LAS float* SL = AL + 3 * DM;
    __syncthreads();
    for (int i = tid; i < 3 * DM / 4; i += NTHR) { const int v = i >> 10, c = (i & 1023) * 4;
        const f32x4 w = *(const f32x4*)(nw + c), sc = *(const f32x4*)(modl + (size_t)v * MODW + (isub * 3 + 1) * DM + c), sh = *(const f32x4*)(modl + (size_t)v * MODW + (isub * 3 + 0) * DM + c);
        *(LAS f32x4*)(AL + v * DM + c) = w * (sc + 1.0f); *(LAS f32x4*)(SL + v * DM + c) = sh; }
    __syncthreads();
    if (slab != nullptr) { const int wave_ = gw & 7, bid_ = gw >> 3, G_ = NGW >> 3; LAS float* red = (LAS float*)(lds + 98304);
        for (int r = bid_; r < nrows - TL; r += G_) {
            const int c0 = 512 * wave_ + 4 * lane; const size_t ro = (size_t)r * DM;
            f32x4 xh[2], sp[8][2];
#pragma unroll
            for (int jj = 0; jj < 2; ++jj) { xh[jj] = *(const f32x4*)(in_ctx + ro + c0 + 256 * jj);
#pragma unroll
                for (int k = 0; k < 8; ++k) sp[k][jj] = *(const f32x4*)(slab + ((size_t)k * 512 + r) * DM + c0 + 256 * jj); }
            float ss = 0.f;
#pragma unroll
            for (int jj = 0; jj < 2; ++jj) { f32x4 s = sp[0][jj];
#pragma unroll
                for (int k = 1; k < 8; ++k) s += sp[k][jj];
                xh[jj] += (*(const f32x4*)(gatev + c0 + 256 * jj) * coef) * s; *(f32x4*)(hctx_out + ro + c0 + 256 * jj) = xh[jj];
                ss += (xh[jj][0] * xh[jj][0] + xh[jj][1] * xh[jj][1]) + (xh[jj][2] * xh[jj][2] + xh[jj][3] * xh[jj][3]); }
            ss = wave_sum(ss);
            __syncthreads();
            if (lane == 0) red[wave_] = ss;
            __syncthreads();
            float tot = 0.f;
#pragma unroll
            for (int w = 0; w < 8; ++w) tot += red[w];
            const float rr = 1.0f / sqrtf(tot * (1.0f / DM) + EPS);
#pragma unroll
            for (int jj = 0; jj < 2; ++jj) { const int c = c0 + 256 * jj;
                const f32x4 a = *(const LAS f32x4*)(AL + 2 * DM + c), sh = *(const LAS f32x4*)(SL + 2 * DM + c);
                const f32x4 y = (xh[jj] * rr) * a + sh;
                v2u o; o.x = pk2(y[0], y[1]); o.y = pk2(y[2], y[3]);
                *(v2u*)(xn + (size_t)(TL + r) * DM + c) = o; }
        }
        nrows = TL;
    }
    f32x4 xq[16];
    if (gw < nrows) { const float* s0 = gw < TL ? in_lat + (size_t)gw * DM : in_ctx + (size_t)(gw - TL) * DM;
#pragma unroll
        for (int j = 0; j < 16; ++j) xq[j] = *(const f32x4*)(s0 + 4 * (lane + 64 * j)); }
    for (int row = gw; row < nrows; row += NGW) {
        const int v = row < SEQ ? 0 : (row < TL ? 1 : 2);
        f32x4 x[16]; float ss = 0.f;
#pragma unroll
        for (int j = 0; j < 16; ++j) x[j] = xq[j];
        { const int nr = row + NGW;
          if (nr < nrows) { const float* s1 = nr < TL ? in_lat + (size_t)nr * DM : in_ctx + (size_t)(nr - TL) * DM;
#pragma unroll
            for (int j = 0; j < 16; ++j) xq[j] = *(const f32x4*)(s1 + 4 * (lane + 64 * j)); } }
#pragma unroll
        for (int j = 0; j < 16; ++j) ss += (x[j][0] * x[j][0] + x[j][1] * x[j][1]) + (x[j][2] * x[j][2] + x[j][3] * x[j][3]);
        const float r = 1.0f / sqrtf(wave_sum(ss) * (1.0f / DM) + EPS);
#pragma unroll
        for (int j = 0; j < 16; ++j) { const int c = 4 * (lane + 64 * j);
            const f32x4 a = *(const LAS f32x4*)(AL + v * DM + c), sh = *(const LAS f32x4*)(SL + v * DM + c);
            const f32x4 y = (x[j] * r) * a + sh;
            v2u o; o.x = pk2(y[0], y[1]); o.y = pk2(y[2], y[3]);
            *(v2u*)(xn + (size_t)row * DM + c) = o; }
    }
}
__device__ __forceinline__ void final_norm_phase(const float* h, const float* __restrict__ fw, float* out, int lane, int gw, int NGW) {
    for (int row = gw; row < TL; row += NGW) {
        const float* src = h + (size_t)row * DM;
        f32x4 x[16]; float ss = 0.f;
#pragma unroll
        for (int j = 0; j < 16; ++j) { x[j] = *(const f32x4*)(src + 4 * (lane + 64 * j)); ss += (x[j][0] * x[j][0] + x[j][1] * x[j][1]) + (x[j][2] * x[j][2] + x[j][3] * x[j][3]); }
        const float r = 1.0f / sqrtf(wave_sum(ss) * (1.0f / DM) + EPS);
#pragma unroll
        for (int j = 0; j < 16; ++j) { const int c = 4 * (lane + 64 * j); const f32x4 w = *(const f32x4*)(fw + c);
            *(f32x4*)(out + (size_t)row * DM + c) = (x[j] * r) * w;
            if ((j & 3) == 3) asm volatile("" ::: "memory"); }
    }
}

__device__ __forceinline__ void gm_prep_phase(const bf16* z, const float* __restrict__ snw, float* vn, int lane, int gw, int NGW) {
    v4u pu[2] = {{0u, 0u, 0u, 0u}, {0u, 0u, 0u, 0u}};
    if (gw < MR) { pu[0] = *(const v4u*)(z + (size_t)gw * ZW + Z_GMV + 8 * lane); pu[1] = *(const v4u*)(z + (size_t)gw * ZW + Z_GMV + 8 * lane + 512); }
    for (int row = gw; row < MR; row += NGW) {
        float x[16]; float s = 0.f;
        const v4u cu0 = pu[0], cu1 = pu[1];
        if (row + NGW < MR) { pu[0] = *(const v4u*)(z + (size_t)(row + NGW) * ZW + Z_GMV + 8 * lane); pu[1] = *(const v4u*)(z + (size_t)(row + NGW) * ZW + Z_GMV + 8 * lane + 512); }
#pragma unroll
        for (int j = 0; j < 2; ++j) { const v4u u = j ? cu1 : cu0;
            x[8 * j + 0] = gelu_tanh(bflo(u.x)); x[8 * j + 1] = gelu_tanh(bfhi(u.x)); x[8 * j + 2] = gelu_tanh(bflo(u.y)); x[8 * j + 3] = gelu_tanh(bfhi(u.y));
            x[8 * j + 4] = gelu_tanh(bflo(u.z)); x[8 * j + 5] = gelu_tanh(bfhi(u.z)); x[8 * j + 6] = gelu_tanh(bflo(u.w)); x[8 * j + 7] = gelu_tanh(bfhi(u.w)); }
#pragma unroll
        for (int i = 0; i < 16; ++i) s += x[i];
        const float mu = wave_sum(s) * (1.0f / 1024.0f); float q = 0.f;
#pragma unroll
        for (int i = 0; i < 16; ++i) { x[i] -= mu; q += x[i] * x[i]; }
        const float rs = 1.0f / sqrtf(wave_sum(q) * (1.0f / 1024.0f) + EPS);
#pragma unroll
        for (int j = 0; j < 2; ++j) { const int c = 8 * lane + 512 * j;
            const f32x4 w0 = *(const f32x4*)(snw + c), w1 = *(const f32x4*)(snw + c + 4);
            *(f32x4*)(vn + (size_t)row * 1024 + c) = (f32x4){x[8 * j + 0] * rs * w0[0], x[8 * j + 1] * rs * w0[1], x[8 * j + 2] * rs * w0[2], x[8 * j + 3] * rs * w0[3]};
            *(f32x4*)(vn + (size_t)row * 1024 + c + 4) = (f32x4){x[8 * j + 4] * rs * w1[0], x[8 * j + 5] * rs * w1[1], x[8 * j + 6] * rs * w1[2], x[8 * j + 7] * rs * w1[3]}; }
    }
}

__device__ __forceinline__ void dn_out_phase(const float* of, const float* ob, const bf16* z, const float* __restrict__ dnw, bf16* ycat, int nrows, int lane, int gw, int NGW) {
    const int sub = lane >> 4, l16 = lane & 15;
    const f32x4 w0 = *(const f32x4*)(dnw + 8 * l16), w1 = *(const f32x4*)(dnw + 8 * l16 + 4);
    f32x4 pf0 = {0.f, 0.f, 0.f, 0.f}, pf1 = pf0, pb0 = pf0, pb1 = pf0; v4u pg = {0u, 0u, 0u, 0u};
    { const int it0 = gw * 4 + sub; if (it0 < nrows * 8) { const int row = it0 >> 3, hd = it0 & 7; const size_t o = (size_t)row * 1024 + hd * 128 + 8 * l16;
        pf0 = *(const f32x4*)(of + o); pf1 = *(const f32x4*)(of + o + 4); pb0 = *(const f32x4*)(ob + o); pb1 = *(const f32x4*)(ob + o + 4); pg = *(const v4u*)(z + (size_t)row * ZW + Z_DNG + hd * 128 + 8 * l16); } }
    for (int it = gw * 4 + sub; it < nrows * 8; it += NGW * 4) {
        const int row = it >> 3, hd = it & 7;
        f32x4 a0 = pf0 + pb0, a1 = pf1 + pb1; const v4u gu = pg;
        { const int it2 = it + NGW * 4; if (it2 < nrows * 8) { const int row2 = it2 >> 3, hd2 = it2 & 7; const size_t o2 = (size_t)row2 * 1024 + hd2 * 128 + 8 * l16;
            pf0 = *(const f32x4*)(of + o2); pf1 = *(const f32x4*)(of + o2 + 4); pb0 = *(const f32x4*)(ob + o2); pb1 = *(const f32x4*)(ob + o2 + 4); pg = *(const v4u*)(z + (size_t)row2 * ZW + Z_DNG + hd2 * 128 + 8 * l16); } }
        float ss = (a0[0] * a0[0] + a0[1] * a0[1]) + (a0[2] * a0[2] + a0[3] * a0[3]) + (a1[0] * a1[0] + a1[1] * a1[1]) + (a1[2] * a1[2] + a1[3] * a1[3]);
        ss += __shfl_xor(ss, 1); ss += __shfl_xor(ss, 2); ss += __shfl_xor(ss, 4); ss += __shfl_xor(ss, 8);
        const float r = 1.0f / sqrtf(ss * (1.0f / 128.0f) + EPS);
        v4u out; out.x = pk2(a0[0] * r * w0[0] * siluf_(bflo(gu.x)), a0[1] * r * w0[1] * siluf_(bfhi(gu.x))); out.y = pk2(a0[2] * r * w0[2] * siluf_(bflo(gu.y)), a0[3] * r * w0[3] * siluf_(bfhi(gu.y)));
        out.z = pk2(a1[0] * r * w1[0] * siluf_(bflo(gu.z)), a1[1] * r * w1[1] * siluf_(bfhi(gu.z))); out.w = pk2(a1[2] * r * w1[2] * siluf_(bflo(gu.w)), a1[3] * r * w1[3] * siluf_(bfhi(gu.w)));
        *(v4u*)(ycat + (size_t)row * DM + 1024 + hd * 128 + 8 * l16) = out;
    }
}
__device__ __forceinline__ void merge_ctx_phase(const float* slab, const bf16* z, bf16* yb, int lane, int gw, int NGW) {
    const int wave_ = gw & 7, bid_ = gw >> 3, G_ = NGW >> 3;
    for (int r = bid_; r < TC; r += G_) { const size_t row = (size_t)TL + r;
#pragma unroll
        for (int jj = 0; jj < 2; ++jj) { const int c = 512 * wave_ + 4 * lane + 256 * jj; f32x4 y = {0.f, 0.f, 0.f, 0.f};
            v2u gu[3]; f32x4 sp[8];
#pragma unroll
            for (int br = 0; br < 3; ++br) gu[br] = *(const v2u*)(z + row * ZW + Z_GA + br * 4096 + c);
#pragma unroll
            for (int k = 0; k < 8; ++k) sp[k] = *(const f32x4*)(slab + ((size_t)k * 512 + r) * DM + c);
#pragma unroll
            for (int br = 0; br < 3; ++br) { f32x4 s = {0.f, 0.f, 0.f, 0.f};
#pragma unroll
                for (int k = (br == 0 ? 0 : (br == 1 ? 2 : 4)); k < (br == 0 ? 2 : (br == 1 ? 4 : 8)); ++k) s += sp[k];
                y[0] += sigmoidf_(bflo(gu[br].x)) * s[0]; y[1] += sigmoidf_(bfhi(gu[br].x)) * s[1]; y[2] += sigmoidf_(bflo(gu[br].y)) * s[2]; y[3] += sigmoidf_(bfhi(gu[br].y)) * s[3]; }
            v2u o; o.x = pk2(y[0], y[1]); o.y = pk2(y[2], y[3]); *(v2u*)(yb + row * DM + c) = o; }
    }
}

__device__ __forceinline__ void vt_phase(const bf16* z, bf16* vf, bf16* vtc, LAS unsigned char* lds, int lane, int wave, int gw, int NGW) {
    LAS unsigned short* T = (LAS unsigned short*)(lds + wave * 8448);
    constexpr int NIT = 2 * 16 * 4 * 2;
    for (int it = gw; it < NIT; it += NGW) {
        const int dh = it & 1; int r = it >> 1; const int tb = 64 + (r & 3); r >>= 2; const int h = r & 15, b = r >> 4;
        const int row0 = tb < 64 ? b * SEQ + tb * 64 : TL + b * CTXL + (tb - 64) * 64;
#pragma unroll
        for (int j = 0; j < 8; ++j) { const int tok = 8 * j + (lane >> 3), ch = lane & 7;
            const v4u v = *(const v4u*)(z + (size_t)(row0 + tok) * ZW + Z_NAV + h * 128 + dh * 64 + 8 * ch);
            LAS unsigned* d = (LAS unsigned*)(T + tok * 66 + 8 * ch); d[0] = v.x; d[1] = v.y; d[2] = v.z; d[3] = v.w; }
        LDS_WAIT(); asm volatile("" ::: "memory");
        unsigned w[32];
#pragma unroll
        for (int t = 0; t < 32; ++t) w[t] = (unsigned)T[(2 * t) * 66 + lane] | ((unsigned)T[(2 * t + 1) * 66 + lane] << 16);
        if (tb < 64) { bf16* dst = vf + (((size_t)(b * 16 + h) * 512 + tb * 8) * 128 + dh * 64 + lane) * 8;
#pragma unroll
            for (int j = 0; j < 8; ++j) *(v4u*)(dst + (size_t)j * 1024) = (v4u){w[4 * j], w[4 * j + 1], w[4 * j + 2], w[4 * j + 3]};
        } else { bf16* dst = vtc + ((size_t)(b * 16 + h) * 128 + dh * 64 + lane) * CTXL + (tb - 64) * 64;
#pragma unroll
            for (int j = 0; j < 8; ++j) *(v4u*)(dst + 8 * j) = (v4u){w[4 * j], w[4 * j + 1], w[4 * j + 2], w[4 * j + 3]}; }
        LDS_WAIT(); asm volatile("" ::: "memory");
    }
}

typedef short bf16x8_t __attribute__((ext_vector_type(8)));
struct AttnState { float mrun, lrun; f32x4 oa[8]; };
template <bool LOC, bool QFR> __device__ __forceinline__ void attn_chunk(AttnState& st, const char* qbase, const char* kbase, const char* vbase,
                                                               const LAS unsigned char* KL, const LAS unsigned char* VL, const LAS float* rpbL, int cc, int drow0, int lo, int cg, int lane) {
    asm volatile("" : "+v"(lane));
    const int q = lane & 15, g = lane >> 4, krl = 8 * (q >> 2) + (q & 3);
    const int c = 16 * cg + q, c0 = min(max(c - 8, 0), 48);
    const unsigned kloff = (unsigned)((q >> 2) * 2048 + g * 64 + (q & 3) * 16), vloff = (unsigned)(g * 2048 + q * 16), qloff = QFR ? (unsigned)lane * 16u : (unsigned)(q * ZW + 8 * g) * 2u;
    const float scale = 0.08838834764831845f;
    f32x4 sX[4], sY[4];
    bf16x8_t fr[LOC ? 4 : 1][8];
    bf16x8_t qf[4];
#pragma unroll
    for (int k = 0; k < 4; ++k) qf[k] = *(const GAS bf16x8_t*)((const GAS char*)qbase + qloff + (QFR ? 1024 : 64) * k);
    if constexpr (LOC) {
#pragma unroll
        for (int i = 0; i < 4; ++i) { const char* pk = kbase + (size_t)i * 16384; asm volatile("" : "+s"(pk));
#pragma unroll
            for (int y = 0; y < 2; ++y)
#pragma unroll
                for (int k = 0; k < 4; ++k) fr[i][4 * y + k] = *(const GAS bf16x8_t*)((const GAS char*)pk + kloff + (1024 * y + 256 * k)); }
        asm volatile("" ::: "memory");
#pragma unroll
        for (int i = 0; i < 4; ++i) { f32x4 ax = {0.f, 0.f, 0.f, 0.f}, ay = ax;
#pragma unroll
            for (int k = 0; k < 4; ++k) { ax = __builtin_amdgcn_mfma_f32_16x16x32_bf16(fr[i][k], qf[k], ax, 0, 0, 0); ay = __builtin_amdgcn_mfma_f32_16x16x32_bf16(fr[i][4 + k], qf[k], ay, 0, 0, 0); }
            sX[i] = ax; sY[i] = ay; }
#pragma unroll
        for (int i = 0; i < 4; ++i) { const char* pv = vbase + (size_t)i * 16384; asm volatile("" : "+s"(pv));
#pragma unroll
            for (int d = 0; d < 8; ++d) fr[i][d] = *(const GAS bf16x8_t*)((const GAS char*)pv + vloff + 256 * d); }
        asm volatile("" ::: "memory");
    } else {
#pragma unroll
        for (int i = 0; i < 4; ++i) { const int keyx = 128 * cc + 32 * i + krl, keyy = keyx + 4;
            const int fx = ((keyx & 15) + 4 * ((keyx >> 4) & 1)) & 15, fy = ((keyy & 15) + 4 * ((keyy >> 4) & 1)) & 15;
            bf16x8_t kx[4], ky[4];
#pragma unroll
            for (int k = 0; k < 4; ++k) { kx[k] = *(const LAS bf16x8_t*)(KL + keyx * 256 + (((4 * k + g) ^ fx) << 4)); ky[k] = *(const LAS bf16x8_t*)(KL + keyy * 256 + (((4 * k + g) ^ fy) << 4)); }
            f32x4 ax = {0.f, 0.f, 0.f, 0.f}, ay = ax;
#pragma unroll
            for (int k = 0; k < 4; ++k) { ax = __builtin_amdgcn_mfma_f32_16x16x32_bf16(kx[k], qf[k], ax, 0, 0, 0); ay = __builtin_amdgcn_mfma_f32_16x16x32_bf16(ky[k], qf[k], ay, 0, 0, 0); }
            sX[i] = ax; sY[i] = ay; }
    }
    float mx = -3.0e38f;
#pragma unroll
    for (int i = 0; i < 4; ++i) {
#pragma unroll
        for (int e = 0; e < 4; ++e) {
            float x = sX[i][e] * scale, y = sY[i][e] * scale;
            if constexpr (LOC) { const int kcx = lo + 8 * g + e, kcy = kcx + 4; const int dr = drow0 + i;
                const bool vx = (kcx >= c0) && (kcx < c0 + 16), vy = (kcy >= c0) && (kcy < c0 + 16);
                const float bx = rpbL[dr * 31 + min(max(kcx - c + 15, 0), 30)], by = rpbL[dr * 31 + min(max(kcy - c + 15, 0), 30)];
                x = vx ? x + bx : -1.0e30f; y = vy ? y + by : -1.0e30f; }
            sX[i][e] = x; sY[i][e] = y; mx = fmaxf(mx, fmaxf(x, y)); }
    }
    mx = fmaxf(mx, __shfl_xor(mx, 16)); mx = fmaxf(mx, __shfl_xor(mx, 32));
    const float mnew = fmaxf(st.mrun, mx), alpha = __expf(st.mrun - mnew);
    st.mrun = mnew;
    float psum = 0.f;
#pragma unroll
    for (int i = 0; i < 4; ++i)
#pragma unroll
        for (int e = 0; e < 4; ++e) { const float x = __expf(sX[i][e] - mnew), y = __expf(sY[i][e] - mnew); sX[i][e] = x; sY[i][e] = y; psum += x + y; }
    st.lrun = st.lrun * alpha + psum;
#pragma unroll
    for (int d = 0; d < 8; ++d) st.oa[d] *= alpha;
#pragma unroll
    for (int i = 0; i < 4; ++i) {
        v4u pu; pu.x = pk2(sX[i][0], sX[i][1]); pu.y = pk2(sX[i][2], sX[i][3]); pu.z = pk2(sY[i][0], sY[i][1]); pu.w = pk2(sY[i][2], sY[i][3]);
        const bf16x8_t pf = __builtin_bit_cast(bf16x8_t, pu);
        if constexpr (LOC) {
#pragma unroll
            for (int d = 0; d < 8; ++d) st.oa[d] = __builtin_amdgcn_mfma_f32_16x16x32_bf16(fr[i][d], pf, st.oa[d], 0, 0, 0);
        } else { const int chn = 16 * cc + 4 * i + g; bf16x8_t vf[8];
#pragma unroll
            for (int d = 0; d < 8; ++d) vf[d] = *(const LAS bf16x8_t*)(VL + (16 * d + q) * 512 + ((chn ^ q) << 4));
#pragma unroll
            for (int d = 0; d < 8; ++d) st.oa[d] = __builtin_amdgcn_mfma_f32_16x16x32_bf16(vf[d], pf, st.oa[d], 0, 0, 0); }
    }
}
template <bool LOCAL> __device__ __forceinline__ void attn_unit(const bf16* z, const bf16* qfb, const bf16* vtl  , const bf16* kf, const LAS unsigned char* KL, const LAS unsigned char* VL, const LAS float* rpbL, bf16* ycat, int b, int r, int cg, int qb, int h, int lane) {
    const int qrow0 = LOCAL ? (b * SEQ + r * 64 + 16 * cg) : (TL + b * CTXL + 16 * qb);
    const int r0 = min(max(r - 4, 0), 56), lo = min(max(16 * cg - 8, 0), 32);
    const char* qbase = LOCAL ? (const char*)qfb + (((size_t)(b * 16 + h) * 256 + r * 4 + cg) * 4) * 1024 : (const char*)(z + (size_t)qrow0 * ZW + Z_NAQ + h * 128);
    AttnState st; st.mrun = -3.0e38f; st.lrun = 0.f;
#pragma unroll
    for (int d = 0; d < 8; ++d) st.oa[d] = (f32x4){0.f, 0.f, 0.f, 0.f};
    if constexpr (LOCAL) {
#pragma unroll 1
        for (int ck = 0; ck < 2; ++ck) {
            const int tok0 = (r0 + 4 * ck) * 64 + lo;
            const char* kbase = (const char*)kf + ((size_t)(b * 16 + h) * 1024 + (tok0 >> 2)) * 1024;
            const char* vbase = (const char*)vtl + ((size_t)(b * 16 + h) * 512 + (tok0 >> 3)) * 2048;
            attn_chunk<true, true>(st, qbase, kbase, vbase, KL, VL, rpbL, 0, r0 + 4 * ck - r + 7, lo, cg, lane);
        }
    }
#pragma unroll 1
    for (int cc = 0; cc < 2; ++cc) attn_chunk<false, LOCAL>(st, qbase, nullptr, nullptr, KL, VL, rpbL, cc, 0, 0, 0, lane);
    asm volatile("" : "+v"(lane));
    const int q = lane & 15, g = lane >> 4;
    float lrun = st.lrun;
    lrun += __shfl_xor(lrun, 16); lrun += __shfl_xor(lrun, 32);
    const float inv = 1.0f / lrun;
    bf16* op = ycat + (size_t)(qrow0 + q) * DM + 2048 + h * 128 + 4 * g;
#pragma unroll
    for (int d = 0; d < 8; ++d) { v2u o; o.x = pk2(st.oa[d][0] * inv, st.oa[d][1] * inv); o.y = pk2(st.oa[d][2] * inv, st.oa[d][3] * inv); *(v2u*)(op + 16 * d) = o; }
}

__device__ __forceinline__ int attn_item_bh(int it) { return (it & 7) + 8 * ((it >> 3) & 3); }
__device__ __forceinline__ void attn_wg(int it, const bf16* z, const bf16* vtl  , const bf16* kf, const bf16* qfb, const bf16* vtc, const float* __restrict__ rpb  , bf16* ycat, bool ctxq, bool stage, LAS unsigned char* lds, int tid) {
    const int bh = attn_item_bh(it), rp = it >> 5, b = bh >> 4, h = bh & 15;
    LAS unsigned char* KL = lds; LAS unsigned char* VL = lds + 65536; LAS float* rpbL = (LAS float*)(lds + RING_BYTES + 1024);
    asm volatile("" : "+v"(tid));
    __syncthreads();
    if (stage) {
#pragma unroll
    for (int j = 0; j < 8; ++j) { const int i = tid + NTHR * j; const int key = i >> 4, ch = i & 15; const int fk = ((key & 15) + 4 * ((key >> 4) & 1)) & 15;
        *(LAS v4u*)(KL + key * 256 + ((ch ^ fk) << 4)) = *(const v4u*)(z + (size_t)(TL + b * CTXL + key) * ZW + Z_NAK + h * 128 + 8 * ch); }
#pragma unroll
    for (int j = 0; j < 8; ++j) { const int i = tid + NTHR * j; const int dim = i >> 5, ch = i & 31;
        *(LAS v4u*)(VL + dim * 512 + ((ch ^ (dim & 15)) << 4)) = *(const v4u*)(vtc + ((size_t)(b * 16 + h) * 128 + dim) * CTXL + 8 * ch); }
    for (int i = tid; i < 465; i += NTHR) rpbL[i] = rpb[h * 465 + i];
    }
    __syncthreads();
    asm volatile("" : "+v"(tid));
    const int wave = __builtin_amdgcn_readfirstlane(tid >> 6), lane = tid & 63;
    attn_unit<true>(z, qfb, vtl, kf, KL, VL, rpbL, ycat, b, 2 * rp + (wave >> 2), wave & 3, 0, h, lane);
    if (ctxq && wave == 0 && (rp & 1) == 0) attn_unit<false>(z, qfb, vtl, kf, KL, VL, rpbL, ycat, b, 0, 0, rp >> 1, h, lane);
}

constexpr int NPOS = CTXL + SEQ;
__device__ __forceinline__ int pos_row(int b, int P) { return P < CTXL ? TL + b * CTXL + P : b * SEQ + (P - CTXL); }

__device__ __forceinline__ void rope_table_phase(float* rope, int lane, int gw, int NGW) {
    for (int i = gw * 64 + lane; i < 2048; i += NGW * 64) { const int pos = i >> 5, fi = i & 31; const float f = powf(10000.0f, -(float)fi * (1.0f / 32.0f)); float s, c; sincosf((float)pos * f, &s, &c); rope[2 * i] = c; rope[2 * i + 1] = s; }
}
__device__ __forceinline__ void dn_prep3_phase(const bf16* z, const float* zab, const float* __restrict__ convw, const float* __restrict__ a_log, const float* __restrict__ dt_bias, const float* rope,
                                               bf16* KB, bf16* QB, bf16* KT, bf16* VT2, float* gout, float* bout, int lane, int gw, int NGW) {
    const int i0 = (2 * lane) & 31; const bool second = (lane & 16) != 0;
#define DN_LOADZ(dst, itx) do { const int tb_ = (itx) >> 3, ch_ = ((itx) & 7) * 128 + 2 * lane; int t0_, T_, base_; \
        if (tb_ < 1024) { t0_ = (tb_ & 511) * 8; T_ = SEQ; base_ = (tb_ >> 9) * SEQ; } else { const int cb_ = tb_ - 1024; t0_ = (cb_ & 31) * 8; T_ = CTXL; base_ = TL + (cb_ >> 5) * CTXL; } \
        _Pragma("unroll") for (int w = 0; w < 3; ++w) { const int zc_ = (w == 0 ? Z_DNK : (w == 1 ? Z_DNV : Z_DNQ)) + ch_; \
            _Pragma("unroll") for (int r = 0; r < 12; ++r) { const int tt_ = t0_ - 2 + r; dst[w][r] = (tt_ >= 0 && tt_ < T_) ? *(const unsigned*)(z + (size_t)(base_ + tt_) * ZW + zc_) : 0u; } } } while (0)
    unsigned zn[3][12];
    if (gw < 1088 * 8) DN_LOADZ(zn, gw);
#pragma unroll 1
    for (int it = gw; it < 1088 * 8; it += NGW) {
        const int tb = it >> 3, hd = it & 7;
        int row0, b, t0, T, base, P0;
        if (tb < 1024) { row0 = tb * 8; b = tb >> 9; t0 = (tb & 511) * 8; T = SEQ; base = b * SEQ; P0 = CTXL + t0; }
        else { const int cb = tb - 1024; row0 = TL + cb * 8; b = cb >> 5; t0 = (cb & 31) * 8; T = CTXL; base = TL + b * CTXL; P0 = t0; }
        (void)T; (void)base;
        const int ch = hd * 128 + 2 * lane;
        unsigned zz[3][12]; f32x2 wv[3][5];
#pragma unroll
        for (int w = 0; w < 3; ++w) { const int wc = (w == 0 ? 0 : (w == 1 ? 1024 : 2048)) + ch;
#pragma unroll
            for (int r = 0; r < 12; ++r) zz[w][r] = zn[w][r];
#pragma unroll
            for (int j = 0; j < 5; ++j) wv[w][j] = *(const f32x2*)(convw + j * 3072 + wc); }
        if (it + NGW < 1088 * 8) DN_LOADZ(zn, it + NGW);
        f32x4 cs[8];
        if (tb < 1024) {
#pragma unroll
            for (int tk = 0; tk < 8; ++tk) { const int t = t0 + tk; const int pos = (lane < 32) ? (t >> 6) : (t & 63); cs[tk] = *(const f32x4*)(rope + (size_t)(pos * 32 + i0) * 2); }
        }
        float y[3][8][2]; float ssq[16];
#pragma unroll
        for (int w = 0; w < 3; ++w)
#pragma unroll
            for (int tk = 0; tk < 8; ++tk) { float a0 = 0.f, a1 = 0.f;
#pragma unroll
                for (int j = 0; j < 5; ++j) { a0 += wv[w][j][0] * bflo(zz[w][tk + j]); a1 += wv[w][j][1] * bfhi(zz[w][tk + j]); }
                y[w][tk][0] = siluf_(a0); y[w][tk][1] = siluf_(a1); }
#pragma unroll
        for (int tk = 0; tk < 8; ++tk) { ssq[tk] = y[0][tk][0] * y[0][tk][0] + y[0][tk][1] * y[0][tk][1]; ssq[8 + tk] = y[2][tk][0] * y[2][tk][0] + y[2][tk][1] * y[2][tk][1]; }
#pragma unroll
        for (int st = 0; st < 4; ++st) { const int msk = 1 << st; const bool up = (lane & msk) != 0;
#pragma unroll
            for (int j = 0; j < (8 >> st); ++j) { const float a = ssq[2 * j], c2 = ssq[2 * j + 1]; const float keep = up ? c2 : a, send = up ? a : c2; ssq[j] = keep + __shfl_xor(send, msk); } }
        float tot = ssq[0]; tot += __shfl_xor(tot, 16); tot += __shfl_xor(tot, 32);
        const float rnl = 1.0f / sqrtf(tot + EPS);
        unsigned kd[8], qd[8];
#pragma unroll
        for (int tk = 0; tk < 8; ++tk) {
            const float rk = __builtin_bit_cast(float, __builtin_amdgcn_readlane(__builtin_bit_cast(int, rnl), tk)), rq = __builtin_bit_cast(float, __builtin_amdgcn_readlane(__builtin_bit_cast(int, rnl), 8 + tk));
            float k0 = y[0][tk][0] * rk, k1 = y[0][tk][1] * rk, q0 = y[2][tk][0] * rq, q1 = y[2][tk][1] * rq;
            if (tb < 1024) { const f32x4 c4 = cs[tk];
                const float pk0 = __shfl_xor(k0, 16), pk1 = __shfl_xor(k1, 16), pq0 = __shfl_xor(q0, 16), pq1 = __shfl_xor(q1, 16);
                if (!second) { k0 = k0 * c4[0] - pk0 * c4[1]; k1 = k1 * c4[2] - pk1 * c4[3]; q0 = q0 * c4[0] - pq0 * c4[1]; q1 = q1 * c4[2] - pq1 * c4[3]; }
                else { k0 = k0 * c4[0] + pk0 * c4[1]; k1 = k1 * c4[2] + pk1 * c4[3]; q0 = q0 * c4[0] + pq0 * c4[1]; q1 = q1 * c4[2] + pq1 * c4[3]; } }
            q0 *= 0.08838834764831845f; q1 *= 0.08838834764831845f;
            y[0][tk][0] = k0; y[0][tk][1] = k1; y[2][tk][0] = q0; y[2][tk][1] = q1;
            kd[tk] = pk2(k0, k1); qd[tk] = pk2(q0, q1);
        }
        { const bool l2 = (lane & 2) == 0, l1 = (lane & 1) == 0;
#define DN_QT4(d) do { unsigned r0_ = (unsigned)__shfl_xor((int)(l2 ? d[2] : d[0]), 2), r1_ = (unsigned)__shfl_xor((int)(l2 ? d[3] : d[1]), 2); d[2] = l2 ? r0_ : d[2]; d[3] = l2 ? r1_ : d[3]; d[0] = l2 ? d[0] : r0_; d[1] = l2 ? d[1] : r1_; \
            r0_ = (unsigned)__shfl_xor((int)(l1 ? d[1] : d[0]), 1); r1_ = (unsigned)__shfl_xor((int)(l1 ? d[3] : d[2]), 1); d[1] = l1 ? r0_ : d[1]; d[3] = l1 ? r1_ : d[3]; d[0] = l1 ? d[0] : r0_; d[2] = l1 ? d[2] : r1_; } while (0)
          unsigned ka[4] = {kd[0], kd[1], kd[2], kd[3]}, kb2[4] = {kd[4], kd[5], kd[6], kd[7]}, qa[4] = {qd[0], qd[1], qd[2], qd[3]}, qb2[4] = {qd[4], qd[5], qd[6], qd[7]};
          DN_QT4(ka); DN_QT4(kb2); DN_QT4(qa); DN_QT4(qb2);
#undef DN_QT4
          const size_t fo2 = ((((((size_t)(b * 8 + hd) * 68 + (P0 >> 6)) * 4 + ((P0 >> 4) & 3)) * 4 + (lane >> 4)) * 4 + ((lane >> 2) & 3)) * 16 + (P0 & 15) + (lane & 3)) * 8;
          *(v4u*)(KB + fo2) = (v4u){ka[0], ka[1], ka[2], ka[3]}; *(v4u*)(KB + fo2 + 32) = (v4u){kb2[0], kb2[1], kb2[2], kb2[3]};
          *(v4u*)(QB + fo2) = (v4u){qa[0], qa[1], qa[2], qa[3]}; *(v4u*)(QB + fo2 + 32) = (v4u){qb2[0], qb2[1], qb2[2], qb2[3]}; }
        const size_t fo = (((((size_t)(b * 8 + hd) * 68 + (P0 >> 6)) * 8 + (lane >> 3)) * 2 + ((P0 >> 5) & 1)) * 64 + ((P0 >> 3) & 3) * 16 + 2 * (lane & 7)) * 8;
        bf16* ktp = KT + fo; bf16* vtp = VT2 + fo;
        *(v4u*)(ktp) = (v4u){pk2(y[0][0][0], y[0][1][0]), pk2(y[0][2][0], y[0][3][0]), pk2(y[0][4][0], y[0][5][0]), pk2(y[0][6][0], y[0][7][0])};
        *(v4u*)(ktp + 8) = (v4u){pk2(y[0][0][1], y[0][1][1]), pk2(y[0][2][1], y[0][3][1]), pk2(y[0][4][1], y[0][5][1]), pk2(y[0][6][1], y[0][7][1])};
        *(v4u*)(vtp) = (v4u){pk2(y[1][0][0], y[1][1][0]), pk2(y[1][2][0], y[1][3][0]), pk2(y[1][4][0], y[1][5][0]), pk2(y[1][6][0], y[1][7][0])};
        *(v4u*)(vtp + 8) = (v4u){pk2(y[1][0][1], y[1][1][1]), pk2(y[1][2][1], y[1][3][1]), pk2(y[1][4][1], y[1][5][1]), pk2(y[1][6][1], y[1][7][1])};
        if (lane < 16) { const int row = row0 + (lane & 7), dir = lane >> 3;
            const float alpha = zab[(size_t)row * 32 + dir * 8 + hd], bz = zab[(size_t)row * 32 + 16 + dir * 8 + hd];
            const float xs = alpha + dt_bias[dir * 8 + hd]; const float sp = xs > 20.f ? xs : log1pf(expf(xs));
            gout[(size_t)row * 16 + dir * 8 + hd] = -expf(a_log[dir * 8 + hd]) * sp;
            bout[(size_t)row * 16 + dir * 8 + hd] = 1.0f / (1.0f + expf(-bz)); }
    }
}
#undef DN_LOADZ


constexpr int NINST = 2 * 8 * 2 * 68;
__device__ __forceinline__ int chunk_P0(int dir, int n) { return dir == 0 ? 64 * n : (n < 4 ? CTXL - 64 * (n + 1) : NPOS - 64 * (n - 3)); }
__device__ __forceinline__ void dn_chunk_phase(const bf16* KB, const bf16* QB, const bf16* KT, const bf16* VT2, const float* G, const float* BETA, bf16* WB, float* UB, bf16* QKM, float* EGb,
                                               LAS unsigned char* lds, int lane, int wave, int gw, int NGW) {
    LAS float* AL = (LAS float*)(lds + wave * 16384);
    LAS unsigned short* T1L = (LAS unsigned short*)AL; LAS unsigned short* T2L = T1L + 4096;
    LAS float* SV = (LAS float*)(lds + RING_BYTES + 1024 + wave * 1024);
    const int q16 = lane & 15, g = lane >> 4;
#pragma unroll 1
    for (int inst = gw; inst < NINST; inst += NGW) {
        const int n = inst % 68, rr = inst / 68, dir = rr & 1, hd = (rr >> 1) & 7, b = rr >> 4;
        const int P0 = chunk_P0(dir, n);
        const int rowi = pos_row(b, dir ? P0 + 63 - lane : P0 + lane);
        const float bi = BETA[(size_t)rowi * 16 + dir * 8 + hd];
        float gc = G[(size_t)rowi * 16 + dir * 8 + hd];
#pragma unroll
        for (int o = 1; o < 64; o <<= 1) { const float t = __shfl_up(gc, o); if (lane >= o) gc += t; }
        asm volatile("s_waitcnt lgkmcnt(0)" ::: "memory");
        SV[lane] = gc; SV[64 + lane] = bi;
        asm volatile("s_waitcnt lgkmcnt(0)" ::: "memory");
        const float gc63 = __shfl(gc, 63);
        EGb[(size_t)inst * 128 + lane] = __expf(gc); EGb[(size_t)inst * 128 + 64 + lane] = __expf(gc63 - gc);
        bf16x8_t kf[4][4];
        const size_t fb0 = ((size_t)(b * 8 + hd) * 68 + (P0 >> 6)) * 4; const int q16p = dir ? 15 - q16 : q16;
#pragma unroll
        for (int blk = 0; blk < 4; ++blk) {
#pragma unroll
            for (int ks = 0; ks < 4; ++ks) kf[blk][ks] = *(const bf16x8_t*)(KB + ((((fb0 + (dir ? 3 - blk : blk)) * 4 + ks) * 4 + g) * 16 + q16p) * 8); }
#pragma unroll
        for (int ib = 0; ib < 4; ++ib) {
            const int i = 16 * ib + q16; const float gci = SV[i], bti = SV[64 + i];
            bf16x8_t qfr[4];
#pragma unroll
            for (int ks = 0; ks < 4; ++ks) qfr[ks] = *(const bf16x8_t*)(QB + ((((fb0 + (dir ? 3 - ib : ib)) * 4 + ks) * 4 + g) * 16 + q16p) * 8);
#pragma unroll
            for (int jb = 0; jb < 4; ++jb) {
                v2u qo = {0u, 0u};
                if (jb <= ib) {
                    f32x4 ck = {0.f, 0.f, 0.f, 0.f}, cq = ck;
#pragma unroll
                    for (int ks = 0; ks < 4; ++ks) { ck = __builtin_amdgcn_mfma_f32_16x16x32_bf16(kf[jb][ks], kf[ib][ks], ck, 0, 0, 0); cq = __builtin_amdgcn_mfma_f32_16x16x32_bf16(kf[jb][ks], qfr[ks], cq, 0, 0, 0); }
                    const f32x4 gcj = *(const LAS f32x4*)(SV + 16 * jb + 4 * g);
                    f32x4 av, qv;
#pragma unroll
                    for (int e = 0; e < 4; ++e) { const int j = 16 * jb + 4 * g + e; const float dec = __expf(gci - gcj[e]);
                        av[e] = (i > j) ? bti * ck[e] * dec : 0.f; qv[e] = (i >= j) ? cq[e] * dec : 0.f; }
                    *(LAS f32x4*)(AL + i * 64 + 16 * jb + 4 * g) = av;
                    qo.x = pk2(qv[0], qv[1]); qo.y = pk2(qv[2], qv[3]);
                }
                *(v2u*)(QKM + ((((size_t)inst * 4 + ib) * 2 + (jb >> 1)) * 64 + (2 * (jb & 1) + (g >> 1)) * 16 + q16) * 8 + 4 * (g & 1)) = qo;
            }
        }
        asm volatile("s_waitcnt lgkmcnt(0)" ::: "memory");
        float T[64];
        {
            T[0] = (lane == 0) ? 1.f : 0.f;
#pragma unroll
            for (int i = 1; i < 64; ++i) {
                float acc0 = (lane == i) ? 1.f : 0.f, acc1 = 0.f;
#pragma unroll
                for (int hb = 0; hb < 2; ++hb) {
                    if (8 * hb < (i + 3) / 4) {
                        f32x4 rowc[8];
#pragma unroll
                        for (int jj = 0; jj < 8; ++jj) rowc[jj] = *(const LAS f32x4*)(AL + i * 64 + 32 * hb + 4 * jj);
#pragma unroll
                        for (int jj = 0; jj < 8; ++jj) {
#pragma unroll
                            for (int e = 0; e < 4; ++e) if (32 * hb + 4 * jj + e < i) { if (jj & 1) acc1 -= rowc[jj][e] * T[32 * hb + 4 * jj + e]; else acc0 -= rowc[jj][e] * T[32 * hb + 4 * jj + e]; } }
                    }
                }
                T[i] = acc0 + acc1;
            }
        }
        asm volatile("s_waitcnt lgkmcnt(0)" ::: "memory");
        { const float s1 = bi, s2 = bi * __expf(gc); const int pc = dir ? 63 - lane : lane;
#pragma unroll
          for (int i = 0; i < 64; ++i) { T1L[i * 64 + pc] = (unsigned short)(pk2(T[i] * s1, 0.f) & 0xffffu); T2L[i * 64 + pc] = (unsigned short)(pk2(T[i] * s2, 0.f) & 0xffffu); } }
        asm volatile("s_waitcnt lgkmcnt(0)" ::: "memory");
        const size_t fb = (((size_t)(b * 8 + hd) * 68 + (P0 >> 6)) * 16 * 64 + lane) * 8;
        const bf16* vtb = VT2 + fb; const bf16* ktb = KT + fb;
#pragma unroll
        for (int half = 0; half < 2; ++half) {
            bf16x8_t xf[8][2];
#pragma unroll
            for (int db = 0; db < 8; ++db)
#pragma unroll
                for (int ks = 0; ks < 2; ++ks) xf[db][ks] = *(const bf16x8_t*)((half ? ktb : vtb) + (2 * db + ks) * 512);
#pragma unroll
            for (int ib = 0; ib < 4; ++ib) {
                bf16x8_t tf[2];
#pragma unroll
                for (int ks = 0; ks < 2; ++ks) tf[ks] = *(const LAS bf16x8_t*)((half ? T2L : T1L) + (16 * ib + q16) * 64 + 32 * ks + 8 * g);
#pragma unroll
                for (int db = 0; db < 8; ++db) {
                    f32x4 c = {0.f, 0.f, 0.f, 0.f};
                    if (half == 0) {
#pragma unroll
                        for (int ks = 0; ks < 2; ++ks) c = __builtin_amdgcn_mfma_f32_16x16x32_bf16(tf[ks], xf[db][ks], c, 0, 0, 0);
                        *(f32x4*)(UB + (((size_t)inst * 8 + db) * 4 + ib) * 256 + lane * 4) = c;
                    } else {
#pragma unroll
                        for (int ks = 0; ks < 2; ++ks) c = __builtin_amdgcn_mfma_f32_16x16x32_bf16(xf[db][ks], tf[ks], c, 0, 0, 0);
                        v2u o; o.x = pk2(c[0], c[1]); o.y = pk2(c[2], c[3]);
                        *(v2u*)(WB + ((((size_t)inst * 4 + ib) * 4 + (db >> 1)) * 64 + (2 * (db & 1) + (g >> 1)) * 16 + q16) * 8 + 4 * (g & 1)) = o;
                    }
                }
            }
        }
        asm volatile("s_waitcnt lgkmcnt(0)" ::: "memory");
    }
}

struct DnStSet { bf16x8_t wf[4], kt[2][2]; f32x4 u4, ek4; float dec; };
struct DnOutSet { bf16x8_t qf[4], qk[2]; f32x4 eg4; int orow[4]; };
__device__ __forceinline__ void dn_scan_phase(const bf16* QB, const bf16* KT, const bf16* WB, const float* UB, const bf16* QKM, const float* EGb, float* OF, float* OB,
                                              LAS unsigned char* lds, int tid, int bid, int G) {
    const int wave = __builtin_amdgcn_readfirstlane(tid >> 6), lane = tid & 63, q16 = lane & 15, g = lane >> 4, rb = wave & 3;
    LAS unsigned short* SbL = (LAS unsigned short*)lds;
    LAS unsigned short* VnL = SbL + 16 * 136;
    LAS unsigned short* Vn2L = VnL + 16 * 72;
#pragma unroll 1
    for (int unit = bid; unit < 256; unit += G) {
        const int dvb = (unit >> 3) & 7, chain = 4 * (unit & 7) + (unit >> 6), dir = chain & 1, hd = (chain >> 1) & 7, b = chain >> 4;
        __syncthreads();
        for (int i = tid; i < 16 * 136 / 2; i += NTHR) ((LAS unsigned*)SbL)[i] = 0u;
        __syncthreads();
        float* od = dir ? OB : OF;
        if (wave < 4) {
            f32x4 s0 = {0.f, 0.f, 0.f, 0.f}, s1 = s0;
            const bf16* ktb = KT + ((size_t)(b * 8 + hd) * 68 * 16 * 64 + (size_t)(4 * rb) * 64 + lane) * 8;
            DnStSet st[3];
#define DN_LOAD_ST(S_, n_) do { const size_t inst_ = (size_t)chain * 68 + (n_); const int P0_ = chunk_P0(dir, (n_)); \
                _Pragma("unroll") for (int ks = 0; ks < 4; ++ks) S_.wf[ks] = *(const bf16x8_t*)(WB + (((inst_ * 4 + rb) * 4 + ks) * 64 + lane) * 8); \
                _Pragma("unroll") for (int t = 0; t < 2; ++t) _Pragma("unroll") for (int ks = 0; ks < 2; ++ks) S_.kt[t][ks] = *(const bf16x8_t*)(ktb + ((size_t)(P0_ >> 6) * 16 + 2 * t + ks) * 512); \
                S_.u4 = *(const f32x4*)(UB + ((inst_ * 8 + dvb) * 4 + rb) * 256 + lane * 4); S_.ek4 = *(const f32x4*)(EGb + inst_ * 128 + 64 + 16 * rb + 4 * g); S_.dec = EGb[inst_ * 128 + 63]; } while (0)
#define DN_STEP_ST(j_, n_) do { if ((n_) + 2 < 68) DN_LOAD_ST(st[((j_) + 2) % 3], (n_) + 2); \
        bf16x8_t sf[4]; \
        _Pragma("unroll") \
        for (int ks = 0; ks < 4; ++ks) sf[ks] = *(const LAS bf16x8_t*)(SbL + q16 * 136 + 32 * ks + 8 * g); \
        f32x4 acc = {0.f, 0.f, 0.f, 0.f}; \
        _Pragma("unroll") \
        for (int ks = 0; ks < 4; ++ks) acc = __builtin_amdgcn_mfma_f32_16x16x32_bf16(st[(j_)].wf[ks], sf[ks], acc, 0, 0, 0); \
        const f32x4 v = st[(j_)].u4 - acc; \
        { v2u o; o.x = pk2(v[0], v[1]); o.y = pk2(v[2], v[3]); *(LAS v2u*)(VnL + q16 * 72 + 16 * rb + 4 * g) = o; \
        const f32x4 vs = v * st[(j_)].ek4; v2u o2; \
        if (dir == 0) { o2.x = pk2(vs[0], vs[1]); o2.y = pk2(vs[2], vs[3]); *(LAS v2u*)(Vn2L + q16 * 72 + 16 * rb + 4 * g) = o2; } \
        else { o2.x = pk2(vs[3], vs[2]); o2.y = pk2(vs[1], vs[0]); *(LAS v2u*)(Vn2L + q16 * 72 + 60 - 16 * rb - 4 * g) = o2; } } \
        __syncthreads(); \
        bf16x8_t vf[2]; \
        _Pragma("unroll") \
        for (int ks = 0; ks < 2; ++ks) vf[ks] = *(const LAS bf16x8_t*)(Vn2L + q16 * 72 + 32 * ks + 8 * g); \
        s0 *= st[(j_)].dec; s1 *= st[(j_)].dec; \
        _Pragma("unroll") \
        for (int ks = 0; ks < 2; ++ks) { s0 = __builtin_amdgcn_mfma_f32_16x16x32_bf16(st[(j_)].kt[0][ks], vf[ks], s0, 0, 0, 0); s1 = __builtin_amdgcn_mfma_f32_16x16x32_bf16(st[(j_)].kt[1][ks], vf[ks], s1, 0, 0, 0); } \
        { v2u o; o.x = pk2(s0[0], s0[1]); o.y = pk2(s0[2], s0[3]); *(LAS v2u*)(SbL + q16 * 136 + 32 * rb + 4 * g) = o; \
        o.x = pk2(s1[0], s1[1]); o.y = pk2(s1[2], s1[3]); *(LAS v2u*)(SbL + q16 * 136 + 32 * rb + 16 + 4 * g) = o; } \
        __syncthreads(); } while (0)
            DN_LOAD_ST(st[0], 0); DN_LOAD_ST(st[1], 1);
#pragma unroll 1
            for (int n3 = 0; n3 < 66; n3 += 3) { DN_STEP_ST(0, n3); DN_STEP_ST(1, n3 + 1); DN_STEP_ST(2, n3 + 2); }
            DN_STEP_ST(0, 66); DN_STEP_ST(1, 67);
#undef DN_STEP_ST
#undef DN_LOAD_ST
        } else {
            DnOutSet os[3];
#define DN_LOAD_OUT(S_, n_) do { const size_t inst_ = (size_t)chain * 68 + (n_); const int P0_ = chunk_P0(dir, (n_)); const int i_ = 16 * rb + q16; \
                const size_t qb_ = (((size_t)(b * 8 + hd) * 68 + (P0_ >> 6)) * 4 + (dir ? 3 - rb : rb)) * 4; (void)i_; \
                _Pragma("unroll") for (int ks = 0; ks < 4; ++ks) S_.qf[ks] = *(const bf16x8_t*)(QB + (((qb_ + ks) * 4 + g) * 16 + (dir ? 15 - q16 : q16)) * 8); \
                _Pragma("unroll") for (int ks = 0; ks < 2; ++ks) S_.qk[ks] = *(const bf16x8_t*)(QKM + (((inst_ * 4 + rb) * 2 + ks) * 64 + lane) * 8); \
                S_.eg4 = *(const f32x4*)(EGb + inst_ * 128 + 16 * rb + 4 * g); \
                _Pragma("unroll") for (int e = 0; e < 4; ++e) { const int io_ = 16 * rb + 4 * g + e; S_.orow[e] = pos_row(b, dir ? P0_ + 63 - io_ : P0_ + io_); } } while (0)
#define DN_STEP_OUT(j_, n_) do { if ((n_) + 2 < 68) DN_LOAD_OUT(os[((j_) + 2) % 3], (n_) + 2); \
        bf16x8_t sf[4]; \
        _Pragma("unroll") \
        for (int ks = 0; ks < 4; ++ks) sf[ks] = *(const LAS bf16x8_t*)(SbL + q16 * 136 + 32 * ks + 8 * g); \
        f32x4 oacc = {0.f, 0.f, 0.f, 0.f}; \
        _Pragma("unroll") \
        for (int ks = 0; ks < 4; ++ks) oacc = __builtin_amdgcn_mfma_f32_16x16x32_bf16(os[(j_)].qf[ks], sf[ks], oacc, 0, 0, 0); \
        oacc *= os[(j_)].eg4; \
        __syncthreads(); \
        bf16x8_t vf[2]; \
        _Pragma("unroll") \
        for (int ks = 0; ks < 2; ++ks) vf[ks] = *(const LAS bf16x8_t*)(VnL + q16 * 72 + 32 * ks + 8 * g); \
        _Pragma("unroll") \
        for (int ks = 0; ks < 2; ++ks) oacc = __builtin_amdgcn_mfma_f32_16x16x32_bf16(os[(j_)].qk[ks], vf[ks], oacc, 0, 0, 0); \
        _Pragma("unroll") \
        for (int e = 0; e < 4; ++e) od[(size_t)os[(j_)].orow[e] * 1024 + hd * 128 + 16 * dvb + q16] = oacc[e]; \
        __syncthreads(); } while (0)
            DN_LOAD_OUT(os[0], 0); DN_LOAD_OUT(os[1], 1);
#pragma unroll 1
            for (int n3 = 0; n3 < 66; n3 += 3) { DN_STEP_OUT(0, n3); DN_STEP_OUT(1, n3 + 1); DN_STEP_OUT(2, n3 + 2); }
            DN_STEP_OUT(0, 66); DN_STEP_OUT(1, 67);
#undef DN_STEP_OUT
#undef DN_LOAD_OUT
        }
    }
}

__device__ __forceinline__ void gm_item2(int chunk, int grp, const bf16* z, const float* vn, const float* __restrict__ sw  , const float* __restrict__ sb  , bf16* ycat, bool stage_w, LAS unsigned char* lds, int tid) {
    LAS unsigned short* WL = (LAS unsigned short*)lds;
    LAS unsigned short* VL = WL + 128 * 136;
    const int row0 = chunk < 64 ? chunk * 128 : TL + (chunk - 64) * 128;
    __syncthreads();
    if (stage_w)
    for (int i = tid; i < 128 * 32; i += NTHR) { const int pp = i >> 5, q4 = (i & 31) * 4;
        const f32x4 w = *(const f32x4*)(sw + (size_t)grp * 16384 + pp * 128 + q4);
        v2u o; o.x = pk2(w[0], w[1]); o.y = pk2(w[2], w[3]); *(LAS v2u*)(WL + pp * 136 + q4) = o; }
    for (int i = tid; i < 128 * 32; i += NTHR) { const int q = i >> 5, c4 = (i & 31) * 4;
        const f32x4 v = *(const f32x4*)(vn + (size_t)(row0 + q) * 1024 + grp * 128 + c4);
        const unsigned a = pk2(v[0], v[1]), b2 = pk2(v[2], v[3]);
        VL[(c4 + 0) * 136 + q] = (unsigned short)(a & 0xffffu); VL[(c4 + 1) * 136 + q] = (unsigned short)(a >> 16);
        VL[(c4 + 2) * 136 + q] = (unsigned short)(b2 & 0xffffu); VL[(c4 + 3) * 136 + q] = (unsigned short)(b2 >> 16); }
    __syncthreads();
    const int wave = __builtin_amdgcn_readfirstlane(tid >> 6), lane = tid & 63, q16 = lane & 15, gq = lane >> 4;
    bf16x8_t af[4];
#pragma unroll
    for (int ks = 0; ks < 4; ++ks) af[ks] = *(const LAS bf16x8_t*)(VL + (16 * wave + q16) * 136 + 32 * ks + 8 * gq);
    const int c = grp * 128 + 16 * wave + 4 * gq;
#pragma unroll
    for (int pb = 0; pb < 8; ++pb) {
        f32x4 acc = {0.f, 0.f, 0.f, 0.f};
#pragma unroll
        for (int ks = 0; ks < 4; ++ks) { const bf16x8_t bfr = *(const LAS bf16x8_t*)(WL + (16 * pb + q16) * 136 + 32 * ks + 8 * gq); acc = __builtin_amdgcn_mfma_f32_16x16x32_bf16(af[ks], bfr, acc, 0, 0, 0); }
        const int pp = 16 * pb + q16; const size_t row = (size_t)(row0 + pp);
        const float bias = sb[grp * 128 + pp];
        const v2u zu = *(const v2u*)(z + row * ZW + Z_GMU + c);
        v2u o; o.x = pk2(gelu_tanh(bflo(zu.x)) * (acc[0] + bias), gelu_tanh(bfhi(zu.x)) * (acc[1] + bias)); o.y = pk2(gelu_tanh(bflo(zu.y)) * (acc[2] + bias), gelu_tanh(bfhi(zu.y)) * (acc[3] + bias));
        *(v2u*)(ycat + row * DM + c) = o;
    }
}


#define MK_ONE_LAUNCH 1

#ifndef MK_ONE_LAUNCH
#define MK_ONE_LAUNCH 1
#endif
constexpr int NPL = 15;
constexpr int NPH = 1 + NLAYER * NPL + 1;
struct Args { const float* in[24]; float* out; unsigned char* ws; int ph_lo, ph_hi; };

__global__ void __launch_bounds__(NTHR, 2) dit_fwd(Args a) {
    extern __shared__ __attribute__((aligned(16))) unsigned char lds_raw[];
    LAS unsigned char* lds = (LAS unsigned char*)lds_raw;
    volatile LAS unsigned* MISC = (volatile LAS unsigned*)(lds + MISC_OFF);
    const int G = gridDim.x, bid = blockIdx.x, NGW = G * NWAVES;
    const int wave0 = __builtin_amdgcn_readfirstlane((int)threadIdx.x >> 6);
#define PHASE_IDS() int tid = wave0 * 64 + (int)__builtin_amdgcn_mbcnt_hi(~0u, __builtin_amdgcn_mbcnt_lo(~0u, 0u)); asm volatile("" : "+v"(tid)); const int lane = tid & 63, wave = __builtin_amdgcn_readfirstlane(tid >> 6), gw = bid * NWAVES + wave; (void)lane; (void)gw
    for (int u = threadIdx.x; u < (LDS_BYTES - RING_BYTES) / 4; u += NTHR) ((LAS unsigned*)(lds + RING_BYTES))[u] = 0u;
    __syncthreads();
    unsigned char* ws0 = a.ws;
    const int lo = a.ph_lo, hi = a.ph_hi;
    XcdBarrier bar; bar.bar = (unsigned*)(ws0 + WS_CTL) + CW_BAR; bar.x = 0; bar.st = nullptr;
    if (hi - lo > 1) bar = xcd_barrier_post((unsigned*)(ws0 + WS_CTL) + CW_BAR, MISC + 8);
#define IN(k) (lo <= (k) && (k) < hi)
#define SEAM(k) do { if (IN(k) && IN((k) + 1)) xcd_barrier(bar); } while (0)

#define SUB_FIRST(b) ((((b) >> 3) & 7) < 4)
#define KAS __attribute__((address_space(4)))
#define PHASE_PTRS() const KAS char* kp_ = (const KAS char*)__builtin_amdgcn_kernarg_segment_ptr(); asm volatile("" : "+s"(kp_)); \
    unsigned char* const ws = *(unsigned char* const KAS*)(kp_ + 200); (void)ws
#define INP(i) (*(const float* const KAS*)(kp_ + 8 * (i)))
#define P_MOD ((float*)(ws + WS_MOD))
#define P_H ((float*)(ws + WS_H))
#define P_XN ((bf16*)(ws + WS_XN))
#define P_HB ((bf16*)(ws + WS_HB))
#define P_Z ((bf16*)(ws + WS_Z))
#define P_ZAB ((float*)(ws + WS_ZAB))
#define P_GG ((float*)(ws + WS_G))
#define P_BETA ((float*)(ws + WS_BETA))
#define P_OF ((float*)(ws + WS_OF))
#define P_OB ((float*)(ws + WS_OB))
#define P_VN ((float*)(ws + WS_VN))
#define P_YCAT ((bf16*)(ws + WS_YCAT))
#define P_YF ((float*)(ws + WS_YF))
#define P_YB ((bf16*)(ws + WS_YB))
#define P_VTL ((bf16*)(ws + WS_VTL))
#define P_VTC ((bf16*)(ws + WS_VTC))
#define P_KB ((bf16*)(ws + WS_KB))
#define P_QB ((bf16*)(ws + WS_QB))
#define P_KT ((bf16*)(ws + WS_KT))
#define P_VT2 ((bf16*)(ws + WS_VT2))
#define P_WB ((bf16*)(ws + WS_WB))
#define P_UB ((float*)(ws + WS_UB))
#define P_QKM ((bf16*)(ws + WS_QKM))
#define P_EG ((float*)(ws + WS_EG))
#define P_ROPE ((float*)(ws + WS_ROPE))

    if (IN(0)) { PHASE_IDS(); PHASE_PTRS();
        LAS float* scr = (LAS float*)(lds + wave * 16384);
        {
            for (int l = 0; l < NLAYER; ++l) {
                for (int s = 0; s < 2; ++s) { const size_t ls = (size_t)l * 2 + s;
                    cvt_matrix<1>(INP(7) + ls * DM * FF, DM, FF, (bf16*)(ws + WS_W13 + ls * SZ_W13), DM, 0, gw, NGW, scr, lane);
                    cvt_matrix<2>(INP(8) + ls * DM * FF, DM, FF, (bf16*)(ws + WS_W13 + ls * SZ_W13), DM, 0, gw, NGW, scr, lane);
                    cvt_matrix<0>(INP(9) + ls * FF * DM, FF, DM, (bf16*)(ws + WS_W2 + ls * SZ_W2), FF, 0, gw, NGW, scr, lane); }
                cvt_matrix<3>(INP(10) + (size_t)l * DM * INW, DM, INW, (bf16*)(ws + WS_WIN + l * SZ_WIN), DM, 0, gw, NGW, scr, lane);
                cvt_matrix<0>(INP(19) + (size_t)l * 1024 * DM, 1024, DM, (bf16*)(ws + WS_PC + l * SZ_SQ), DM, 0, gw, NGW, scr, lane);
                cvt_matrix<0>(INP(20) + (size_t)l * 1024 * DM, 1024, DM, (bf16*)(ws + WS_PC + l * SZ_SQ), DM, 1024, gw, NGW, scr, lane);
                cvt_matrix<0>(INP(21) + (size_t)l * 2048 * DM, 2048, DM, (bf16*)(ws + WS_PC + l * SZ_SQ), DM, 2048, gw, NGW, scr, lane);
                cvt_matrix<0>(INP(22) + (size_t)l * DM * DM, DM, DM, (bf16*)(ws + WS_WO + l * SZ_SQ), DM, 0, gw, NGW, scr, lane);
            }
        }
        rope_table_phase(P_ROPE, lane, gw, NGW);
        __syncthreads();
        mod_phase(INP(1), INP(3), INP(4), INP(5), P_MOD, lds, tid, lane, wave, bid, G, 0, NLAYER);
    }
    SEAM(0);

    for (int l = 0; l < NLAYER; ++l) {
        const int pb = 1 + l * NPL;
        const bool lastl = (l + 1 == NLAYER);
        for (int sub = 0; sub < 2; ++sub) {
            const int p0 = pb + (sub ? 12 : 0), isub = sub ? 2 : 0;
            const bool first = (l == 0 && sub == 0);
            const bool ctxrows = !(lastl && sub == 1);
            const int MRs = ctxrows ? MR : TL;
            if (IN(p0)) { PHASE_IDS(); PHASE_PTRS();
                const bool hasslab = ctxrows && !first;
                const float* gv = sub == 0 ? P_MOD + ((size_t)(l - 1) * 3 + 2) * MODW + (2 * 3 + 2) * DM : P_MOD + ((size_t)l * 3 + 2) * MODW + (1 * 3 + 2) * DM;
                norm_phase(first ? INP(0) : P_H, first ? INP(2) : P_H + (size_t)TL * DM, INP(6) + ((size_t)l * 3 + isub) * DM, P_MOD + (size_t)l * 3 * MODW, isub, P_XN, MRs,
                           hasslab ? (const float*)(ws + WS_SLAB) : nullptr, gv, sub == 0 ? 0.5f : 1.0f, P_H + (size_t)TL * DM, lds, tid, lane, gw, NGW); }
            SEAM(p0);
            if (IN(p0 + 1)) { PHASE_PTRS();
                pg8::Gemm g{P_XN, (const bf16*)(ws + WS_W13 + ((size_t)l * 2 + sub) * SZ_W13), MRs, 2 * FF, DM, DM, DM};
                pg8::SplitOrder S; S.init(MRs, 2 * FF, DM, G, bid, !ctxrows);
                pg8::EpiSwiGLUS E{{P_HB, FF}, (unsigned)WS_SLAB, (unsigned)(WS_CTL + CW_UF * 4)};
                pg8::gemm_phase<pg8::EpiSwiGLUS, pg8::SplitOrder, true, true>(lds, g, S, E, wave0);
            }
            SEAM(p0 + 1);
            if (IN(p0 + 2)) { PHASE_PTRS();
                pg8::Gemm g{P_HB, (const bf16*)(ws + WS_W2 + ((size_t)l * 2 + sub) * SZ_W2), MRs, DM, FF, FF, FF};
                if (lastl && sub == 1) {
                    pg8::PanelOrder S{G, bid};
                    pg8::EpiFinal E{P_H, *(float* const KAS*)(kp_ + 192), P_MOD + (size_t)l * 3 * MODW + (isub * 3 + 2) * DM, MODW, 0.5f, INP(23), (float*)(ws + WS_SLAB), (unsigned*)(ws + WS_CTL) + CW_FN, (LAS float*)(lds + RING_BYTES + 2048)};
                    pg8::gemm_phase<pg8::EpiFinal, pg8::PanelOrder, true, true>(lds, g, S, E, wave0);
                } else {
                pg8::CombOrder S; S.init(TL, DM, G, bid, 1, ctxrows, SUB_FIRST(bid));
                pg8::EpiResidSlab E{{first ? INP(0) : P_H, first ? INP(2) : P_H + (size_t)TL * DM, P_H, P_MOD + (size_t)l * 3 * MODW + (isub * 3 + 2) * DM, MODW, 0.5f}, {(float*)(ws + WS_SLAB)}};
                pg8::gemm_phase<pg8::EpiResidSlab, pg8::CombOrder, true, true>(lds, g, S, E, wave0);
                }
            }
            if (!(lastl && sub == 1)) SEAM(p0 + 2);
            if (sub == 0) {
                if (IN(pb + 3)) { PHASE_IDS(); PHASE_PTRS();
                    norm_phase(P_H, first ? INP(2) : P_H + (size_t)TL * DM, INP(6) + ((size_t)l * 3 + 1) * DM, P_MOD + (size_t)l * 3 * MODW, 1, P_XN, MR,
                               (const float*)(ws + WS_SLAB), P_MOD + ((size_t)l * 3 + 2) * MODW + (0 * 3 + 2) * DM, 0.5f, P_H + (size_t)TL * DM, lds, tid, lane, gw, NGW); }
                SEAM(pb + 3);
                if (IN(pb + 4)) { PHASE_PTRS();
                    pg8::Gemm g{P_XN, (const bf16*)(ws + WS_WIN + l * SZ_WIN), MR, ZN, DM, DM, DM}; pg8::StaticOrder S; S.init(MR, ZN, G, bid);
                    pg8::EpiZ E{P_Z, ZW, P_ZAB, ZW / 256, (bf16*)(ws + WS_GF), Z_GA / 256, (bf16*)P_YF, (bf16*)P_YF + (size_t)16 * 1024 * 1024, Z_NAK / 256, Z_NAQ / 256, P_VTL, Z_NAV / 256};
                    pg8::gemm_phase<pg8::EpiZ, pg8::StaticOrder, true, true>(lds, g, S, E, wave0);
                }
                SEAM(pb + 4);
                if (IN(pb + 5)) { PHASE_IDS(); PHASE_PTRS();
                    dn_prep3_phase(P_Z, P_ZAB, INP(11) + (size_t)l * 5 * 3072, INP(12) + l * 16, INP(13) + l * 16, P_ROPE, P_KB, P_QB, P_KT, P_VT2, P_GG, P_BETA, lane, gw, NGW);
                    gm_prep_phase(P_Z, INP(17) + (size_t)l * 1024, P_VN, lane, (gw + NGW / 2) % NGW, NGW);
                    vt_phase(P_Z, P_VTL, P_VTC, lds, lane, wave, gw, NGW);
                }
                SEAM(pb + 5);
                if (IN(pb + 6)) { PHASE_IDS(); PHASE_PTRS();
                    dn_chunk_phase(P_KB, P_QB, P_KT, P_VT2, P_GG, P_BETA, P_WB, P_UB, P_QKM, P_EG, lds, lane, wave, gw, NGW);
                    { unsigned* aq = (unsigned*)(ws + WS_CTL) + CW_AQ + (l * 8 + (bid & 7)) * 32; volatile LAS unsigned* slot = (volatile LAS unsigned*)(lds + RING_BYTES);
                      int last_bh = -1;
                      for (;;) {
                          __syncthreads();
                          if (tid == 0) *slot = __hip_atomic_fetch_add(aq, 1u, __ATOMIC_RELAXED, __HIP_MEMORY_SCOPE_AGENT);
                          __syncthreads();
                          const unsigned j = *slot;
                          if (j >= 128u) break;
                          const int it = (int)(8u * j) + (bid & 7), ibh = attn_item_bh(it);
                          attn_wg(it, P_Z, P_VTL, (const bf16*)P_YF, (const bf16*)P_YF + (size_t)16 * 1024 * 1024, P_VTC, INP(18) + (size_t)l * 16 * 465, P_YCAT, !lastl, ibh != last_bh, lds, tid);
                          last_bh = ibh;
                      } }
                }
                SEAM(pb + 6);
                if (IN(pb + 7)) { PHASE_IDS(); PHASE_PTRS();
                    dn_scan_phase(P_QB, P_KT, P_WB, P_UB, P_QKM, P_EG, P_OF, P_OB, lds, tid, bid, G);
                    { unsigned* gq = (unsigned*)(ws + WS_CTL) + CW_AQ + (16 + l) * 32; volatile LAS unsigned* slot = (volatile LAS unsigned*)(lds + RING_BYTES); const unsigned nit = (lastl ? 64 : 68) * 8; int last_grp = -1;
                      for (;;) {
                          __syncthreads();
                          if (tid == 0) *slot = __hip_atomic_fetch_add(gq, 1u, __ATOMIC_RELAXED, __HIP_MEMORY_SCOPE_AGENT);
                          __syncthreads();
                          const unsigned it = *slot;
                          if (it >= nit) break;
                          gm_item2((int)(it >> 3), (int)(it & 7), P_Z, P_VN, INP(15) + (size_t)l * 8 * 16384, INP(16) + (size_t)l * 1024, P_YCAT, (int)(it & 7) != last_grp, lds, tid);
                          last_grp = (int)(it & 7);
                      } }
                }
                SEAM(pb + 7);
                if (IN(pb + 8)) { PHASE_IDS(); PHASE_PTRS(); dn_out_phase(P_OF, P_OB, P_Z, INP(14) + (size_t)l * 128, P_YCAT, lastl ? TL : MR, lane, gw, NGW); }
                SEAM(pb + 8);
                if (IN(pb + 9)) { PHASE_PTRS();
                    const bf16* pc = (const bf16*)(ws + WS_PC + l * SZ_SQ);
                    pg8::CombOrder S; S.init(TL, DM, G, bid, 0, !lastl, SUB_FIRST(bid)); pg8::Gemm g{P_YCAT, pc, lastl ? TL : MR, DM, DM, DM, DM};
                    pg8::EpiMergeHS E{{(const bf16*)(ws + WS_GF), P_YB}, {(float*)(ws + WS_SLAB)}};
                    pg8::gemm_phase<pg8::EpiMergeHS, pg8::CombOrder, true, true>(lds, g, S, E, wave0);
                }
                SEAM(pb + 9);
                if (IN(pb + 10)) { PHASE_IDS(); PHASE_PTRS(); if (!lastl) merge_ctx_phase((const float*)(ws + WS_SLAB), P_Z, P_YB, lane, gw, NGW); }
                if (!lastl) SEAM(pb + 10);
                if (IN(pb + 11)) { PHASE_PTRS();
                    pg8::Gemm g{P_YB, (const bf16*)(ws + WS_WO + l * SZ_SQ), lastl ? TL : MR, DM, DM, DM, DM};
                    pg8::CombOrder S; S.init(TL, DM, G, bid, 0, !lastl, SUB_FIRST(bid));
                    pg8::EpiResidSlab E{{P_H, P_H + (size_t)TL * DM, P_H, P_MOD + (size_t)l * 3 * MODW + (1 * 3 + 2) * DM, MODW, 1.0f}, {(float*)(ws + WS_SLAB)}};
                    pg8::gemm_phase<pg8::EpiResidSlab, pg8::CombOrder, true, true>(lds, g, S, E, wave0);
                }
                SEAM(pb + 11);
            }
        }
    }
#undef IN
#undef SEAM
}

extern "C" void kernel_launch(void* const* d_in, const int* in_sizes, int n_in, void* d_out, int out_size, void* d_ws, size_t ws_size, hipStream_t stream) {
    static int grid = 0;
    if (grid == 0) {
        if (n_in != 24 || out_size != TL * DM || ws_size < WS_END) { fprintf(stderr, "kernel_launch: unexpected shapes (n_in %d, out %d, ws %zu < %zu); nothing launched\n", n_in, out_size, ws_size, (size_t)WS_END); grid = -1; return; }
        int dev = 0, cus = 0, per_cu = 0;
        if (hipGetDevice(&dev) != hipSuccess || hipDeviceGetAttribute(&cus, hipDeviceAttributeMultiprocessorCount, dev) != hipSuccess) { grid = -1; return; }
        if (hipFuncSetAttribute((const void*)dit_fwd, hipFuncAttributeMaxDynamicSharedMemorySize, LDS_BYTES) != hipSuccess) { fprintf(stderr, "kernel_launch: hipFuncSetAttribute failed\n"); grid = -1; return; }
        if (hipOccupancyMaxActiveBlocksPerMultiprocessor(&per_cu, (const void*)dit_fwd, NTHR, LDS_BYTES) != hipSuccess || per_cu < 1) { fprintf(stderr, "kernel_launch: occupancy query reports %d\n", per_cu); }
        (void)hipGetLastError();
        grid = cus;
        if (grid % 16 != 0) { fprintf(stderr, "kernel_launch: %d CUs: the row-panel exchange of the last GEMM needs a multiple of 16 workgroups; nothing launched\n", grid); grid = -1; return; }
    }
    if (grid < 0) return;
    if (hipMemsetAsync((char*)d_ws + WS_CTL, 0, CTL_ZERO_BYTES, stream) != hipSuccess) return;
    Args a{};
    for (int i = 0; i < 24; ++i) a.in[i] = (const float*)d_in[i];
    a.out = (float*)d_out; a.ws = (unsigned char*)d_ws;
#if MK_ONE_LAUNCH
    a.ph_lo = 0; a.ph_hi = NPH;
    hipLaunchKernelGGL(dit_fwd, dim3(grid), dim3(NTHR), LDS_BYTES, stream, a);
#else
    for (int p = 0; p < NPH; ++p) { a.ph_lo = p; a.ph_hi = p + 1; hipLaunchKernelGGL(dit_fwd, dim3(grid), dim3(NTHR), LDS_BYTES, stream, a); }
#endif
}
```

```cpp
#include <hip/hip_runtime.h>
#include <cstdio>
#include <cstdint>

namespace pg8 {
#define PG8_LAS __attribute__((address_space(3)))
typedef unsigned short bf16_t;
typedef short bf16x8 __attribute__((ext_vector_type(8)));
typedef float f32x4 __attribute__((ext_vector_type(4)));
typedef unsigned u32x4 __attribute__((ext_vector_type(4)));
constexpr int BM = 256, BK = 64, HALF = 128, HTB = HALF * BK * 2  , STAGE_BYTES = 8 * HTB, NXCD = 8, WGM = 8;

__host__ __device__ __forceinline__ int lds_byte(int r, int c) { const int st = (r >> 4) * 2 + (c >> 5), rr = r & 15, cc = c & 31, ob = rr * 64 + cc * 2; return st * 1024 + (ob ^ (((ob >> 9) & 1) << 5)); }
__host__ __device__ __forceinline__ void stage_rc(int b, int& R, int& C) { const int st = b / 1024, sb = b % 1024, swz = sb ^ (((sb >> 9) & 1) << 5); R = (st >> 1) * 16 + swz / 64; C = (st & 1) * 32 + (swz % 64) / 2; }
__host__ __device__ __forceinline__ int perm32(int rho) { const int n = rho >> 4, i = rho & 15; return 8 * (i >> 2) + 4 * n + (i & 3); }

struct Unit { int pm, pn, kt0, nt, ks; };
struct Gemm { const bf16_t* A; const bf16_t* Bt; int M, N, K, lda, ldb; };

struct StaticOrder {
    int nM, nN, nwg, G, c;
    __host__ __device__ void init(int M, int N, int G_, int c_) { nM = M / BM; nN = N / BM; nwg = nM * nN; G = G_; c = c_; }
    __host__ __device__ bool next(int i, Unit& u) const {
        const long L = (long)i * G + c; if (L >= nwg) return false;
        int wgid = (int)L; { const int q = nwg / NXCD, r = nwg % NXCD, xcd = wgid % NXCD, off = wgid / NXCD; wgid = (xcd < r ? xcd * (q + 1) : r * (q + 1) + (xcd - r) * q) + off; }
        const int nig = WGM * nN, gid = wgid / nig, fm = gid * WGM, gsz = (nM - fm) < WGM ? (nM - fm) : WGM;
        u.pm = fm + ((wgid % nig) % gsz); u.pn = (wgid % nig) / gsz; u.kt0 = 0; u.nt = 0; u.ks = -1; return true;
    }
    __device__ __forceinline__ void a_ready(const Unit&) const {}
    __device__ __forceinline__ void done(const Unit&) const {}
};

struct SubOrder {
    int G, c, kmode;
    __device__ __forceinline__ bool next(int i, Unit& u) const {
        const int idx = i * G + c; if (idx >= 256) return false;
        const int tile = idx >> 3, ks = idx & 7; u.pm = 32 + (tile >> 4); u.pn = tile & 15; u.ks = ks;
        if (kmode == 0) { u.kt0 = 8 * ks; u.nt = 8; } else { u.kt0 = ks < 4 ? 12 * ks : 48 + 10 * (ks - 4); u.nt = ks < 4 ? 12 : 10; }
        return true;
    }
    __device__ __forceinline__ void a_ready(const Unit&) const {}
    __device__ __forceinline__ void done(const Unit&) const {}
};

struct CombOrder {
    StaticOrder main; SubOrder sub; int nfirst; bool sub_first;
    __device__ __forceinline__ void init(int M, int N, int G, int c, int kmode, bool has_sub, bool sf) {
        main.init(M, N, G, c); sub = SubOrder{G, c, kmode}; sub_first = sf;
        const int my_main = c < main.nwg ? (main.nwg - c + G - 1) / G : 0, my_sub = (has_sub && c < 256) ? (256 - c + G - 1) / G : 0;
        nfirst = sf ? my_sub : (has_sub ? my_main : (1 << 30));
    }
    __device__ __forceinline__ bool next(int i, Unit& u) const {
        const bool in_first = i < nfirst, use_sub = (sub_first == in_first);
        const int j = in_first ? i : i - nfirst, G = main.G, c = main.c;
        const int idx = j * G + c, idc = idx < 255 ? idx : 255, tile = idc >> 3, ks = idc & 7;
        const int kt0s = sub.kmode == 0 ? 8 * ks : (ks < 4 ? 12 * ks : 48 + 10 * (ks - 4)), nts = sub.kmode == 0 ? 8 : (ks < 4 ? 12 : 10);
        int wgid = idx < main.nwg - 1 ? idx : main.nwg - 1;
        { const int q = main.nwg / NXCD, r = main.nwg % NXCD, xcd = wgid % NXCD, off = wgid / NXCD; wgid = (xcd < r ? xcd * (q + 1) : r * (q + 1) + (xcd - r) * q) + off; }
        const int nig = WGM * main.nN, gid = wgid / nig, fm = gid * WGM, gsz = (main.nM - fm) < WGM ? (main.nM - fm) : WGM;
        const int pmm = fm + ((wgid % nig) % gsz), pnm = (wgid % nig) / gsz;
        u.pm = use_sub ? 32 + (tile >> 4) : pmm; u.pn = use_sub ? (tile & 15) : pnm; u.kt0 = use_sub ? kt0s : 0; u.nt = use_sub ? nts : 0; u.ks = use_sub ? ks : -1;
        return use_sub ? idx < 256 : idx < main.nwg;
    }
    __device__ __forceinline__ void a_ready(const Unit&) const {}
    __device__ __forceinline__ void done(const Unit&) const {}
};

struct SplitOrder {
    int nM, nN, nwg, G, c, nfull, hk; bool split;
    __device__ __forceinline__ void init(int M, int N, int K, int G_, int c_, bool want) { nM = M / BM; nN = N / BM; nwg = nM * nN; G = G_; c = c_; nfull = nwg / G; hk = K / BK / 2;
        split = want && (nwg - nfull * G) * 2 == G && (hk & 1) == 0; }
    __device__ __forceinline__ bool next(int i, Unit& u) const {
        const bool half = split && i >= nfull;
        const int L = half ? nfull * G + (c >> 1) : i * G + c;
        int wgid = L < nwg - 1 ? L : nwg - 1;
        { const int q = nwg / NXCD, r = nwg % NXCD, xcd = wgid % NXCD, off = wgid / NXCD; wgid = (xcd < r ? xcd * (q + 1) : r * (q + 1) + (xcd - r) * q) + off; }
        const int nig = WGM * nN, gid = wgid / nig, fm = gid * WGM, gsz = (nM - fm) < WGM ? (nM - fm) : WGM;
        u.pm = fm + ((wgid % nig) % gsz); u.pn = (wgid % nig) / gsz; u.kt0 = half ? (c & 1) * hk : 0; u.nt = half ? hk : 0; u.ks = half ? c : -1;
        return half ? i == nfull : L < nwg;
    }
    __device__ __forceinline__ void a_ready(const Unit&) const {}
    __device__ __forceinline__ void done(const Unit&) const {}
};

struct PanelOrder {
    int G, c;
    __device__ __forceinline__ bool next(int i, Unit& u) const {
        const int x = c & 7, j = c >> 3, xa = G == 256;
        const int pl = xa ? 4 * (x >> 1) + (j & 3) : (c >> 4), pn = xa ? 8 * (x & 1) + (j >> 2) : (c & 15), ppr = G >> 4;
        u.pm = i * ppr + pl; u.pn = pn; u.kt0 = 0; u.nt = 0; u.ks = -1;
        return u.pm < 32;
    }
    __device__ __forceinline__ void a_ready(const Unit&) const {}
    __device__ __forceinline__ void done(const Unit&) const {}
};

typedef __bf16 pg8_bf16x2 __attribute__((ext_vector_type(2)));
__device__ __forceinline__ unsigned cvt_pk_bf16(float lo, float hi) { pg8_bf16x2 v = {(__bf16)lo, (__bf16)hi}; return __builtin_bit_cast(unsigned, v); }

__device__ __forceinline__ float bf_lo(unsigned u) { return __builtin_bit_cast(float, u << 16); }
__device__ __forceinline__ float bf_hi(unsigned u) { return __builtin_bit_cast(float, u & 0xffff0000u); }
__device__ __forceinline__ float fast_sigmoid(float x) { return __builtin_amdgcn_rcpf(1.0f + __expf(-x)); }
__device__ __forceinline__ float fast_silu(float x) { return x * fast_sigmoid(x); }
__device__ __forceinline__ int rm_src(int lane) { return (((lane >> 2) + 16 * (lane & 3)) << 2); }
__device__ __forceinline__ int mf_src(int lane) { return ((4 * (lane & 15) + (lane >> 4)) << 2); }
typedef int pg8_i32x4 __attribute__((ext_vector_type(4)));
__device__ __forceinline__ pg8_i32x4 lperm_i(const pg8_i32x4 v, int a) { pg8_i32x4 r;
    r.x = __builtin_amdgcn_ds_bpermute(a, v.x); r.y = __builtin_amdgcn_ds_bpermute(a, v.y); r.z = __builtin_amdgcn_ds_bpermute(a, v.z); r.w = __builtin_amdgcn_ds_bpermute(a, v.w); return r; }
__device__ __forceinline__ f32x4 lperm(const f32x4 v, int a) { return __builtin_bit_cast(f32x4, lperm_i(__builtin_bit_cast(pg8_i32x4, v), a)); }
__device__ __forceinline__ u32x4 lperm(const u32x4 v, int a) { return __builtin_bit_cast(u32x4, lperm_i(__builtin_bit_cast(pg8_i32x4, v), a)); }

struct EpiSwiGLU {
    static constexpr bool PERM = true, AFTER_DRAIN = false, MIDK = false;
    bf16_t* H; int ldh;
    __device__ __forceinline__ void operator()(const f32x4 (&acc)[2][2][4][2], const Unit& u, int wr, int wc, int fr, int fq) const {
        const int row0 = u.pm * BM + wr * 64 + fr, col0 = u.pn * HALF + wc * 32 + 8 * fq;
#pragma unroll
        for (int ai = 0; ai < 2; ++ai)
#pragma unroll
            for (int m = 0; m < 4; ++m) { bf16_t* rowp = H + (size_t)(row0 + ai * HALF + m * 16) * ldh + col0;
                const f32x4 a0 = acc[ai][0][m][0], a1 = acc[ai][0][m][1], b0 = acc[ai][1][m][0], b1 = acc[ai][1][m][1];
                u32x4 w; w.x = cvt_pk_bf16(fast_silu(a0[0]) * b0[0], fast_silu(a0[1]) * b0[1]); w.y = cvt_pk_bf16(fast_silu(a0[2]) * b0[2], fast_silu(a0[3]) * b0[3]);
                w.z = cvt_pk_bf16(fast_silu(a1[0]) * b1[0], fast_silu(a1[1]) * b1[1]); w.w = cvt_pk_bf16(fast_silu(a1[2]) * b1[2], fast_silu(a1[3]) * b1[3]);
                *(u32x4*)rowp = w; }
    }
};
struct EpiSwiGLUS {
    static constexpr bool PERM = true, AFTER_DRAIN = false, MIDK = false;
    EpiSwiGLU e; unsigned slab_off, flag_off;
    __device__ __forceinline__ void operator()(const f32x4 (&acc)[2][2][4][2], const Unit& u, int wr, int wc, int fr, int fq) const {
        if (u.ks < 0) { e(acc, u, wr, wc, fr, fq); return; }
        int lane = fr + 16 * fq; asm volatile("" : "+v"(lane));
        const int pair = u.ks >> 1, wid = wr * 4 + wc;
        const __attribute__((address_space(4))) char* kp = (const __attribute__((address_space(4))) char*)__builtin_amdgcn_kernarg_segment_ptr(); asm volatile("" : "+s"(kp));
        char* const wsb = *(char* const __attribute__((address_space(4)))*)(kp + 200);
        float* const slab = (float*)(wsb + slab_off); unsigned* const flags = (unsigned*)(wsb + flag_off);
        const unsigned off0 = (unsigned)(((pair * 8 + wid) * 32) * 64 + lane) * 16u;
        if ((u.ks & 1) == 0) {
            const __amdgpu_buffer_rsrc_t rs = __builtin_amdgcn_make_buffer_rsrc(slab, 0, 128 * 8 * 32 * 64 * 16, 0x00020000);
#pragma unroll
            for (int ai = 0; ai < 2; ++ai)
#pragma unroll
                for (int bj = 0; bj < 2; ++bj)
#pragma unroll
                    for (int m = 0; m < 4; ++m)
#pragma unroll
                        for (int n = 0; n < 2; ++n) __builtin_amdgcn_raw_buffer_store_b128(__builtin_bit_cast(u32x4, acc[ai][bj][m][n]), rs, off0 + (unsigned)((((ai * 2 + bj) * 4 + m) * 2 + n) * 1024), 0, 16);
            asm volatile("s_waitcnt vmcnt(0)" ::: "memory"); __builtin_amdgcn_s_barrier();
            if (wid == 0 && lane == 0) __hip_atomic_store(flags + pair * 32, 1u, __ATOMIC_RELAXED, __HIP_MEMORY_SCOPE_AGENT);
            return;
        }
        if (wid == 0 && lane == 0) { unsigned sp = 0u; while (__hip_atomic_load(flags + pair * 32, __ATOMIC_RELAXED, __HIP_MEMORY_SCOPE_AGENT) == 0u && ++sp < (1u << 21)) __builtin_amdgcn_s_sleep(1);
            __builtin_amdgcn_fence(__ATOMIC_ACQUIRE, "agent"); asm volatile("s_waitcnt vmcnt(0)" ::: "memory"); }
        __builtin_amdgcn_s_barrier();
        const char* sp_ = (const char*)slab + off0;
        const int row0 = u.pm * BM + wr * 64 + (lane & 15), col0 = u.pn * HALF + wc * 32 + 8 * (lane >> 4);
#pragma unroll
        for (int ai = 0; ai < 2; ++ai)
#pragma unroll
            for (int m = 0; m < 4; ++m) {
                const f32x4 a0 = acc[ai][0][m][0] + *(const f32x4*)(sp_ + (((ai * 2 + 0) * 4 + m) * 2 + 0) * 1024), a1 = acc[ai][0][m][1] + *(const f32x4*)(sp_ + (((ai * 2 + 0) * 4 + m) * 2 + 1) * 1024);
                const f32x4 b0 = acc[ai][1][m][0] + *(const f32x4*)(sp_ + (((ai * 2 + 1) * 4 + m) * 2 + 0) * 1024), b1 = acc[ai][1][m][1] + *(const f32x4*)(sp_ + (((ai * 2 + 1) * 4 + m) * 2 + 1) * 1024);
                u32x4 w; w.x = cvt_pk_bf16(fast_silu(a0[0]) * b0[0], fast_silu(a0[1]) * b0[1]); w.y = cvt_pk_bf16(fast_silu(a0[2]) * b0[2], fast_silu(a0[3]) * b0[3]);
                w.z = cvt_pk_bf16(fast_silu(a1[0]) * b1[0], fast_silu(a1[1]) * b1[1]); w.w = cvt_pk_bf16(fast_silu(a1[2]) * b1[2], fast_silu(a1[3]) * b1[3]);
                *(u32x4*)(e.H + (size_t)(row0 + ai * HALF + m * 16) * e.ldh + col0) = w;
                asm volatile("" ::: "memory"); }
    }
};
struct EpiResid {
    static constexpr bool PERM = false, AFTER_DRAIN = false, MIDK = false;
    const float* in_lat; const float* in_ctx; float* out; const float* gate; int gate_vstride; float coef;
    __device__ __forceinline__ void operator()(const f32x4 (&acc)[2][2][4][2], const Unit& u, int wr, int wc, int fr, int fq) const {
        const int v = u.pm < 16 ? 0 : (u.pm < 32 ? 1 : 2);
        const float* gp = gate + (size_t)v * gate_vstride;
        const int lane = fr + 16 * fq, nsel = (lane >> 2) & 1;
        const int pa0 = (((lane >> 3) + 16 * (lane & 3)) << 2), pa1 = pa0 + 32;
        const int row0 = u.pm * BM + wr * 64 + (lane >> 3), col0 = u.pn * BM + wc * 32 + 4 * (lane & 7);
        const float* inb = u.pm < 32 ? in_lat + (size_t)row0 * 4096 : in_ctx + (size_t)(row0 - 8192) * 4096;
        float* outb = out + (size_t)row0 * 4096;
        f32x4 gv[2];
#pragma unroll
        for (int bj = 0; bj < 2; ++bj) gv[bj] = *(const f32x4*)(gp + col0 + bj * HALF) * coef;
        f32x4 xa[2][2], xb[2][2];
#define PG8_RLD(dst, g) do { const size_t ro_ = (size_t)(((g) >> 2) * HALF + ((g) & 3) * 16) * 4096 + col0; _Pragma("unroll") for (int bj = 0; bj < 2; ++bj) _Pragma("unroll") for (int h = 0; h < 2; ++h) \
            dst[bj][h] = *(const f32x4*)(inb + ro_ + (size_t)(8 * h) * 4096 + bj * HALF); } while (0)
#define PG8_RST(src, g) do { const size_t ro_ = (size_t)(((g) >> 2) * HALF + ((g) & 3) * 16) * 4096 + col0; _Pragma("unroll") for (int bj = 0; bj < 2; ++bj) _Pragma("unroll") for (int h = 0; h < 2; ++h) { \
            const f32x4 t0_ = lperm(acc[(g) >> 2][bj][(g) & 3][0], h ? pa1 : pa0), t1_ = lperm(acc[(g) >> 2][bj][(g) & 3][1], h ? pa1 : pa0); \
            *(f32x4*)(outb + ro_ + (size_t)(8 * h) * 4096 + bj * HALF) = src[bj][h] + gv[bj] * (nsel ? t1_ : t0_); } } while (0)
        PG8_RLD(xa, 0);
#pragma unroll
        for (int g = 0; g < 8; g += 2) {
            PG8_RLD(xb, g + 1);
            PG8_RST(xa, g);
            if (g + 2 < 8) PG8_RLD(xa, g + 2);
            PG8_RST(xb, g + 1);
        }
#undef PG8_RLD
#undef PG8_RST
    }
};
struct EpiFinal {
    static constexpr bool PERM = false, AFTER_DRAIN = false, MIDK = false;
    const float* in; float* outp; const float* gate; int gate_vstride; float coef; const float* fw; float* stats  ; unsigned* cnt  ; PG8_LAS float* red  ;
    __device__ __forceinline__ void operator()(f32x4 (&acc)[2][2][4][2], const Unit& u, int wr, int wc, int fr, int fq) const {
        const int v = u.pm < 16 ? 0 : 1;
        const float* gp = gate + (size_t)v * gate_vstride;
        int lane = fr + 16 * fq; asm volatile("" : "+v"(lane));
        const int nsel = (lane >> 2) & 1;
        const int pa0 = (((lane >> 3) + 16 * (lane & 3)) << 2), pa1 = pa0 + 32;
        const int rl = wr * 64 + (lane >> 3);
        const int row0 = u.pm * BM + rl, col0 = u.pn * BM + wc * 32 + 4 * (lane & 7);
        const float* inb = in + (size_t)row0 * 4096;
#pragma unroll
        for (int g = 0; g < 8; ++g) {
            const size_t ro = (size_t)((g >> 2) * HALF + (g & 3) * 16) * 4096 + col0;
            float s0 = 0.f, s1 = 0.f;
#pragma unroll
            for (int bj = 0; bj < 2; ++bj) { f32x4& c0 = acc[g >> 2][bj][g & 3][0]; f32x4& c1 = acc[g >> 2][bj][g & 3][1];
                const f32x4 gvv = *(const f32x4*)(gp + col0 + bj * HALF) * coef;
                const f32x4 x0 = *(const f32x4*)(inb + ro + bj * HALF), x1 = *(const f32x4*)(inb + ro + (size_t)8 * 4096 + bj * HALF);
                const f32x4 t00 = lperm(c0, pa0), t10 = lperm(c1, pa0); const f32x4 h0 = x0 + gvv * (nsel ? t10 : t00);
                const f32x4 t01 = lperm(c0, pa1), t11 = lperm(c1, pa1); const f32x4 h1 = x1 + gvv * (nsel ? t11 : t01);
                c0 = h0; c1 = h1; asm volatile("" : "+v"(c0), "+v"(c1));
                s0 += (h0[0] * h0[0] + h0[1] * h0[1]) + (h0[2] * h0[2] + h0[3] * h0[3]); s1 += (h1[0] * h1[0] + h1[1] * h1[1]) + (h1[2] * h1[2] + h1[3] * h1[3]); }
            s0 += __shfl_xor(s0, 1); s0 += __shfl_xor(s0, 2); s0 += __shfl_xor(s0, 4); s1 += __shfl_xor(s1, 1); s1 += __shfl_xor(s1, 2); s1 += __shfl_xor(s1, 4);
            if ((lane & 7) == 0) { const int tr = (g >> 2) * HALF + (g & 3) * 16 + rl; red[tr * 4 + wc] = s0; red[(tr + 8) * 4 + wc] = s1; }
            asm volatile("" ::: "memory");
        }
        asm volatile("s_waitcnt lgkmcnt(0)" ::: "memory"); __builtin_amdgcn_s_barrier();
        if (wr == 0) { const int r = wc * 64 + lane; const float s = (red[r * 4] + red[r * 4 + 1]) + (red[r * 4 + 2] + red[r * 4 + 3]);
            __hip_atomic_store(stats + ((size_t)u.pm * BM + r) * 16 + u.pn, s, __ATOMIC_RELAXED, __HIP_MEMORY_SCOPE_AGENT); }
        asm volatile("s_waitcnt vmcnt(0) lgkmcnt(0)" ::: "memory"); __builtin_amdgcn_s_barrier();
        if (wr == 0 && wc == 0 && lane == 0) { unsigned* cp = cnt + u.pm * 32;
            (void)__hip_atomic_fetch_add(cp, 1u, __ATOMIC_RELAXED, __HIP_MEMORY_SCOPE_AGENT);
            unsigned sp = 0u; while (__hip_atomic_load(cp, __ATOMIC_RELAXED, __HIP_MEMORY_SCOPE_AGENT) < 16u && ++sp < (1u << 21)) __builtin_amdgcn_s_sleep(1);
            __builtin_amdgcn_fence(__ATOMIC_ACQUIRE, "agent"); asm volatile("s_waitcnt vmcnt(0)" ::: "memory"); }
        __builtin_amdgcn_s_barrier();
        if (wr == 0) { const int r = wc * 64 + lane; const float* sp_ = stats + ((size_t)u.pm * BM + r) * 16; float s = 0.f;
#pragma unroll
            for (int t = 0; t < 16; ++t) s += __hip_atomic_load(sp_ + t, __ATOMIC_RELAXED, __HIP_MEMORY_SCOPE_AGENT);
            red[1024 + r] = 1.0f / sqrtf(s * (1.0f / 4096.0f) + 1e-6f); }
        asm volatile("s_waitcnt vmcnt(0) lgkmcnt(0)" ::: "memory"); __builtin_amdgcn_s_barrier();
        float* outb = outp + (size_t)row0 * 4096;
#pragma unroll
        for (int g = 0; g < 8; ++g) {
#pragma unroll
            for (int bj = 0; bj < 2; ++bj) { const f32x4 fwv = *(const f32x4*)(fw + col0 + bj * HALF);
#pragma unroll
                for (int h = 0; h < 2; ++h) { const float rs = red[1024 + (g >> 2) * HALF + (g & 3) * 16 + 8 * h + rl];
                    *(f32x4*)(outb + (size_t)((g >> 2) * HALF + (g & 3) * 16 + 8 * h) * 4096 + col0 + bj * HALF) = acc[g >> 2][bj][g & 3][h] * rs * fwv; } }
            asm volatile("" ::: "memory"); }
        asm volatile("s_waitcnt lgkmcnt(0)" ::: "memory"); __builtin_amdgcn_s_barrier();
    }
};
struct EpiZ {
    static constexpr bool PERM = true, AFTER_DRAIN = false, MIDK = false;
    bf16_t* Z; int ldz; float* ZAB; int nmain; bf16_t* GF; int ga0; bf16_t* KF; bf16_t* QF; int nk0, nq0; bf16_t* VF; int nv0;
    __device__ __forceinline__ void operator()(const f32x4 (&acc)[2][2][4][2], const Unit& u, int wr, int wc, int fr, int fq) const {
        const int row0 = u.pm * BM + wr * 64 + fr;
        if (u.pn >= ga0 && u.pn < nmain && u.pm < 32) {
            bf16_t* gp = GF + ((((size_t)u.pm * 48 + (u.pn - ga0)) * 8 + (wr * 4 + wc)) * 16 * 64 + (fr + 16 * fq)) * 8;
#pragma unroll
            for (int ai = 0; ai < 2; ++ai)
#pragma unroll
                for (int m = 0; m < 4; ++m)
#pragma unroll
                    for (int bj = 0; bj < 2; ++bj) { f32x4 v0 = acc[ai][bj][m][0], v1 = acc[ai][bj][m][1];
#pragma unroll
                        for (int i = 0; i < 4; ++i) { v0[i] = __expf(-fminf(fmaxf(v0[i], -30.f), 30.f)); v1[i] = __expf(-fminf(fmaxf(v1[i], -30.f), 30.f)); }
                        u32x4 w; w.x = cvt_pk_bf16(v0[0], v0[1]); w.y = cvt_pk_bf16(v0[2], v0[3]); w.z = cvt_pk_bf16(v1[0], v1[1]); w.w = cvt_pk_bf16(v1[2], v1[3]);
                        *(u32x4*)(gp + ((ai * 4 + m) * 2 + bj) * 512) = w; }
        } else if (u.pm < 32 && (unsigned)(u.pn - nk0) < 8u) {
            const int b = u.pm >> 4, t0 = (u.pm & 15) * BM + wr * 64 + fr;
#pragma unroll
            for (int ai = 0; ai < 2; ++ai)
#pragma unroll
                for (int m = 0; m < 4; ++m)
#pragma unroll
                    for (int bj = 0; bj < 2; ++bj) { const f32x4 v0 = acc[ai][bj][m][0], v1 = acc[ai][bj][m][1]; const int t = t0 + ai * HALF + m * 16;
                        u32x4 w; w.x = cvt_pk_bf16(v0[0], v0[1]); w.y = cvt_pk_bf16(v0[2], v0[3]); w.z = cvt_pk_bf16(v1[0], v1[1]); w.w = cvt_pk_bf16(v1[2], v1[3]);
                        *(u32x4*)(KF + (((size_t)(b * 16 + 2 * (u.pn - nk0) + bj) * 1024 + (t >> 2)) * 512) + wc * 128 + fq * 32 + (t & 3) * 8) = w; }
        } else if (u.pm < 32 && (unsigned)(u.pn - nv0) < 8u) {
            const int b = u.pm >> 4, t0 = (u.pm & 15) * BM + wr * 64 + (fr & 8);
            const bool lo4 = (fr & 4) == 0, lo2 = (fr & 2) == 0, lo1 = (fr & 1) == 0;
#pragma unroll
            for (int ai = 0; ai < 2; ++ai)
#pragma unroll
                for (int m = 0; m < 4; ++m)
#pragma unroll
                    for (int bj = 0; bj < 2; ++bj) { const f32x4 v0 = acc[ai][bj][m][0], v1 = acc[ai][bj][m][1];
                        unsigned w0 = cvt_pk_bf16(v0[0], v0[1]), w1 = cvt_pk_bf16(v0[2], v0[3]), w2 = cvt_pk_bf16(v1[0], v1[1]), w3 = cvt_pk_bf16(v1[2], v1[3]);
                        { const unsigned r0 = (unsigned)__shfl_xor((int)(lo4 ? w2 : w0), 4), r1 = (unsigned)__shfl_xor((int)(lo4 ? w3 : w1), 4); w2 = lo4 ? r0 : w2; w3 = lo4 ? r1 : w3; w0 = lo4 ? w0 : r0; w1 = lo4 ? w1 : r1; }
                        { const unsigned r0 = (unsigned)__shfl_xor((int)(lo2 ? w1 : w0), 2), r1 = (unsigned)__shfl_xor((int)(lo2 ? w3 : w2), 2); w1 = lo2 ? r0 : w1; w3 = lo2 ? r1 : w3; w0 = lo2 ? w0 : r0; w2 = lo2 ? w2 : r1; }
                        { const unsigned p0 = (unsigned)__shfl_xor((int)w0, 1), p1 = (unsigned)__shfl_xor((int)w1, 1), p2 = (unsigned)__shfl_xor((int)w2, 1), p3 = (unsigned)__shfl_xor((int)w3, 1);
                          w0 = lo1 ? (w0 & 0xffffu) | (p0 << 16) : (p0 >> 16) | (w0 & 0xffff0000u); w1 = lo1 ? (w1 & 0xffffu) | (p1 << 16) : (p1 >> 16) | (w1 & 0xffff0000u);
                          w2 = lo1 ? (w2 & 0xffffu) | (p2 << 16) : (p2 >> 16) | (w2 & 0xffff0000u); w3 = lo1 ? (w3 & 0xffffu) | (p3 << 16) : (p3 >> 16) | (w3 & 0xffff0000u); }
                        u32x4 w; w.x = w0; w.y = w1; w.z = w2; w.w = w3;
                        *(u32x4*)(VF + ((((size_t)(b * 16 + 2 * (u.pn - nv0) + bj) * 512 + ((t0 + ai * HALF + m * 16) >> 3)) * 128) + wc * 32 + fq * 8 + (fr & 7)) * 8) = w; }
        } else if (u.pm < 32 && (unsigned)(u.pn - nq0) < 8u) {
            const int b = u.pm >> 4, rg0 = (u.pm & 15) * 16 + wr * 4;
#pragma unroll
            for (int ai = 0; ai < 2; ++ai)
#pragma unroll
                for (int m = 0; m < 4; ++m)
#pragma unroll
                    for (int bj = 0; bj < 2; ++bj) { const f32x4 v0 = acc[ai][bj][m][0], v1 = acc[ai][bj][m][1];
                        u32x4 w; w.x = cvt_pk_bf16(v0[0], v0[1]); w.y = cvt_pk_bf16(v0[2], v0[3]); w.z = cvt_pk_bf16(v1[0], v1[1]); w.w = cvt_pk_bf16(v1[2], v1[3]);
                        *(u32x4*)(QF + ((((size_t)(b * 16 + 2 * (u.pn - nq0) + bj) * 256 + rg0 + ai * 8 + m) * 4 + wc) * 64 + (fr + 16 * fq)) * 8) = w; }
        } else if (u.pn < nmain) {
            const int col0 = u.pn * BM + wc * 32 + 8 * fq;
#pragma unroll
            for (int ai = 0; ai < 2; ++ai)
#pragma unroll
                for (int m = 0; m < 4; ++m) { bf16_t* rowp = Z + (size_t)(row0 + ai * HALF + m * 16) * ldz + col0;
#pragma unroll
                    for (int bj = 0; bj < 2; ++bj) { const f32x4 v0 = acc[ai][bj][m][0], v1 = acc[ai][bj][m][1];
                        u32x4 w; w.x = cvt_pk_bf16(v0[0], v0[1]); w.y = cvt_pk_bf16(v0[2], v0[3]); w.z = cvt_pk_bf16(v1[0], v1[1]); w.w = cvt_pk_bf16(v1[2], v1[3]);
                        *(u32x4*)(rowp + bj * HALF) = w; } }
        } else if (wc == 0) {
#pragma unroll
            for (int ai = 0; ai < 2; ++ai)
#pragma unroll
                for (int m = 0; m < 4; ++m) { float* rowp = ZAB + (size_t)(row0 + ai * HALF + m * 16) * 32 + 8 * fq;
                    *(f32x4*)(rowp) = acc[ai][0][m][0]; *(f32x4*)(rowp + 4) = acc[ai][0][m][1]; }
        }
    }
};
template <int S> struct EpiMerge {
    static constexpr bool PERM = true, AFTER_DRAIN = false, MIDK = false;
    const bf16_t* Z; int ldz; int gcol; float* YF; bf16_t* YB;
    __device__ __forceinline__ void operator()(const f32x4 (&acc)[2][2][4][2], const Unit& u, int wr, int wc, int fr, int fq) const {
        const int row0 = u.pm * BM + wr * 64 + fr, col0 = u.pn * BM + wc * 32 + 8 * fq;
#pragma unroll
        for (int ai = 0; ai < 2; ++ai)
#pragma unroll
            for (int m = 0; m < 4; ++m) { const size_t row = (size_t)(row0 + ai * HALF + m * 16);
#pragma unroll
                for (int bj = 0; bj < 2; ++bj) { const int c = col0 + bj * HALF;
                    const u32x4 g = *(const u32x4*)(Z + row * ldz + gcol + c);
                    f32x4 t0 = acc[ai][bj][m][0], t1 = acc[ai][bj][m][1];
                    t0[0] *= fast_sigmoid(bf_lo(g.x)); t0[1] *= fast_sigmoid(bf_hi(g.x)); t0[2] *= fast_sigmoid(bf_lo(g.y)); t0[3] *= fast_sigmoid(bf_hi(g.y));
                    t1[0] *= fast_sigmoid(bf_lo(g.z)); t1[1] *= fast_sigmoid(bf_hi(g.z)); t1[2] *= fast_sigmoid(bf_lo(g.w)); t1[3] *= fast_sigmoid(bf_hi(g.w));
                    float* yf = YF + row * 4096 + c;
                    if (S == 0) { *(f32x4*)yf = t0; *(f32x4*)(yf + 4) = t1; }
                    else { t0 += *(const f32x4*)yf; t1 += *(const f32x4*)(yf + 4);
                        if (S == 1) { *(f32x4*)yf = t0; *(f32x4*)(yf + 4) = t1; }
                        else { u32x4 w; w.x = cvt_pk_bf16(t0[0], t0[1]); w.y = cvt_pk_bf16(t0[2], t0[3]); w.z = cvt_pk_bf16(t1[0], t1[1]); w.w = cvt_pk_bf16(t1[2], t1[3]);
                            *(u32x4*)(YB + row * 4096 + c) = w; } } }
                asm volatile("" ::: "memory"); }
    }
};

struct EpiSlab {
    static constexpr bool PERM = false, AFTER_DRAIN = false, MIDK = false;
    float* slab;
    __device__ __forceinline__ void operator()(const f32x4 (&acc)[2][2][4][2], const Unit& u, int wr, int wc, int fr, int fq) const {
        const int row0 = u.pm * BM + wr * 64 + fr - 8192, col0 = u.pn * BM + wc * 32 + 4 * fq;
        float* outb = slab + ((size_t)u.ks * 512 + row0) * 4096 + col0;
#pragma unroll
        for (int ai = 0; ai < 2; ++ai)
#pragma unroll
            for (int m = 0; m < 4; ++m)
#pragma unroll
                for (int bj = 0; bj < 2; ++bj)
#pragma unroll
                    for (int n = 0; n < 2; ++n) *(f32x4*)(outb + (size_t)(ai * HALF + m * 16) * 4096 + bj * HALF + n * 16) = acc[ai][bj][m][n];
    }
};

struct EpiSlabP {
    static constexpr bool PERM = true, AFTER_DRAIN = false, MIDK = false;
    float* slab;
    __device__ __forceinline__ void operator()(const f32x4 (&acc)[2][2][4][2], const Unit& u, int wr, int wc, int fr, int fq) const {
        const int row0 = u.pm * BM + wr * 64 + fr - 8192, col0 = u.pn * BM + wc * 32 + 8 * fq;
        float* outb = slab + ((size_t)u.ks * 512 + row0) * 4096 + col0;
#pragma unroll
        for (int ai = 0; ai < 2; ++ai)
#pragma unroll
            for (int m = 0; m < 4; ++m)
#pragma unroll
                for (int bj = 0; bj < 2; ++bj) { float* o = outb + (size_t)(ai * HALF + m * 16) * 4096 + bj * HALF; *(f32x4*)o = acc[ai][bj][m][0]; *(f32x4*)(o + 4) = acc[ai][bj][m][1]; }
    }
};
struct EpiResidSlab {
    static constexpr bool PERM = false, AFTER_DRAIN = false, MIDK = false;
    EpiResid r; EpiSlab s;
    __device__ __forceinline__ void operator()(const f32x4 (&acc)[2][2][4][2], const Unit& u, int wr, int wc, int fr, int fq) const { if (u.ks >= 0) s(acc, u, wr, wc, fr, fq); else r(acc, u, wr, wc, fr, fq); }
};
struct EpiMergeH {
    static constexpr bool PERM = true, AFTER_DRAIN = false, MIDK = true;
    static constexpr int T1 = 16, T2 = 32;
    const bf16_t* GF; bf16_t* YB;
    __device__ __forceinline__ void midk(f32x4 (&acc)[2][2][4][2], const Unit& u, int which, int wr, int wc, int fr, int fq) const {
        int lane = fr + 16 * fq; asm volatile("" : "+v"(lane));
        const bf16_t* gn0 = GF + ((((size_t)u.pm * 48 + which * 16 + u.pn) * 8 + (wr * 4 + wc)) * 16 * 64 + lane) * 8;
#pragma unroll
        for (int ai = 0; ai < 2; ++ai)
#pragma unroll
            for (int mp = 0; mp < 4; mp += 2) {
                u32x4 gn[2][2], gd[2][2];
#pragma unroll
                for (int mm = 0; mm < 2; ++mm)
#pragma unroll
                    for (int bj = 0; bj < 2; ++bj) { const int o = ((ai * 4 + mp + mm) * 2 + bj) * 512;
                        gn[mm][bj] = *(const u32x4*)(gn0 + o); gd[mm][bj] = *(const u32x4*)(gn0 + (size_t)16 * 8 * 16 * 64 * 8 + o); }
#pragma unroll
                for (int mm = 0; mm < 2; ++mm)
#pragma unroll
                    for (int bj = 0; bj < 2; ++bj) { const u32x4 a = gn[mm][bj], b = gd[mm][bj]; f32x4& t0 = acc[ai][bj][mp + mm][0]; f32x4& t1 = acc[ai][bj][mp + mm][1];
                        t0[0] *= (1.f + (bf_lo(b.x))) * __builtin_amdgcn_rcpf(1.f + (bf_lo(a.x))); t0[1] *= (1.f + (bf_hi(b.x))) * __builtin_amdgcn_rcpf(1.f + (bf_hi(a.x)));
                        t0[2] *= (1.f + (bf_lo(b.y))) * __builtin_amdgcn_rcpf(1.f + (bf_lo(a.y))); t0[3] *= (1.f + (bf_hi(b.y))) * __builtin_amdgcn_rcpf(1.f + (bf_hi(a.y)));
                        t1[0] *= (1.f + (bf_lo(b.z))) * __builtin_amdgcn_rcpf(1.f + (bf_lo(a.z))); t1[1] *= (1.f + (bf_hi(b.z))) * __builtin_amdgcn_rcpf(1.f + (bf_hi(a.z)));
                        t1[2] *= (1.f + (bf_lo(b.w))) * __builtin_amdgcn_rcpf(1.f + (bf_lo(a.w))); t1[3] *= (1.f + (bf_hi(b.w))) * __builtin_amdgcn_rcpf(1.f + (bf_hi(a.w))); }
                asm volatile("" ::: "memory");
            }
    }
    __device__ __forceinline__ void operator()(const f32x4 (&acc)[2][2][4][2], const Unit& u, int wr, int wc, int fr, int fq) const {
        const int row0 = u.pm * BM + wr * 64 + fr, col0 = u.pn * BM + wc * 32 + 8 * fq;
        const bf16_t* gc0 = GF + ((((size_t)u.pm * 48 + 32 + u.pn) * 8 + (wr * 4 + wc)) * 16 * 64 + (fr + 16 * fq)) * 8;
#pragma unroll
        for (int ai = 0; ai < 2; ++ai)
#pragma unroll
            for (int m = 0; m < 4; ++m) { const size_t row = (size_t)(row0 + ai * HALF + m * 16);
#pragma unroll
                for (int bj = 0; bj < 2; ++bj) { const int c = col0 + bj * HALF;
                    const u32x4 g = *(const u32x4*)(gc0 + ((ai * 4 + m) * 2 + bj) * 512);
                    f32x4 t0 = acc[ai][bj][m][0], t1 = acc[ai][bj][m][1];
                    t0[0] *= __builtin_amdgcn_rcpf(1.f + (bf_lo(g.x))); t0[1] *= __builtin_amdgcn_rcpf(1.f + (bf_hi(g.x))); t0[2] *= __builtin_amdgcn_rcpf(1.f + (bf_lo(g.y))); t0[3] *= __builtin_amdgcn_rcpf(1.f + (bf_hi(g.y)));
                    t1[0] *= __builtin_amdgcn_rcpf(1.f + (bf_lo(g.z))); t1[1] *= __builtin_amdgcn_rcpf(1.f + (bf_hi(g.z))); t1[2] *= __builtin_amdgcn_rcpf(1.f + (bf_lo(g.w))); t1[3] *= __builtin_amdgcn_rcpf(1.f + (bf_hi(g.w)));
                    u32x4 w; w.x = cvt_pk_bf16(t0[0], t0[1]); w.y = cvt_pk_bf16(t0[2], t0[3]); w.z = cvt_pk_bf16(t1[0], t1[1]); w.w = cvt_pk_bf16(t1[2], t1[3]);
                    *(u32x4*)(YB + row * 4096 + c) = w; }
                if (m & 1) asm volatile("" ::: "memory"); }
    }
};
struct EpiMergeHS {
    static constexpr bool PERM = true, AFTER_DRAIN = false, MIDK = true;
    static constexpr int T1 = EpiMergeH::T1, T2 = EpiMergeH::T2;
    EpiMergeH m; EpiSlabP s;
    __device__ __forceinline__ void midk(f32x4 (&acc)[2][2][4][2], const Unit& u, int which, int wr, int wc, int fr, int fq) const { if (u.ks < 0) m.midk(acc, u, which, wr, wc, fr, fq); }
    __device__ __forceinline__ void operator()(const f32x4 (&acc)[2][2][4][2], const Unit& u, int wr, int wc, int fr, int fq) const { if (u.ks >= 0) s(acc, u, wr, wc, fr, fq); else m(acc, u, wr, wc, fr, fq); }
};
template <class Epi, class Sched, bool ALIGN_EPI = false, bool SP2 = false>
__device__ __forceinline__ void gemm_phase(PG8_LAS unsigned char* lds, const Gemm g, const Sched& S, const Epi& E, int wave0) {
    int tid = wave0 * 64 + (int)__builtin_amdgcn_mbcnt_hi(~0u, __builtin_amdgcn_mbcnt_lo(~0u, 0u)); asm volatile("" : "+v"(tid));
    const int wid = __builtin_amdgcn_readfirstlane(tid >> 6), lane = tid & 63, wr = wid >> 2, wc = wid & 3, fr = lane & 15, fq = lane >> 4;
    const int ntdef = g.K / BK;
    unsigned voffA[2], voffB[2];
#pragma unroll
    for (int i = 0; i < 2; ++i) { int R, C; stage_rc(tid * 16 + i * 8192, R, C); const int Rb = Epi::PERM ? ((R & ~31) + perm32(R & 31)) : R;
        voffA[i] = (unsigned)(R * g.lda + C) * 2u; voffB[i] = (unsigned)(Rb * g.ldb + C) * 2u; }
    const size_t kstep = (size_t)(BK * 2);
    const size_t hstepA = (size_t)HALF * g.lda * 2, hstepB = (size_t)HALF * g.ldb * 2;
    const size_t tstepA = 2 * hstepA, tstepB = 2 * hstepB;
    const unsigned ldsw = (unsigned)wid * 1024u;
    const int aoff = lds_byte(wr * 64 + fr, fq * 8), boff = lds_byte(wc * 32 + fr, fq * 8);
#define PG8_SA(b, h) (((b) * 2 + (h)) * HTB)
#define PG8_SB(b, h) ((4 + (b) * 2 + (h)) * HTB)
#define PG8_STAGE(bufoff, gbase, voff) do { _Pragma("unroll") for (int _i = 0; _i < 2; ++_i) \
        __builtin_amdgcn_global_load_lds((const unsigned*)((const char*)(gbase) + (voff)[_i]), (PG8_LAS unsigned*)(lds + (bufoff) + ldsw + _i * 8192), 16, 0, 0); } while (0)
#define PG8_LDA(dst, b, h) do { _Pragma("unroll") for (int m = 0; m < 4; ++m) _Pragma("unroll") for (int k = 0; k < 2; ++k) dst[m][k] = *(const PG8_LAS bf16x8*)(lds + PG8_SA(b, h) + aoff + m * 2048 + k * 1024); } while (0)
#define PG8_LDB(dst, b, h) do { _Pragma("unroll") for (int n = 0; n < 2; ++n) _Pragma("unroll") for (int k = 0; k < 2; ++k) dst[n][k] = *(const PG8_LAS bf16x8*)(lds + PG8_SB(b, h) + boff + n * 2048 + k * 1024); } while (0)
#define PG8_MMA(ai, bj, At, Bt) do { __builtin_amdgcn_s_setprio(1); _Pragma("unroll") for (int m = 0; m < 4; ++m) _Pragma("unroll") for (int n = 0; n < 2; ++n) _Pragma("unroll") for (int k = 0; k < 2; ++k) \
        acc[ai][bj][m][n] = __builtin_amdgcn_mfma_f32_16x16x32_bf16(Bt[n][k], At[m][k], acc[ai][bj][m][n], 0, 0, 0); __builtin_amdgcn_s_setprio(0); } while (0)
#define PG8_WAIT_V(n) asm volatile("s_waitcnt vmcnt(" #n ")" ::: "memory")
#define PG8_WAIT_L(n) asm volatile("s_waitcnt lgkmcnt(" #n ")" ::: "memory")
#define PG8_BAR __builtin_amdgcn_s_barrier()
#define PG8_SCHED __builtin_amdgcn_sched_barrier(0)
    Unit cur, nxt; int ui = 0;
    if (!S.next(0, cur)) return;
    f32x4 acc[2][2][4][2];
#pragma unroll
    for (int a = 0; a < 2; ++a)
#pragma unroll
        for (int b = 0; b < 2; ++b)
#pragma unroll
            for (int m = 0; m < 4; ++m)
#pragma unroll
                for (int n = 0; n < 2; ++n) acc[a][b][m][n] = (f32x4){0.f, 0.f, 0.f, 0.f};
    bf16x8 At[4][2], B0[2][2], B1[2][2];
    const char* cA = (const char*)g.A + (size_t)cur.pm * tstepA + (size_t)cur.kt0 * kstep; const char* cB = (const char*)g.Bt + (size_t)cur.pn * tstepB + (size_t)cur.kt0 * kstep;
    S.a_ready(cur);
    if constexpr (SP2) {
        PG8_STAGE(PG8_SB(0, 0), cB, voffB); PG8_STAGE(PG8_SB(0, 1), cB + hstepB, voffB); PG8_STAGE(PG8_SA(0, 0), cA, voffA); PG8_STAGE(PG8_SA(0, 1), cA + hstepA, voffA);
        if (wr == 1) PG8_BAR;
        PG8_WAIT_V(2); PG8_BAR;
        PG8_STAGE(PG8_SB(1, 0), cB + kstep, voffB); PG8_STAGE(PG8_SA(1, 0), cA + kstep, voffA); PG8_STAGE(PG8_SB(1, 1), cB + hstepB + kstep, voffB);
        PG8_WAIT_V(6); PG8_BAR;
    } else {
        PG8_STAGE(PG8_SB(0, 0), cB, voffB); PG8_STAGE(PG8_SA(0, 0), cA, voffA); PG8_STAGE(PG8_SB(0, 1), cB + hstepB, voffB); PG8_STAGE(PG8_SA(0, 1), cA + hstepA, voffA);
        if (wr == 1) PG8_BAR;
        PG8_WAIT_V(4); PG8_BAR;
        PG8_STAGE(PG8_SB(1, 0), cB + kstep, voffB); PG8_STAGE(PG8_SA(1, 0), cA + kstep, voffA); PG8_STAGE(PG8_SB(1, 1), cB + hstepB + kstep, voffB);
        PG8_WAIT_V(6); PG8_BAR;
    }
    for (;;) {
        const bool has_next = S.next(ui + 1, nxt);
        const char* nA = has_next ? (const char*)g.A + (size_t)nxt.pm * tstepA + (size_t)nxt.kt0 * kstep : cA; const char* nB = has_next ? (const char*)g.Bt + (size_t)nxt.pn * tstepB + (size_t)nxt.kt0 * kstep : cB;
        const int nt = cur.nt > 0 ? cur.nt : ntdef;
        for (int t = 0; t < nt; t += 2) {
            const bool last = (t == nt - 2);
            const char* a1 = cA + (size_t)(t + 1) * kstep;
            const char* a2 = last ? nA : cA + (size_t)(t + 2) * kstep; const char* b2 = last ? nB : cB + (size_t)(t + 2) * kstep;
            const char* a3 = a2 + kstep; const char* b3 = b2 + kstep;
            if (last && has_next) S.a_ready(nxt);
            if constexpr (Epi::MIDK) { if (t == Epi::T1 || t == Epi::T2) E.midk(acc, cur, t == Epi::T1 ? 0 : 1, wr, wc, fr, fq); }
            if constexpr (SP2) {
            PG8_LDB(B0, 0, 0); PG8_LDB(B1, 0, 1); PG8_SCHED; PG8_LDA(At, 0, 0); PG8_STAGE(PG8_SA(1, 1), a1 + hstepA, voffA);
            PG8_WAIT_V(8); PG8_WAIT_L(0); PG8_BAR; PG8_MMA(0, 0, At, B0); PG8_MMA(0, 1, At, B1); PG8_BAR; PG8_SCHED;
            PG8_LDA(At, 0, 1); PG8_STAGE(PG8_SB(0, 0), b2, voffB); PG8_STAGE(PG8_SB(0, 1), b2 + hstepB, voffB); PG8_STAGE(PG8_SA(0, 0), a2, voffA);
            PG8_WAIT_V(8); PG8_WAIT_L(0); PG8_BAR; PG8_MMA(1, 0, At, B0); PG8_MMA(1, 1, At, B1); PG8_BAR; PG8_SCHED;
            PG8_LDB(B0, 1, 0); PG8_LDB(B1, 1, 1); PG8_SCHED; PG8_LDA(At, 1, 0); PG8_STAGE(PG8_SA(0, 1), a2 + hstepA, voffA);
            PG8_WAIT_V(8); PG8_WAIT_L(0); PG8_BAR; PG8_MMA(0, 0, At, B0); PG8_MMA(0, 1, At, B1); PG8_BAR; PG8_SCHED;
            PG8_LDA(At, 1, 1); PG8_STAGE(PG8_SB(1, 0), b3, voffB); PG8_STAGE(PG8_SB(1, 1), b3 + hstepB, voffB); PG8_STAGE(PG8_SA(1, 0), a3, voffA);
            PG8_WAIT_V(8); PG8_WAIT_L(0); PG8_BAR; PG8_MMA(1, 0, At, B0); PG8_MMA(1, 1, At, B1); PG8_BAR; PG8_SCHED;
            } else {
            PG8_LDB(B0, 0, 0); PG8_SCHED; PG8_LDA(At, 0, 0); PG8_STAGE(PG8_SA(1, 1), a1 + hstepA, voffA);
            PG8_WAIT_L(8); PG8_BAR; PG8_WAIT_L(0); PG8_MMA(0, 0, At, B0); PG8_BAR; PG8_SCHED;
            PG8_LDB(B1, 0, 1); PG8_STAGE(PG8_SB(0, 0), b2, voffB);
            PG8_BAR; PG8_WAIT_L(0); PG8_MMA(0, 1, At, B1); PG8_BAR;
            PG8_LDA(At, 0, 1); PG8_STAGE(PG8_SA(0, 0), a2, voffA);
            PG8_BAR; PG8_WAIT_L(0); PG8_MMA(1, 0, At, B0); PG8_BAR; PG8_SCHED;
            PG8_STAGE(PG8_SB(0, 1), b2 + hstepB, voffB);
            PG8_WAIT_V(6); PG8_BAR; PG8_MMA(1, 1, At, B1); PG8_BAR;
            PG8_LDB(B0, 1, 0); PG8_SCHED; PG8_LDA(At, 1, 0); PG8_STAGE(PG8_SA(0, 1), a2 + hstepA, voffA);
            PG8_WAIT_L(8); PG8_BAR; PG8_WAIT_L(0); PG8_MMA(0, 0, At, B0); PG8_BAR; PG8_SCHED;
            PG8_LDB(B1, 1, 1); PG8_STAGE(PG8_SB(1, 0), b3, voffB);
            PG8_BAR; PG8_WAIT_L(0); PG8_MMA(0, 1, At, B1); PG8_BAR;
            PG8_LDA(At, 1, 1); PG8_STAGE(PG8_SA(1, 0), a3, voffA);
            PG8_BAR; PG8_WAIT_L(0); PG8_MMA(1, 0, At, B0); PG8_BAR; PG8_SCHED;
            PG8_STAGE(PG8_SB(1, 1), b3 + hstepB, voffB);
            PG8_WAIT_V(6); PG8_BAR; PG8_MMA(1, 1, At, B1); PG8_BAR;
            }
        }
        if constexpr (ALIGN_EPI) { if (wr == 0) PG8_BAR; }
        if constexpr (!Epi::AFTER_DRAIN) { E(acc, cur, wr, wc, fr, fq); S.done(cur); }
        if (!has_next) break;
#pragma unroll
        for (int a = 0; a < 2; ++a)
#pragma unroll
            for (int b = 0; b < 2; ++b)
#pragma unroll
                for (int m = 0; m < 4; ++m)
#pragma unroll
                    for (int n = 0; n < 2; ++n) acc[a][b][m][n] = (f32x4){0.f, 0.f, 0.f, 0.f};
        cur = nxt; cA = nA; cB = nB; ++ui;
        if constexpr (ALIGN_EPI) { if (wr == 1) PG8_BAR; }
    }
    PG8_WAIT_V(0);
    if constexpr (!ALIGN_EPI) { if (wr == 0) PG8_BAR; }
    PG8_BAR;
    if constexpr (Epi::AFTER_DRAIN) { E.fused(acc, cur, wr, wc, fr, fq, lds, wid, lane); S.done(cur); }
#undef PG8_SA
#undef PG8_SB
#undef PG8_STAGE
#undef PG8_LDA
#undef PG8_LDB
#undef PG8_MMA
#undef PG8_WAIT_V
#undef PG8_WAIT_L
#undef PG8_BAR
#undef PG8_SCHED
}
}

constexpr int DM = 4096, FF = 5632, SEQ = 4096, CTXL = 256, TL = 8192, TC = 512, MR = TL + TC, NLAYER = 2;
constexpr int ZW = 24576, ZN = 24832, INW = 24608, MODW = 36864;
constexpr int Z_DNK = 0, Z_DNV = 1024, Z_NAK = 2048, Z_NAV = 4096, Z_DNQ = 6144, Z_NAQ = 7168, Z_DNG = 9216, Z_GMU = 10240, Z_GMV = 11264, Z_GA = 12288;
constexpr float EPS = 1e-6f;
constexpr int NWAVES = 8, NTHR = 512;
typedef unsigned short bf16;
typedef float f32x4 __attribute__((ext_vector_type(4)));
typedef float f32x2 __attribute__((ext_vector_type(2)));
typedef unsigned v4u __attribute__((ext_vector_type(4)));
typedef unsigned v2u __attribute__((ext_vector_type(2)));
#define GAS __attribute__((address_space(1)))

constexpr size_t al256(size_t x) { return (x + 255) & ~(size_t)255; }
constexpr size_t WS_CTL = 0, CTL_ZERO_BYTES = 1u << 20;
constexpr size_t WS_MOD = CTL_ZERO_BYTES;
constexpr size_t WS_W13 = WS_MOD + al256((size_t)NLAYER * 3 * MODW * 4);
constexpr size_t SZ_W13 = (size_t)2 * FF * DM * 2;
constexpr size_t WS_W2 = WS_W13 + 4 * SZ_W13;
constexpr size_t SZ_W2 = (size_t)DM * FF * 2;
constexpr size_t WS_WIN = WS_W2 + 4 * SZ_W2;
constexpr size_t SZ_WIN = (size_t)ZN * DM * 2;
constexpr size_t WS_PC = WS_WIN + 2 * SZ_WIN;
constexpr size_t SZ_SQ = (size_t)DM * DM * 2;
constexpr size_t WS_WO = WS_PC + 2 * SZ_SQ;
constexpr size_t WS_H = WS_WO + 2 * SZ_SQ;
constexpr size_t WS_XN = WS_H + (size_t)MR * DM * 4;
constexpr size_t WS_HB = WS_XN + (size_t)MR * DM * 2;
constexpr size_t WS_Z = WS_HB + (size_t)MR * FF * 2;
constexpr size_t WS_ZAB = WS_Z + (size_t)MR * ZW * 2;
constexpr size_t SZ_DN = (size_t)MR * 1024 * 4;
constexpr size_t WS_G = WS_ZAB + (size_t)MR * 32 * 4;
constexpr size_t WS_BETA = WS_G + (size_t)MR * 16 * 4;
constexpr size_t WS_OF = WS_BETA + (size_t)MR * 16 * 4, WS_OB = WS_OF + SZ_DN;
constexpr size_t WS_VN = WS_OB + SZ_DN;
constexpr size_t WS_YCAT = WS_VN + SZ_DN;
constexpr size_t WS_YF = WS_YCAT + (size_t)MR * DM * 2;
constexpr size_t WS_YB = WS_YF + (size_t)MR * DM * 4;
constexpr size_t WS_VTL = WS_YB + (size_t)MR * DM * 2;
constexpr size_t WS_VTC = WS_VTL + (size_t)2 * 16 * 128 * SEQ * 2;
constexpr size_t WS_KB = WS_VTC + (size_t)2 * 16 * 128 * CTXL * 2;
constexpr size_t WS_QB = WS_KB + (size_t)MR * 1024 * 2;
constexpr size_t WS_KT = WS_QB + (size_t)MR * 1024 * 2;
constexpr size_t SZ_KT = (size_t)2 * 8 * 128 * (CTXL + SEQ) * 2;
constexpr size_t WS_VT2 = WS_KT + SZ_KT;
constexpr size_t WS_WB = WS_VT2 + SZ_KT;
constexpr size_t WS_UB = WS_WB + (size_t)2176 * 64 * 128 * 2;
constexpr size_t WS_QKM = WS_UB + (size_t)2176 * 64 * 128 * 4;
constexpr size_t WS_EG = WS_QKM + (size_t)2176 * 64 * 64 * 2;
constexpr size_t WS_ROPE = WS_EG + (size_t)2176 * 128 * 4;
constexpr size_t WS_SLAB = WS_ROPE + 2048 * 2 * 4;
constexpr size_t WS_GF = WS_SLAB + (size_t)8 * TC * DM * 4;
constexpr size_t WS_END = WS_GF + (size_t)32 * 48 * 8 * 16 * 64 * 8 * 2;
constexpr int CW_AQ = 1024;
constexpr int CW_FN = 2048;
constexpr int CW_UF = 8192;
constexpr int CW_BAR = 4096;

constexpr int RING_BYTES = 131072, MISC_OFF = RING_BYTES + 320, LDS_BYTES = 147456;

#define LAS __attribute__((address_space(3)))
#define LDS_WAIT() asm volatile("s_waitcnt lgkmcnt(0)" ::: "memory")
#define VM_WAIT() asm volatile("s_waitcnt vmcnt(0)" ::: "memory")
#define XB_TMO      128
#define XB_XCNT(j)  (256  + 64 * (j))
#define XB_XSUB(j)  (1280 + 64 * (j))
#define XB_XGEN(j)  (2304 + 64 * (j))
#define XB_TOP      3328
#define XB_TOPGEN   3392
#define XCD_BAR_WORDS 3456
#define XB_SPIN_CAP (1u << 18)

__device__ __forceinline__ unsigned xb_ld(unsigned* p)              { return __hip_atomic_load(p, __ATOMIC_RELAXED, __HIP_MEMORY_SCOPE_AGENT); }
__device__ __forceinline__ unsigned xb_add(unsigned* p, unsigned v) { return __hip_atomic_fetch_add(p, v, __ATOMIC_RELAXED, __HIP_MEMORY_SCOPE_AGENT); }
__device__ __forceinline__ unsigned xb_xcc_id() { return (unsigned)__builtin_amdgcn_s_getreg((3 << 11) | 20) & 0xFu; }
#define XB_SPIN(cond, bar) do { unsigned _sp = 0; while (cond) { __builtin_amdgcn_s_sleep(1); \
    if ((++_sp & 255u) == 0u) { if (xb_ld(&(bar)[XB_TMO])) break; if (_sp > XB_SPIN_CAP) { atomicAdd(&(bar)[XB_TMO], 1u); break; } } } } while (0)

struct XcdBarrier {
    unsigned* bar; unsigned x;
    volatile LAS unsigned* st;
};

__device__ __forceinline__ XcdBarrier xcd_barrier_post(unsigned* bar, volatile LAS unsigned* st) {
    XcdBarrier b; b.bar = bar; b.x = xb_xcc_id(); b.st = st;
    if (threadIdx.x == 0) (void)xb_add(&bar[XB_XCNT(b.x)], 1u);
    return b;
}
__device__ __forceinline__ void xcd_barrier_complete(unsigned* bar, unsigned x, unsigned& nloc, unsigned& nx) {
    const unsigned G = gridDim.x * gridDim.y * gridDim.z;
    unsigned sum, cnt, mine, sp = 0u;
    for (;;) {
        sum = 0u; cnt = 0u; mine = 0u;
#pragma unroll
        for (unsigned j = 0; j < 16; ++j) { const unsigned c = xb_ld(&bar[XB_XCNT(j)]); sum += c; cnt += (c > 0u) ? 1u : 0u; mine = (j == x) ? c : mine; }
        if (sum == G) break;
        __builtin_amdgcn_s_sleep(1);
        if ((++sp & 255u) == 0u) { if (xb_ld(&bar[XB_TMO])) break; if (sp > XB_SPIN_CAP) { atomicAdd(&bar[XB_TMO], 1u); break; } }
    }
    nloc = mine > 0u ? mine : 1u; nx = cnt > 0u ? cnt : 1u;
}

__device__ __forceinline__ void xcd_barrier(const XcdBarrier& b) {
    asm volatile("s_waitcnt vmcnt(0)" ::: "memory");
    __syncthreads();
    if (threadIdx.x == 0) {
        unsigned* bar = b.bar;
        __builtin_amdgcn_s_waitcnt(0);
        unsigned nloc = b.st[0], nx = b.st[1];
        if (nloc == 0u) { xcd_barrier_complete(bar, b.x, nloc, nx); b.st[0] = nloc; b.st[1] = nx; }
        const unsigned old = xb_add(&bar[XB_XSUB(b.x)], 1u);
        const unsigned gen = old / nloc;
        if (old + 1u == (gen + 1u) * nloc) {
            __builtin_amdgcn_fence(__ATOMIC_RELEASE, "agent");
            asm volatile("s_waitcnt vmcnt(0)" ::: "memory");
            const unsigned og = xb_add(&bar[XB_TOP], 1u);
            const unsigned tg = og / nx;
            if (og + 1u == (tg + 1u) * nx) xb_add(&bar[XB_TOPGEN], 1u);
            else XB_SPIN(xb_ld(&bar[XB_TOPGEN]) == tg, bar);
            __builtin_amdgcn_fence(__ATOMIC_ACQUIRE, "agent");
            xb_add(&bar[XB_XGEN(b.x)], 1u);
            asm volatile("s_waitcnt vmcnt(0)" ::: "memory");
        } else {
            XB_SPIN(xb_ld(&bar[XB_XGEN(b.x)]) == gen, bar);
            __builtin_amdgcn_fence(__ATOMIC_ACQUIRE, "agent");
            asm volatile("s_waitcnt vmcnt(0)" ::: "memory");
        }
    }
    __syncthreads();
}

__device__ __forceinline__ float wave_sum(float v) {
#pragma unroll
    for (int o = 1; o < 64; o <<= 1) v += __shfl_xor(v, o);
    return v;
}
__device__ __forceinline__ float wave_max(float v) {
#pragma unroll
    for (int o = 1; o < 64; o <<= 1) v = fmaxf(v, __shfl_xor(v, o));
    return v;
}
__device__ __forceinline__ float bflo(unsigned u) { return __builtin_bit_cast(float, u << 16); }
__device__ __forceinline__ float bfhi(unsigned u) { return __builtin_bit_cast(float, u & 0xffff0000u); }
typedef __bf16 bf16x2v_t __attribute__((ext_vector_type(2)));
__device__ __forceinline__ unsigned pk2(float lo, float hi) { bf16x2v_t v = {(__bf16)lo, (__bf16)hi}; return __builtin_bit_cast(unsigned, v); }
__device__ __forceinline__ float sigmoidf_(float x) { return 1.0f / (1.0f + __expf(-x)); }
__device__ __forceinline__ float siluf_(float x) { return x * sigmoidf_(x); }
__device__ __forceinline__ float gelu_tanh(float x) { const float u = 1.5957691216057308f * (x + 0.044715f * x * x * x); return x / (1.0f + __expf(-u)); }
__device__ __forceinline__ void row_info(int row, int& base, int& t, int& T, int& v) {
    if (row < TL) { const int b = row >> 12; base = b << 12; t = row & 4095; T = SEQ; v = b; }
    else { const int r = row - TL; const int b = r >> 8; base = TL + (b << 8); t = r & 255; T = CTXL; v = 2; }
}

__device__ __forceinline__ void cvt_item(const float* __restrict__ W, int N, bf16* WT, size_t dpitch, int k0, int n0, size_t dbase, LAS float* scr, int lane) {
#pragma unroll 8
    for (int i = 0; i < 32; ++i) { const int kk = 2 * i + (lane >> 5); scr[kk * 33 + (lane & 31)] = __builtin_nontemporal_load(W + (size_t)(k0 + kk) * N + n0 + (lane & 31)); }
    LDS_WAIT(); asm volatile("" ::: "memory");
    const int c = lane & 7;
#pragma unroll
    for (int j = 0; j < 4; ++j) { const int n = (lane >> 3) + 8 * j; const LAS float* s = scr + (8 * c) * 33 + n;
        v4u o; o.x = pk2(s[0 * 33], s[1 * 33]); o.y = pk2(s[2 * 33], s[3 * 33]); o.z = pk2(s[4 * 33], s[5 * 33]); o.w = pk2(s[6 * 33], s[7 * 33]);
        __builtin_nontemporal_store(o, (GAS v4u*)(WT + dbase + (size_t)n * dpitch + k0 + 8 * c)); }
    LDS_WAIT(); asm volatile("" ::: "memory");
}
template <int MODE> __device__ __forceinline__ void cvt_matrix(const float* __restrict__ W, int K, int N, bf16* WT, size_t dpitch, int koff, int gw, int NGW, LAS float* scr, int lane) {
    const int nblk = N / 32, ngroups = (K / 512) * nblk, wg = gw >> 3, G_ = NGW >> 3, wv = gw & 7;
    for (int gi = wg; gi < ngroups; gi += G_) {
        const int kq = gi / nblk, nb = gi - kq * nblk, kb = 8 * kq + wv, n0 = nb * 32;
        int drow0;
        if (MODE == 0) drow0 = n0;
        else if (MODE == 1) drow0 = (n0 >> 7) * 256 + (n0 & 127);
        else if (MODE == 2) drow0 = (n0 >> 7) * 256 + 128 + (n0 & 127);
        else drow0 = nb < 64 ? n0 : (nb == 64 ? ZW : n0 - 32);
        cvt_item(W, N, WT, dpitch, kb * 64, n0, (size_t)drow0 * dpitch + koff, scr, lane);
    }
}

__device__ __forceinline__ void mod_phase(const float* __restrict__ cvec, const float* __restrict__ cctx, const float* __restrict__ ada_w, const float* __restrict__ ada_b, float* mod,
                                          LAS unsigned char* lds, int tid, int lane, int wave, int bid, int G, int l_lo, int l_hi) {
    LAS float* sc = (LAS float*)lds;
    LAS float* red = (LAS float*)(lds + 49152);
    for (int i = tid; i < 3 * DM; i += NTHR) { const int v = i >> 12, k = i & 4095; const float x = v < 2 ? cvec[v * DM + k] : cctx[k]; sc[i] = siluf_(x); }
    __syncthreads();
    const int cl = lane & 15, kr = lane >> 4;
    for (int item = l_lo * (MODW / 64) + bid; item < l_hi * (MODW / 64); item += G) {
        const int l = item / (MODW / 64), cb = item - l * (MODW / 64), col0 = cb * 64;
        const float* wp = ada_w + (size_t)l * DM * MODW + col0 + 4 * cl;
        f32x4 a0 = {0.f, 0.f, 0.f, 0.f}, a1 = a0, a2 = a0;
#pragma unroll 8
        for (int i = 0; i < 128; ++i) { const int k = wave * 4 + kr + 32 * i;
            const f32x4 w = *(const f32x4*)(wp + (size_t)k * MODW);
            a0 += w * sc[k]; a1 += w * sc[DM + k]; a2 += w * sc[2 * DM + k]; }
#pragma unroll
        for (int e = 0; e < 4; ++e) { a0[e] += __shfl_xor(a0[e], 16); a0[e] += __shfl_xor(a0[e], 32); a1[e] += __shfl_xor(a1[e], 16); a1[e] += __shfl_xor(a1[e], 32); a2[e] += __shfl_xor(a2[e], 16); a2[e] += __shfl_xor(a2[e], 32); }
        if (kr == 0) {
#pragma unroll
            for (int e = 0; e < 4; ++e) { red[(wave * 3 + 0) * 64 + 4 * cl + e] = a0[e]; red[(wave * 3 + 1) * 64 + 4 * cl + e] = a1[e]; red[(wave * 3 + 2) * 64 + 4 * cl + e] = a2[e]; } }
        __syncthreads();
        if (tid < 192) { const int v = tid >> 6, c = tid & 63; float s = 0.f;
#pragma unroll
            for (int w = 0; w < 8; ++w) s += red[(w * 3 + v) * 64 + c];
            mod[((size_t)l * 3 + v) * MODW + col0 + c] = s + ada_b[(size_t)l * MODW + col0 + c]; }
        __syncthreads();
    }
}

__device__ __forceinline__ void norm_phase(const float* in_lat, const float* in_ctx, const float* __restrict__ nw, const float* modl  , int isub, bf16* xn, int nrows,
                                           const float* slab, const float* gatev, float coef, float* hctx_out, LAS unsigned char* lds, int tid, int lane, int gw, int NGW) {
    LAS float* AL = (LAS float*)lds;
    LAS float* SL = AL + 3 * DM;
    __syncthreads();
    for (int i = tid; i < 3 * DM / 4; i += NTHR) { const int v = i >> 10, c = (i & 1023) * 4;
        const f32x4 w = *(const f32x4*)(nw + c), sc = *(const f32x4*)(modl + (size_t)v * MODW + (isub * 3 + 1) * DM + c), sh = *(const f32x4*)(modl + (size_t)v * MODW + (isub * 3 + 0) * DM + c);
        *(LAS f32x4*)(AL + v * DM + c) = w * (sc + 1.0f); *(LAS f32x4*)(SL + v * DM + c) = sh; }
    __syncthreads();
    if (nrows > TL) { const int wave_ = gw & 7, bid_ = gw >> 3, G_ = NGW >> 3; LAS float* red = (LAS float*)(lds + 98304);
        for (int r = bid_; r < nrows - TL; r += G_) {
            const int c0 = 512 * wave_ + 4 * lane; const size_t ro = (size_t)r * DM;
            f32x4 xh[2], sp[8][2];
#pragma unroll
            for (int jj = 0; jj < 2; ++jj) { xh[jj] = *(const f32x4*)(in_ctx + ro + c0 + 256 * jj);
                if (slab != nullptr) {
#pragma unroll
                    for (int k = 0; k < 8; ++k) sp[k][jj] = *(const f32x4*)(slab + ((size_t)k * 512 + r) * DM + c0 + 256 * jj); } }
            float ss = 0.f;
#pragma unroll
            for (int jj = 0; jj < 2; ++jj) {
                if (slab != nullptr) { f32x4 s = sp[0][jj];
#pragma unroll
                    for (int k = 1; k < 8; ++k) s += sp[k][jj];
                    xh[jj] += (*(const f32x4*)(gatev + c0 + 256 * jj) * coef) * s; *(f32x4*)(hctx_out + ro + c0 + 256 * jj) = xh[jj]; }
                ss += (xh[jj][0] * xh[jj][0] + xh[jj][1] * xh[jj][1]) + (xh[jj][2] * xh[jj][2] + xh[jj][3] * xh[jj][3]); }
            ss = wave_sum(ss);
            __syncthreads();
            if (lane == 0) red[wave_] = ss;
            __syncthreads();
            float tot = 0.f;
#pragma unroll
            for (int w = 0; w < 8; ++w) tot += red[w];
            const float rr = 1.0f / sqrtf(tot * (1.0f / DM) + EPS);
#pragma unroll
            for (int jj = 0; jj < 2; ++jj) { const int c = c0 + 256 * jj;
                const f32x4 a = *(const LAS f32x4*)(AL + 2 * DM + c), sh = *(const LAS f32x4*)(SL + 2 * DM + c);
                const f32x4 y = (xh[jj] * rr) * a + sh;
                v2u o; o.x = pk2(y[0], y[1]); o.y = pk2(y[2], y[3]);
                *(v2u*)(xn + (size_t)(TL + r) * DM + c) = o; }
        }
        nrows = TL;
    }
    f32x4 xq[16];
    if (gw < nrows) { const float* s0 = gw < TL ? in_lat + (size_t)gw * DM : in_ctx + (size_t)(gw - TL) * DM;
#pragma unroll
        for (int j = 0; j < 16; ++j) xq[j] = *(const f32x4*)(s0 + 4 * (lane + 64 * j)); }
    for (int row = gw; row < nrows; row += NGW) {
        const int v = row < SEQ ? 0 : (row < TL ? 1 : 2);
        f32x4 x[16]; float ss = 0.f;
#pragma unroll
        for (int j = 0; j < 16; ++j) x[j] = xq[j];
        { const int nr = row + NGW;
          if (nr < nrows) { const float* s1 = nr < TL ? in_lat + (size_t)nr * DM : in_ctx + (size_t)(nr - TL) * DM;
#pragma unroll
            for (int j = 0; j < 16; ++j) xq[j] = *(const f32x4*)(s1 + 4 * (lane + 64 * j)); } }
#pragma unroll
        for (int j = 0; j < 16; ++j) ss += (x[j][0] * x[j][0] + x[j][1] * x[j][1]) + (x[j][2] * x[j][2] + x[j][3] * x[j][3]);
        const float r = 1.0f / sqrtf(wave_sum(ss) * (1.0f / DM) + EPS);
#pragma unroll
        for (int j = 0; j < 16; ++j) { const int c = 4 * (lane + 64 * j);
            const f32x4 a = *(const LAS f32x4*)(AL + v * DM + c), sh = *(const LAS f32x4*)(SL + v * DM + c);
            const f32x4 y = (x[j] * r) * a + sh;
            v2u o; o.x = pk2(y[0], y[1]); o.y = pk2(y[2], y[3]);
            *(v2u*)(xn + (size_t)row * DM + c) = o; }
    }
}
__device__ __forceinline__ void final_norm_phase(const float* h, const float* __restrict__ fw, float* out, int lane, int gw, int NGW) {
    for (int row = gw; row < TL; row += NGW) {
        const float* src = h + (size_t)row * DM;
        f32x4 x[16]; float ss = 0.f;
#pragma unroll
        for (int j = 0; j < 16; ++j) { x[j] = *(const f32x4*)(src + 4 * (lane + 64 * j)); ss += (x[j][0] * x[j][0] + x[j][1] * x[j][1]) + (x[j][2] * x[j][2] + x[j][3] * x[j][3]); }
        const float r = 1.0f / sqrtf(wave_sum(ss) * (1.0f / DM) + EPS);
#pragma unroll
        for (int j = 0; j < 16; ++j) { const int c = 4 * (lane + 64 * j); const f32x4 w = *(const f32x4*)(fw + c);
            *(f32x4*)(out + (size_t)row * DM + c) = (x[j] * r) * w;
            if ((j & 3) == 3) asm volatile("" ::: "memory"); }
    }
}

__device__ __forceinline__ void gm_prep_phase(const bf16* z, const float* __restrict__ snw, float* vn, int lane, int gw, int NGW) {
    v4u pu[2] = {{0u, 0u, 0u, 0u}, {0u, 0u, 0u, 0u}};
    if (gw < MR) { pu[0] = *(const v4u*)(z + (size_t)gw * ZW + Z_GMV + 8 * lane); pu[1] = *(const v4u*)(z + (size_t)gw * ZW + Z_GMV + 8 * lane + 512); }
    for (int row = gw; row < MR; row += NGW) {
        float x[16]; float s = 0.f;
        const v4u cu0 = pu[0], cu1 = pu[1];
        if (row + NGW < MR) { pu[0] = *(const v4u*)(z + (size_t)(row + NGW) * ZW + Z_GMV + 8 * lane); pu[1] = *(const v4u*)(z + (size_t)(row + NGW) * ZW + Z_GMV + 8 * lane + 512); }
#pragma unroll
        for (int j = 0; j < 2; ++j) { const v4u u = j ? cu1 : cu0;
            x[8 * j + 0] = gelu_tanh(bflo(u.x)); x[8 * j + 1] = gelu_tanh(bfhi(u.x)); x[8 * j + 2] = gelu_tanh(bflo(u.y)); x[8 * j + 3] = gelu_tanh(bfhi(u.y));
            x[8 * j + 4] = gelu_tanh(bflo(u.z)); x[8 * j + 5] = gelu_tanh(bfhi(u.z)); x[8 * j + 6] = gelu_tanh(bflo(u.w)); x[8 * j + 7] = gelu_tanh(bfhi(u.w)); }
#pragma unroll
        for (int i = 0; i < 16; ++i) s += x[i];
        const float mu = wave_sum(s) * (1.0f / 1024.0f); float q = 0.f;
#pragma unroll
        for (int i = 0; i < 16; ++i) { x[i] -= mu; q += x[i] * x[i]; }
        const float rs = 1.0f / sqrtf(wave_sum(q) * (1.0f / 1024.0f) + EPS);
#pragma unroll
        for (int j = 0; j < 2; ++j) { const int c = 8 * lane + 512 * j;
            const f32x4 w0 = *(const f32x4*)(snw + c), w1 = *(const f32x4*)(snw + c + 4);
            *(f32x4*)(vn + (size_t)row * 1024 + c) = (f32x4){x[8 * j + 0] * rs * w0[0], x[8 * j + 1] * rs * w0[1], x[8 * j + 2] * rs * w0[2], x[8 * j + 3] * rs * w0[3]};
            *(f32x4*)(vn + (size_t)row * 1024 + c + 4) = (f32x4){x[8 * j + 4] * rs * w1[0], x[8 * j + 5] * rs * w1[1], x[8 * j + 6] * rs * w1[2], x[8 * j + 7] * rs * w1[3]}; }
    }
}

__device__ __forceinline__ void dn_out_phase(const float* of, const float* ob, const bf16* z, const float* __restrict__ dnw, bf16* ycat, int nrows, int lane, int gw, int NGW) {
    const int sub = lane >> 4, l16 = lane & 15;
    const f32x4 w0 = *(const f32x4*)(dnw + 8 * l16), w1 = *(const f32x4*)(dnw + 8 * l16 + 4);
    f32x4 pf0 = {0.f, 0.f, 0.f, 0.f}, pf1 = pf0, pb0 = pf0, pb1 = pf0; v4u pg = {0u, 0u, 0u, 0u};
    { const int it0 = gw * 4 + sub; if (it0 < nrows * 8) { const int row = it0 >> 3, hd = it0 & 7; const size_t o = (size_t)row * 1024 + hd * 128 + 8 * l16;
        pf0 = *(const f32x4*)(of + o); pf1 = *(const f32x4*)(of + o + 4); pb0 = *(const f32x4*)(ob + o); pb1 = *(const f32x4*)(ob + o + 4); pg = *(const v4u*)(z + (size_t)row * ZW + Z_DNG + hd * 128 + 8 * l16); } }
    for (int it = gw * 4 + sub; it < nrows * 8; it += NGW * 4) {
        const int row = it >> 3, hd = it & 7;
        f32x4 a0 = pf0 + pb0, a1 = pf1 + pb1; const v4u gu = pg;
        { const int it2 = it + NGW * 4; if (it2 < nrows * 8) { const int row2 = it2 >> 3, hd2 = it2 & 7; const size_t o2 = (size_t)row2 * 1024 + hd2 * 128 + 8 * l16;
            pf0 = *(const f32x4*)(of + o2); pf1 = *(const f32x4*)(of + o2 + 4); pb0 = *(const f32x4*)(ob + o2); pb1 = *(const f32x4*)(ob + o2 + 4); pg = *(const v4u*)(z + (size_t)row2 * ZW + Z_DNG + hd2 * 128 + 8 * l16); } }
        float ss = (a0[0] * a0[0] + a0[1] * a0[1]) + (a0[2] * a0[2] + a0[3] * a0[3]) + (a1[0] * a1[0] + a1[1] * a1[1]) + (a1[2] * a1[2] + a1[3] * a1[3]);
        ss += __shfl_xor(ss, 1); ss += __shfl_xor(ss, 2); ss += __shfl_xor(ss, 4); ss += __shfl_xor(ss, 8);
        const float r = 1.0f / sqrtf(ss * (1.0f / 128.0f) + EPS);
        v4u out; out.x = pk2(a0[0] * r * w0[0] * siluf_(bflo(gu.x)), a0[1] * r * w0[1] * siluf_(bfhi(gu.x))); out.y = pk2(a0[2] * r * w0[2] * siluf_(bflo(gu.y)), a0[3] * r * w0[3] * siluf_(bfhi(gu.y)));
        out.z = pk2(a1[0] * r * w1[0] * siluf_(bflo(gu.z)), a1[1] * r * w1[1] * siluf_(bfhi(gu.z))); out.w = pk2(a1[2] * r * w1[2] * siluf_(bflo(gu.w)), a1[3] * r * w1[3] * siluf_(bfhi(gu.w)));
        *(v4u*)(ycat + (size_t)row * DM + 1024 + hd * 128 + 8 * l16) = out;
    }
}
__device__ __forceinline__ void merge_ctx_phase(const float* slab, const bf16* z, bf16* yb, int lane, int gw, int NGW) {
    const int wave_ = gw & 7, bid_ = gw >> 3, G_ = NGW >> 3;
    for (int r = bid_; r < TC; r += G_) { const size_t row = (size_t)TL + r;
#pragma unroll
        for (int jj = 0; jj < 2; ++jj) { const int c = 512 * wave_ + 4 * lane + 256 * jj; f32x4 y = {0.f, 0.f, 0.f, 0.f};
            v2u gu[3]; f32x4 sp[8];
#pragma unroll
            for (int br = 0; br < 3; ++br) gu[br] = *(const v2u*)(z + row * ZW + Z_GA + br * 4096 + c);
#pragma unroll
            for (int k = 0; k < 8; ++k) sp[k] = *(const f32x4*)(slab + ((size_t)k * 512 + r) * DM + c);
#pragma unroll
            for (int br = 0; br < 3; ++br) { f32x4 s = {0.f, 0.f, 0.f, 0.f};
#pragma unroll
                for (int k = (br == 0 ? 0 : (br == 1 ? 2 : 4)); k < (br == 0 ? 2 : (br == 1 ? 4 : 8)); ++k) s += sp[k];
                y[0] += sigmoidf_(bflo(gu[br].x)) * s[0]; y[1] += sigmoidf_(bfhi(gu[br].x)) * s[1]; y[2] += sigmoidf_(bflo(gu[br].y)) * s[2]; y[3] += sigmoidf_(bfhi(gu[br].y)) * s[3]; }
            v2u o; o.x = pk2(y[0], y[1]); o.y = pk2(y[2], y[3]); *(v2u*)(yb + row * DM + c) = o; }
    }
}

__device__ __forceinline__ void vt_phase(const bf16* z, bf16* vf, bf16* vtc, LAS unsigned char* lds, int lane, int wave, int gw, int NGW) {
    LAS unsigned short* T = (LAS unsigned short*)(lds + wave * 8448);
    constexpr int NIT = 2 * 16 * 4 * 2;
    for (int it = gw; it < NIT; it += NGW) {
        const int dh = it & 1; int r = it >> 1; const int tb = 64 + (r & 3); r >>= 2; const int h = r & 15, b = r >> 4;
        const int row0 = tb < 64 ? b * SEQ + tb * 64 : TL + b * CTXL + (tb - 64) * 64;
#pragma unroll
        for (int j = 0; j < 8; ++j) { const int tok = 8 * j + (lane >> 3), ch = lane & 7;
            const v4u v = *(const v4u*)(z + (size_t)(row0 + tok) * ZW + Z_NAV + h * 128 + dh * 64 + 8 * ch);
            LAS unsigned* d = (LAS unsigned*)(T + tok * 66 + 8 * ch); d[0] = v.x; d[1] = v.y; d[2] = v.z; d[3] = v.w; }
        LDS_WAIT(); asm volatile("" ::: "memory");
        unsigned w[32];
#pragma unroll
        for (int t = 0; t < 32; ++t) w[t] = (unsigned)T[(2 * t) * 66 + lane] | ((unsigned)T[(2 * t + 1) * 66 + lane] << 16);
        if (tb < 64) { bf16* dst = vf + (((size_t)(b * 16 + h) * 512 + tb * 8) * 128 + dh * 64 + lane) * 8;
#pragma unroll
            for (int j = 0; j < 8; ++j) *(v4u*)(dst + (size_t)j * 1024) = (v4u){w[4 * j], w[4 * j + 1], w[4 * j + 2], w[4 * j + 3]};
        } else { bf16* dst = vtc + ((size_t)(b * 16 + h) * 128 + dh * 64 + lane) * CTXL + (tb - 64) * 64;
#pragma unroll
            for (int j = 0; j < 8; ++j) *(v4u*)(dst + 8 * j) = (v4u){w[4 * j], w[4 * j + 1], w[4 * j + 2], w[4 * j + 3]}; }
        LDS_WAIT(); asm volatile("" ::: "memory");
    }
}

typedef short bf16x8_t __attribute__((ext_vector_type(8)));
struct AttnState { float mrun, lrun; f32x4 oa[8]; };
template <bool LOC, bool QFR> __device__ __forceinline__ void attn_chunk(AttnState& st, const char* qbase, const char* kbase, const char* vbase,
                                                               const LAS unsigned char* KL, const LAS unsigned char* VL, const LAS float* rpbL, int cc, int drow0, int lo, int cg, int lane) {
    asm volatile("" : "+v"(lane));
    const int q = lane & 15, g = lane >> 4, krl = 8 * (q >> 2) + (q & 3);
    const int c = 16 * cg + q, c0 = min(max(c - 8, 0), 48);
    const unsigned kloff = (unsigned)((q >> 2) * 2048 + g * 64 + (q & 3) * 16), vloff = (unsigned)(g * 2048 + q * 16), qloff = QFR ? (unsigned)lane * 16u : (unsigned)(q * ZW + 8 * g) * 2u;
    const float scale = 0.08838834764831845f;
    f32x4 sX[4], sY[4];
    bf16x8_t fr[LOC ? 4 : 1][8];
    bf16x8_t qf[4];
#pragma unroll
    for (int k = 0; k < 4; ++k) qf[k] = *(const GAS bf16x8_t*)((const GAS char*)qbase + qloff + (QFR ? 1024 : 64) * k);
    if constexpr (LOC) {
#pragma unroll
        for (int i = 0; i < 4; ++i) { const char* pk = kbase + (size_t)i * 16384; asm volatile("" : "+s"(pk));
#pragma unroll
            for (int y = 0; y < 2; ++y)
#pragma unroll
                for (int k = 0; k < 4; ++k) fr[i][4 * y + k] = *(const GAS bf16x8_t*)((const GAS char*)pk + kloff + (1024 * y + 256 * k)); }
        asm volatile("" ::: "memory");
#pragma unroll
        for (int i = 0; i < 4; ++i) { f32x4 ax = {0.f, 0.f, 0.f, 0.f}, ay = ax;
#pragma unroll
            for (int k = 0; k < 4; ++k) { ax = __builtin_amdgcn_mfma_f32_16x16x32_bf16(fr[i][k], qf[k], ax, 0, 0, 0); ay = __builtin_amdgcn_mfma_f32_16x16x32_bf16(fr[i][4 + k], qf[k], ay, 0, 0, 0); }
            sX[i] = ax; sY[i] = ay; }
#pragma unroll
        for (int i = 0; i < 4; ++i) { const char* pv = vbase + (size_t)i * 16384; asm volatile("" : "+s"(pv));
#pragma unroll
            for (int d = 0; d < 8; ++d) fr[i][d] = *(const GAS bf16x8_t*)((const GAS char*)pv + vloff + 256 * d); }
        asm volatile("" ::: "memory");
    } else {
#pragma unroll
        for (int i = 0; i < 4; ++i) { const int keyx = 128 * cc + 32 * i + krl, keyy = keyx + 4;
            const int fx = ((keyx & 15) + 4 * ((keyx >> 4) & 1)) & 15, fy = ((keyy & 15) + 4 * ((keyy >> 4) & 1)) & 15;
            bf16x8_t kx[4], ky[4];
#pragma unroll
            for (int k = 0; k < 4; ++k) { kx[k] = *(const LAS bf16x8_t*)(KL + keyx * 256 + (((4 * k + g) ^ fx) << 4)); ky[k] = *(const LAS bf16x8_t*)(KL + keyy * 256 + (((4 * k + g) ^ fy) << 4)); }
            f32x4 ax = {0.f, 0.f, 0.f, 0.f}, ay = ax;
#pragma unroll
            for (int k = 0; k < 4; ++k) { ax = __builtin_amdgcn_mfma_f32_16x16x32_bf16(kx[k], qf[k], ax, 0, 0, 0); ay = __builtin_amdgcn_mfma_f32_16x16x32_bf16(ky[k], qf[k], ay, 0, 0, 0); }
            sX[i] = ax; sY[i] = ay; }
    }
    float mx = -3.0e38f;
#pragma unroll
    for (int i = 0; i < 4; ++i) {
#pragma unroll
        for (int e = 0; e < 4; ++e) {
            float x = sX[i][e] * scale, y = sY[i][e] * scale;
            if constexpr (LOC) { const int kcx = lo + 8 * g + e, kcy = kcx + 4; const int dr = drow0 + i;
                const bool vx = (kcx >= c0) && (kcx < c0 + 16), vy = (kcy >= c0) && (kcy < c0 + 16);
                const float bx = rpbL[dr * 31 + min(max(kcx - c + 15, 0), 30)], by = rpbL[dr * 31 + min(max(kcy - c + 15, 0), 30)];
                x = vx ? x + bx : -1.0e30f; y = vy ? y + by : -1.0e30f; }
            sX[i][e] = x; sY[i][e] = y; mx = fmaxf(mx, fmaxf(x, y)); }
    }
    mx = fmaxf(mx, __shfl_xor(mx, 16)); mx = fmaxf(mx, __shfl_xor(mx, 32));
    const float mnew = fmaxf(st.mrun, mx), alpha = __expf(st.mrun - mnew);
    st.mrun = mnew;
    float psum = 0.f;
#pragma unroll
    for (int i = 0; i < 4; ++i)
#pragma unroll
        for (int e = 0; e < 4; ++e) { const float x = __expf(sX[i][e] - mnew), y = __expf(sY[i][e] - mnew); sX[i][e] = x; sY[i][e] = y; psum += x + y; }
    st.lrun = st.lrun * alpha + psum;
#pragma unroll
    for (int d = 0; d < 8; ++d) st.oa[d] *= alpha;
#pragma unroll
    for (int i = 0; i < 4; ++i) {
        v4u pu; pu.x = pk2(sX[i][0], sX[i][1]); pu.y = pk2(sX[i][2], sX[i][3]); pu.z = pk2(sY[i][0], sY[i][1]); pu.w = pk2(sY[i][2], sY[i][3]);
        const bf16x8_t pf = __builtin_bit_cast(bf16x8_t, pu);
        if constexpr (LOC) {
#pragma unroll
            for (int d = 0; d < 8; ++d) st.oa[d] = __builtin_amdgcn_mfma_f32_16x16x32_bf16(fr[i][d], pf, st.oa[d], 0, 0, 0);
        } else { const int chn = 16 * cc + 4 * i + g; bf16x8_t vf[8];
#pragma unroll
            for (int d = 0; d < 8; ++d) vf[d] = *(const LAS bf16x8_t*)(VL + (16 * d + q) * 512 + ((chn ^ q) << 4));
#pragma unroll
            for (int d = 0; d < 8; ++d) st.oa[d] = __builtin_amdgcn_mfma_f32_16x16x32_bf16(vf[d], pf, st.oa[d], 0, 0, 0); }
    }
}
template <bool LOCAL> __device__ __forceinline__ void attn_unit(const bf16* z, const bf16* qfb, const bf16* vtl  , const bf16* kf, const LAS unsigned char* KL, const LAS unsigned char* VL, const LAS float* rpbL, bf16* ycat, int b, int r, int cg, int qb, int h, int lane) {
    const int qrow0 = LOCAL ? (b * SEQ + r * 64 + 16 * cg) : (TL + b * CTXL + 16 * qb);
    const int r0 = min(max(r - 4, 0), 56), lo = min(max(16 * cg - 8, 0), 32);
    const char* qbase = LOCAL ? (const char*)qfb + (((size_t)(b * 16 + h) * 256 + r * 4 + cg) * 4) * 1024 : (const char*)(z + (size_t)qrow0 * ZW + Z_NAQ + h * 128);
    AttnState st; st.mrun = -3.0e38f; st.lrun = 0.f;
#pragma unroll
    for (int d = 0; d < 8; ++d) st.oa[d] = (f32x4){0.f, 0.f, 0.f, 0.f};
    if constexpr (LOCAL) {
#pragma unroll 1
        for (int ck = 0; ck < 2; ++ck) {
            const int tok0 = (r0 + 4 * ck) * 64 + lo;
            const char* kbase = (const char*)kf + ((size_t)(b * 16 + h) * 1024 + (tok0 >> 2)) * 1024;
            const char* vbase = (const char*)vtl + ((size_t)(b * 16 + h) * 512 + (tok0 >> 3)) * 2048;
            attn_chunk<true, true>(st, qbase, kbase, vbase, KL, VL, rpbL, 0, r0 + 4 * ck - r + 7, lo, cg, lane);
        }
    }
#pragma unroll 1
    for (int cc = 0; cc < 2; ++cc) attn_chunk<false, LOCAL>(st, qbase, nullptr, nullptr, KL, VL, rpbL, cc, 0, 0, 0, lane);
    asm volatile("" : "+v"(lane));
    const int q = lane & 15, g = lane >> 4;
    float lrun = st.lrun;
    lrun += __shfl_xor(lrun, 16); lrun += __shfl_xor(lrun, 32);
    const float inv = 1.0f / lrun;
    bf16* op = ycat + (size_t)(qrow0 + q) * DM + 2048 + h * 128 + 4 * g;
#pragma unroll
    for (int d = 0; d < 8; ++d) { v2u o; o.x = pk2(st.oa[d][0] * inv, st.oa[d][1] * inv); o.y = pk2(st.oa[d][2] * inv, st.oa[d][3] * inv); *(v2u*)(op + 16 * d) = o; }
}

__device__ __forceinline__ int attn_item_bh(int it) { return (it & 7) + 8 * ((it >> 3) & 3); }
__device__ __forceinline__ void attn_wg(int it, const bf16* z, const bf16* vtl  , const bf16* kf, const bf16* qfb, const bf16* vtc, const float* __restrict__ rpb  , bf16* ycat, bool ctxq, bool stage, LAS unsigned char* lds, int tid) {
    const int bh = attn_item_bh(it), rp = it >> 5, b = bh >> 4, h = bh & 15;
    LAS unsigned char* KL = lds; LAS unsigned char* VL = lds + 65536; LAS float* rpbL = (LAS float*)(lds + RING_BYTES + 1024);
    asm volatile("" : "+v"(tid));
    __syncthreads();
    if (stage) {
#pragma unroll
    for (int j = 0; j < 8; ++j) { const int i = tid + NTHR * j; const int key = i >> 4, ch = i & 15; const int fk = ((key & 15) + 4 * ((key >> 4) & 1)) & 15;
        *(LAS v4u*)(KL + key * 256 + ((ch ^ fk) << 4)) = *(const v4u*)(z + (size_t)(TL + b * CTXL + key) * ZW + Z_NAK + h * 128 + 8 * ch); }
#pragma unroll
    for (int j = 0; j < 8; ++j) { const int i = tid + NTHR * j; const int dim = i >> 5, ch = i & 31;
        *(LAS v4u*)(VL + dim * 512 + ((ch ^ (dim & 15)) << 4)) = *(const v4u*)(vtc + ((size_t)(b * 16 + h) * 128 + dim) * CTXL + 8 * ch); }
    for (int i = tid; i < 465; i += NTHR) rpbL[i] = rpb[h * 465 + i];
    }
    __syncthreads();
    asm volatile("" : "+v"(tid));
    const int wave = __builtin_amdgcn_readfirstlane(tid >> 6), lane = tid & 63;
    attn_unit<true>(z, qfb, vtl, kf, KL, VL, rpbL, ycat, b, 2 * rp + (wave >> 2), wave & 3, 0, h, lane);
    if (ctxq && wave == 0 && (rp & 1) == 0) attn_unit<false>(z, qfb, vtl, kf, KL, VL, rpbL, ycat, b, 0, 0, rp >> 1, h, lane);
}

constexpr int NPOS = CTXL + SEQ;
__device__ __forceinline__ int pos_row(int b, int P) { return P < CTXL ? TL + b * CTXL + P : b * SEQ + (P - CTXL); }

__device__ __forceinline__ void rope_table_phase(float* rope, int lane, int gw, int NGW) {
    for (int i = gw * 64 + lane; i < 2048; i += NGW * 64) { const int pos = i >> 5, fi = i & 31; const float f = powf(10000.0f, -(float)fi * (1.0f / 32.0f)); float s, c; sincosf((float)pos * f, &s, &c); rope[2 * i] = c; rope[2 * i + 1] = s; }
}
__device__ __forceinline__ void dn_prep3_phase(const bf16* z, const float* zab, const float* __restrict__ convw, const float* __restrict__ a_log, const float* __restrict__ dt_bias, const float* rope,
                                               bf16* KB, bf16* QB, bf16* KT, bf16* VT2, float* gout, float* bout, int lane, int gw, int NGW) {
    const int i0 = (2 * lane) & 31; const bool second = (lane & 16) != 0;
#define DN_LOADZ(dst, itx) do { const int tb_ = (itx) >> 3, ch_ = ((itx) & 7) * 128 + 2 * lane; int t0_, T_, base_; \
        if (tb_ < 1024) { t0_ = (tb_ & 511) * 8; T_ = SEQ; base_ = (tb_ >> 9) * SEQ; } else { const int cb_ = tb_ - 1024; t0_ = (cb_ & 31) * 8; T_ = CTXL; base_ = TL + (cb_ >> 5) * CTXL; } \
        _Pragma("unroll") for (int w = 0; w < 3; ++w) { const int zc_ = (w == 0 ? Z_DNK : (w == 1 ? Z_DNV : Z_DNQ)) + ch_; \
            _Pragma("unroll") for (int r = 0; r < 12; ++r) { const int tt_ = t0_ - 2 + r; dst[w][r] = (tt_ >= 0 && tt_ < T_) ? *(const unsigned*)(z + (size_t)(base_ + tt_) * ZW + zc_) : 0u; } } } while (0)
    unsigned zn[3][12];
    if (gw < 1088 * 8) DN_LOADZ(zn, gw);
#pragma unroll 1
    for (int it = gw; it < 1088 * 8; it += NGW) {
        const int tb = it >> 3, hd = it & 7;
        int row0, b, t0, T, base, P0;
        if (tb < 1024) { row0 = tb * 8; b = tb >> 9; t0 = (tb & 511) * 8; T = SEQ; base = b * SEQ; P0 = CTXL + t0; }
        else { const int cb = tb - 1024; row0 = TL + cb * 8; b = cb >> 5; t0 = (cb & 31) * 8; T = CTXL; base = TL + b * CTXL; P0 = t0; }
        (void)T; (void)base;
        const int ch = hd * 128 + 2 * lane;
        unsigned zz[3][12]; f32x2 wv[3][5];
#pragma unroll
        for (int w = 0; w < 3; ++w) { const int wc = (w == 0 ? 0 : (w == 1 ? 1024 : 2048)) + ch;
#pragma unroll
            for (int r = 0; r < 12; ++r) zz[w][r] = zn[w][r];
#pragma unroll
            for (int j = 0; j < 5; ++j) wv[w][j] = *(const f32x2*)(convw + j * 3072 + wc); }
        if (it + NGW < 1088 * 8) DN_LOADZ(zn, it + NGW);
        f32x4 cs[8];
        if (tb < 1024) {
#pragma unroll
            for (int tk = 0; tk < 8; ++tk) { const int t = t0 + tk; const int pos = (lane < 32) ? (t >> 6) : (t & 63); cs[tk] = *(const f32x4*)(rope + (size_t)(pos * 32 + i0) * 2); }
        }
        float y[3][8][2]; float ssq[16];
#pragma unroll
        for (int w = 0; w < 3; ++w)
#pragma unroll
            for (int tk = 0; tk < 8; ++tk) { float a0 = 0.f, a1 = 0.f;
#pragma unroll
                for (int j = 0; j < 5; ++j) { a0 += wv[w][j][0] * bflo(zz[w][tk + j]); a1 += wv[w][j][1] * bfhi(zz[w][tk + j]); }
                y[w][tk][0] = siluf_(a0); y[w][tk][1] = siluf_(a1); }
#pragma unroll
        for (int tk = 0; tk < 8; ++tk) { ssq[tk] = y[0][tk][0] * y[0][tk][0] + y[0][tk][1] * y[0][tk][1]; ssq[8 + tk] = y[2][tk][0] * y[2][tk][0] + y[2][tk][1] * y[2][tk][1]; }
#pragma unroll
        for (int st = 0; st < 4; ++st) { const int msk = 1 << st; const bool up = (lane & msk) != 0;
#pragma unroll
            for (int j = 0; j < (8 >> st); ++j) { const float a = ssq[2 * j], c2 = ssq[2 * j + 1]; const float keep = up ? c2 : a, send = up ? a : c2; ssq[j] = keep + __shfl_xor(send, msk); } }
        float tot = ssq[0]; tot += __shfl_xor(tot, 16); tot += __shfl_xor(tot, 32);
        const float rnl = 1.0f / sqrtf(tot + EPS);
        unsigned kd[8], qd[8];
#pragma unroll
        for (int tk = 0; tk < 8; ++tk) {
            const float rk = __builtin_bit_cast(float, __builtin_amdgcn_readlane(__builtin_bit_cast(int, rnl), tk)), rq = __builtin_bit_cast(float, __builtin_amdgcn_readlane(__builtin_bit_cast(int, rnl), 8 + tk));
            float k0 = y[0][tk][0] * rk, k1 = y[0][tk][1] * rk, q0 = y[2][tk][0] * rq, q1 = y[2][tk][1] * rq;
            if (tb < 1024) { const f32x4 c4 = cs[tk];
                const float pk0 = __shfl_xor(k0, 16), pk1 = __shfl_xor(k1, 16), pq0 = __shfl_xor(q0, 16), pq1 = __shfl_xor(q1, 16);
                if (!second) { k0 = k0 * c4[0] - pk0 * c4[1]; k1 = k1 * c4[2] - pk1 * c4[3]; q0 = q0 * c4[0] - pq0 * c4[1]; q1 = q1 * c4[2] - pq1 * c4[3]; }
                else { k0 = k0 * c4[0] + pk0 * c4[1]; k1 = k1 * c4[2] + pk1 * c4[3]; q0 = q0 * c4[0] + pq0 * c4[1]; q1 = q1 * c4[2] + pq1 * c4[3]; } }
            q0 *= 0.08838834764831845f; q1 *= 0.08838834764831845f;
            y[0][tk][0] = k0; y[0][tk][1] = k1; y[2][tk][0] = q0; y[2][tk][1] = q1;
            kd[tk] = pk2(k0, k1); qd[tk] = pk2(q0, q1);
        }
        { const bool l2 = (lane & 2) == 0, l1 = (lane & 1) == 0;
#define DN_QT4(d) do { unsigned r0_ = (unsigned)__shfl_xor((int)(l2 ? d[2] : d[0]), 2), r1_ = (unsigned)__shfl_xor((int)(l2 ? d[3] : d[1]), 2); d[2] = l2 ? r0_ : d[2]; d[3] = l2 ? r1_ : d[3]; d[0] = l2 ? d[0] : r0_; d[1] = l2 ? d[1] : r1_; \
            r0_ = (unsigned)__shfl_xor((int)(l1 ? d[1] : d[0]), 1); r1_ = (unsigned)__shfl_xor((int)(l1 ? d[3] : d[2]), 1); d[1] = l1 ? r0_ : d[1]; d[3] = l1 ? r1_ : d[3]; d[0] = l1 ? d[0] : r0_; d[2] = l1 ? d[2] : r1_; } while (0)
          unsigned ka[4] = {kd[0], kd[1], kd[2], kd[3]}, kb2[4] = {kd[4], kd[5], kd[6], kd[7]}, qa[4] = {qd[0], qd[1], qd[2], qd[3]}, qb2[4] = {qd[4], qd[5], qd[6], qd[7]};
          DN_QT4(ka); DN_QT4(kb2); DN_QT4(qa); DN_QT4(qb2);
#undef DN_QT4
          const size_t fo2 = ((((((size_t)(b * 8 + hd) * 68 + (P0 >> 6)) * 4 + ((P0 >> 4) & 3)) * 4 + (lane >> 4)) * 4 + ((lane >> 2) & 3)) * 16 + (P0 & 15) + (lane & 3)) * 8;
          *(v4u*)(KB + fo2) = (v4u){ka[0], ka[1], ka[2], ka[3]}; *(v4u*)(KB + fo2 + 32) = (v4u){kb2[0], kb2[1], kb2[2], kb2[3]};
          *(v4u*)(QB + fo2) = (v4u){qa[0], qa[1], qa[2], qa[3]}; *(v4u*)(QB + fo2 + 32) = (v4u){qb2[0], qb2[1], qb2[2], qb2[3]}; }
        const size_t fo = (((((size_t)(b * 8 + hd) * 68 + (P0 >> 6)) * 8 + (lane >> 3)) * 2 + ((P0 >> 5) & 1)) * 64 + ((P0 >> 3) & 3) * 16 + 2 * (lane & 7)) * 8;
        bf16* ktp = KT + fo; bf16* vtp = VT2 + fo;
        *(v4u*)(ktp) = (v4u){pk2(y[0][0][0], y[0][1][0]), pk2(y[0][2][0], y[0][3][0]), pk2(y[0][4][0], y[0][5][0]), pk2(y[0][6][0], y[0][7][0])};
        *(v4u*)(ktp + 8) = (v4u){pk2(y[0][0][1], y[0][1][1]), pk2(y[0][2][1], y[0][3][1]), pk2(y[0][4][1], y[0][5][1]), pk2(y[0][6][1], y[0][7][1])};
        *(v4u*)(vtp) = (v4u){pk2(y[1][0][0], y[1][1][0]), pk2(y[1][2][0], y[1][3][0]), pk2(y[1][4][0], y[1][5][0]), pk2(y[1][6][0], y[1][7][0])};
        *(v4u*)(vtp + 8) = (v4u){pk2(y[1][0][1], y[1][1][1]), pk2(y[1][2][1], y[1][3][1]), pk2(y[1][4][1], y[1][5][1]), pk2(y[1][6][1], y[1][7][1])};
        if (lane < 16) { const int row = row0 + (lane & 7), dir = lane >> 3;
            const float alpha = zab[(size_t)row * 32 + dir * 8 + hd], bz = zab[(size_t)row * 32 + 16 + dir * 8 + hd];
            const float xs = alpha + dt_bias[dir * 8 + hd]; const float sp = xs > 20.f ? xs : log1pf(expf(xs));
            gout[(size_t)row * 16 + dir * 8 + hd] = -expf(a_log[dir * 8 + hd]) * sp;
            bout[(size_t)row * 16 + dir * 8 + hd] = 1.0f / (1.0f + expf(-bz)); }
    }
}
#undef DN_LOADZ


constexpr int NINST = 2 * 8 * 2 * 68;
__device__ __forceinline__ int chunk_P0(int dir, int n) { return dir == 0 ? 64 * n : (n < 4 ? CTXL - 64 * (n + 1) : NPOS - 64 * (n - 3)); }
__device__ __forceinline__ void dn_chunk_phase(const bf16* KB, const bf16* QB, const bf16* KT, const bf16* VT2, const float* G, const float* BETA, bf16* WB, float* UB, bf16* QKM, float* EGb,
                                               LAS unsigned char* lds, int lane, int wave, int gw, int NGW) {
    LAS float* AL = (LAS float*)(lds + wave * 16384);
    LAS unsigned short* T1L = (LAS unsigned short*)AL; LAS unsigned short* T2L = T1L + 4096;
    LAS float* SV = (LAS float*)(lds + RING_BYTES + 1024 + wave * 1024);
    const int q16 = lane & 15, g = lane >> 4;
#pragma unroll 1
    for (int inst = gw; inst < NINST; inst += NGW) {
        const int n = inst % 68, rr = inst / 68, dir = rr & 1, hd = (rr >> 1) & 7, b = rr >> 4;
        const int P0 = chunk_P0(dir, n);
        const int rowi = pos_row(b, dir ? P0 + 63 - lane : P0 + lane);
        const float bi = BETA[(size_t)rowi * 16 + dir * 8 + hd];
        float gc = G[(size_t)rowi * 16 + dir * 8 + hd];
#pragma unroll
        for (int o = 1; o < 64; o <<= 1) { const float t = __shfl_up(gc, o); if (lane >= o) gc += t; }
        asm volatile("s_waitcnt lgkmcnt(0)" ::: "memory");
        SV[lane] = gc; SV[64 + lane] = bi;
        asm volatile("s_waitcnt lgkmcnt(0)" ::: "memory");
        const float gc63 = __shfl(gc, 63);
        EGb[(size_t)inst * 128 + lane] = __expf(gc); EGb[(size_t)inst * 128 + 64 + lane] = __expf(gc63 - gc);
        bf16x8_t kf[4][4];
        const size_t fb0 = ((size_t)(b * 8 + hd) * 68 + (P0 >> 6)) * 4; const int q16p = dir ? 15 - q16 : q16;
#pragma unroll
        for (int blk = 0; blk < 4; ++blk) {
#pragma unroll
            for (int ks = 0; ks < 4; ++ks) kf[blk][ks] = *(const bf16x8_t*)(KB + ((((fb0 + (dir ? 3 - blk : blk)) * 4 + ks) * 4 + g) * 16 + q16p) * 8); }
#pragma unroll
        for (int ib = 0; ib < 4; ++ib) {
            const int i = 16 * ib + q16; const float gci = SV[i], bti = SV[64 + i];
            bf16x8_t qfr[4];
#pragma unroll
            for (int ks = 0; ks < 4; ++ks) qfr[ks] = *(const bf16x8_t*)(QB + ((((fb0 + (dir ? 3 - ib : ib)) * 4 + ks) * 4 + g) * 16 + q16p) * 8);
#pragma unroll
            for (int jb = 0; jb < 4; ++jb) {
                v2u qo = {0u, 0u};
                if (jb <= ib) {
                    f32x4 ck = {0.f, 0.f, 0.f, 0.f}, cq = ck;
#pragma unroll
                    for (int ks = 0; ks < 4; ++ks) { ck = __builtin_amdgcn_mfma_f32_16x16x32_bf16(kf[jb][ks], kf[ib][ks], ck, 0, 0, 0); cq = __builtin_amdgcn_mfma_f32_16x16x32_bf16(kf[jb][ks], qfr[ks], cq, 0, 0, 0); }
                    const f32x4 gcj = *(const LAS f32x4*)(SV + 16 * jb + 4 * g);
                    f32x4 av, qv;
#pragma unroll
                    for (int e = 0; e < 4; ++e) { const int j = 16 * jb + 4 * g + e; const float dec = __expf(gci - gcj[e]);
                        av[e] = (i > j) ? bti * ck[e] * dec : 0.f; qv[e] = (i >= j) ? cq[e] * dec : 0.f; }
                    *(LAS f32x4*)(AL + i * 64 + 16 * jb + 4 * g) = av;
                    qo.x = pk2(qv[0], qv[1]); qo.y = pk2(qv[2], qv[3]);
                }
                *(v2u*)(QKM + ((((size_t)inst * 4 + ib) * 2 + (jb >> 1)) * 64 + (2 * (jb & 1) + (g >> 1)) * 16 + q16) * 8 + 4 * (g & 1)) = qo;
            }
        }
        asm volatile("s_waitcnt lgkmcnt(0)" ::: "memory");
        float T[64];
        {
            T[0] = (lane == 0) ? 1.f : 0.f;
#pragma unroll
            for (int i = 1; i < 64; ++i) {
                float acc0 = (lane == i) ? 1.f : 0.f, acc1 = 0.f;
#pragma unroll
                for (int hb = 0; hb < 2; ++hb) {
                    if (8 * hb < (i + 3) / 4) {
                        f32x4 rowc[8];
#pragma unroll
                        for (int jj = 0; jj < 8; ++jj) rowc[jj] = *(const LAS f32x4*)(AL + i * 64 + 32 * hb + 4 * jj);
#pragma unroll
                        for (int jj = 0; jj < 8; ++jj) {
#pragma unroll
                            for (int e = 0; e < 4; ++e) if (32 * hb + 4 * jj + e < i) { if (jj & 1) acc1 -= rowc[jj][e] * T[32 * hb + 4 * jj + e]; else acc0 -= rowc[jj][e] * T[32 * hb + 4 * jj + e]; } }
                    }
                }
                T[i] = acc0 + acc1;
            }
        }
        asm volatile("s_waitcnt lgkmcnt(0)" ::: "memory");
        { const float s1 = bi, s2 = bi * __expf(gc); const int pc = dir ? 63 - lane : lane;
#pragma unroll
          for (int i = 0; i < 64; ++i) { T1L[i * 64 + pc] = (unsigned short)(pk2(T[i] * s1, 0.f) & 0xffffu); T2L[i * 64 + pc] = (unsigned short)(pk2(T[i] * s2, 0.f) & 0xffffu); } }
        asm volatile("s_waitcnt lgkmcnt(0)" ::: "memory");
        const size_t fb = (((size_t)(b * 8 + hd) * 68 + (P0 >> 6)) * 16 * 64 + lane) * 8;
        const bf16* vtb = VT2 + fb; const bf16* ktb = KT + fb;
#pragma unroll
        for (int half = 0; half < 2; ++half) {
            bf16x8_t xf[8][2];
#pragma unroll
            for (int db = 0; db < 8; ++db)
#pragma unroll
                for (int ks = 0; ks < 2; ++ks) xf[db][ks] = *(const bf16x8_t*)((half ? ktb : vtb) + (2 * db + ks) * 512);
#pragma unroll
            for (int ib = 0; ib < 4; ++ib) {
                bf16x8_t tf[2];
#pragma unroll
                for (int ks = 0; ks < 2; ++ks) tf[ks] = *(const LAS bf16x8_t*)((half ? T2L : T1L) + (16 * ib + q16) * 64 + 32 * ks + 8 * g);
#pragma unroll
                for (int db = 0; db < 8; ++db) {
                    f32x4 c = {0.f, 0.f, 0.f, 0.f};
                    if (half == 0) {
#pragma unroll
                        for (int ks = 0; ks < 2; ++ks) c = __builtin_amdgcn_mfma_f32_16x16x32_bf16(tf[ks], xf[db][ks], c, 0, 0, 0);
                        *(f32x4*)(UB + (((size_t)inst * 8 + db) * 4 + ib) * 256 + lane * 4) = c;
                    } else {
#pragma unroll
                        for (int ks = 0; ks < 2; ++ks) c = __builtin_amdgcn_mfma_f32_16x16x32_bf16(xf[db][ks], tf[ks], c, 0, 0, 0);
                        v2u o; o.x = pk2(c[0], c[1]); o.y = pk2(c[2], c[3]);
                        *(v2u*)(WB + ((((size_t)inst * 4 + ib) * 4 + (db >> 1)) * 64 + (2 * (db & 1) + (g >> 1)) * 16 + q16) * 8 + 4 * (g & 1)) = o;
                    }
                }
            }
        }
        asm volatile("s_waitcnt lgkmcnt(0)" ::: "memory");
    }
}

struct DnStSet { bf16x8_t wf[4], kt[2][2]; f32x4 u4, ek4; float dec; };
struct DnOutSet { bf16x8_t qf[4], qk[2]; f32x4 eg4; int orow[4]; };
__device__ __forceinline__ void dn_scan_phase(const bf16* QB, const bf16* KT, const bf16* WB, const float* UB, const bf16* QKM, const float* EGb, float* OF, float* OB,
                                              LAS unsigned char* lds, int tid, int bid, int G) {
    const int wave = __builtin_amdgcn_readfirstlane(tid >> 6), lane = tid & 63, q16 = lane & 15, g = lane >> 4, rb = wave & 3;
    LAS unsigned short* SbL = (LAS unsigned short*)lds;
    LAS unsigned short* VnL = SbL + 16 * 136;
    LAS unsigned short* Vn2L = VnL + 16 * 72;
#pragma unroll 1
    for (int unit = bid; unit < 256; unit += G) {
        const int dvb = (unit >> 3) & 7, chain = 4 * (unit & 7) + (unit >> 6), dir = chain & 1, hd = (chain >> 1) & 7, b = chain >> 4;
        __syncthreads();
        for (int i = tid; i < 16 * 136 / 2; i += NTHR) ((LAS unsigned*)SbL)[i] = 0u;
        __syncthreads();
        float* od = dir ? OB : OF;
        if (wave < 4) {
            f32x4 s0 = {0.f, 0.f, 0.f, 0.f}, s1 = s0;
            const bf16* ktb = KT + ((size_t)(b * 8 + hd) * 68 * 16 * 64 + (size_t)(4 * rb) * 64 + lane) * 8;
            DnStSet st[3];
#define DN_LOAD_ST(S_, n_) do { const size_t inst_ = (size_t)chain * 68 + (n_); const int P0_ = chunk_P0(dir, (n_)); \
                _Pragma("unroll") for (int ks = 0; ks < 4; ++ks) S_.wf[ks] = *(const bf16x8_t*)(WB + (((inst_ * 4 + rb) * 4 + ks) * 64 + lane) * 8); \
                _Pragma("unroll") for (int t = 0; t < 2; ++t) _Pragma("unroll") for (int ks = 0; ks < 2; ++ks) S_.kt[t][ks] = *(const bf16x8_t*)(ktb + ((size_t)(P0_ >> 6) * 16 + 2 * t + ks) * 512); \
                S_.u4 = *(const f32x4*)(UB + ((inst_ * 8 + dvb) * 4 + rb) * 256 + lane * 4); S_.ek4 = *(const f32x4*)(EGb + inst_ * 128 + 64 + 16 * rb + 4 * g); S_.dec = EGb[inst_ * 128 + 63]; } while (0)
#define DN_STEP_ST(j_, n_) do { if ((n_) + 2 < 68) DN_LOAD_ST(st[((j_) + 2) % 3], (n_) + 2); \
        bf16x8_t sf[4]; \
        _Pragma("unroll") \
        for (int ks = 0; ks < 4; ++ks) sf[ks] = *(const LAS bf16x8_t*)(SbL + q16 * 136 + 32 * ks + 8 * g); \
        f32x4 acc = {0.f, 0.f, 0.f, 0.f}; \
        _Pragma("unroll") \
        for (int ks = 0; ks < 4; ++ks) acc = __builtin_amdgcn_mfma_f32_16x16x32_bf16(st[(j_)].wf[ks], sf[ks], acc, 0, 0, 0); \
        const f32x4 v = st[(j_)].u4 - acc; \
        { v2u o; o.x = pk2(v[0], v[1]); o.y = pk2(v[2], v[3]); *(LAS v2u*)(VnL + q16 * 72 + 16 * rb + 4 * g) = o; \
        const f32x4 vs = v * st[(j_)].ek4; v2u o2; \
        if (dir == 0) { o2.x = pk2(vs[0], vs[1]); o2.y = pk2(vs[2], vs[3]); *(LAS v2u*)(Vn2L + q16 * 72 + 16 * rb + 4 * g) = o2; } \
        else { o2.x = pk2(vs[3], vs[2]); o2.y = pk2(vs[1], vs[0]); *(LAS v2u*)(Vn2L + q16 * 72 + 60 - 16 * rb - 4 * g) = o2; } } \
        __syncthreads(); \
        bf16x8_t vf[2]; \
        _Pragma("unroll") \
        for (int ks = 0; ks < 2; ++ks) vf[ks] = *(const LAS bf16x8_t*)(Vn2L + q16 * 72 + 32 * ks + 8 * g); \
        s0 *= st[(j_)].dec; s1 *= st[(j_)].dec; \
        _Pragma("unroll") \
        for (int ks = 0; ks < 2; ++ks) { s0 = __builtin_amdgcn_mfma_f32_16x16x32_bf16(st[(j_)].kt[0][ks], vf[ks], s0, 0, 0, 0); s1 = __builtin_amdgcn_mfma_f32_16x16x32_bf16(st[(j_)].kt[1][ks], vf[ks], s1, 0, 0, 0); } \
        { v2u o; o.x = pk2(s0[0], s0[1]); o.y = pk2(s0[2], s0[3]); *(LAS v2u*)(SbL + q16 * 136 + 32 * rb + 4 * g) = o; \
        o.x = pk2(s1[0], s1[1]); o.y = pk2(s1[2], s1[3]); *(LAS v2u*)(SbL + q16 * 136 + 32 * rb + 16 + 4 * g) = o; } \
        __syncthreads(); } while (0)
            DN_LOAD_ST(st[0], 0); DN_LOAD_ST(st[1], 1);
#pragma unroll 1
            for (int n3 = 0; n3 < 66; n3 += 3) { DN_STEP_ST(0, n3); DN_STEP_ST(1, n3 + 1); DN_STEP_ST(2, n3 + 2); }
            DN_STEP_ST(0, 66); DN_STEP_ST(1, 67);
#undef DN_STEP_ST
#undef DN_LOAD_ST
        } else {
            DnOutSet os[3];
#define DN_LOAD_OUT(S_, n_) do { const size_t inst_ = (size_t)chain * 68 + (n_); const int P0_ = chunk_P0(dir, (n_)); const int i_ = 16 * rb + q16; \
                const size_t qb_ = (((size_t)(b * 8 + hd) * 68 + (P0_ >> 6)) * 4 + (dir ? 3 - rb : rb)) * 4; (void)i_; \
                _Pragma("unroll") for (int ks = 0; ks < 4; ++ks) S_.qf[ks] = *(const bf16x8_t*)(QB + (((qb_ + ks) * 4 + g) * 16 + (dir ? 15 - q16 : q16)) * 8); \
                _Pragma("unroll") for (int ks = 0; ks < 2; ++ks) S_.qk[ks] = *(const bf16x8_t*)(QKM + (((inst_ * 4 + rb) * 2 + ks) * 64 + lane) * 8); \
                S_.eg4 = *(const f32x4*)(EGb + inst_ * 128 + 16 * rb + 4 * g); \
                _Pragma("unroll") for (int e = 0; e < 4; ++e) { const int io_ = 16 * rb + 4 * g + e; S_.orow[e] = pos_row(b, dir ? P0_ + 63 - io_ : P0_ + io_); } } while (0)
#define DN_STEP_OUT(j_, n_) do { if ((n_) + 2 < 68) DN_LOAD_OUT(os[((j_) + 2) % 3], (n_) + 2); \
        bf16x8_t sf[4]; \
        _Pragma("unroll") \
        for (int ks = 0; ks < 4; ++ks) sf[ks] = *(const LAS bf16x8_t*)(SbL + q16 * 136 + 32 * ks + 8 * g); \
        f32x4 oacc = {0.f, 0.f, 0.f, 0.f}; \
        _Pragma("unroll") \
        for (int ks = 0; ks < 4; ++ks) oacc = __builtin_amdgcn_mfma_f32_16x16x32_bf16(os[(j_)].qf[ks], sf[ks], oacc, 0, 0, 0); \
        oacc *= os[(j_)].eg4; \
        __syncthreads(); \
        bf16x8_t vf[2]; \
        _Pragma("unroll") \
        for (int ks = 0; ks < 2; ++ks) vf[ks] = *(const LAS bf16x8_t*)(VnL + q16 * 72 + 32 * ks + 8 * g); \
        _Pragma("unroll") \
        for (int ks = 0; ks < 2; ++ks) oacc = __builtin_amdgcn_mfma_f32_16x16x32_bf16(os[(j_)].qk[ks], vf[ks], oacc, 0, 0, 0); \
        _Pragma("unroll") \
        for (int e = 0; e < 4; ++e) od[(size_t)os[(j_)].orow[e] * 1024 + hd * 128 + 16 * dvb + q16] = oacc[e]; \
        __syncthreads(); } while (0)
            DN_LOAD_OUT(os[0], 0); DN_LOAD_OUT(os[1], 1);
#pragma unroll 1
            for (int n3 = 0; n3 < 66; n3 += 3) { DN_STEP_OUT(0, n3); DN_STEP_OUT(1, n3 + 1); DN_STEP_OUT(2, n3 + 2); }
            DN_STEP_OUT(0, 66); DN_STEP_OUT(1, 67);
#undef DN_STEP_OUT
#undef DN_LOAD_OUT
        }
    }
}

__device__ __forceinline__ void gm_item2(int chunk, int grp, const bf16* z, const float* vn, const float* __restrict__ sw  , const float* __restrict__ sb  , bf16* ycat, bool stage_w, LAS unsigned char* lds, int tid) {
    LAS unsigned short* WL = (LAS unsigned short*)lds;
    LAS unsigned short* VL = WL + 128 * 136;
    const int row0 = chunk < 64 ? chunk * 128 : TL + (chunk - 64) * 128;
    __syncthreads();
    if (stage_w)
    for (int i = tid; i < 128 * 32; i += NTHR) { const int pp = i >> 5, q4 = (i & 31) * 4;
        const f32x4 w = *(const f32x4*)(sw + (size_t)grp * 16384 + pp * 128 + q4);
        v2u o; o.x = pk2(w[0], w[1]); o.y = pk2(w[2], w[3]); *(LAS v2u*)(WL + pp * 136 + q4) = o; }
    for (int i = tid; i < 128 * 32; i += NTHR) { const int q = i >> 5, c4 = (i & 31) * 4;
        const f32x4 v = *(const f32x4*)(vn + (size_t)(row0 + q) * 1024 + grp * 128 + c4);
        const unsigned a = pk2(v[0], v[1]), b2 = pk2(v[2], v[3]);
        VL[(c4 + 0) * 136 + q] = (unsigned short)(a & 0xffffu); VL[(c4 + 1) * 136 + q] = (unsigned short)(a >> 16);
        VL[(c4 + 2) * 136 + q] = (unsigned short)(b2 & 0xffffu); VL[(c4 + 3) * 136 + q] = (unsigned short)(b2 >> 16); }
    __syncthreads();
    const int wave = __builtin_amdgcn_readfirstlane(tid >> 6), lane = tid & 63, q16 = lane & 15, gq = lane >> 4;
    bf16x8_t af[4];
#pragma unroll
    for (int ks = 0; ks < 4; ++ks) af[ks] = *(const LAS bf16x8_t*)(VL + (16 * wave + q16) * 136 + 32 * ks + 8 * gq);
    const int c = grp * 128 + 16 * wave + 4 * gq;
#pragma unroll
    for (int pb = 0; pb < 8; ++pb) {
        f32x4 acc = {0.f, 0.f, 0.f, 0.f};
#pragma unroll
        for (int ks = 0; ks < 4; ++ks) { const bf16x8_t bfr = *(const LAS bf16x8_t*)(WL + (16 * pb + q16) * 136 + 32 * ks + 8 * gq); acc = __builtin_amdgcn_mfma_f32_16x16x32_bf16(af[ks], bfr, acc, 0, 0, 0); }
        const int pp = 16 * pb + q16; const size_t row = (size_t)(row0 + pp);
        const float bias = sb[grp * 128 + pp];
        const v2u zu = *(const v2u*)(z + row * ZW + Z_GMU + c);
        v2u o; o.x = pk2(gelu_tanh(bflo(zu.x)) * (acc[0] + bias), gelu_tanh(bfhi(zu.x)) * (acc[1] + bias)); o.y = pk2(gelu_tanh(bflo(zu.y)) * (acc[2] + bias), gelu_tanh(bfhi(zu.y)) * (acc[3] + bias));
        *(v2u*)(ycat + row * DM + c) = o;
    }
}


#define MK_ONE_LAUNCH 1

#ifndef MK_ONE_LAUNCH
#define MK_ONE_LAUNCH 1
#endif
constexpr int NPL = 15;
constexpr int NPH = 1 + NLAYER * NPL + 1;
struct Args { const float* in[24]; float* out; unsigned char* ws; int ph_lo, ph_hi; };

__global__ void __launch_bounds__(NTHR, 2) dit_fwd(Args a) {
    extern __shared__ __attribute__((aligned(16))) unsigned char lds_raw[];
    LAS unsigned char* lds = (LAS unsigned char*)lds_raw;
    volatile LAS unsigned* MISC = (volatile LAS unsigned*)(lds + MISC_OFF);
    const int G = gridDim.x, bid = blockIdx.x, NGW = G * NWAVES;
    const int wave0 = __builtin_amdgcn_readfirstlane((int)threadIdx.x >> 6);
#define PHASE_IDS() int tid = wave0 * 64 + (int)__builtin_amdgcn_mbcnt_hi(~0u, __builtin_amdgcn_mbcnt_lo(~0u, 0u)); asm volatile("" : "+v"(tid)); const int lane = tid & 63, wave = __builtin_amdgcn_readfirstlane(tid >> 6), gw = bid * NWAVES + wave; (void)lane; (void)gw
    for (int u = threadIdx.x; u < (LDS_BYTES - RING_BYTES) / 4; u += NTHR) ((LAS unsigned*)(lds + RING_BYTES))[u] = 0u;
    __syncthreads();
    unsigned char* ws0 = a.ws;
    const int lo = a.ph_lo, hi = a.ph_hi;
    XcdBarrier bar; bar.bar = (unsigned*)(ws0 + WS_CTL) + CW_BAR; bar.x = 0; bar.st = nullptr;
    if (hi - lo > 1) bar = xcd_barrier_post((unsigned*)(ws0 + WS_CTL) + CW_BAR, MISC + 8);
#define IN(k) (lo <= (k) && (k) < hi)
#define SEAM(k) do { if (IN(k) && IN((k) + 1)) xcd_barrier(bar); } while (0)

#define SUB_FIRST(b) ((((b) >> 3) & 7) < 4)
#define KAS __attribute__((address_space(4)))
#define PHASE_PTRS() const KAS char* kp_ = (const KAS char*)__builtin_amdgcn_kernarg_segment_ptr(); asm volatile("" : "+s"(kp_)); \
    unsigned char* const ws = *(unsigned char* const KAS*)(kp_ + 200); (void)ws
#define INP(i) (*(const float* const KAS*)(kp_ + 8 * (i)))
#define P_MOD ((float*)(ws + WS_MOD))
#define P_H ((float*)(ws + WS_H))
#define P_XN ((bf16*)(ws + WS_XN))
#define P_HB ((bf16*)(ws + WS_HB))
#define P_Z ((bf16*)(ws + WS_Z))
#define P_ZAB ((float*)(ws + WS_ZAB))
#define P_GG ((float*)(ws + WS_G))
#define P_BETA ((float*)(ws + WS_BETA))
#define P_OF ((float*)(ws + WS_OF))
#define P_OB ((float*)(ws + WS_OB))
#define P_VN ((float*)(ws + WS_VN))
#define P_YCAT ((bf16*)(ws + WS_YCAT))
#define P_YF ((float*)(ws + WS_YF))
#define P_YB ((bf16*)(ws + WS_YB))
#define P_VTL ((bf16*)(ws + WS_VTL))
#define P_VTC ((bf16*)(ws + WS_VTC))
#define P_KB ((bf16*)(ws + WS_KB))
#define P_QB ((bf16*)(ws + WS_QB))
#define P_KT ((bf16*)(ws + WS_KT))
#define P_VT2 ((bf16*)(ws + WS_VT2))
#define P_WB ((bf16*)(ws + WS_WB))
#define P_UB ((float*)(ws + WS_UB))
#define P_QKM ((bf16*)(ws + WS_QKM))
#define P_EG ((float*)(ws + WS_EG))
#define P_ROPE ((float*)(ws + WS_ROPE))

    if (IN(0)) { PHASE_IDS(); PHASE_PTRS();
        LAS float* scr = (LAS float*)(lds + wave * 16384);
        {
            for (int l = 0; l < NLAYER; ++l) {
                for (int s = 0; s < 2; ++s) { const size_t ls = (size_t)l * 2 + s;
                    cvt_matrix<1>(INP(7) + ls * DM * FF, DM, FF, (bf16*)(ws + WS_W13 + ls * SZ_W13), DM, 0, gw, NGW, scr, lane);
                    cvt_matrix<2>(INP(8) + ls * DM * FF, DM, FF, (bf16*)(ws + WS_W13 + ls * SZ_W13), DM, 0, gw, NGW, scr, lane);
                    cvt_matrix<0>(INP(9) + ls * FF * DM, FF, DM, (bf16*)(ws + WS_W2 + ls * SZ_W2), FF, 0, gw, NGW, scr, lane); }
                cvt_matrix<3>(INP(10) + (size_t)l * DM * INW, DM, INW, (bf16*)(ws + WS_WIN + l * SZ_WIN), DM, 0, gw, NGW, scr, lane);
                cvt_matrix<0>(INP(19) + (size_t)l * 1024 * DM, 1024, DM, (bf16*)(ws + WS_PC + l * SZ_SQ), DM, 0, gw, NGW, scr, lane);
                cvt_matrix<0>(INP(20) + (size_t)l * 1024 * DM, 1024, DM, (bf16*)(ws + WS_PC + l * SZ_SQ), DM, 1024, gw, NGW, scr, lane);
                cvt_matrix<0>(INP(21) + (size_t)l * 2048 * DM, 2048, DM, (bf16*)(ws + WS_PC + l * SZ_SQ), DM, 2048, gw, NGW, scr, lane);
                cvt_matrix<0>(INP(22) + (size_t)l * DM * DM, DM, DM, (bf16*)(ws + WS_WO + l * SZ_SQ), DM, 0, gw, NGW, scr, lane);
            }
        }
        rope_table_phase(P_ROPE, lane, gw, NGW);
        __syncthreads();
        mod_phase(INP(1), INP(3), INP(4), INP(5), P_MOD, lds, tid, lane, wave, bid, G, 0, NLAYER);
    }
    SEAM(0);

    for (int l = 0; l < NLAYER; ++l) {
        const int pb = 1 + l * NPL;
        const bool lastl = (l + 1 == NLAYER);
        for (int sub = 0; sub < 2; ++sub) {
            const int p0 = pb + (sub ? 12 : 0), isub = sub ? 2 : 0;
            const bool first = (l == 0 && sub == 0);
            const bool ctxrows = !(lastl && sub == 1);
            const int MRs = ctxrows ? MR : TL;
            if (IN(p0)) { PHASE_IDS(); PHASE_PTRS();
                const bool hasslab = ctxrows && !first;
                const float* gv = sub == 0 ? P_MOD + ((size_t)(l - 1) * 3 + 2) * MODW + (2 * 3 + 2) * DM : P_MOD + ((size_t)l * 3 + 2) * MODW + (1 * 3 + 2) * DM;
                norm_phase(first ? INP(0) : P_H, first ? INP(2) : P_H + (size_t)TL * DM, INP(6) + ((size_t)l * 3 + isub) * DM, P_MOD + (size_t)l * 3 * MODW, isub, P_XN, MRs,
                           hasslab ? (const float*)(ws + WS_SLAB) : nullptr, gv, sub == 0 ? 0.5f : 1.0f, P_H + (size_t)TL * DM, lds, tid, lane, gw, NGW); }
            SEAM(p0);
            if (IN(p0 + 1)) { PHASE_PTRS();
                pg8::Gemm g{P_XN, (const bf16*)(ws + WS_W13 + ((size_t)l * 2 + sub) * SZ_W13), MRs, 2 * FF, DM, DM, DM};
                pg8::SplitOrder S; S.init(MRs, 2 * FF, DM, G, bid, !ctxrows);
                pg8::EpiSwiGLUS E{{P_HB, FF}, (unsigned)WS_SLAB, (unsigned)(WS_CTL + CW_UF * 4)};
                pg8::gemm_phase<pg8::EpiSwiGLUS, pg8::SplitOrder, true, true>(lds, g, S, E, wave0);
            }
            SEAM(p0 + 1);
            if (IN(p0 + 2)) { PHASE_PTRS();
                pg8::Gemm g{P_HB, (const bf16*)(ws + WS_W2 + ((size_t)l * 2 + sub) * SZ_W2), MRs, DM, FF, FF, FF};
                if (lastl && sub == 1) {
                    pg8::PanelOrder S{G, bid};
                    pg8::EpiFinal E{P_H, *(float* const KAS*)(kp_ + 192), P_MOD + (size_t)l * 3 * MODW + (isub * 3 + 2) * DM, MODW, 0.5f, INP(23), (float*)(ws + WS_SLAB), (unsigned*)(ws + WS_CTL) + CW_FN, (LAS float*)(lds + RING_BYTES + 2048)};
                    pg8::gemm_phase<pg8::EpiFinal, pg8::PanelOrder, true, true>(lds, g, S, E, wave0);
                } else {
                pg8::CombOrder S; S.init(TL, DM, G, bid, 1, ctxrows, SUB_FIRST(bid));
                pg8::EpiResidSlab E{{first ? INP(0) : P_H, first ? INP(2) : P_H + (size_t)TL * DM, P_H, P_MOD + (size_t)l * 3 * MODW + (isub * 3 + 2) * DM, MODW, 0.5f}, {(float*)(ws + WS_SLAB)}};
                pg8::gemm_phase<pg8::EpiResidSlab, pg8::CombOrder, true, true>(lds, g, S, E, wave0);
                }
            }
            if (!(lastl && sub == 1)) SEAM(p0 + 2);
            if (sub == 0) {
                if (IN(pb + 3)) { PHASE_IDS(); PHASE_PTRS();
                    norm_phase(P_H, first ? INP(2) : P_H + (size_t)TL * DM, INP(6) + ((size_t)l * 3 + 1) * DM, P_MOD + (size_t)l * 3 * MODW, 1, P_XN, MR,
                               (const float*)(ws + WS_SLAB), P_MOD + ((size_t)l * 3 + 2) * MODW + (0 * 3 + 2) * DM, 0.5f, P_H + (size_t)TL * DM, lds, tid, lane, gw, NGW); }
                SEAM(pb + 3);
                if (IN(pb + 4)) { PHASE_PTRS();
                    pg8::Gemm g{P_XN, (const bf16*)(ws + WS_WIN + l * SZ_WIN), MR, ZN, DM, DM, DM}; pg8::StaticOrder S; S.init(MR, ZN, G, bid);
                    pg8::EpiZ E{P_Z, ZW, P_ZAB, ZW / 256, (bf16*)(ws + WS_GF), Z_GA / 256, (bf16*)P_YF, (bf16*)P_YF + (size_t)16 * 1024 * 1024, Z_NAK / 256, Z_NAQ / 256, P_VTL, Z_NAV / 256};
                    pg8::gemm_phase<pg8::EpiZ, pg8::StaticOrder, true, true>(lds, g, S, E, wave0);
                }
                SEAM(pb + 4);
                if (IN(pb + 5)) { PHASE_IDS(); PHASE_PTRS();
                    dn_prep3_phase(P_Z, P_ZAB, INP(11) + (size_t)l * 5 * 3072, INP(12) + l * 16, INP(13) + l * 16, P_ROPE, P_KB, P_QB, P_KT, P_VT2, P_GG, P_BETA, lane, gw, NGW);
                    gm_prep_phase(P_Z, INP(17) + (size_t)l * 1024, P_VN, lane, (gw + NGW / 2) % NGW, NGW);
                    vt_phase(P_Z, P_VTL, P_VTC, lds, lane, wave, (gw + 3 * (NGW / 4)) % NGW, NGW);
                }
                SEAM(pb + 5);
                if (IN(pb + 6)) { PHASE_IDS(); PHASE_PTRS();
                    dn_chunk_phase(P_KB, P_QB, P_KT, P_VT2, P_GG, P_BETA, P_WB, P_UB, P_QKM, P_EG, lds, lane, wave, gw, NGW);
                    { unsigned* aq = (unsigned*)(ws + WS_CTL) + CW_AQ + (l * 8 + (bid & 7)) * 32; volatile LAS unsigned* slot = (volatile LAS unsigned*)(lds + RING_BYTES);
                      int last_bh = -1;
                      for (;;) {
                          __syncthreads();
                          if (tid == 0) *slot = __hip_atomic_fetch_add(aq, 1u, __ATOMIC_RELAXED, __HIP_MEMORY_SCOPE_AGENT);
                          __syncthreads();
                          const unsigned j = *slot;
                          if (j >= 128u) break;
                          const int it = (int)(8u * j) + (bid & 7), ibh = attn_item_bh(it);
                          attn_wg(it, P_Z, P_VTL, (const bf16*)P_YF, (const bf16*)P_YF + (size_t)16 * 1024 * 1024, P_VTC, INP(18) + (size_t)l * 16 * 465, P_YCAT, !lastl, ibh != last_bh, lds, tid);
                          last_bh = ibh;
                      } }
                }
                SEAM(pb + 6);
                if (IN(pb + 7)) { PHASE_IDS(); PHASE_PTRS();
                    dn_scan_phase(P_QB, P_KT, P_WB, P_UB, P_QKM, P_EG, P_OF, P_OB, lds, tid, bid, G);
                    { unsigned* gq = (unsigned*)(ws + WS_CTL) + CW_AQ + (16 + l) * 32; volatile LAS unsigned* slot = (volatile LAS unsigned*)(lds + RING_BYTES); const unsigned nit = (lastl ? 64 : 68) * 8; int last_grp = -1;
                      for (;;) {
                          __syncthreads();
                          if (tid == 0) *slot = __hip_atomic_fetch_add(gq, 1u, __ATOMIC_RELAXED, __HIP_MEMORY_SCOPE_AGENT);
                          __syncthreads();
                          const unsigned it = *slot;
                          if (it >= nit) break;
                          gm_item2((int)(it >> 3), (int)(it & 7), P_Z, P_VN, INP(15) + (size_t)l * 8 * 16384, INP(16) + (size_t)l * 1024, P_YCAT, (int)(it & 7) != last_grp, lds, tid);
                          last_grp = (int)(it & 7);
                      } }
                }
                SEAM(pb + 7);
                if (IN(pb + 8)) { PHASE_IDS(); PHASE_PTRS(); dn_out_phase(P_OF, P_OB, P_Z, INP(14) + (size_t)l * 128, P_YCAT, lastl ? TL : MR, lane, gw, NGW); }
                SEAM(pb + 8);
                if (IN(pb + 9)) { PHASE_PTRS();
                    const bf16* pc = (const bf16*)(ws + WS_PC + l * SZ_SQ);
                    pg8::CombOrder S; S.init(TL, DM, G, bid, 0, !lastl, SUB_FIRST(bid)); pg8::Gemm g{P_YCAT, pc, lastl ? TL : MR, DM, DM, DM, DM};
                    pg8::EpiMergeHS E{{(const bf16*)(ws + WS_GF), P_YB}, {(float*)(ws + WS_SLAB)}};
                    pg8::gemm_phase<pg8::EpiMergeHS, pg8::CombOrder, true, true>(lds, g, S, E, wave0);
                }
                SEAM(pb + 9);
                if (IN(pb + 10)) { PHASE_IDS(); PHASE_PTRS(); if (!lastl) merge_ctx_phase((const float*)(ws + WS_SLAB), P_Z, P_YB, lane, gw, NGW); }
                if (!lastl) SEAM(pb + 10);
                if (IN(pb + 11)) { PHASE_PTRS();
                    pg8::Gemm g{P_YB, (const bf16*)(ws + WS_WO + l * SZ_SQ), lastl ? TL : MR, DM, DM, DM, DM};
                    pg8::CombOrder S; S.init(TL, DM, G, bid, 0, !lastl, SUB_FIRST(bid));
                    pg8::EpiResidSlab E{{P_H, P_H + (size_t)TL * DM, P_H, P_MOD + (size_t)l * 3 * MODW + (1 * 3 + 2) * DM, MODW, 1.0f}, {(float*)(ws + WS_SLAB)}};
                    pg8::gemm_phase<pg8::EpiResidSlab, pg8::CombOrder, true, true>(lds, g, S, E, wave0);
                }
                SEAM(pb + 11);
            }
        }
    }
#undef IN
#undef SEAM
}

extern "C" void kernel_launch(void* const* d_in, const int* in_sizes, int n_in, void* d_out, int out_size, void* d_ws, size_t ws_size, hipStream_t stream) {
    static int grid = 0;
    if (grid == 0) {
        if (n_in != 24 || out_size != TL * DM || ws_size < WS_END) { fprintf(stderr, "kernel_launch: unexpected shapes (n_in %d, out %d, ws %zu < %zu); nothing launched\n", n_in, out_size, ws_size, (size_t)WS_END); grid = -1; return; }
        int dev = 0, cus = 0, per_cu = 0;
        if (hipGetDevice(&dev) != hipSuccess || hipDeviceGetAttribute(&cus, hipDeviceAttributeMultiprocessorCount, dev) != hipSuccess) { grid = -1; return; }
        if (hipFuncSetAttribute((const void*)dit_fwd, hipFuncAttributeMaxDynamicSharedMemorySize, LDS_BYTES) != hipSuccess) { fprintf(stderr, "kernel_launch: hipFuncSetAttribute failed\n"); grid = -1; return; }
        if (hipOccupancyMaxActiveBlocksPerMultiprocessor(&per_cu, (const void*)dit_fwd, NTHR, LDS_BYTES) != hipSuccess || per_cu < 1) { fprintf(stderr, "kernel_launch: occupancy query reports %d\n", per_cu); }
        (void)hipGetLastError();
        grid = cus;
        if (grid % 16 != 0) { fprintf(stderr, "kernel_launch: %d CUs: the row-panel exchange of the last GEMM needs a multiple of 16 workgroups; nothing launched\n", grid); grid = -1; return; }
    }
    if (grid < 0) return;
    if (hipMemsetAsync((char*)d_ws + WS_CTL, 0, CTL_ZERO_BYTES, stream) != hipSuccess) return;
    Args a{};
    for (int i = 0; i < 24; ++i) a.in[i] = (const float*)d_in[i];
    a.out = (float*)d_out; a.ws = (unsigned char*)d_ws;
#if MK_ONE_LAUNCH
    a.ph_lo = 0; a.ph_hi = NPH;
    hipLaunchKernelGGL(dit_fwd, dim3(grid), dim3(NTHR), LDS_BYTES, stream, a);
#else
    for (int p = 0; p < NPH; ++p) { a.ph_lo = p; a.ph_hi = p + 1; hipLaunchKernelGGL(dit_fwd, dim3(grid), dim3(NTHR), LDS_BYTES, stream, a); }
#endif
}
```
